# Optimizing an MI355X kernel written in HIP

```python
import functools
import jax, jax.numpy as jnp
from jax import lax
import numpy as np

D_MODEL = 1024
BATCH = 2
SEQ = 8192
DEPTH = 2
DEC_BATCH = 32
DEC_SEQ = 4
PAST_LEN = 8192
PAGE_SIZE = 128

N_EVEN = (DEPTH + 1) // 2
N_ODD = DEPTH // 2
A_HEADS = 4
A_HEAD_DIM = D_MODEL // 8
A_WIDTH = A_HEADS * A_HEAD_DIM
B_HEADS = 4
B_HEAD_DIM = D_MODEL // 8
B_WIDTH = B_HEADS * B_HEAD_DIM
C_HEADS = 4
C_KEY_WIDTH = D_MODEL // 2
C_VAL_WIDTH = D_MODEL
C_KEY_DIM = C_KEY_WIDTH // C_HEADS
C_VAL_DIM = C_VAL_WIDTH // C_HEADS
C_GATE_RANK = 16
GLA_GATE_NORMALIZER = 16.0
CHUNK = 64
Q_BLOCK = 128
EVEN_IN = 4 * A_WIDTH + 4 * B_WIDTH + B_HEADS
ODD_IN = 2 * C_KEY_WIDTH + 2 * C_VAL_WIDTH + C_GATE_RANK
EPS = 1e-6

kernel_name = 'hgrn2_fox_gla_hybrid_step'


def _split(a, widths):
    idx = [int(i) for i in np.cumsum(widths)[:-1]]
    return jnp.split(a, idx, axis=-1)


def rmsnorm(x, g):
    xf = x.astype(jnp.float32)
    y = xf * lax.rsqrt(jnp.mean(xf * xf, axis=-1, keepdims=True) + EPS)
    return (y * g.astype(jnp.float32)).astype(x.dtype)


def head_rmsnorm(o, g):
    of = o.astype(jnp.float32)
    y = of * lax.rsqrt(jnp.mean(of * of, axis=-1, keepdims=True) + EPS)
    return y * g.reshape(o.shape[-2], o.shape[-1]).astype(jnp.float32)


def gated_linear_chunked(q, k, v, log_f, s0):
    bsz, L, H, dk = q.shape
    dv = v.shape[-1]
    c = min(CHUNK, L)
    pad = (-L) % c
    q, k, v, log_f = (a.astype(jnp.float32) for a in (q, k, v, log_f))
    if pad:
        pw = ((0, 0), (0, pad), (0, 0), (0, 0))
        q, k, v, log_f = (jnp.pad(a, pw) for a in (q, k, v, log_f))
    n = (L + pad) // c

    def to_chunks(a):
        return a.reshape(bsz, n, c, H, a.shape[-1]).swapaxes(0, 1)

    causal = jnp.tril(jnp.ones((c, c), dtype=bool))

    def step(S, inp):
        qc, kc, vc, gc = inp
        b = jnp.cumsum(gc, axis=1)
        o_inter = jnp.einsum('bthk,bhkv->bthv', qc * jnp.exp(b), S)
        diff = b[:, :, None] - b[:, None, :]
        decay = jnp.exp(jnp.where(causal[None, :, :, None, None], diff, -jnp.inf))
        scores = jnp.einsum('bthk,bshk,btshk->btsh', qc, kc, decay)
        o_intra = jnp.einsum('btsh,bshv->bthv', scores, vc)
        b_last = b[:, -1]
        S_new = S * jnp.exp(b_last)[..., None] + jnp.einsum(
            'bshk,bshv->bhkv', kc * jnp.exp(b_last[:, None] - b), vc)
        return S_new, o_inter + o_intra

    s_final, o = lax.scan(step, s0.astype(jnp.float32),
                          (to_chunks(q), to_chunks(k), to_chunks(v), to_chunks(log_f)))
    o = o.swapaxes(0, 1).reshape(bsz, n * c, H, dv)[:, :L]
    return o, s_final


def fox_prompt(q, k, v, log_f):
    bsz, L, H, dh = q.shape
    scale = dh ** -0.5
    c = jnp.cumsum(log_f, axis=1).swapaxes(1, 2)
    nb = L // Q_BLOCK
    qb = q.reshape(bsz, nb, Q_BLOCK, H, dh).swapaxes(0, 1)
    cb = c.reshape(bsz, H, nb, Q_BLOCK).transpose(2, 0, 1, 3)
    starts = jnp.arange(nb, dtype=jnp.int32) * Q_BLOCK
    key_pos = jnp.arange(L, dtype=jnp.int32)

    def block(args):
        qi, ci, s0 = args
        t = s0 + jnp.arange(Q_BLOCK, dtype=jnp.int32)
        logits = jnp.einsum('bthd,bshd->bhts', qi, k).astype(jnp.float32) * scale \
            + ci[..., None] - c[:, :, None, :]
        logits = jnp.where(t[:, None] >= key_pos[None, :], logits, -jnp.inf)
        p = jax.nn.softmax(logits, axis=-1).astype(v.dtype)
        return jnp.einsum('bhts,bshd->bthd', p, v)

    out = lax.map(block, (qb, cb, starts))
    return out.swapaxes(0, 1).reshape(bsz, L, H, dh)


def fox_sample(q, k, v, log_f, k_pages, v_pages, logf_pages, page_table):
    db, T, H, dh = q.shape
    scale = dh ** -0.5
    k_past = k_pages[page_table].reshape(db, -1, H, dh)
    v_past = v_pages[page_table].reshape(db, -1, H, dh)
    lf_past = logf_pages[page_table].reshape(db, -1, H).astype(jnp.float32)
    P = k_past.shape[1]
    cum_new = jnp.cumsum(log_f, axis=1).swapaxes(1, 2)
    suffix_past = (lax.cumsum(lf_past, axis=1, reverse=True) - lf_past).swapaxes(1, 2)
    logit_past = jnp.einsum('bthd,bshd->bhts', q, k_past).astype(jnp.float32) * scale \
        + cum_new[..., None] + suffix_past[:, :, None, :]
    logit_new = jnp.einsum('bthd,bshd->bhts', q, k).astype(jnp.float32) * scale \
        + cum_new[..., None] - cum_new[:, :, None, :]
    causal = jnp.tril(jnp.ones((T, T), dtype=bool))
    logit_new = jnp.where(causal, logit_new, -jnp.inf)
    p = jax.nn.softmax(jnp.concatenate([logit_past, logit_new], axis=-1), axis=-1).astype(v.dtype)
    return jnp.einsum('bhts,bshd->bthd', p[..., :P], v_past) + jnp.einsum('bhts,bshd->bthd', p[..., P:], v)


def even_mixer(h, w_in, b_fox, lb, hgrn_gain, w_out, hgrn_s0, fox_attend):
    bsz, L, _ = h.shape
    proj = h @ w_in
    qa, fa, ia, ga, qb, kb, vb, gb, fb = _split(proj, [A_WIDTH] * 4 + [B_WIDTH] * 4 + [B_HEADS])
    f = lb + (1.0 - lb) * jax.nn.sigmoid(fa.astype(jnp.float32))
    ha = lambda a: a.reshape(bsz, L, A_HEADS, A_HEAD_DIM)
    o_a, s_a = gated_linear_chunked(ha(qa), ha(1.0 - f), ha(ia), ha(jnp.log(f)), hgrn_s0)
    o_a = head_rmsnorm(o_a, hgrn_gain).reshape(bsz, L, A_WIDTH).astype(h.dtype) * jax.nn.silu(ga)
    hb = lambda a: a.reshape(bsz, L, B_HEADS, B_HEAD_DIM)
    log_fb = jax.nn.log_sigmoid((fb + b_fox).astype(jnp.float32))
    kb_h, vb_h = hb(kb), hb(vb)
    o_b = fox_attend(hb(qb), kb_h, vb_h, log_fb).reshape(bsz, L, B_WIDTH).astype(h.dtype) * jax.nn.silu(gb)
    out = jnp.concatenate([o_a, o_b], axis=-1) @ w_out
    return out, s_a, kb_h, vb_h, log_fb


def odd_mixer(h, w_in, w_gate, b_gate, gla_gain, w_out, gla_s0):
    bsz, L, _ = h.shape
    proj = h @ w_in
    q, k, v, g, r = _split(proj, [C_KEY_WIDTH, C_KEY_WIDTH, C_VAL_WIDTH, C_VAL_WIDTH, C_GATE_RANK])
    log_f = jax.nn.log_sigmoid((r @ w_gate + b_gate).astype(jnp.float32)) / GLA_GATE_NORMALIZER
    hk = lambda a: a.reshape(bsz, L, C_HEADS, C_KEY_DIM)
    hv = lambda a: a.reshape(bsz, L, C_HEADS, C_VAL_DIM)
    o, s = gated_linear_chunked(hk(q) * C_KEY_DIM ** -0.5, hk(k), hv(v), hk(log_f), gla_s0)
    o = head_rmsnorm(o, gla_gain).reshape(bsz, L, C_VAL_WIDTH).astype(h.dtype) * jax.nn.silu(g)
    return o @ w_out, s


def run_trunk(x, fox_attend, hgrn_s0, gla_s0, norm_even, w_in_even, b_fox_f, lb_logits, hgrn_gain,
              w_out_even, norm_odd, w_in_odd, w_gla_gate, b_gla_gate, gla_gain, w_out_odd, final_norm):
    lb_all = jnp.cumsum(jax.nn.softmax(lb_logits.astype(jnp.float32), axis=0), axis=0)
    ks, vs, lfs, hs, gs = [], [], [], [], []
    for l in range(DEPTH):
        i = l // 2
        if l % 2 == 0:
            out, s_a, kb, vb, lfb = even_mixer(rmsnorm(x, norm_even[i]), w_in_even[i], b_fox_f[i], lb_all[i],
                                               hgrn_gain[i], w_out_even[i], hgrn_s0[i],
                                               functools.partial(fox_attend, i))
            ks.append(kb); vs.append(vb); lfs.append(lfb); hs.append(s_a)
        else:
            out, s_c = odd_mixer(rmsnorm(x, norm_odd[i]), w_in_odd[i], w_gla_gate[i], b_gla_gate[i],
                                 gla_gain[i], w_out_odd[i], gla_s0[i])
            gs.append(s_c)
        x = x + out
    return rmsnorm(x, final_norm), jnp.stack(ks), jnp.stack(vs), jnp.stack(lfs), jnp.stack(hs), jnp.stack(gs)


def setup_inputs(seed: int = 0) -> dict:
    key = jax.random.key(seed)
    ks = jax.random.split(key, 24)
    n_pages = PAST_LEN // PAGE_SIZE
    n_used = DEC_BATCH * n_pages
    n_pool = n_used + (n_used + 3) // 4
    nrm = jax.random.normal
    page_table = jax.random.permutation(ks[0], n_pool)[:n_used].reshape(DEC_BATCH, n_pages).astype(jnp.int32)
    return {
        'x_prompt': nrm(ks[1], (BATCH, SEQ, D_MODEL), jnp.float32),
        'x_sample': nrm(ks[2], (DEC_BATCH, DEC_SEQ, D_MODEL), jnp.float32),
        'cache_fox_k': nrm(ks[3], (N_EVEN, n_pool, PAGE_SIZE, B_HEADS, B_HEAD_DIM), jnp.float32),
        'cache_fox_v': nrm(ks[4], (N_EVEN, n_pool, PAGE_SIZE, B_HEADS, B_HEAD_DIM), jnp.float32),
        'cache_fox_logf': jax.nn.log_sigmoid(8.0 + 0.5 * nrm(ks[5], (N_EVEN, n_pool, PAGE_SIZE, B_HEADS), jnp.float32)),
        'state_hgrn': 0.5 * nrm(ks[6], (N_EVEN, DEC_BATCH, A_HEADS, A_HEAD_DIM, A_HEAD_DIM), jnp.float32),
        'state_gla': nrm(ks[7], (N_ODD, DEC_BATCH, C_HEADS, C_KEY_DIM, C_VAL_DIM), jnp.float32),
        'page_table': page_table,
        'norm_even': 1.0 + 0.1 * nrm(ks[8], (N_EVEN, D_MODEL), jnp.float32),
        'w_in_even': nrm(ks[9], (N_EVEN, D_MODEL, EVEN_IN), jnp.float32) * D_MODEL ** -0.5,
        'b_fox_f': 4.0 + 0.5 * nrm(ks[10], (N_EVEN, B_HEADS), jnp.float32),
        'lb_logits': 0.5 * nrm(ks[11], (N_EVEN + 1, A_WIDTH), jnp.float32),
        'hgrn_gain': 1.0 + 0.1 * nrm(ks[12], (N_EVEN, A_WIDTH), jnp.float32),
        'w_out_even': nrm(ks[13], (N_EVEN, A_WIDTH + B_WIDTH, D_MODEL), jnp.float32) * (A_WIDTH + B_WIDTH) ** -0.5,
        'norm_odd': 1.0 + 0.1 * nrm(ks[14], (N_ODD, D_MODEL), jnp.float32),
        'w_in_odd': nrm(ks[15], (N_ODD, D_MODEL, ODD_IN), jnp.float32) * D_MODEL ** -0.5,
        'w_gla_gate': nrm(ks[16], (N_ODD, C_GATE_RANK, C_KEY_WIDTH), jnp.float32) * C_GATE_RANK ** -0.5,
        'b_gla_gate': 0.1 * nrm(ks[17], (N_ODD, C_KEY_WIDTH), jnp.float32),
        'gla_gain': 1.0 + 0.1 * nrm(ks[18], (N_ODD, C_VAL_WIDTH), jnp.float32),
        'w_out_odd': nrm(ks[19], (N_ODD, C_VAL_WIDTH, D_MODEL), jnp.float32) * C_VAL_WIDTH ** -0.5,
        'final_norm': 1.0 + 0.1 * nrm(ks[20], (D_MODEL,), jnp.float32),
    }


def reference(x_prompt, x_sample, cache_fox_k, cache_fox_v, cache_fox_logf, state_hgrn, state_gla, page_table,
              norm_even, w_in_even, b_fox_f, lb_logits, hgrn_gain, w_out_even, norm_odd, w_in_odd,
              w_gla_gate, b_gla_gate, gla_gain, w_out_odd, final_norm):
    weights = (norm_even, w_in_even, b_fox_f, lb_logits, hgrn_gain, w_out_even, norm_odd, w_in_odd,
               w_gla_gate, b_gla_gate, gla_gain, w_out_odd, final_norm)
    bsz, L, _ = x_prompt.shape
    hgrn0 = jnp.zeros((N_EVEN, bsz, A_HEADS, A_HEAD_DIM, A_HEAD_DIM), jnp.float32)
    gla0 = jnp.zeros((N_ODD, bsz, C_HEADS, C_KEY_DIM, C_VAL_DIM), jnp.float32)
    fox_p = lambda i, q, k, v, lf: fox_prompt(q, k, v, lf)
    y_prompt, kp, vp, lfp, hgrn_p, gla_p = run_trunk(x_prompt, fox_p, hgrn0, gla0, *weights)
    n_pp = L // PAGE_SIZE
    fox_k_prompt = kp.reshape(N_EVEN, bsz, n_pp, PAGE_SIZE, B_HEADS, B_HEAD_DIM)
    fox_v_prompt = vp.reshape(N_EVEN, bsz, n_pp, PAGE_SIZE, B_HEADS, B_HEAD_DIM)
    fox_logf_prompt = lfp.reshape(N_EVEN, bsz, n_pp, PAGE_SIZE, B_HEADS)
    fox_s = lambda i, q, k, v, lf: fox_sample(q, k, v, lf, cache_fox_k[i], cache_fox_v[i], cache_fox_logf[i], page_table)
    y_sample, fox_k_sample, fox_v_sample, fox_logf_sample, hgrn_s, gla_s = run_trunk(
        x_sample, fox_s, state_hgrn, state_gla, *weights)
    return (y_prompt, y_sample, fox_k_prompt, fox_v_prompt, fox_logf_prompt, hgrn_p, gla_p,
            fox_k_sample, fox_v_sample, fox_logf_sample, hgrn_s, gla_s)
```

```cpp
#include <hip/hip_runtime.h>
#include <hip/hip_bf16.h>
#include <cstdio>
#include <cstdint>

constexpr int DM = 1024;
constexpr int SEQ = 8192, NB = 2;
constexpr int MP = NB * SEQ;
constexpr int DB = 32, DT = 4;
constexpr int MS = DB * DT;
constexpr int MT = MP + MS;
constexpr int MTP = 16640;
constexpr int EVEN_IN = 4100, ODD_IN = 3088;
constexpr int NH = 4, HD = 128;
constexpr int PAST = 8192, PAGE = 128, NPAGES = PAST / PAGE;
constexpr float EPS = 1e-6f;
constexpr float ATT_SCALE = 0.08838834764831845f;
constexpr float LOG2E = 1.4426950408889634f;

constexpr size_t O_Y = 0;
constexpr size_t O_KP = (size_t)MT * DM;
constexpr size_t O_VP = O_KP + (size_t)MP * 512;
constexpr size_t O_LFP = O_VP + (size_t)MP * 512;
constexpr size_t O_HSP = O_LFP + (size_t)MP * 4;
constexpr size_t O_GSP = O_HSP + (size_t)NB * NH * 128 * 128;
constexpr size_t O_KS = O_GSP + (size_t)NB * NH * 128 * 256;
constexpr size_t O_VS = O_KS + (size_t)MS * 512;
constexpr size_t O_LFS = O_VS + (size_t)MS * 512;
constexpr size_t O_HSS = O_LFS + (size_t)MS * 4;
constexpr size_t O_GSS = O_HSS + (size_t)DB * NH * 128 * 128;
constexpr size_t O_END = O_GSS + (size_t)DB * NH * 128 * 256;
static_assert(O_END == 40567296, "output size");

constexpr size_t MiB = 1u << 20;
constexpr size_t WS_CTL = 0, CTL_ZERO_BYTES = 1 * MiB;
constexpr size_t WS_W1T = 2 * MiB;
constexpr size_t WS_W2T = 10 * MiB;
constexpr size_t WS_W3T = 12 * MiB;
constexpr size_t WS_W4T = 18 * MiB;
constexpr size_t WS_LB = 20 * MiB;
constexpr size_t WS_LFB = 20 * MiB + 65536;
constexpr size_t WS_CB = 21 * MiB;
constexpr size_t WS_SUFX = 22 * MiB;
constexpr size_t WS_PML = 26 * MiB;
constexpr size_t WS_PO = 26 * MiB + 65536;
constexpr size_t WS_BTOT = 28 * MiB;
constexpr size_t WS_WR = 29 * MiB;
constexpr size_t WS_XN = 32 * MiB;
constexpr size_t WS_QA = 66 * MiB;
constexpr size_t WS_IA = 84 * MiB;
constexpr size_t WS_GA = 102 * MiB;
constexpr size_t WS_GB = 120 * MiB;
constexpr size_t WS_GF = 138 * MiB;
constexpr size_t WS_QBH = 172 * MiB;
constexpr size_t WS_KBH = 188 * MiB;
constexpr size_t WS_VBH = 204 * MiB;
constexpr size_t WS_QS = 220 * MiB;
constexpr size_t WS_MIX = 224 * MiB;
constexpr size_t WS_X1 = 258 * MiB;
constexpr size_t WS_SLOC = 324 * MiB;
constexpr size_t WS_Q3 = 342 * MiB;
constexpr size_t WS_K3 = 360 * MiB;
constexpr size_t WS_V3 = 378 * MiB;
constexpr size_t WS_G3 = 412 * MiB;
constexpr size_t WS_GF3 = 446 * MiB;
constexpr size_t WS_SLOC3 = 480 * MiB;
constexpr size_t WS_MIX2 = 512 * MiB;
constexpr size_t WS_END = 546 * MiB;
constexpr int CW_TMO = 0;
constexpr int CW_BAR = 4096;
constexpr int CW_SS1 = 16384;
constexpr int CW_SS2 = 40960;
static_assert((CW_SS2 + MT) * 4 <= (int)CTL_ZERO_BYTES, "CTL");

constexpr int RING_OFF = 0, RING_BYTES = 131072;
constexpr int LDSCTL_OFF = 146944, MISC_OFF = LDSCTL_OFF + 320;
constexpr int LDS_BYTES = 147456;
constexpr int NWAVES = 8;
namespace pg8 {
#define PG8_LAS __attribute__((address_space(3)))
typedef unsigned short bf16_t;
typedef short bf16x8 __attribute__((ext_vector_type(8)));
typedef float f32x4 __attribute__((ext_vector_type(4)));
typedef unsigned u32x4 __attribute__((ext_vector_type(4)));
constexpr int BM = 256, BK = 64, HALF = 128, HTB = HALF * BK * 2  , STAGE_BYTES = 8 * HTB, NXCD = 8, WGM = 8;

__host__ __device__ __forceinline__ int lds_byte(int r, int c) { const int st = (r >> 4) * 2 + (c >> 5), rr = r & 15, cc = c & 31, ob = rr * 64 + cc * 2; return st * 1024 + (ob ^ (((ob >> 9) & 1) << 5)); }
__host__ __device__ __forceinline__ void stage_rc(int b, int& R, int& C) { const int st = b / 1024, sb = b % 1024, swz = sb ^ (((sb >> 9) & 1) << 5); R = (st >> 1) * 16 + swz / 64; C = (st & 1) * 32 + (swz % 64) / 2; }
__host__ __device__ __forceinline__ int perm32(int rho) { const int n = rho >> 4, i = rho & 15; return 8 * (i >> 2) + 4 * n + (i & 3); }

struct Unit { int pm, pn; };
struct Gemm { const bf16_t* A; const bf16_t* Bt; int M, N, K; };

struct StaticOrder {
    int nM, nN, nwg, G, c;
    __host__ __device__ void init(int M, int N, int G_, int c_) { nM = M / BM; nN = N / BM; nwg = nM * nN; G = G_; c = c_; }
    __host__ __device__ bool next(int i, Unit& u) const {
        const long L = (long)i * G + c; if (L >= nwg) return false;
        int wgid = (int)L; { const int q = nwg / NXCD, r = nwg % NXCD, xcd = wgid % NXCD, off = wgid / NXCD; wgid = (xcd < r ? xcd * (q + 1) : r * (q + 1) + (xcd - r) * q) + off; }
        const int nig = WGM * nN, gid = wgid / nig, fm = gid * WGM, gsz = (nM - fm) < WGM ? (nM - fm) : WGM;
        u.pm = fm + ((wgid % nig) % gsz); u.pn = (wgid % nig) / gsz; return true;
    }
    __device__ __forceinline__ void a_ready(const Unit&) const {}
    __device__ __forceinline__ void done(const Unit&) const {}
};

__device__ __forceinline__ unsigned cvt_pk_bf16(float lo, float hi) { unsigned r; asm volatile("v_cvt_pk_bf16_f32 %0, %1, %2" : "=v"(r) : "v"(lo), "v"(hi)); return r; }
typedef float f32x2 __attribute__((ext_vector_type(2)));
template <class Epi, class Sched, bool ALIGN_EPI = false, bool SP2 = false>
__device__ __forceinline__ void gemm_phase(PG8_LAS unsigned char* lds, const Gemm g, const Sched& S, const Epi& E) {
    const int tid = threadIdx.x, wid = __builtin_amdgcn_readfirstlane(tid >> 6), lane = tid & 63, wr = wid >> 2, wc = wid & 3, fr = lane & 15, fq = lane >> 4;
    const int K = g.K, nt = K / BK;
    unsigned voffA[2], voffB[2];
#pragma unroll
    for (int i = 0; i < 2; ++i) { int R, C; stage_rc(tid * 16 + i * 8192, R, C); const int Rb = Epi::PERM ? ((R & ~31) + perm32(R & 31)) : R;
        voffA[i] = (unsigned)(R * K + C) * 2u; voffB[i] = (unsigned)(Rb * K + C) * 2u; }
    const size_t kstep = (size_t)(BK * 2);
    const size_t hstep = (size_t)HALF * K * 2;
    const size_t tstep = 2 * hstep;
    const unsigned ldsw = (unsigned)wid * 1024u;
    const int aoff = lds_byte(wr * 64 + fr, fq * 8), boff = lds_byte(wc * 32 + fr, fq * 8);
#define PG8_SA(b, h) (((b) * 2 + (h)) * HTB)
#define PG8_SB(b, h) ((4 + (b) * 2 + (h)) * HTB)
#define PG8_STAGE(bufoff, gbase, voff) do { _Pragma("unroll") for (int _i = 0; _i < 2; ++_i) \
        __builtin_amdgcn_global_load_lds((const unsigned*)((const char*)(gbase) + (voff)[_i]), (PG8_LAS unsigned*)(lds + (bufoff) + ldsw + _i * 8192), 16, 0, 0); } while (0)
#define PG8_LDA(dst, b, h) do { _Pragma("unroll") for (int m = 0; m < 4; ++m) _Pragma("unroll") for (int k = 0; k < 2; ++k) dst[m][k] = *(const PG8_LAS bf16x8*)(lds + PG8_SA(b, h) + aoff + m * 2048 + k * 1024); } while (0)
#define PG8_LDB(dst, b, h) do { _Pragma("unroll") for (int n = 0; n < 2; ++n) _Pragma("unroll") for (int k = 0; k < 2; ++k) dst[n][k] = *(const PG8_LAS bf16x8*)(lds + PG8_SB(b, h) + boff + n * 2048 + k * 1024); } while (0)
#define PG8_MMA(ai, bj, At, Bt) do { __builtin_amdgcn_s_setprio(1); _Pragma("unroll") for (int m = 0; m < 4; ++m) _Pragma("unroll") for (int n = 0; n < 2; ++n) _Pragma("unroll") for (int k = 0; k < 2; ++k) \
        acc[ai][bj][m][n] = __builtin_amdgcn_mfma_f32_16x16x32_bf16(Bt[n][k], At[m][k], acc[ai][bj][m][n], 0, 0, 0); __builtin_amdgcn_s_setprio(0); } while (0)
#define PG8_WAIT_V(n) asm volatile("s_waitcnt vmcnt(" #n ")" ::: "memory")
#define PG8_WAIT_L(n) asm volatile("s_waitcnt lgkmcnt(" #n ")" ::: "memory")
#define PG8_BAR __builtin_amdgcn_s_barrier()
#define PG8_SCHED __builtin_amdgcn_sched_barrier(0)
    Unit cur, nxt; int ui = 0;
    if (!S.next(0, cur)) return;
    f32x4 acc[2][2][4][2];
#pragma unroll
    for (int a = 0; a < 2; ++a)
#pragma unroll
        for (int b = 0; b < 2; ++b)
#pragma unroll
            for (int m = 0; m < 4; ++m)
#pragma unroll
                for (int n = 0; n < 2; ++n) acc[a][b][m][n] = (f32x4){0.f, 0.f, 0.f, 0.f};
    bf16x8 At[4][2], B0[2][2], B1[2][2];
    const char* cA = (const char*)g.A + (size_t)cur.pm * tstep; const char* cB = (const char*)g.Bt + (size_t)cur.pn * tstep;
    S.a_ready(cur);
    if constexpr (SP2) {
        PG8_STAGE(PG8_SB(0, 0), cB, voffB); PG8_STAGE(PG8_SB(0, 1), cB + hstep, voffB); PG8_STAGE(PG8_SA(0, 0), cA, voffA); PG8_STAGE(PG8_SA(0, 1), cA + hstep, voffA);
        if (wr == 1) PG8_BAR;
        PG8_WAIT_V(2); PG8_BAR;
        PG8_STAGE(PG8_SB(1, 0), cB + kstep, voffB); PG8_STAGE(PG8_SA(1, 0), cA + kstep, voffA); PG8_STAGE(PG8_SB(1, 1), cB + hstep + kstep, voffB);
        PG8_WAIT_V(6); PG8_BAR;
    } else {
        PG8_STAGE(PG8_SB(0, 0), cB, voffB); PG8_STAGE(PG8_SA(0, 0), cA, voffA); PG8_STAGE(PG8_SB(0, 1), cB + hstep, voffB); PG8_STAGE(PG8_SA(0, 1), cA + hstep, voffA);
        if (wr == 1) PG8_BAR;
        PG8_WAIT_V(4); PG8_BAR;
        PG8_STAGE(PG8_SB(1, 0), cB + kstep, voffB); PG8_STAGE(PG8_SA(1, 0), cA + kstep, voffA); PG8_STAGE(PG8_SB(1, 1), cB + hstep + kstep, voffB);
        PG8_WAIT_V(6); PG8_BAR;
    }
    for (;;) {
        const bool has_next = S.next(ui + 1, nxt);
        const char* nA = has_next ? (const char*)g.A + (size_t)nxt.pm * tstep : cA; const char* nB = has_next ? (const char*)g.Bt + (size_t)nxt.pn * tstep : cB;
        for (int t = 0; t < nt; t += 2) {
            const bool last = (t == nt - 2);
            const char* a1 = cA + (size_t)(t + 1) * kstep;
            const char* a2 = last ? nA : cA + (size_t)(t + 2) * kstep; const char* b2 = last ? nB : cB + (size_t)(t + 2) * kstep;
            const char* a3 = a2 + kstep; const char* b3 = b2 + kstep;
            if (last && has_next) S.a_ready(nxt);
            if constexpr (SP2) {
            PG8_LDB(B0, 0, 0); PG8_LDB(B1, 0, 1); PG8_SCHED; PG8_LDA(At, 0, 0); PG8_STAGE(PG8_SA(1, 1), a1 + hstep, voffA);
            PG8_WAIT_V(8); PG8_WAIT_L(0); PG8_BAR; PG8_MMA(0, 0, At, B0); PG8_MMA(0, 1, At, B1); PG8_BAR; PG8_SCHED;
            PG8_LDA(At, 0, 1); PG8_STAGE(PG8_SB(0, 0), b2, voffB); PG8_STAGE(PG8_SB(0, 1), b2 + hstep, voffB); PG8_STAGE(PG8_SA(0, 0), a2, voffA);
            PG8_WAIT_V(8); PG8_WAIT_L(0); PG8_BAR; PG8_MMA(1, 0, At, B0); PG8_MMA(1, 1, At, B1); PG8_BAR; PG8_SCHED;
            PG8_LDB(B0, 1, 0); PG8_LDB(B1, 1, 1); PG8_SCHED; PG8_LDA(At, 1, 0); PG8_STAGE(PG8_SA(0, 1), a2 + hstep, voffA);
            PG8_WAIT_V(8); PG8_WAIT_L(0); PG8_BAR; PG8_MMA(0, 0, At, B0); PG8_MMA(0, 1, At, B1); PG8_BAR; PG8_SCHED;
            PG8_LDA(At, 1, 1); PG8_STAGE(PG8_SB(1, 0), b3, voffB); PG8_STAGE(PG8_SB(1, 1), b3 + hstep, voffB); PG8_STAGE(PG8_SA(1, 0), a3, voffA);
            PG8_WAIT_V(8); PG8_WAIT_L(0); PG8_BAR; PG8_MMA(1, 0, At, B0); PG8_MMA(1, 1, At, B1); PG8_BAR; PG8_SCHED;
            } else {
            PG8_LDB(B0, 0, 0); PG8_SCHED; PG8_LDA(At, 0, 0); PG8_STAGE(PG8_SA(1, 1), a1 + hstep, voffA);
            PG8_WAIT_L(8); PG8_BAR; PG8_WAIT_L(0); PG8_MMA(0, 0, At, B0); PG8_BAR; PG8_SCHED;
            PG8_LDB(B1, 0, 1); PG8_STAGE(PG8_SB(0, 0), b2, voffB);
            PG8_BAR; PG8_WAIT_L(0); PG8_MMA(0, 1, At, B1); PG8_BAR;
            PG8_LDA(At, 0, 1); PG8_STAGE(PG8_SA(0, 0), a2, voffA);
            PG8_BAR; PG8_WAIT_L(0); PG8_MMA(1, 0, At, B0); PG8_BAR; PG8_SCHED;
            PG8_STAGE(PG8_SB(0, 1), b2 + hstep, voffB);
            PG8_WAIT_V(6); PG8_BAR; PG8_MMA(1, 1, At, B1); PG8_BAR;
            PG8_LDB(B0, 1, 0); PG8_SCHED; PG8_LDA(At, 1, 0); PG8_STAGE(PG8_SA(0, 1), a2 + hstep, voffA);
            PG8_WAIT_L(8); PG8_BAR; PG8_WAIT_L(0); PG8_MMA(0, 0, At, B0); PG8_BAR; PG8_SCHED;
            PG8_LDB(B1, 1, 1); PG8_STAGE(PG8_SB(1, 0), b3, voffB);
            PG8_BAR; PG8_WAIT_L(0); PG8_MMA(0, 1, At, B1); PG8_BAR;
            PG8_LDA(At, 1, 1); PG8_STAGE(PG8_SA(1, 0), a3, voffA);
            PG8_BAR; PG8_WAIT_L(0); PG8_MMA(1, 0, At, B0); PG8_BAR; PG8_SCHED;
            PG8_STAGE(PG8_SB(1, 1), b3 + hstep, voffB);
            PG8_WAIT_V(6); PG8_BAR; PG8_MMA(1, 1, At, B1); PG8_BAR;
            }
        }
        if constexpr (ALIGN_EPI) { if (wr == 0) PG8_BAR; }
        if constexpr (!Epi::AFTER_DRAIN) { E(acc, cur, wr, wc, fr, fq); S.done(cur); }
        if (!has_next) break;
#pragma unroll
        for (int a = 0; a < 2; ++a)
#pragma unroll
            for (int b = 0; b < 2; ++b)
#pragma unroll
                for (int m = 0; m < 4; ++m)
#pragma unroll
                    for (int n = 0; n < 2; ++n) acc[a][b][m][n] = (f32x4){0.f, 0.f, 0.f, 0.f};
        cur = nxt; cA = nA; cB = nB; ++ui;
        if constexpr (ALIGN_EPI) { if (wr == 1) PG8_BAR; }
    }
    PG8_WAIT_V(0);
    if constexpr (!ALIGN_EPI) { if (wr == 0) PG8_BAR; }
    PG8_BAR;
    if constexpr (Epi::AFTER_DRAIN) { E.fused(acc, cur, wr, wc, fr, fq, lds, wid, lane); S.done(cur); }
#undef PG8_SA
#undef PG8_SB
#undef PG8_STAGE
#undef PG8_LDA
#undef PG8_LDB
#undef PG8_MMA
#undef PG8_WAIT_V
#undef PG8_WAIT_L
#undef PG8_BAR
#undef PG8_SCHED
}
}
#define GAS __attribute__((address_space(1)))
#define LAS __attribute__((address_space(3)))
typedef unsigned short bf16;
typedef unsigned v4u __attribute__((ext_vector_type(4)));
typedef float f32x4 __attribute__((ext_vector_type(4)));
typedef short bf16x8 __attribute__((ext_vector_type(8)));
typedef GAS unsigned gu32;
typedef GAS unsigned long long gu64;
#define RLX_AGENT __ATOMIC_RELAXED, __HIP_MEMORY_SCOPE_AGENT
#define LDS_WAIT() asm volatile("s_waitcnt lgkmcnt(0)" ::: "memory")
#define VM_WAIT() asm volatile("s_waitcnt vmcnt(0)" ::: "memory")
__device__ __forceinline__ unsigned long long rt() { return __builtin_amdgcn_s_memrealtime(); }
__device__ __forceinline__ unsigned f2bf(float f) { unsigned u = __builtin_bit_cast(unsigned, f); return (u + 0x7fffu + ((u >> 16) & 1u)) >> 16; }
__device__ __forceinline__ unsigned pk2(float lo, float hi) { return f2bf(lo) | (f2bf(hi) << 16); }

#define XB_TMO      128
#define XB_XCNT(j)  (256  + 64 * (j))
#define XB_XSUB(j)  (1280 + 64 * (j))
#define XB_XGEN(j)  (2304 + 64 * (j))
#define XB_TOP      3328
#define XB_TOPGEN   3392
#define XCD_BAR_WORDS 3456
#define XB_SPIN_CAP (1u << 18)

__device__ __forceinline__ unsigned xb_ld(unsigned* p)              { return __hip_atomic_load(p, __ATOMIC_RELAXED, __HIP_MEMORY_SCOPE_AGENT); }
__device__ __forceinline__ unsigned xb_add(unsigned* p, unsigned v) { return __hip_atomic_fetch_add(p, v, __ATOMIC_RELAXED, __HIP_MEMORY_SCOPE_AGENT); }
__device__ __forceinline__ unsigned xb_xcc_id() { return (unsigned)__builtin_amdgcn_s_getreg((3 << 11) | 20) & 0xFu; }
#define XB_SPIN(cond, bar) do { unsigned _sp = 0; while (cond) { __builtin_amdgcn_s_sleep(1); \
    if ((++_sp & 255u) == 0u) { if (xb_ld(&(bar)[XB_TMO])) break; if (_sp > XB_SPIN_CAP) { atomicAdd(&(bar)[XB_TMO], 1u); break; } } } } while (0)

struct XcdBarrier {
    unsigned* bar; unsigned x;
    volatile LAS unsigned* st;
};

__device__ __forceinline__ XcdBarrier xcd_barrier_post(unsigned* bar, volatile LAS unsigned* st) {
    XcdBarrier b; b.bar = bar; b.x = xb_xcc_id(); b.st = st;
    if (threadIdx.x == 0) (void)xb_add(&bar[XB_XCNT(b.x)], 1u);
    return b;
}
__device__ __forceinline__ void xcd_barrier_complete(unsigned* bar, unsigned x, unsigned& nloc, unsigned& nx) {
    const unsigned G = gridDim.x * gridDim.y * gridDim.z;
    unsigned sum, cnt, mine, sp = 0u;
    for (;;) {
        sum = 0u; cnt = 0u; mine = 0u;
#pragma unroll
        for (unsigned j = 0; j < 16; ++j) { const unsigned c = xb_ld(&bar[XB_XCNT(j)]); sum += c; cnt += (c > 0u) ? 1u : 0u; mine = (j == x) ? c : mine; }
        if (sum == G) break;
        __builtin_amdgcn_s_sleep(1);
        if ((++sp & 255u) == 0u) { if (xb_ld(&bar[XB_TMO])) break; if (sp > XB_SPIN_CAP) { atomicAdd(&bar[XB_TMO], 1u); break; } }
    }
    nloc = mine > 0u ? mine : 1u; nx = cnt > 0u ? cnt : 1u;
}

__device__ __forceinline__ void xcd_barrier(const XcdBarrier& b) {
    asm volatile("s_waitcnt vmcnt(0)" ::: "memory");
    __syncthreads();
    if (threadIdx.x == 0) {
        unsigned* bar = b.bar;
        __builtin_amdgcn_s_waitcnt(0);
        unsigned nloc = b.st[0], nx = b.st[1];
        if (nloc == 0u) { xcd_barrier_complete(bar, b.x, nloc, nx); b.st[0] = nloc; b.st[1] = nx; }
        const unsigned old = xb_add(&bar[XB_XSUB(b.x)], 1u);
        const unsigned gen = old / nloc;
        if (old + 1u == (gen + 1u) * nloc) {
            __builtin_amdgcn_fence(__ATOMIC_RELEASE, "agent");
            asm volatile("s_waitcnt vmcnt(0)" ::: "memory");
            const unsigned og = xb_add(&bar[XB_TOP], 1u);
            const unsigned tg = og / nx;
            if (og + 1u == (tg + 1u) * nx) xb_add(&bar[XB_TOPGEN], 1u);
            else XB_SPIN(xb_ld(&bar[XB_TOPGEN]) == tg, bar);
            __builtin_amdgcn_fence(__ATOMIC_ACQUIRE, "agent");
            xb_add(&bar[XB_XGEN(b.x)], 1u);
            asm volatile("s_waitcnt vmcnt(0)" ::: "memory");
        } else {
            XB_SPIN(xb_ld(&bar[XB_XGEN(b.x)]) == gen, bar);
            __builtin_amdgcn_fence(__ATOMIC_ACQUIRE, "agent");
            asm volatile("s_waitcnt vmcnt(0)" ::: "memory");
        }
    }
    __syncthreads();
}

typedef unsigned u32x2v __attribute__((ext_vector_type(2)));
struct Frame {
    LAS unsigned char* lds;
    volatile LAS unsigned* MISC;
    gu32* ctl;
    int tid, lane, wave;
    int G;
    unsigned char* ws;
    float* out;
    const float *xp, *xs, *ck, *cv, *clf, *sh, *sg; const int* pt;
    const float *norm_even, *w_in_even, *b_fox, *lb_logits, *hgrn_gain, *w_out_even, *norm_odd, *w_in_odd, *w_gla_gate, *b_gla_gate, *gla_gain, *w_out_odd, *final_norm;
};
#define WSP(T, off) ((T*)(F.ws + (off)))

__device__ __forceinline__ float wave_sum(float v) {
#pragma unroll
    for (int o = 1; o < 64; o <<= 1) v += __shfl_xor(v, o);
    return v;
}
__device__ __forceinline__ float fast_exp(float x) { return __builtin_amdgcn_exp2f(x * LOG2E); }
__device__ __forceinline__ float sigmoidf_(float x) { return __builtin_amdgcn_rcpf(1.0f + fast_exp(-x)); }
__device__ __forceinline__ float siluf_(float x) { return x * sigmoidf_(x); }
__device__ __forceinline__ float log_sigmoidf_(float x) {
    const float e = __expf(-fabsf(x));
    return fminf(x, 0.f) - log1pf(e);
}
__device__ __forceinline__ float bf2f(unsigned short b) { return __builtin_bit_cast(float, (unsigned)b << 16); }
__device__ __forceinline__ void st_bf4(bf16* p, f32x4 v) { u32x2v w; w.x = pk2(v[0], v[1]); w.y = pk2(v[2], v[3]); *(GAS u32x2v*)p = w; }

__device__ __forceinline__ void p0_transpose_item(const float* W, int K, int ld, int N, bf16* WT, LAS float* scr, int item, int lane, const float* gain) {
    const int nblk = N / 32, kb = item / nblk, nb = item % nblk, k0 = 64 * kb, n0 = 32 * nb;
#pragma unroll 8
    for (int i = 0; i < 32; ++i) { const int kk = 2 * i + (lane >> 5); float w = W[(size_t)(k0 + kk) * ld + n0 + (lane & 31)]; if (gain) w *= gain[k0 + kk]; scr[kk * 33 + (lane & 31)] = w; }
    LDS_WAIT(); asm volatile("" ::: "memory");
    const int c = lane & 7;
#pragma unroll
    for (int j = 0; j < 4; ++j) { const int n = (lane >> 3) + 8 * j; const LAS float* s = scr + (8 * c) * 33 + n;
        v4u o; o.x = pk2(s[0 * 33], s[1 * 33]); o.y = pk2(s[2 * 33], s[3 * 33]); o.z = pk2(s[4 * 33], s[5 * 33]); o.w = pk2(s[6 * 33], s[7 * 33]);
        *(GAS v4u*)(WT + (size_t)(n0 + n) * K + k0 + 8 * c) = o; }
    LDS_WAIT(); asm volatile("" ::: "memory");
}

__device__ __forceinline__ float block_excl_scan(float v, LAS float* scr, int lane, int wave, float* total) {
    float inc = v;
#pragma unroll
    for (int o = 1; o < 64; o <<= 1) { const float t = __shfl_up(inc, o); if (lane >= o) inc += t; }
    if (lane == 63) scr[wave] = inc;
    __syncthreads();
    float pre = 0.f, tot = 0.f;
#pragma unroll
    for (int w = 0; w < 8; ++w) { const float t = scr[w]; if (w < wave) pre += t; tot += t; }
    __syncthreads();
    *total = tot;
    return pre + inc - v;
}

__device__ __forceinline__ void p0_prologue(Frame& F) {
    LAS float* scr = (LAS float*)(F.lds + RING_OFF + F.wave * 16384);
    const int gw = (int)blockIdx.x * NWAVES + F.wave, NGW = F.G * NWAVES;
    constexpr int I1 = 16 * (4096 / 32), I2 = 16 * (1024 / 32), I3 = 16 * (3072 / 32), I4 = I2, NITEMS = I1 + I2 + I3 + I4;
    for (int it = gw; it < NITEMS; it += NGW) {
        int r = it;
        if (r < I1) { p0_transpose_item(F.w_in_even, DM, EVEN_IN, 4096, WSP(bf16, WS_W1T), scr, r, F.lane, nullptr); continue; } r -= I1;
        if (r < I2) { p0_transpose_item(F.w_out_even, DM, DM, 1024, WSP(bf16, WS_W2T), scr, r, F.lane, nullptr); continue; } r -= I2;
        if (r < I3) { p0_transpose_item(F.w_in_odd, DM, ODD_IN, 3072, WSP(bf16, WS_W3T), scr, r, F.lane, F.norm_odd); continue; } r -= I3;
        p0_transpose_item(F.w_out_odd, DM, DM, 1024, WSP(bf16, WS_W4T), scr, r, F.lane, nullptr);
    }
    if (blockIdx.x == 0) { float* LB = WSP(float, WS_LB); const int c = F.tid; LB[c] = 1.0f / (1.0f + __expf(F.lb_logits[512 + c] - F.lb_logits[c])); }
    { float* WR = WSP(float, WS_WR); const int gt = (int)blockIdx.x * 512 + F.tid;
      for (int e = gt; e < 1024 * 16; e += F.G * 512) { const int k = e >> 4, j = e & 15; WR[e] = F.w_in_odd[(size_t)k * ODD_IN + 3072 + j] * F.norm_odd[k]; } }
    __syncthreads();
    if (blockIdx.x < DB) {
        const int b = blockIdx.x; float* SUFX = WSP(float, WS_SUFX);
        LAS float* sscr = (LAS float*)(F.lds + RING_OFF);
        const int i = F.tid; f32x4 v[16];
#pragma unroll
        for (int j = 0; j < 16; ++j) { const int s = 8191 - (16 * i + j); const int pg = F.pt[b * NPAGES + (s >> 7)]; v[j] = *(const GAS f32x4*)(F.clf + ((size_t)pg * PAGE + (s & 127)) * 4); }
        f32x4 run = {0.f, 0.f, 0.f, 0.f};
#pragma unroll
        for (int j = 0; j < 16; ++j) { const f32x4 t = v[j]; v[j] = run; run += t; }
        float tot; f32x4 pre;
        pre.x = block_excl_scan(run.x, sscr, F.lane, F.wave, &tot);
        pre.y = block_excl_scan(run.y, sscr, F.lane, F.wave, &tot);
        pre.z = block_excl_scan(run.z, sscr, F.lane, F.wave, &tot);
        pre.w = block_excl_scan(run.w, sscr, F.lane, F.wave, &tot);
#pragma unroll
        for (int j = 0; j < 16; ++j) { const int s = 8191 - (16 * i + j); const f32x4 o = (v[j] + pre) * LOG2E;
            SUFX[(size_t)(b * 4 + 0) * PAST + s] = o.x; SUFX[(size_t)(b * 4 + 1) * PAST + s] = o.y; SUFX[(size_t)(b * 4 + 2) * PAST + s] = o.z; SUFX[(size_t)(b * 4 + 3) * PAST + s] = o.w; }
    }
    LAS float* wfb = (LAS float*)(F.lds + RING_OFF);
    __syncthreads();
    for (int k = F.tid; k < 1024; k += 512) *(LAS f32x4*)(wfb + 4 * k) = *(const GAS f32x4*)(F.w_in_even + (size_t)k * EVEN_IN + 4096);
    __syncthreads();
    bf16* XN = WSP(bf16, WS_XN); float* LFB = WSP(float, WS_LFB);
    const f32x4 bf = *(const GAS f32x4*)F.b_fox;
    for (int m = gw; m < MT; m += NGW) {
        const float* xrow = m < MP ? F.xp + (size_t)m * DM : F.xs + (size_t)(m - MP) * DM;
        const GAS f32x4* xr = (const GAS f32x4*)xrow + F.lane;
        f32x4 v[4]; float s = 0.f;
#pragma unroll
        for (int j = 0; j < 4; ++j) { v[j] = xr[64 * j]; s += (v[j].x * v[j].x + v[j].y * v[j].y) + (v[j].z * v[j].z + v[j].w * v[j].w); }
        const float rstd = 1.0f / sqrtf(wave_sum(s) * (1.f / DM) + EPS);
        f32x4 d = {0.f, 0.f, 0.f, 0.f};
        GAS unsigned long long* o8 = (GAS unsigned long long*)(XN + (size_t)m * DM) + F.lane;
#pragma unroll
        for (int j = 0; j < 4; ++j) { const int c0 = 4 * F.lane + 256 * j; const f32x4 g = *(const GAS f32x4*)(F.norm_even + c0);
            const f32x4 h = v[j] * rstd * g;
            o8[64 * j] = (unsigned long long)pk2(h.x, h.y) | ((unsigned long long)pk2(h.z, h.w) << 32);
            d += h.x * *(LAS f32x4*)(wfb + 4 * c0) + h.y * *(LAS f32x4*)(wfb + 4 * c0 + 4) + h.z * *(LAS f32x4*)(wfb + 4 * c0 + 8) + h.w * *(LAS f32x4*)(wfb + 4 * c0 + 12); }
        d.x = wave_sum(d.x); d.y = wave_sum(d.y); d.z = wave_sum(d.z); d.w = wave_sum(d.w);
        if (F.lane == 0) { f32x4 lf; lf.x = log_sigmoidf_(d.x + bf.x); lf.y = log_sigmoidf_(d.y + bf.y); lf.z = log_sigmoidf_(d.z + bf.z); lf.w = log_sigmoidf_(d.w + bf.w);
            *(GAS f32x4*)(LFB + (size_t)m * 4) = lf;
            float* o = m < MP ? F.out + O_LFP + (size_t)m * 4 : F.out + O_LFS + (size_t)(m - MP) * 4; *(GAS f32x4*)o = lf; }
    }
    __syncthreads();
}

__device__ __forceinline__ void fox_cumsum_unit(Frame& F, int bh) {
    const int b = bh >> 2, h = bh & 3; const float* LFB = WSP(float, WS_LFB); float* CB = WSP(float, WS_CB);
    LAS float* sscr = (LAS float*)(F.lds + RING_OFF);
    float v[16]; float run = 0.f;
#pragma unroll
    for (int j = 0; j < 16; ++j) { run += LFB[(size_t)(b * SEQ + 16 * F.tid + j) * 4 + h]; v[j] = run; }
    float tot; const float pre = block_excl_scan(run, sscr, F.lane, F.wave, &tot);
#pragma unroll
    for (int j = 0; j < 16; ++j) CB[(size_t)bh * SEQ + 16 * F.tid + j] = -(v[j] + pre) * (1.0f / ATT_SCALE);
}

struct P1 { bf16 *QA, *IA, *GA, *GB, *QBH, *KBH, *VBH; float *GF, *QS; const float* LB; float* out; };
__device__ __forceinline__ void epi1_4(const P1& p, int m, int c, f32x4 v) {
    const int sec = c >> 9, cs = c & 511;
    const size_t rc = (size_t)m * 512 + cs;
    switch (sec) {
    case 0: st_bf4(p.QA + rc, v); break;
    case 1: { const f32x4 lb = *(const GAS f32x4*)(p.LB + cs); f32x4 g;
#pragma unroll
        for (int i = 0; i < 4; ++i) { const float f = lb[i] + (1.0f - lb[i]) * sigmoidf_(v[i]); g[i] = __logf(f); }
        *(GAS f32x4*)(p.GF + rc) = g; } break;
    case 2: st_bf4(p.IA + rc, v); break;
    case 3: { f32x4 g; for (int i = 0; i < 4; ++i) g[i] = siluf_(v[i]); st_bf4(p.GA + rc, g); } break;
    case 4: if (m < MP) { const int b = m >> 13, s = m & 8191, h = cs >> 7, d = cs & 127; st_bf4(p.QBH + ((size_t)((b * 4 + h) * SEQ + s) * HD + d), v); }
            else *(GAS f32x4*)(p.QS + (size_t)(m - MP) * 512 + cs) = v;
            break;
    case 5: if (m < MP) { const int b = m >> 13, s = m & 8191, h = cs >> 7, d = cs & 127; st_bf4(p.KBH + ((size_t)((b * 4 + h) * SEQ + s) * HD + d), v); *(GAS f32x4*)(p.out + O_KP + rc) = v; }
            else *(GAS f32x4*)(p.out + O_KS + (size_t)(m - MP) * 512 + cs) = v;
            break;
    case 6: if (m < MP) { const int b = m >> 13, s = m & 8191, h = cs >> 7, d = cs & 127; st_bf4(p.VBH + ((size_t)((b * 4 + h) * SEQ + s) * HD + d), v); *(GAS f32x4*)(p.out + O_VP + rc) = v; }
            else *(GAS f32x4*)(p.out + O_VS + (size_t)(m - MP) * 512 + cs) = v;
            break;
    default: { f32x4 g; for (int i = 0; i < 4; ++i) g[i] = siluf_(v[i]); st_bf4(p.GB + rc, g); } break;
    }
}
struct P2 { const float *xp, *xs; float* X1; bf16* X1B; float* SS; };
__device__ __forceinline__ float epi2_4(const P2& p, int m, int c, f32x4 v) {
    const float* xr = m < MP ? p.xp + (size_t)m * DM : p.xs + (size_t)(m - MP) * DM;
    const f32x4 o = *(const GAS f32x4*)(xr + c) + v;
    *(GAS f32x4*)(p.X1 + (size_t)m * DM + c) = o; st_bf4(p.X1B + (size_t)m * DM + c, o);
    return (o.x * o.x + o.y * o.y) + (o.z * o.z + o.w * o.w);
}
struct P3 { bf16 *Q3, *K3, *V3, *G3; const float* SS; };
__device__ __forceinline__ void epi3_4(const P3& p, int m, int c, f32x4 v, float rstd) {
    v = v * rstd;
    if (c < 512) { st_bf4(p.Q3 + (size_t)m * 512 + c, v * ATT_SCALE); }
    else if (c < 1024) { st_bf4(p.K3 + (size_t)m * 512 + (c - 512), v); }
    else if (c < 2048) { st_bf4(p.V3 + (size_t)m * 1024 + (c - 1024), v); }
    else { f32x4 g; for (int i = 0; i < 4; ++i) g[i] = siluf_(v[i]); st_bf4(p.G3 + (size_t)m * 1024 + (c - 2048), g); }
}
struct P4 { const float* X1; float* Y; float* SS; };
__device__ __forceinline__ float epi4_4(const P4& p, int m, int c, f32x4 v) {
    const f32x4 o = *(const GAS f32x4*)(p.X1 + (size_t)m * DM + c) + v;
    *(GAS f32x4*)(p.Y + (size_t)m * DM + c) = o;
    return (o.x * o.x + o.y * o.y) + (o.z * o.z + o.w * o.w);
}

struct Epi1 { static constexpr bool PERM = false, AFTER_DRAIN = false; P1 p;
    __device__ __forceinline__ void operator()(const pg8::f32x4 (&acc)[2][2][4][2], const pg8::Unit& u, int wr, int wc, int fr, int fq) const {
#pragma unroll
        for (int ai = 0; ai < 2; ++ai)
#pragma unroll
            for (int m = 0; m < 4; ++m) { const int row = u.pm * 256 + ai * 128 + wr * 64 + m * 16 + fr;
#pragma unroll
                for (int bj = 0; bj < 2; ++bj)
#pragma unroll
                    for (int n = 0; n < 2; ++n) epi1_4(p, row, u.pn * 256 + bj * 128 + wc * 32 + n * 16 + 4 * fq, acc[ai][bj][m][n]); }
    } };
struct Epi2 { static constexpr bool PERM = false, AFTER_DRAIN = false; P2 p;
    __device__ __forceinline__ void operator()(const pg8::f32x4 (&acc)[2][2][4][2], const pg8::Unit& u, int wr, int wc, int fr, int fq) const {
#pragma unroll
        for (int ai = 0; ai < 2; ++ai)
#pragma unroll
            for (int m = 0; m < 4; ++m) { const int row = u.pm * 256 + ai * 128 + wr * 64 + m * 16 + fr; float ss = 0.f;
#pragma unroll
                for (int bj = 0; bj < 2; ++bj)
#pragma unroll
                    for (int n = 0; n < 2; ++n) ss += epi2_4(p, row, u.pn * 256 + bj * 128 + wc * 32 + n * 16 + 4 * fq, acc[ai][bj][m][n]);
                ss += __shfl_xor(ss, 16); ss += __shfl_xor(ss, 32);
                if (fq == 0) atomicAdd(p.SS + row, ss); }
    } };
struct Epi3 { static constexpr bool PERM = false, AFTER_DRAIN = false; P3 p;
    __device__ __forceinline__ void operator()(const pg8::f32x4 (&acc)[2][2][4][2], const pg8::Unit& u, int wr, int wc, int fr, int fq) const {
#pragma unroll
        for (int ai = 0; ai < 2; ++ai)
#pragma unroll
            for (int m = 0; m < 4; ++m) { const int row = u.pm * 256 + ai * 128 + wr * 64 + m * 16 + fr;
                const float rstd = 1.0f / sqrtf(__hip_atomic_load(p.SS + row, __ATOMIC_RELAXED, __HIP_MEMORY_SCOPE_AGENT) * (1.f / DM) + EPS);
#pragma unroll
                for (int bj = 0; bj < 2; ++bj)
#pragma unroll
                    for (int n = 0; n < 2; ++n) epi3_4(p, row, u.pn * 256 + bj * 128 + wc * 32 + n * 16 + 4 * fq, acc[ai][bj][m][n], rstd); }
    } };
struct Epi4 { static constexpr bool PERM = false, AFTER_DRAIN = false; P4 p;
    __device__ __forceinline__ void operator()(const pg8::f32x4 (&acc)[2][2][4][2], const pg8::Unit& u, int wr, int wc, int fr, int fq) const {
#pragma unroll
        for (int ai = 0; ai < 2; ++ai)
#pragma unroll
            for (int m = 0; m < 4; ++m) { const int row = u.pm * 256 + ai * 128 + wr * 64 + m * 16 + fr; float ss = 0.f;
#pragma unroll
                for (int bj = 0; bj < 2; ++bj)
#pragma unroll
                    for (int n = 0; n < 2; ++n) ss += epi4_4(p, row, u.pn * 256 + bj * 128 + wc * 32 + n * 16 + 4 * fq, acc[ai][bj][m][n]);
                ss += __shfl_xor(ss, 16); ss += __shfl_xor(ss, 32);
                if (fq == 0) atomicAdd(p.SS + row, ss); }
    } };

template <class EpiF>
__device__ __forceinline__ void sgemm_unit(const bf16* A, const bf16* WT, int u, int wave, int lane, const EpiF& epi) {
    const int fr = lane & 15, fq = lane >> 4;
    const GAS bf16x8* wp = (const GAS bf16x8*)(WT + (size_t)(16 * u + fr) * DM + 8 * fq);
    const GAS bf16x8* ap = (const GAS bf16x8*)(A + (size_t)(MP + 16 * wave + fr) * DM + 8 * fq);
    pg8::f32x4 acc = {0.f, 0.f, 0.f, 0.f};
#pragma unroll 1
    for (int k0 = 0; k0 < 32; k0 += 8) {
        bf16x8 wv[8], av[8];
#pragma unroll
        for (int i = 0; i < 8; ++i) { wv[i] = wp[(k0 + i) * 4]; av[i] = ap[(k0 + i) * 4]; }
#pragma unroll
        for (int i = 0; i < 8; ++i) acc = __builtin_amdgcn_mfma_f32_16x16x32_bf16(wv[i], av[i], acc, 0, 0, 0);
    }
    epi(MP + 16 * wave + fr, 16 * u + 4 * fq, acc);
}

typedef float f32x2_t __attribute__((ext_vector_type(2)));
typedef __bf16 bf16x2_t __attribute__((ext_vector_type(2)));
__device__ __forceinline__ unsigned cvtpk_s(float lo, float hi) { f32x2_t v = {lo, hi}; bf16x2_t b = __builtin_convertvector(v, bf16x2_t); return __builtin_bit_cast(unsigned, b); }
__device__ __forceinline__ bf16x8 pack8f(f32x4 a, f32x4 b) { v4u w = {cvtpk_s(a[0], a[1]), cvtpk_s(a[2], a[3]), cvtpk_s(b[0], b[1]), cvtpk_s(b[2], b[3])}; return __builtin_bit_cast(bf16x8, w); }
typedef short s16x4 __attribute__((ext_vector_type(4)));

struct LaArgs {
    const bf16* Q; const bf16* Kp; const float* G;
    const bf16* V; const bf16* GATE; int ldv;
    const float* gain;
    bf16* MIXo; int mixoff;
    float* SBUF; float* BTOT;
    const float* S0; float* S1;
};
template <int DV, bool HAS_K, int MODE>
__device__ __forceinline__ void la_unit(LAS unsigned char* lds, const LaArgs& a, int m0, int h, int tid, int wave, int lane) {
    constexpr int NVT = DV / 128, NCH = MODE == 2 ? 1 : 4, TV = MODE == 2 ? 4 : 64;
    constexpr bool FULL = MODE != 0;
    constexpr int A1_OFF = 0, K1_OFF = 17408, K2T_OFF = 34816, VT_OFF = 53248, P_OFF = VT_OFF + DV * 144, TOT_OFF = P_OFF + 9216, EBR_OFF = TOT_OFF + 2048, EBL_OFF = EBR_OFF + 512, SSQ_OFF = EBL_OFF + 512;
    static_assert(SSQ_OFF + 2048 <= RING_BYTES, "LA LDS");
    const int c = tid & 127, seg = tid >> 7, fr = lane & 15, fq = lane >> 4, vbase = wave * (DV / 8);
    LAS float* TOT = (LAS float*)(lds + TOT_OFF); LAS float* EBR = (LAS float*)(lds + EBR_OFF); LAS float* EBL = (LAS float*)(lds + EBL_OFF); LAS float* SSQ = (LAS float*)(lds + SSQ_OFF);
    f32x4 S[8][NVT];
#pragma unroll
    for (int kt = 0; kt < 8; ++kt)
#pragma unroll
        for (int vt = 0; vt < NVT; ++vt) {
            if (MODE == 0) S[kt][vt] = (f32x4){0.f, 0.f, 0.f, 0.f};
            else if (MODE == 1) S[kt][vt] = *(const GAS f32x4*)(a.SBUF + ((size_t)((wave * 8 + kt) * NVT + vt) * 64 + lane) * 4);
            else { const int v = vbase + 16 * vt + fr;
#pragma unroll
                for (int j = 0; j < 4; ++j) S[kt][vt][j] = a.S0[(size_t)(16 * kt + 4 * fq + j) * DV + v]; }
        }
    float btot_run = 0.f;
#pragma unroll 1
    for (int ch = 0; ch < NCH; ++ch) {
        const int mr0 = m0 + 64 * ch;
        float g[16], kv[16], qv[16];
#pragma unroll
        for (int i = 0; i < 16; ++i) { const int t = 16 * seg + i; const bool ok = t < TV; const size_t off = (size_t)(mr0 + t) * 512 + h * 128 + c;
            g[i] = ok ? a.G[off] : 0.f;
            if (FULL) qv[i] = ok ? bf2f(a.Q[off]) : 0.f;
            if (HAS_K) kv[i] = ok ? bf2f(a.Kp[off]) : 0.f; }
#pragma unroll
        for (int i = 0; i < 16; ++i) { if (!HAS_K) kv[i] = 1.0f - __expf(g[i]); if (i) g[i] += g[i - 1]; }
        TOT[seg * 128 + c] = g[15];
        __syncthreads();
        const float t0 = TOT[c], t1 = TOT[128 + c], t2 = TOT[256 + c], t3 = TOT[384 + c];
        const float pre = seg == 0 ? 0.f : seg == 1 ? t0 : seg == 2 ? t0 + t1 : t0 + t1 + t2;
        const float bl = (t0 + t1) + (t2 + t3), bref = t0 + t1;
        if (seg == 0) { EBR[c] = __expf(bref); EBL[c] = __expf(bl); btot_run += bl; }
        {   v4u k2a, k2b; unsigned k2w[8];
#pragma unroll
            for (int i = 0; i < 16; i += 2) { const float b0 = g[i] + pre, b1 = g[i + 1] + pre;
                k2w[i >> 1] = cvtpk_s(kv[i] * __expf(bl - b0), kv[i + 1] * __expf(bl - b1));
                if (FULL) { const int t = 16 * seg + i;
                    *(LAS bf16*)(lds + A1_OFF + ((t) * 136 + c) * 2) = (bf16)(cvtpk_s(qv[i] * __expf(b0 - bref), 0.f) & 0xffffu);
                    *(LAS bf16*)(lds + A1_OFF + ((t + 1) * 136 + c) * 2) = (bf16)(cvtpk_s(qv[i + 1] * __expf(b1 - bref), 0.f) & 0xffffu);
                    *(LAS bf16*)(lds + K1_OFF + ((t) * 136 + c) * 2) = (bf16)(cvtpk_s(kv[i] * __expf(bref - b0), 0.f) & 0xffffu);
                    *(LAS bf16*)(lds + K1_OFF + ((t + 1) * 136 + c) * 2) = (bf16)(cvtpk_s(kv[i + 1] * __expf(bref - b1), 0.f) & 0xffffu); } }
            k2a = (v4u){k2w[0], k2w[1], k2w[2], k2w[3]}; k2b = (v4u){k2w[4], k2w[5], k2w[6], k2w[7]};
            *(LAS v4u*)(lds + K2T_OFF + (c * 72 + 16 * seg) * 2) = k2a; *(LAS v4u*)(lds + K2T_OFF + (c * 72 + 16 * seg + 8) * 2) = k2b; }
#pragma unroll
        for (int ps = 0; ps < NVT; ++ps) { const int v = 128 * ps + c; unsigned short vv[16];
#pragma unroll
            for (int i = 0; i < 16; ++i) { const int t = 16 * seg + i; vv[i] = (t < TV) ? a.V[(size_t)(mr0 + t) * a.ldv + h * DV + v] : (unsigned short)0; }
            v4u wa, wb;
            wa.x = vv[0] | ((unsigned)vv[1] << 16); wa.y = vv[2] | ((unsigned)vv[3] << 16); wa.z = vv[4] | ((unsigned)vv[5] << 16); wa.w = vv[6] | ((unsigned)vv[7] << 16);
            wb.x = vv[8] | ((unsigned)vv[9] << 16); wb.y = vv[10] | ((unsigned)vv[11] << 16); wb.z = vv[12] | ((unsigned)vv[13] << 16); wb.w = vv[14] | ((unsigned)vv[15] << 16);
            *(LAS v4u*)(lds + VT_OFF + (v * 72 + 16 * seg) * 2) = wa; *(LAS v4u*)(lds + VT_OFF + (v * 72 + 16 * seg + 8) * 2) = wb; }
        __syncthreads();
        if (FULL) {
            const int tt = wave >> 1, st0 = 2 * (wave & 1);
            f32x4 p0 = {0.f, 0.f, 0.f, 0.f}, p1 = {0.f, 0.f, 0.f, 0.f};
#pragma unroll
            for (int ks = 0; ks < 4; ++ks) {
                const bf16x8 av = *(const LAS bf16x8*)(lds + A1_OFF + ((16 * tt + fr) * 136 + 32 * ks + 8 * fq) * 2);
                const bf16x8 b0 = *(const LAS bf16x8*)(lds + K1_OFF + ((16 * st0 + fr) * 136 + 32 * ks + 8 * fq) * 2);
                const bf16x8 b1 = *(const LAS bf16x8*)(lds + K1_OFF + ((16 * (st0 + 1) + fr) * 136 + 32 * ks + 8 * fq) * 2);
                p0 = __builtin_amdgcn_mfma_f32_16x16x32_bf16(av, b0, p0, 0, 0, 0);
                p1 = __builtin_amdgcn_mfma_f32_16x16x32_bf16(av, b1, p1, 0, 0, 0);
            }
#pragma unroll
            for (int j = 0; j < 4; ++j) { const int t = 16 * tt + 4 * fq + j, s0 = 16 * st0 + fr, s1 = s0 + 16;
                const float x0 = (s0 <= t) ? p0[j] : 0.f, x1 = (s1 <= t) ? p1[j] : 0.f;
                *(LAS bf16*)(lds + P_OFF + (t * 72 + s0) * 2) = (bf16)(cvtpk_s(x0, 0.f) & 0xffffu);
                *(LAS bf16*)(lds + P_OFF + (t * 72 + s1) * 2) = (bf16)(cvtpk_s(x1, 0.f) & 0xffffu); }
            __syncthreads();
        }
        bf16x8 vb[NVT][2];
#pragma unroll
        for (int vt = 0; vt < NVT; ++vt)
#pragma unroll
            for (int ks = 0; ks < 2; ++ks) vb[vt][ks] = *(const LAS bf16x8*)(lds + VT_OFF + ((vbase + 16 * vt + fr) * 72 + 32 * ks + 8 * fq) * 2);
        f32x4 o[4][NVT];
        if (FULL) {
#pragma unroll
            for (int tt = 0; tt < 4; ++tt)
#pragma unroll
                for (int vt = 0; vt < NVT; ++vt) o[tt][vt] = (f32x4){0.f, 0.f, 0.f, 0.f};
#pragma unroll
            for (int tt = 0; tt < 4; ++tt)
#pragma unroll
                for (int ks = 0; ks < 2; ++ks) { const bf16x8 pa = *(const LAS bf16x8*)(lds + P_OFF + ((16 * tt + fr) * 72 + 32 * ks + 8 * fq) * 2);
#pragma unroll
                    for (int vt = 0; vt < NVT; ++vt) o[tt][vt] = __builtin_amdgcn_mfma_f32_16x16x32_bf16(pa, vb[vt][ks], o[tt][vt], 0, 0, 0); }
#pragma unroll
            for (int ks = 0; ks < 4; ++ks) {
                const f32x4 e0 = *(const LAS f32x4*)(EBR + 32 * ks + 4 * fq), e1 = *(const LAS f32x4*)(EBR + 32 * ks + 16 + 4 * fq);
                bf16x8 sb[NVT];
#pragma unroll
                for (int vt = 0; vt < NVT; ++vt) sb[vt] = pack8f(S[2 * ks][vt] * e0, S[2 * ks + 1][vt] * e1);
#pragma unroll
                for (int tt = 0; tt < 4; ++tt) {
                    const s16x4 alo = *(const LAS s16x4*)(lds + A1_OFF + ((16 * tt + fr) * 136 + 32 * ks + 4 * fq) * 2);
                    const s16x4 ahi = *(const LAS s16x4*)(lds + A1_OFF + ((16 * tt + fr) * 136 + 32 * ks + 16 + 4 * fq) * 2);
                    const bf16x8 aa = __builtin_shufflevector(alo, ahi, 0, 1, 2, 3, 4, 5, 6, 7);
#pragma unroll
                    for (int vt = 0; vt < NVT; ++vt) o[tt][vt] = __builtin_amdgcn_mfma_f32_16x16x32_bf16(aa, sb[vt], o[tt][vt], 0, 0, 0);
                }
            }
        }
#pragma unroll
        for (int kt = 0; kt < 8; ++kt) {
            const f32x4 el = *(const LAS f32x4*)(EBL + 16 * kt + 4 * fq);
#pragma unroll
            for (int vt = 0; vt < NVT; ++vt) S[kt][vt] = S[kt][vt] * el;
#pragma unroll
            for (int ks = 0; ks < 2; ++ks) { const bf16x8 ka = *(const LAS bf16x8*)(lds + K2T_OFF + ((16 * kt + fr) * 72 + 32 * ks + 8 * fq) * 2);
#pragma unroll
                for (int vt = 0; vt < NVT; ++vt) S[kt][vt] = __builtin_amdgcn_mfma_f32_16x16x32_bf16(ka, vb[vt][ks], S[kt][vt], 0, 0, 0); }
        }
        if (FULL) {
#pragma unroll
            for (int tt = 0; tt < 4; ++tt) { f32x4 ss = {0.f, 0.f, 0.f, 0.f};
#pragma unroll
                for (int vt = 0; vt < NVT; ++vt) ss += o[tt][vt] * o[tt][vt];
#pragma unroll
                for (int j = 0; j < 4; ++j) { float x = ss[j]; x += __shfl_xor(x, 1); x += __shfl_xor(x, 2); x += __shfl_xor(x, 4); x += __shfl_xor(x, 8); ss[j] = x; }
                if (fr == 0) *(LAS f32x4*)(SSQ + wave * 64 + 16 * tt + 4 * fq) = ss; }
            __syncthreads();
#pragma unroll
            for (int tt = 0; tt < 4; ++tt) {
                if (MODE == 2 && tt > 0) break;
                f32x4 tot = {0.f, 0.f, 0.f, 0.f};
#pragma unroll
                for (int w = 0; w < 8; ++w) tot += *(const LAS f32x4*)(SSQ + w * 64 + 16 * tt + 4 * fq);
#pragma unroll
                for (int j = 0; j < 4; ++j) { const int t = 16 * tt + 4 * fq + j; if (t >= TV) continue;
                    const float rstd = 1.0f / sqrtf(tot[j] * (1.0f / DV) + EPS);
#pragma unroll
                    for (int vt = 0; vt < NVT; ++vt) { const int v = vbase + 16 * vt + fr; const size_t row = (size_t)(mr0 + t);
                        const float val = o[tt][vt][j] * rstd * a.gain[h * DV + v] * bf2f(a.GATE[row * a.ldv + h * DV + v]);
                        a.MIXo[row * 1024 + a.mixoff + h * DV + v] = (bf16)(cvtpk_s(val, 0.f) & 0xffffu); } }
            }
        }
        __syncthreads();
    }
    if (MODE == 0) {
#pragma unroll
        for (int kt = 0; kt < 8; ++kt)
#pragma unroll
            for (int vt = 0; vt < NVT; ++vt) *(GAS f32x4*)(a.SBUF + ((size_t)((wave * 8 + kt) * NVT + vt) * 64 + lane) * 4) = S[kt][vt];
        if (seg == 0) a.BTOT[c] = btot_run;
    }
    if (MODE == 2) {
#pragma unroll
        for (int kt = 0; kt < 8; ++kt)
#pragma unroll
            for (int vt = 0; vt < NVT; ++vt) { const int v = vbase + 16 * vt + fr;
#pragma unroll
                for (int j = 0; j < 4; ++j) a.S1[(size_t)(16 * kt + 4 * fq + j) * DV + v] = S[kt][vt][j]; }
    }
}

template <int DV>
__device__ __forceinline__ void la_scan(float* SLOC, const float* BTOT, float* outstate, int gtid, int gthreads) {
    constexpr int NVT = DV / 128, L = 16384 * NVT;
    for (int eg = gtid; eg < 8 * L; eg += gthreads) {
        const int bh = eg / L, e = eg % L;
        const int j = e & 3, ln = (e >> 2) & 63, rest = e >> 8, vt = rest % NVT, kt = (rest / NVT) & 7, w = rest / (NVT * 8);
        const int k = 16 * kt + 4 * (ln >> 4) + j, v = w * (DV / 8) + 16 * vt + (ln & 15);
        float loc[32], dec[32];
#pragma unroll
        for (int sc = 0; sc < 32; ++sc) { loc[sc] = SLOC[(size_t)(bh * 32 + sc) * L + e]; dec[sc] = BTOT[(size_t)(bh * 32 + sc) * 128 + k]; }
        float cur = 0.f;
#pragma unroll
        for (int sc = 0; sc < 32; ++sc) { SLOC[(size_t)(bh * 32 + sc) * L + e] = cur; cur = cur * __expf(dec[sc]) + loc[sc]; }
        outstate[(size_t)(bh * 128 + k) * DV + v] = cur;
    }
}

namespace fox {
using TIN = __hip_bfloat16; using TOUT = __hip_bfloat16;
constexpr int D = 128, SKV = 8192, WINDOW = SKV; constexpr float THR = 8.f; constexpr bool WSKIP = false;
constexpr int OSTR = 1024, GSTR = 512;
constexpr float SCALE = 0.08838834764831845f;
constexpr int NW = 8, QBLK = 32, KVBLK = 64, QB = NW * QBLK;
constexpr int SHM_V = KVBLK * D * 2, SHM_K = KVBLK * D * 2;
constexpr int LDS_BIAS = 2 * SHM_V + 2 * SHM_K + NW * 64 * 4;
constexpr int LDS_BYTES = LDS_BIAS + 512;
constexpr int ORS = 136, OST_WAVE = 32 * ORS * 2, OST_OFF = 69632;

using bf16 = __hip_bfloat16;
typedef short bf16x8 __attribute__((ext_vector_type(8)));
typedef short s16x4 __attribute__((ext_vector_type(4)));
typedef float f32x16 __attribute__((ext_vector_type(16)));
typedef float f32x4 __attribute__((ext_vector_type(4)));
typedef unsigned u32x4 __attribute__((ext_vector_type(4)));
template <class A, class Bt> struct same_t { static constexpr bool v = false; };
template <class A> struct same_t<A, A> { static constexpr bool v = true; };

#define KSWZ(row, colB) ((row) * 256 + ((colB) ^ (((row) & 7) << 4)))
#define SBAR() __builtin_amdgcn_sched_barrier(0)
__device__ __forceinline__ int v_st(int k, int c) { const int kk = (k & ~0xC) | ((k & 4) << 1) | ((k & 8) >> 1); return ((kk >> 3) * 4 + (c >> 5)) * 512 + ((kk & 7) * 32 + (c & 31)) * 2; }
__device__ __forceinline__ int v_rd_base(int lane) { return ((lane & 3) << 3) | (((lane >> 2) & 3) << 6) | (((lane >> 4) & 1) << 5) | (((lane >> 5) & 1) << 8); }
constexpr int v_rd_off(int d0, int ks, int half) { return d0 * 512 + ks * 4096 + half * 2048; }
__device__ __forceinline__ int crow(int r, int hi) { return (r & 3) + 8 * (r >> 2) + 4 * hi; }
__device__ __forceinline__ unsigned cvtpk(float lo, float hi) {
    unsigned r; asm volatile("v_cvt_pk_bf16_f32 %0, %1, %2" : "=v"(r) : "v"(lo), "v"(hi)); return r;
}
__device__ __forceinline__ bf16x8 pack8(f32x4 a, f32x4 b) {
    u32x4 w = {cvtpk(a[0], a[1]), cvtpk(a[2], a[3]), cvtpk(b[0], b[1]), cvtpk(b[2], b[3])};
    return *reinterpret_cast<bf16x8*>(&w);
}
template <class T> __device__ __forceinline__ bf16x8 load8(const T* p) {
    if constexpr (same_t<T, float>::v) { return pack8(*(const f32x4*)p, *(const f32x4*)(p + 4)); }
    else { return *reinterpret_cast<const bf16x8*>(p); }
}
__device__ __forceinline__ void mask_tile(f32x16& p0, f32x16& p1, int dq, unsigned W) {
    const float NEG = -__builtin_inff();
#pragma unroll
    for (int r = 0; r < 16; ++r) {
        const int c = (r & 3) + 8 * (r >> 2);
        if ((unsigned)(dq - c) >= W) p0[r] = NEG;
        if ((unsigned)(dq - c - 32) >= W) p1[r] = NEG;
    }
}
__device__ __forceinline__ void partialSM(f32x16& p0, f32x16& p1, float& m_reg, float& mn, float& alpha) {
    float pmax = p0[0]; for (int r = 1; r < 16; ++r) pmax = fmaxf(pmax, p0[r]); for (int r = 0; r < 16; ++r) pmax = fmaxf(pmax, p1[r]);
    { auto rr = __builtin_amdgcn_permlane32_swap(__float_as_uint(pmax), __float_as_uint(pmax), false, false);
      pmax = fmaxf(__uint_as_float(rr[0]), __uint_as_float(rr[1])); }
    constexpr float C2 = 1.4426950408889634f * SCALE;
    if (__builtin_expect(__all((pmax - m_reg) * SCALE <= THR), 1)) { mn = m_reg; alpha = 1.f; }
    else { mn = fmaxf(m_reg, pmax); alpha = __builtin_amdgcn_exp2f((m_reg - mn) * C2); m_reg = mn; }
    const float mnL = -mn * C2;
    for (int r = 0; r < 16; ++r) p0[r] = fmaf(p0[r], C2, mnL); for (int r = 0; r < 16; ++r) p1[r] = fmaf(p1[r], C2, mnL);
    for (int r = 0; r < 16; ++r) p0[r] = __builtin_amdgcn_exp2f(p0[r]);
}
__device__ __forceinline__ void finishSM(f32x16& p0, f32x16& p1, float alpha, float& l_reg, bf16x8& pa0, bf16x8& pa1, bf16x8& pa2, bf16x8& pa3) {
    for (int r = 0; r < 16; ++r) p1[r] = __builtin_amdgcn_exp2f(p1[r]);
    float ps = 0; for (int r = 0; r < 16; ++r) ps += p0[r]; for (int r = 0; r < 16; ++r) ps += p1[r];
    { auto rr = __builtin_amdgcn_permlane32_swap(__float_as_uint(ps), __float_as_uint(ps), false, false);
      ps = __uint_as_float(rr[0]) + __uint_as_float(rr[1]); }
    l_reg = l_reg * alpha + ps;
#define PK4(P, B_, OUT) do { unsigned a0 = cvtpk(P[B_+0], P[B_+1]), a1 = cvtpk(P[B_+2], P[B_+3]);                          \
        unsigned b0 = cvtpk(P[B_+4], P[B_+5]), b1 = cvtpk(P[B_+6], P[B_+7]);                                             \
        auto r0 = __builtin_amdgcn_permlane32_swap(a0, b0, false, false); auto r1 = __builtin_amdgcn_permlane32_swap(a1, b1, false, false); \
        u32x4 w = {r0[0], r1[0], r0[1], r1[1]}; OUT = *reinterpret_cast<bf16x8*>(&w); } while (0)
    PK4(p0, 0, pa0); PK4(p0, 8, pa1); PK4(p1, 0, pa2); PK4(p1, 8, pa3);
#undef PK4
}
template <int KB, bool SK>
__device__ __forceinline__ void qkt(f32x16& p0, f32x16& p1, const char* K_lds, int r32, int hi, const char* qs, bool act) {
    if (SK && !act) { const float NEG = -__builtin_inff();
#pragma unroll
        for (int r = 0; r < 16; ++r) { p0[r] = NEG; p1[r] = NEG; } return; }
    p0 = f32x16{}; p1 = f32x16{};
    const char* kb[4];
#pragma unroll
    for (int dd = 0; dd < 4; ++dd) kb[dd] = K_lds + KB * SHM_K + KSWZ(r32, (dd * 16 + hi * 8) * 2);
#pragma unroll
    for (int d0 = 0; d0 < 8; ++d0) { const char* a = kb[d0 & 3] + (d0 >> 2) * 128;
        bf16x8 b0 = *reinterpret_cast<const bf16x8*>(a);
        bf16x8 b1 = *reinterpret_cast<const bf16x8*>(a + 32 * 256);
        const bf16x8 qv = *reinterpret_cast<const bf16x8*>(qs + d0 * 32);
        p0 = __builtin_amdgcn_mfma_f32_32x32x16_bf16(b0, qv, p0, 0, 0, 0);
        p1 = __builtin_amdgcn_mfma_f32_32x32x16_bf16(b1, qv, p1, 0, 0, 0); }
}
template <int VB, bool SK>
__device__ __forceinline__ void pv_tile(f32x16* o, int vb0, bf16x8 pa0, bf16x8 pa1, bf16x8 pa2, bf16x8 pa3, bool act) {
    if (SK && !act) return;
#define TRRD(dst, off) asm volatile("ds_read_b64_tr_b16 %0, %1 offset:%2" : "=&v"(dst) : "v"(vb0), "i"(off) : "memory")
#define PV_D0(d0) do { s16x4 l0, l1, l2, l3, h0, h1, h2, h3; constexpr int b_ = VB * SHM_V + v_rd_off(d0, 0, 0);     \
        TRRD(l0, b_); TRRD(h0, b_ + 2048); TRRD(l1, b_ + 4096); TRRD(h1, b_ + 6144); TRRD(l2, b_ + 8192); TRRD(h2, b_ + 10240); TRRD(l3, b_ + 12288); TRRD(h3, b_ + 14336); \
        asm volatile("s_waitcnt lgkmcnt(0)" ::: "memory"); SBAR();                 \
        o[d0] = __builtin_amdgcn_mfma_f32_32x32x16_bf16(pa0, (bf16x8){l0[0], l0[1], l0[2], l0[3], h0[0], h0[1], h0[2], h0[3]}, o[d0], 0, 0, 0);   \
        o[d0] = __builtin_amdgcn_mfma_f32_32x32x16_bf16(pa1, (bf16x8){l1[0], l1[1], l1[2], l1[3], h1[0], h1[1], h1[2], h1[3]}, o[d0], 0, 0, 0);   \
        o[d0] = __builtin_amdgcn_mfma_f32_32x32x16_bf16(pa2, (bf16x8){l2[0], l2[1], l2[2], l2[3], h2[0], h2[1], h2[2], h2[3]}, o[d0], 0, 0, 0);   \
        o[d0] = __builtin_amdgcn_mfma_f32_32x32x16_bf16(pa3, (bf16x8){l3[0], l3[1], l3[2], l3[3], h3[0], h3[1], h3[2], h3[3]}, o[d0], 0, 0, 0); } while (0)
    PV_D0(0); PV_D0(1); PV_D0(2); PV_D0(3);
#undef PV_D0
#undef TRRD
}

template <class TIn, class TOut> struct BlockRef { const TIn* Q; const TIn* K; const TIn* V; TOut* O; int P0; const float* CB; const TIn* G; };
template <class TIn> struct Seam {
    bf16x8 qr[8];
    bf16x8 st_v0, st_v1, st_k0, st_k1; f32x4 sf0, sf1, sf2, sf3; float st_b;
    f32x4 tq[16];
};
__device__ __forceinline__ int swa_jlo(int P0, int W) { const int lowk = P0 - W + 1; return lowk > 0 ? lowk / KVBLK : 0; }
#define ROW(p, k0, rr) ((p) + (size_t)(k0) * D + (unsigned)((rr) * D + sc))
#define VMW() asm volatile("s_waitcnt vmcnt(0)" ::: "memory")
#define VMWN(n) asm volatile("s_waitcnt vmcnt(%0)" :: "i"(n) : "memory")
#define SLOAD_H(Kp, Vp, Cp, k0) do { S.st_v0 = load8<TIn>(ROW(Vp, k0, sr)); S.st_v1 = load8<TIn>(ROW(Vp, k0, 32 + sr));              \
                         S.st_k0 = load8<TIn>(ROW(Kp, k0, sr)); S.st_k1 = load8<TIn>(ROW(Kp, k0, 32 + sr)); S.st_b = ((Cp) + (k0))[(unsigned)(tid & 63)]; } while (0)
#define SWRITE_HK(bf) do { *(bf16x8*)(K_lds + (bf) * SHM_K + kws) = S.st_k0; *(bf16x8*)(K_lds + (bf) * SHM_K + kws + 32 * 256) = S.st_k1; if (tid < 64) *(float*)(K_lds + 2 * SHM_K + NW * 64 * 4 + (bf) * 256 + tid * 4) = S.st_b; } while (0)
#define SWRITE_HV(bf) do { *(bf16x8*)(V_lds + (bf) * SHM_V + vst0) = S.st_v0; *(bf16x8*)(V_lds + (bf) * SHM_V + vst1) = S.st_v1; } while (0)
#define SWRITE_H(bf) do { SWRITE_HV(bf); SWRITE_HK(bf); } while (0)
#define SLOAD_F(p, k0) do { S.sf0 = *(const f32x4*)ROW(p, k0, sr); S.sf1 = *(const f32x4*)(ROW(p, k0, sr) + 4);                \
                            S.sf2 = *(const f32x4*)ROW(p, k0, 32 + sr); S.sf3 = *(const f32x4*)(ROW(p, k0, 32 + sr) + 4); } while (0)
#define SWRITE_KF(bf) do { *(bf16x8*)(K_lds + (bf) * SHM_K + kws) = pack8(S.sf0, S.sf1); *(bf16x8*)(K_lds + (bf) * SHM_K + kws + 32 * 256) = pack8(S.sf2, S.sf3); } while (0)
#define SWRITE_VF(bf) do { *(bf16x8*)(V_lds + (bf) * SHM_V + vst0) = pack8(S.sf0, S.sf1); *(bf16x8*)(V_lds + (bf) * SHM_V + vst1) = pack8(S.sf2, S.sf3); } while (0)
template <class TIn, class TOut>
__device__ __forceinline__ void causal_swa_prime(const BlockRef<TIn, TOut>& cur, int W, char* lds, Seam<TIn>& S) {
    constexpr bool F32 = same_t<TIn, float>::v;
    const int tid = threadIdx.x, wid = __builtin_amdgcn_readfirstlane(tid >> 6), lane = tid & 63, r32 = lane & 31, hi = lane >> 5;
    const int sr = tid >> 4, sc = (tid & 15) * 8, kws = KSWZ(sr, sc * 2); char* K_lds = lds + 2 * SHM_V;
    const int kb0 = swa_jlo(cur.P0, W) * KVBLK;
    for (int d0 = 0; d0 < 8; ++d0) S.qr[d0] = load8<TIn>(cur.Q + (size_t)(wid * QBLK + r32) * D + d0 * 16 + hi * 8);
    if constexpr (F32) { SLOAD_F((const float*)cur.K, kb0); VMW(); SWRITE_KF(0); SBAR(); SLOAD_F((const float*)cur.V, kb0); }
    else { SLOAD_H(cur.K, cur.V, cur.CB, kb0); VMW(); SWRITE_HK(0); }
    { char* const qsw = lds + OST_OFF + wid * OST_WAVE + r32 * ORS * 2 + hi * 16;
#pragma unroll
      for (int d0 = 0; d0 < 8; ++d0) *reinterpret_cast<bf16x8*>(qsw + d0 * 32) = S.qr[d0]; }
    __syncthreads();
}
template <class TIn, class TOut>
__device__ __forceinline__ void causal_swa_block(const BlockRef<TIn, TOut>& cur, const BlockRef<TIn, TOut>& nxt, int skv, int W, char* lds, Seam<TIn>& S) {
    constexpr bool F32 = same_t<TIn, float>::v;
    const int tid = threadIdx.x, wid = __builtin_amdgcn_readfirstlane(tid >> 6), lane = tid & 63, r32 = lane & 31, hi = lane >> 5;
    const int j_lo = swa_jlo(cur.P0, W);
    int j_hi = (cur.P0 + QB - 1) / KVBLK + 1; if (j_hi > skv / KVBLK) j_hi = skv / KVBLK;
    const int NT = j_hi - j_lo;
    const int kbn = swa_jlo(nxt.P0, W) * KVBLK;
    const int qlo = cur.P0 + wid * QBLK, qm = qlo + r32 - 4 * hi;
    char* V_lds = lds; char* K_lds = lds + 2 * SHM_V;
    float* ws = (float*)(lds + 2 * SHM_V + 2 * SHM_K) + wid * 64; float* li_l = ws, * al_l = ws + 32;
    float m_reg = -1e30f, l_reg = 0; f32x16 o[4] = {};
    const int sr = tid >> 4, sc = (tid & 15) * 8, vst0 = v_st(sr, sc), vst1 = v_st(32 + sr, sc), kws = KSWZ(sr, sc * 2);
    const int vb0 = (int)(uintptr_t)V_lds + v_rd_base(lane);
    char* const qs = lds + OST_OFF + wid * OST_WAVE + r32 * ORS * 2 + hi * 16;
    const TIn* Kh = cur.K; const TIn* Vh = cur.V; const float* Ch = cur.CB;
#define RESC(a) do { if (__any((a) < 1.f)) { if (hi == 0) al_l[r32] = (a); asm volatile("s_waitcnt lgkmcnt(0)" ::: "memory");              \
                     for (int d_ = 0; d_ < 4; ++d_) for (int r = 0; r < 16; ++r) o[d_][r] *= al_l[crow(r, hi)]; } } while (0)
#define KBASE(t) ((j_lo + (t)) * KVBLK)
#define ACT(t) (KBASE(t) <= qlo + QBLK - 1 && KBASE(t) + KVBLK - 1 >= qlo - W + 1)
#define MASKT(P0_, P1_, t) do { const int kb_ = KBASE(t); if ((!SK || ACT(t)) && (kb_ + KVBLK - 1 > qlo || kb_ <= qlo + QBLK - 1 - W)) mask_tile(P0_, P1_, qm - kb_, (unsigned)W); } while (0)
#define BIASADD(P0_, P1_, KB_) do { const float* bl_ = (const float*)(K_lds + 2 * SHM_K + NW * 64 * 4 + (KB_) * 256) + 4 * hi;                    \
        _Pragma("unroll") for (int g_ = 0; g_ < 4; ++g_) { const f32x4 b0_ = *(const f32x4*)(bl_ + 8 * g_), b1_ = *(const f32x4*)(bl_ + 32 + 8 * g_); \
            _Pragma("unroll") for (int i_ = 0; i_ < 4; ++i_) { P0_[4 * g_ + i_] += b0_[i_]; P1_[4 * g_ + i_] += b1_[i_]; } } } while (0)
    constexpr int NQL = F32 ? 16 : 0;
    constexpr bool SK = WSKIP && !F32;
#define SEAM_K0() do { VMWN(NQL); if constexpr (F32) { SWRITE_KF(0); SBAR(); SLOAD_F((const float*)nxt.V, kbn); } else { SWRITE_HK(0); } SBAR(); } while (0)
    f32x16 pA0, pA1, pB0, pB1; float mnA, mnB, alA, alB; bf16x8 pa0, pa1, pa2, pa3;
    if constexpr (F32) { VMW(); SWRITE_VF(0); SBAR(); } else { SWRITE_HV(0); SBAR(); }
    if (NT > 1) { if constexpr (F32) SLOAD_F((const float*)Kh, KBASE(1)); else SLOAD_H(Kh, Vh, Ch, KBASE(1)); }
    SBAR(); qkt<0, SK>(pA0, pA1, K_lds, r32, hi, qs, ACT(0));
    if constexpr (F32) { if (NT > 1) { VMW(); SWRITE_KF(1); SBAR(); SLOAD_F((const float*)Vh, KBASE(1)); } }
    BIASADD(pA0, pA1, 0); MASKT(pA0, pA1, 0); partialSM(pA0, pA1, m_reg, mnA, alA);
    if (NT > 1) { VMW(); if constexpr (F32) { SWRITE_VF(1); SBAR(); if (NT > 2) SLOAD_F((const float*)Kh, KBASE(2)); } else SWRITE_H(1); }
    __syncthreads();
#define HALF_STEP(PX0, PX1, mnX, alX, PY0, PY1, alY, t, KB, VB, SB) do {                                                      \
        SBAR(); qkt<KB, SK>(PX0, PX1, K_lds, r32, hi, qs, ACT(t));                                             \
        finishSM(PY0, PY1, alY, l_reg, pa0, pa1, pa2, pa3); SBAR();                                                           \
        if ((t) + 1 < NT) { if constexpr (F32) { VMW(); SWRITE_KF(SB); SBAR(); SLOAD_F((const float*)Vh, KBASE((t) + 1)); }  \
                            else { SLOAD_H(Kh, Vh, Ch, KBASE((t) + 1)); } SBAR(); }                                               \
        pv_tile<VB, SK>(o, vb0, pa0, pa1, pa2, pa3, ACT((t) - 1)); BIASADD(PX0, PX1, KB); MASKT(PX0, PX1, (t)); partialSM(PX0, PX1, m_reg, mnX, alX);                                        \
        __syncthreads();                                                                                                      \
        if ((t) + 1 < NT) { VMW(); if constexpr (F32) { SWRITE_VF(SB); SBAR(); if ((t) + 2 < NT) SLOAD_F((const float*)Kh, KBASE((t) + 2)); } \
                            else { SWRITE_H(SB); } }                                                                          \
        RESC(alX); __syncthreads(); } while (0)
    for (int t = 1; t + 1 < NT; t += 2) {
        HALF_STEP(pB0, pB1, mnB, alB, pA0, pA1, alA, t, 1, 0, 0);
        HALF_STEP(pA0, pA1, mnA, alA, pB0, pB1, alB, t + 1, 0, 1, 1);
    }
    const bool even = (NT & 1) == 0;
    if (even) { SBAR(); qkt<1, SK>(pB0, pB1, K_lds, r32, hi, qs, ACT(NT - 1)); SBAR(); }
#define QROW(e) (nxt.Q + (size_t)(wid * QBLK + r32) * D + ((e) >> 1) * 16 + hi * 8 + ((e) & 1) * 4)
    if constexpr (F32) { SLOAD_F((const float*)nxt.K, kbn); SBAR();
#pragma unroll
        for (int e = 0; e < 8; ++e) S.tq[e] = *(const f32x4*)QROW(e); }
    else { SLOAD_H(nxt.K, nxt.V, nxt.CB, kbn); SBAR(); }
    SBAR();
    finishSM(pA0, pA1, alA, l_reg, pa0, pa1, pa2, pa3); SBAR();
    if constexpr (F32) {
#pragma unroll
        for (int e = 8; e < 16; ++e) S.tq[e] = *(const f32x4*)QROW(e); SBAR(); }
#undef QROW
    pv_tile<0, SK>(o, vb0, pa0, pa1, pa2, pa3, ACT(even ? NT - 2 : NT - 1));
    if (even) { BIASADD(pB0, pB1, 1); MASKT(pB0, pB1, NT - 1); partialSM(pB0, pB1, m_reg, mnB, alB); __syncthreads(); RESC(alB);
        finishSM(pB0, pB1, alB, l_reg, pa0, pa1, pa2, pa3); SBAR(); pv_tile<1, SK>(o, vb0, pa0, pa1, pa2, pa3, ACT(NT - 1)); }
    SBAR(); SEAM_K0();
    {
    int tz = threadIdx.x; asm volatile("" : "+v"(tz));
    const int lane_e = tz & 63, wid_e = __builtin_amdgcn_readfirstlane(tz >> 6), r32_e = lane_e & 31, hi_e = lane_e >> 5;
    float* li_e = (float*)(lds + 2 * SHM_V + 2 * SHM_K) + wid_e * 64;
    if (hi_e == 0) li_e[r32_e] = l_reg; asm volatile("s_waitcnt lgkmcnt(0)" ::: "memory");
    float rli[16];
#pragma unroll
    for (int r = 0; r < 16; ++r) rli[r] = __builtin_amdgcn_rcpf(li_e[crow(r, hi_e)]);
    char* ost = lds + OST_OFF + wid_e * OST_WAVE;
    {   char* ob = ost + (4 * hi_e * ORS + r32_e) * 2;
#pragma unroll
        for (int r = 0; r < 16; ++r) {
#pragma unroll
            for (int d0 = 0; d0 < 4; ++d0) { const float v = o[d0][r] * rli[r]; const float vn = __shfl_xor(v, 1);
                if ((r32_e & 1) == 0) *(unsigned*)(ob + (((r & 3) + 8 * (r >> 2)) * ORS + d0 * 32) * 2) = cvtpk(v, vn); } } }
    asm volatile("s_waitcnt lgkmcnt(0)" ::: "memory");
    if constexpr (!F32) {
        const TIn* qn = nxt.Q + (size_t)(wid_e * QBLK + r32_e) * D + hi_e * 8;
#pragma unroll
        for (int d0 = 0; d0 < 8; ++d0) S.qr[d0] = load8<TIn>(qn + d0 * 16); }
    {   const int orow = lane_e >> 4, och = lane_e & 15;
        const TOut* Ow_c = cur.O + (size_t)(wid_e * QBLK + orow) * OSTR + och * 8; TOut* Ow = const_cast<TOut*>(Ow_c);
        const TIn* Gw = cur.G + (size_t)(wid_e * QBLK + orow) * GSTR + och * 8;
#pragma unroll
        for (int i = 0; i < 8; ++i) {
            const u32x4 ov = *(const u32x4*)(ost + (4 * i + orow) * ORS * 2 + och * 16);
            const u32x4 gv = *(const u32x4*)(Gw + (size_t)(4 * i) * GSTR);
            u32x4 w;
#pragma unroll
            for (int k = 0; k < 4; ++k) w[k] = cvtpk(__uint_as_float(ov[k] << 16) * __uint_as_float(gv[k] << 16), __uint_as_float(ov[k] & 0xffff0000u) * __uint_as_float(gv[k] & 0xffff0000u));
            *(u32x4*)(Ow + (size_t)(4 * i) * OSTR) = w; } }
    if constexpr (!F32) {
        char* qsw = ost + r32_e * ORS * 2 + hi_e * 16;
#pragma unroll
        for (int d0 = 0; d0 < 8; ++d0) *reinterpret_cast<bf16x8*>(qsw + d0 * 32) = S.qr[d0]; }
    }
    if constexpr (F32) {
#pragma unroll
        for (int d0 = 0; d0 < 8; ++d0) S.qr[d0] = pack8(S.tq[2 * d0], S.tq[2 * d0 + 1]); }
    __syncthreads();
#undef RESC
#undef KBASE
#undef ACT
#undef MASKT
#undef SEAM_K0
#undef BIASADD
#undef HALF_STEP
}
#undef ROW
#undef VMW
#undef VMWN
#undef SLOAD_H
#undef SWRITE_HK
#undef SWRITE_HV
#undef SWRITE_H
#undef SLOAD_F
#undef SWRITE_KF
#undef SWRITE_VF


}

namespace dec {
constexpr int D = 128, PG16 = 16, WAVES = 4, GE = 4, GEP = 4, HPL = 1, NSPLIT = 4, TOK_STRIDE = 512;
constexpr int PPW = (PAST / PG16) / NSPLIT / WAVES;
constexpr int LDS_P = 0, LDS_MRG = WAVES * 64 * HPL, MRG_REC = 4 + D, LDS_FLOATS = LDS_MRG + WAVES * GEP * MRG_REC + 4;
using bf16x2 = __attribute__((ext_vector_type(2))) __bf16;
using u32x4  = __attribute__((ext_vector_type(4))) unsigned;
using f32x4  = __attribute__((ext_vector_type(4))) float;
using f32x8  = __attribute__((ext_vector_type(8))) float;
__device__ __forceinline__ float dot2(unsigned k, unsigned q, float acc) { return __builtin_amdgcn_fdot2_f32_bf16(__builtin_bit_cast(bf16x2, k), __builtin_bit_cast(bf16x2, q), acc, false); }
__device__ __forceinline__ unsigned cvtpk(float lo, float hi) { unsigned r; asm volatile("v_cvt_pk_bf16_f32 %0, %1, %2" : "=v"(r) : "v"(lo), "v"(hi)); return r; }
template <int CTRL> __device__ __forceinline__ float dpp(float x) { return __builtin_bit_cast(float, __builtin_amdgcn_mov_dpp(__builtin_bit_cast(int, x), CTRL, 0xf, 0xf, true)); }
constexpr int XOR1 = 0xB1, XOR2 = 0x4E, XOR7 = 0x141, XOR8 = 0x128, ROR4 = 0x124;
__device__ __forceinline__ float xrow16_max(float x) {
  auto s = __builtin_amdgcn_permlane16_swap(__float_as_uint(x), __float_as_uint(x), false, false);
  x = fmaxf(__uint_as_float(s[0]), __uint_as_float(s[1]));
  auto t = __builtin_amdgcn_permlane32_swap(__float_as_uint(x), __float_as_uint(x), false, false);
  return fmaxf(__uint_as_float(t[0]), __uint_as_float(t[1]));
}
__device__ __forceinline__ float xrow16_sum(float x) {
  auto s = __builtin_amdgcn_permlane16_swap(__float_as_uint(x), __float_as_uint(x), false, false);
  x = __uint_as_float(s[0]) + __uint_as_float(s[1]);
  auto t = __builtin_amdgcn_permlane32_swap(__float_as_uint(x), __float_as_uint(x), false, false);
  return __uint_as_float(t[0]) + __uint_as_float(t[1]);
}
__device__ __forceinline__ f32x8 ld8(const float* p) { return __builtin_nontemporal_load(reinterpret_cast<const f32x8*>(p)); }
__device__ __forceinline__ u32x4 tobf(f32x8 x) { u32x4 w = {cvtpk(x[0], x[1]), cvtpk(x[2], x[3]), cvtpk(x[4], x[5]), cvtpk(x[6], x[7])}; return w; }

struct DecArgs { const float* q; const float* k; const float* v; const int* pt; const float* sufx; float* pml; float* po; };

__device__ __forceinline__ void decode_unit(const DecArgs& a, int b, int kvh, int s, float* lds, int wave, int lane) {
  const int r = lane >> 4, c = lane & 15;
  constexpr float C2 = ATT_SCALE * 1.4426950408889634f;
  const int sp0 = s * (PAST / PG16 / NSPLIT);
  int btv = 0;
  if (lane < PPW) { const int sp = sp0 + wave + 4 * lane; btv = a.pt[b * NPAGES + (sp >> 3)] * 8 + (sp & 7); }
  u32x4 qpk[GEP];
#pragma unroll
  for (int g = 0; g < GEP; ++g) qpk[g] = tobf(*reinterpret_cast<const f32x8*>(a.q + ((size_t)(b * 4 + g) * 512 + kvh * D + 8 * c)));
  const size_t loff = (size_t)r * TOK_STRIDE + 8 * c;
  const float* sufx = a.sufx + (size_t)(b * 4 + kvh) * PAST + r + 4 * (c >> 2);
#define PAGE_BASE(spid) ((size_t)(spid) * (PG16 * TOK_STRIDE) + (size_t)kvh * D)
#define ISSUE(i_) do { const int phys_ = __builtin_amdgcn_readlane(btv, (i_)); const float* kb_ = a.k + PAGE_BASE(phys_) + loff; const float* vb_ = a.v + PAGE_BASE(phys_) + loff; \
    _Pragma("unroll") for (int t_ = 0; t_ < 4; ++t_) { Kn[t_] = ld8(kb_ + (size_t)t_ * 4 * TOK_STRIDE); Vn[t_] = ld8(vb_ + (size_t)t_ * 4 * TOK_STRIDE); } \
    bn = sufx[(sp0 + wave + 4 * (i_)) * PG16]; } while (0)
  f32x8 Kn[4], Vn[4]; float bn;
  float m[HPL], l[HPL], acc[GEP * 8];
#pragma unroll
  for (int j = 0; j < HPL; ++j) { m[j] = -INFINITY; l[j] = 0.f; }
#pragma unroll
  for (int k = 0; k < GEP * 8; ++k) acc[k] = 0.f;
  ISSUE(0);
  for (int i = 0; i < PPW; ++i) {
    u32x4 Kc[4], Vc[4];
#pragma unroll
    for (int t = 0; t < 4; ++t) { Kc[t] = tobf(Kn[t]); Vc[t] = tobf(Vn[t]); }
    const float bias = bn;
    if (i + 1 < PPW) ISSUE(i + 1);
    float x[4 * GEP];
#pragma unroll
    for (int t = 0; t < 4; ++t)
#pragma unroll
      for (int g = 0; g < GEP; ++g) { float d = 0.f;
#pragma unroll
          for (int k = 0; k < 4; ++k) d = dot2(Kc[t][k], qpk[g][k], d);
        x[t * GEP + g] = d; }
#define TR_STEP(HALF, CTRL, BIT) _Pragma("unroll") for (int h = 0; h < (HALF); ++h) _Pragma("unroll") for (int j = 0; j < HPL; ++j) { \
      const float lo_ = x[h * HPL + j], hi_ = x[(h + (HALF)) * HPL + j]; const float t1_ = lo_ + dpp<CTRL>(lo_), t2_ = hi_ + dpp<CTRL>(hi_); \
      x[h * HPL + j] = (c & (BIT)) ? t2_ : t1_; }
    TR_STEP(8, XOR8, 8) TR_STEP(4, XOR7, 4) TR_STEP(2, XOR2, 2) TR_STEP(1, XOR1, 1)
#undef TR_STEP
    float p[HPL], alpha[HPL];
#pragma unroll
    for (int j = 0; j < HPL; ++j) {
      const float sc = x[j] * C2 + bias;
      float pm = sc; pm = fmaxf(pm, dpp<ROR4>(pm)); pm = fmaxf(pm, dpp<XOR8>(pm)); pm = xrow16_max(pm);
      const float mn = fmaxf(m[j], pm), msub = (mn == -INFINITY) ? 0.f : mn;
      alpha[j] = __builtin_amdgcn_exp2f(m[j] - msub); p[j] = __builtin_amdgcn_exp2f(sc - msub);
      l[j] = fmaf(l[j], alpha[j], p[j]); m[j] = mn;
    }
#pragma unroll
    for (int q4 = 0; q4 < 4; ++q4)
#pragma unroll
      for (int j = 0; j < HPL; ++j) {
        const float al = q4 == 0 ? dpp<0x00>(alpha[j]) : q4 == 1 ? dpp<0x55>(alpha[j]) : q4 == 2 ? dpp<0xAA>(alpha[j]) : dpp<0xFF>(alpha[j]);
#pragma unroll
        for (int k = 0; k < 8; ++k) acc[(q4 * HPL + j) * 8 + k] *= al; }
    float* prow = lds + LDS_P + (wave * 4 + r) * 16 * HPL;
#pragma unroll
    for (int j = 0; j < HPL; ++j) prow[c * HPL + j] = p[j];
    asm volatile("s_waitcnt lgkmcnt(0)" ::: "memory");
    f32x4 pr[GEP];
#pragma unroll
    for (int u = 0; u < GEP; ++u) pr[u] = *reinterpret_cast<const f32x4*>(prow + 4 * u);
#pragma unroll
    for (int t = 0; t < 4; ++t) {
      float vf[8];
#pragma unroll
      for (int k = 0; k < 4; ++k) { vf[2 * k] = __builtin_bit_cast(float, Vc[t][k] << 16); vf[2 * k + 1] = __builtin_bit_cast(float, Vc[t][k] & 0xffff0000u); }
#pragma unroll
      for (int g = 0; g < GE; ++g) { const float pg_ = pr[(t * GEP + g) >> 2][(t * GEP + g) & 3];
#pragma unroll
        for (int k = 0; k < 8; ++k) acc[g * 8 + k] = fmaf(pg_, vf[k], acc[g * 8 + k]); } }
  }
#undef ISSUE
#undef PAGE_BASE
#pragma unroll
  for (int k = 0; k < GE * 8; ++k) acc[k] = xrow16_sum(acc[k]);
#pragma unroll
  for (int j = 0; j < HPL; ++j) { float t = l[j]; t += dpp<ROR4>(t); t += dpp<XOR8>(t); l[j] = xrow16_sum(t); }
  float* mrg = lds + LDS_MRG;
  if (r == 0) {
#pragma unroll
    for (int g = 0; g < GE; ++g) {
      float* rec = mrg + (wave * GEP + g) * MRG_REC;
#pragma unroll
      for (int k = 0; k < 8; k += 4) *reinterpret_cast<f32x4*>(rec + 4 + 8 * c + k) = f32x4{acc[g * 8 + k], acc[g * 8 + k + 1], acc[g * 8 + k + 2], acc[g * 8 + k + 3]};
      if (c == g / HPL) { rec[0] = m[g % HPL]; rec[1] = l[g % HPL]; } } }
  __syncthreads();
  {
    const int g = wave, d0 = 2 * lane;
    const size_t row = (size_t)(b * 4 + kvh) * 4 + g;
    float M = -INFINITY;
#pragma unroll
    for (int w = 0; w < WAVES; ++w) M = fmaxf(M, mrg[(w * GEP + g) * MRG_REC]);
    float L = 0.f, o0 = 0.f, o1 = 0.f;
#pragma unroll
    for (int w = 0; w < WAVES; ++w) { const float* rec = mrg + (w * GEP + g) * MRG_REC; const float lw = rec[1];
      const float wt = (lw > 0.f) ? __builtin_amdgcn_exp2f(rec[0] - M) : 0.f;
      L = fmaf(wt, lw, L); o0 = fmaf(wt, rec[4 + d0], o0); o1 = fmaf(wt, rec[4 + d0 + 1], o1); }
    const size_t slot = row * NSPLIT + s;
    *reinterpret_cast<float2*>(a.po + slot * D + d0) = make_float2(o0, o1);
    if (lane == 0) *reinterpret_cast<float2*>(a.pml + 2 * slot) = make_float2(M, L);
  }
  __syncthreads();
}

struct CombArgs { const float* pml; const float* po; const float* q; const float* knew; const float* vnew; const float* lfb; const unsigned short* gate; unsigned short* mix; };
__device__ __forceinline__ void combine_row(const CombArgs& a, int b, int h, int t, int lane) {
  constexpr float C2 = ATT_SCALE * 1.4426950408889634f;
  const size_t row = (size_t)(b * 4 + h) * 4 + t; const int d0 = 2 * lane;
  const float* pml = a.pml + row * NSPLIT * 2; const float* po = a.po + row * NSPLIT * D;
  const float2 qv = *reinterpret_cast<const float2*>(a.q + (size_t)(b * 4 + t) * 512 + h * D + d0);
  float scn[4]; float cum = 0.f;
#pragma unroll
  for (int s = 0; s < 4; ++s) {
    const float2 kv = *reinterpret_cast<const float2*>(a.knew + (size_t)(b * 4 + s) * 512 + h * D + d0);
    float d = qv.x * kv.x + qv.y * kv.y;
#pragma unroll
    for (int o = 1; o < 64; o <<= 1) d += __shfl_xor(d, o);
    cum += a.lfb[(size_t)(MP + b * 4 + s) * 4 + h];
    scn[s] = (s <= t) ? d * C2 - cum * LOG2E : -INFINITY;
  }
  float M = -INFINITY;
#pragma unroll
  for (int s = 0; s < NSPLIT; ++s) M = fmaxf(M, pml[2 * s]);
#pragma unroll
  for (int s = 0; s < 4; ++s) M = fmaxf(M, scn[s]);
  float L = 0.f, o0 = 0.f, o1 = 0.f;
#pragma unroll
  for (int s = 0; s < NSPLIT; ++s) { const float ls = pml[2 * s + 1], w = (ls > 0.f) ? __builtin_amdgcn_exp2f(pml[2 * s] - M) : 0.f;
    const float2 av = *reinterpret_cast<const float2*>(po + (size_t)s * D + d0);
    L = fmaf(w, ls, L); o0 = fmaf(w, av.x, o0); o1 = fmaf(w, av.y, o1); }
#pragma unroll
  for (int s = 0; s < 4; ++s) { const float w = __builtin_amdgcn_exp2f(scn[s] - M);
    const float2 vv = *reinterpret_cast<const float2*>(a.vnew + (size_t)(b * 4 + s) * 512 + h * D + d0);
    L += w; o0 = fmaf(w, vv.x, o0); o1 = fmaf(w, vv.y, o1); }
  const float inv = 1.f / L;
  const size_t ms = (size_t)(MP + b * 4 + t);
  const unsigned gp = *reinterpret_cast<const unsigned*>(a.gate + ms * 512 + h * D + d0);
  const float g0 = __uint_as_float(gp << 16), g1 = __uint_as_float(gp & 0xffff0000u);
  *reinterpret_cast<unsigned*>(a.mix + ms * 1024 + 512 + h * D + d0) = cvtpk(o0 * inv * g0, o1 * inv * g1);
}
}

__device__ __forceinline__ void p6_rpass(Frame& F) {
    LAS float* WRt = (LAS float*)(F.lds + RING_OFF);
    LAS float* WGl = (LAS float*)(F.lds + RING_OFF + 65536);
    const float* WR = WSP(float, WS_WR);
    for (int e = F.tid; e < 16384; e += 512) WRt[(e & 15) * 1024 + (e >> 4)] = WR[e];
    for (int e = F.tid; e < 8192; e += 512) WGl[e] = F.w_gla_gate[e];
    __syncthreads();
    const int gw = (int)blockIdx.x * NWAVES + F.wave, NGW = F.G * NWAVES;
    const float* X1 = WSP(float, WS_X1); float* GF3 = WSP(float, WS_GF3); const float* SS1 = (const float*)(F.ctl + CW_SS1);
    for (int m = gw; m < MT; m += NGW) {
        const GAS f32x4* xr = (const GAS f32x4*)(X1 + (size_t)m * DM) + F.lane;
        f32x4 v[4];
#pragma unroll
        for (int j = 0; j < 4; ++j) v[j] = xr[64 * j];
        const float rstd = 1.0f / sqrtf(SS1[m] * (1.f / DM) + EPS);
        LAS float* rb = (LAS float*)(F.lds + RING_OFF + 98304) + F.wave * 16;
#pragma unroll 1
        for (int jj = 0; jj < 16; ++jj) { float s = 0.f;
#pragma unroll
            for (int j = 0; j < 4; ++j) { const f32x4 w = *(const LAS f32x4*)(WRt + jj * 1024 + 4 * F.lane + 256 * j); s += (v[j].x * w.x + v[j].y * w.y) + (v[j].z * w.z + v[j].w * w.w); }
            s = wave_sum(s) * rstd; if (F.lane == 0) rb[jj] = s; }
        LDS_WAIT(); asm volatile("" ::: "memory");
#pragma unroll
        for (int cc = 0; cc < 2; ++cc) { const int c0 = 4 * F.lane + 256 * cc; f32x4 acc = *(const GAS f32x4*)(F.b_gla_gate + c0);
#pragma unroll 4
            for (int jj = 0; jj < 16; ++jj) acc += rb[jj] * *(const LAS f32x4*)(WGl + jj * 512 + c0);
            f32x4 lf; lf.x = log_sigmoidf_(acc.x) * 0.0625f; lf.y = log_sigmoidf_(acc.y) * 0.0625f; lf.z = log_sigmoidf_(acc.z) * 0.0625f; lf.w = log_sigmoidf_(acc.w) * 0.0625f;
            *(GAS f32x4*)(GF3 + (size_t)m * 512 + c0) = lf; }
    }
    __syncthreads();
}
__device__ __forceinline__ void p11_final(Frame& F) {
    const int gw = (int)blockIdx.x * NWAVES + F.wave, NGW = F.G * NWAVES;
    const float* SS2 = (const float*)(F.ctl + CW_SS2);
    for (int m = gw; m < MT; m += NGW) {
        GAS f32x4* yr = (GAS f32x4*)(F.out + O_Y + (size_t)m * DM) + F.lane;
        const float rstd = 1.0f / sqrtf(SS2[m] * (1.f / DM) + EPS);
#pragma unroll
        for (int j = 0; j < 4; ++j) { const f32x4 g = *(const GAS f32x4*)(F.final_norm + 4 * F.lane + 256 * j); yr[64 * j] = yr[64 * j] * rstd * g; }
    }
}

struct SE1 { P1 p; __device__ __forceinline__ void operator()(int m, int c, f32x4 v) const { epi1_4(p, m, c, v); } };
struct SE2 { P2 p; __device__ __forceinline__ void operator()(int m, int c, f32x4 v) const { float ss = epi2_4(p, m, c, v); ss += __shfl_xor(ss, 16); ss += __shfl_xor(ss, 32); if (((c >> 2) & 3) == 0) atomicAdd(p.SS + m, ss); } };
struct SE3 { P3 p; __device__ __forceinline__ void operator()(int m, int c, f32x4 v) const { const float rstd = 1.0f / sqrtf(p.SS[m] * (1.f / DM) + EPS); epi3_4(p, m, c, v, rstd); } };
struct SE4 { P4 p; __device__ __forceinline__ void operator()(int m, int c, f32x4 v) const { float ss = epi4_4(p, m, c, v); ss += __shfl_xor(ss, 16); ss += __shfl_xor(ss, 32); if (((c >> 2) & 3) == 0) atomicAdd(p.SS + m, ss); } };
typedef fox::BlockRef<fox::TIN, fox::TOUT> FoxRef;
__device__ __forceinline__ FoxRef fox_ref(unsigned char* ws, int bh, int qb) {
    const fox::TIN* Q = (const fox::TIN*)(ws + WS_QBH); const fox::TIN* K = (const fox::TIN*)(ws + WS_KBH); const fox::TIN* V = (const fox::TIN*)(ws + WS_VBH);
    const int b = bh >> 2, h = bh & 3; FoxRef r;
    r.Q = Q + ((size_t)bh * SEQ + (size_t)qb * 256) * 128; r.K = K + (size_t)bh * SEQ * 128; r.V = V + (size_t)bh * SEQ * 128;
    r.O = (fox::TOUT*)(ws + WS_MIX) + ((size_t)(b * SEQ + qb * 256)) * 1024 + 512 + h * 128; r.G = (const fox::TIN*)(ws + WS_GB) + ((size_t)(b * SEQ + qb * 256)) * 512 + h * 128;
    r.CB = (const float*)(ws + WS_CB) + (size_t)bh * SEQ; r.P0 = qb * 256; return r;
}

#ifndef MK_N_LAUNCHES
#define MK_N_LAUNCHES 1
#endif
constexpr int N_LAUNCHES = MK_N_LAUNCHES;
constexpr int N_PHASES = 12;
struct Args { const void* in[21]; float* out; unsigned char* ws; int ph_lo, ph_hi; };
__global__ void __launch_bounds__(NWAVES * 64, 2) hybrid_fwd(Args args) {
    extern __shared__ __attribute__((aligned(16))) unsigned char lds[];
    Frame F;
    F.lds = (LAS unsigned char*)lds;
    F.MISC = (volatile LAS unsigned*)(F.lds + MISC_OFF);
    F.tid = threadIdx.x; F.lane = F.tid & 63; F.wave = __builtin_amdgcn_readfirstlane(F.tid >> 6);
    F.G = gridDim.x;
    F.ws = args.ws; F.out = args.out; F.ctl = (gu32*)(args.ws + WS_CTL);
    F.xp = (const float*)args.in[0]; F.xs = (const float*)args.in[1]; F.ck = (const float*)args.in[2]; F.cv = (const float*)args.in[3]; F.clf = (const float*)args.in[4];
    F.sh = (const float*)args.in[5]; F.sg = (const float*)args.in[6]; F.pt = (const int*)args.in[7];
    F.norm_even = (const float*)args.in[8]; F.w_in_even = (const float*)args.in[9]; F.b_fox = (const float*)args.in[10]; F.lb_logits = (const float*)args.in[11];
    F.hgrn_gain = (const float*)args.in[12]; F.w_out_even = (const float*)args.in[13]; F.norm_odd = (const float*)args.in[14]; F.w_in_odd = (const float*)args.in[15];
    F.w_gla_gate = (const float*)args.in[16]; F.b_gla_gate = (const float*)args.in[17]; F.gla_gain = (const float*)args.in[18]; F.w_out_odd = (const float*)args.in[19]; F.final_norm = (const float*)args.in[20];
    for (int u = F.tid; u < (LDS_BYTES - LDSCTL_OFF) / 4; u += NWAVES * 64) ((LAS unsigned*)(F.lds + LDSCTL_OFF))[u] = 0u;
    __syncthreads();
    XcdBarrier bar; bar.bar = (unsigned*)(F.ctl + CW_BAR); bar.x = 0; bar.st = nullptr;
    if (N_LAUNCHES == 1) bar = xcd_barrier_post((unsigned*)(F.ctl + CW_BAR), F.MISC + 8);
#define GRID_BAR() do { if (N_LAUNCHES == 1) xcd_barrier(bar); } while (0)
    const int lo = args.ph_lo, hi = args.ph_hi;
#ifndef SUB_MASK
#define SUB_MASK 7
#endif
#ifndef PH_MASK
#define PH_MASK 0xFFF
#endif
#define IN(k) ((((PH_MASK) >> (k)) & 1) && lo <= (k) && (k) < hi)
#define BOTH(k) (IN(k) && IN((k) + 1))
    const int bid = blockIdx.x;

    if (IN(0)) { p0_prologue(F); if (BOTH(0)) GRID_BAR(); }

    if (IN(1)) {
        if (bid < 8) fox_cumsum_unit(F, bid);
        P1 p{WSP(bf16, WS_QA), WSP(bf16, WS_IA), WSP(bf16, WS_GA), WSP(bf16, WS_GB), WSP(bf16, WS_QBH), WSP(bf16, WS_KBH), WSP(bf16, WS_VBH), WSP(float, WS_GF), WSP(float, WS_QS), WSP(float, WS_LB), F.out};
        { pg8::Gemm g{WSP(bf16, WS_XN), WSP(bf16, WS_W1T), MP, 4096, DM}; pg8::StaticOrder S; S.init(MP, 4096, F.G, bid);
          Epi1 E{p};
          pg8::gemm_phase<Epi1, pg8::StaticOrder, true, true>(F.lds + RING_OFF, g, S, E); }
        for (int u = bid; u < 256; u += F.G)
            sgemm_unit(WSP(bf16, WS_XN), WSP(bf16, WS_W1T), u, F.wave, F.lane, SE1{p});
        if (BOTH(1)) GRID_BAR();
    }

    if (IN(2)) {
        const int half = F.G / 2;
        if (bid < half) {
            if (SUB_MASK & 1) for (int L = bid; L < 128; L += half) {
                const int bh = L & 7, x = L >> 3;
                const FoxRef b0 = fox_ref(F.ws, bh, x), b1 = fox_ref(F.ws, bh, 31 - x);
                fox::Seam<fox::TIN> S;
                fox::causal_swa_prime<fox::TIN, fox::TOUT>(b0, fox::WINDOW, (char*)lds + RING_OFF, S);
                FoxRef cur = b0; int pass = 0;
                for (;;) { const bool last = pass == 1; const FoxRef nxt = last ? cur : b1;
                    fox::causal_swa_block<fox::TIN, fox::TOUT>(cur, nxt, fox::SKV, fox::WINDOW, (char*)lds + RING_OFF, S);
                    if (last) break; cur = nxt; pass = 1; }
            }
        } else {
            const int cb = bid - half, nb = F.G - half;
            if (SUB_MASK & 2) { dec::DecArgs da{WSP(float, WS_QS), F.ck, F.cv, F.pt, WSP(float, WS_SUFX), WSP(float, WS_PML), WSP(float, WS_PO)};
              float* dl = (float*)(lds + RING_OFF) + (F.wave >> 2) * dec::LDS_FLOATS;
              for (int wu = cb; wu < 256; wu += nb) { const int du = 2 * wu + (F.wave >> 2); dec::decode_unit(da, du >> 4, (du >> 2) & 3, du & 3, dl, F.wave & 3, F.lane); } }
            __syncthreads();
            if (SUB_MASK & 4) { LaArgs a{}; a.Q = WSP(bf16, WS_QA); a.Kp = nullptr; a.G = WSP(float, WS_GF); a.V = WSP(bf16, WS_IA); a.GATE = WSP(bf16, WS_GA); a.ldv = 512; a.gain = F.hgrn_gain; a.MIXo = WSP(bf16, WS_MIX); a.mixoff = 0;
              for (int u = cb; u < 256; u += nb) { const int bh = u >> 5, sc = u & 31; a.SBUF = WSP(float, WS_SLOC) + (size_t)u * 16384; a.BTOT = WSP(float, WS_BTOT) + (size_t)u * 128;
                  la_unit<128, false, 0>(F.lds + RING_OFF, a, (bh >> 2) * SEQ + sc * 256, bh & 3, F.tid, F.wave, F.lane); }
              for (int u = cb; u < 128; u += nb) { a.S0 = F.sh + (size_t)u * 16384; a.S1 = F.out + O_HSS + (size_t)u * 16384;
                  la_unit<128, false, 2>(F.lds + RING_OFF, a, MP + (u >> 2) * 4, u & 3, F.tid, F.wave, F.lane); } }
        }
        if (BOTH(2)) GRID_BAR();
    }

    if (IN(3)) {
        la_scan<128>(WSP(float, WS_SLOC), WSP(float, WS_BTOT), F.out + O_HSP, bid * 512 + F.tid, F.G * 512);
        dec::CombArgs ca{WSP(float, WS_PML), WSP(float, WS_PO), WSP(float, WS_QS), F.out + O_KS, F.out + O_VS, WSP(float, WS_LFB), WSP(bf16, WS_GB), WSP(bf16, WS_MIX)};
        for (int r = bid * NWAVES + F.wave; r < 512; r += F.G * NWAVES) dec::combine_row(ca, r >> 4, (r >> 2) & 3, r & 3, F.lane);
        if (BOTH(3)) GRID_BAR();
    }

    if (IN(4)) {
        LaArgs a{}; a.Q = WSP(bf16, WS_QA); a.Kp = nullptr; a.G = WSP(float, WS_GF); a.V = WSP(bf16, WS_IA); a.GATE = WSP(bf16, WS_GA); a.ldv = 512; a.gain = F.hgrn_gain; a.MIXo = WSP(bf16, WS_MIX); a.mixoff = 0;
        for (int u = bid; u < 256; u += F.G) { const int bh = u >> 5, sc = u & 31; a.SBUF = WSP(float, WS_SLOC) + (size_t)u * 16384; a.BTOT = nullptr;
            la_unit<128, false, 1>(F.lds + RING_OFF, a, (bh >> 2) * SEQ + sc * 256, bh & 3, F.tid, F.wave, F.lane); }
        if (BOTH(4)) GRID_BAR();
    }

    if (IN(5)) {
        P2 p{F.xp, F.xs, WSP(float, WS_X1), WSP(bf16, WS_XN), (float*)(F.ctl + CW_SS1)};
        { pg8::Gemm g{WSP(bf16, WS_MIX), WSP(bf16, WS_W2T), MP, 1024, DM}; pg8::StaticOrder S; S.init(MP, 1024, F.G, bid);
          Epi2 E{p};
          pg8::gemm_phase<Epi2, pg8::StaticOrder, true, true>(F.lds + RING_OFF, g, S, E); }
        for (int u = bid; u < 64; u += F.G)
            sgemm_unit(WSP(bf16, WS_MIX), WSP(bf16, WS_W2T), u, F.wave, F.lane, SE2{p});
        if (BOTH(5)) GRID_BAR();
    }

    if (IN(6)) {
        if (SUB_MASK & 1) p6_rpass(F);
        P3 p{WSP(bf16, WS_Q3), WSP(bf16, WS_K3), WSP(bf16, WS_V3), WSP(bf16, WS_G3), (const float*)(F.ctl + CW_SS1)};
        if (SUB_MASK & 2) { pg8::Gemm g{WSP(bf16, WS_XN), WSP(bf16, WS_W3T), MP, 3072, DM}; pg8::StaticOrder S; S.init(MP, 3072, F.G, bid);
          Epi3 E{p};
          pg8::gemm_phase<Epi3, pg8::StaticOrder, true, true>(F.lds + RING_OFF, g, S, E); }
        if (SUB_MASK & 4) for (int u = bid; u < 192; u += F.G)
            sgemm_unit(WSP(bf16, WS_XN), WSP(bf16, WS_W3T), u, F.wave, F.lane, SE3{p});
        if (BOTH(6)) GRID_BAR();
    }

    if (IN(7)) {
        LaArgs a{}; a.Q = WSP(bf16, WS_Q3); a.Kp = WSP(bf16, WS_K3); a.G = WSP(float, WS_GF3); a.V = WSP(bf16, WS_V3); a.GATE = WSP(bf16, WS_G3); a.ldv = 1024; a.gain = F.gla_gain; a.MIXo = WSP(bf16, WS_MIX2); a.mixoff = 0;
        for (int u = bid; u < 256; u += F.G) { const int bh = u >> 5, sc = u & 31; a.SBUF = WSP(float, WS_SLOC3) + (size_t)u * 32768; a.BTOT = WSP(float, WS_BTOT) + 32768 + (size_t)u * 128;
            la_unit<256, true, 0>(F.lds + RING_OFF, a, (bh >> 2) * SEQ + sc * 256, bh & 3, F.tid, F.wave, F.lane); }
        for (int u = bid; u < 128; u += F.G) { a.S0 = F.sg + (size_t)u * 32768; a.S1 = F.out + O_GSS + (size_t)u * 32768;
            la_unit<256, true, 2>(F.lds + RING_OFF, a, MP + (u >> 2) * 4, u & 3, F.tid, F.wave, F.lane); }
        if (BOTH(7)) GRID_BAR();
    }
    if (IN(8)) {
        la_scan<256>(WSP(float, WS_SLOC3), WSP(float, WS_BTOT) + 32768, F.out + O_GSP, bid * 512 + F.tid, F.G * 512);
        if (BOTH(8)) GRID_BAR();
    }
    if (IN(9)) {
        LaArgs a{}; a.Q = WSP(bf16, WS_Q3); a.Kp = WSP(bf16, WS_K3); a.G = WSP(float, WS_GF3); a.V = WSP(bf16, WS_V3); a.GATE = WSP(bf16, WS_G3); a.ldv = 1024; a.gain = F.gla_gain; a.MIXo = WSP(bf16, WS_MIX2); a.mixoff = 0;
        for (int u = bid; u < 256; u += F.G) { const int bh = u >> 5, sc = u & 31; a.SBUF = WSP(float, WS_SLOC3) + (size_t)u * 32768; a.BTOT = nullptr;
            la_unit<256, true, 1>(F.lds + RING_OFF, a, (bh >> 2) * SEQ + sc * 256, bh & 3, F.tid, F.wave, F.lane); }
        if (BOTH(9)) GRID_BAR();
    }
    if (IN(10)) {
        P4 p{WSP(float, WS_X1), F.out + O_Y, (float*)(F.ctl + CW_SS2)};
        { pg8::Gemm g{WSP(bf16, WS_MIX2), WSP(bf16, WS_W4T), MP, 1024, DM}; pg8::StaticOrder S; S.init(MP, 1024, F.G, bid);
          Epi4 E{p};
          pg8::gemm_phase<Epi4, pg8::StaticOrder, true, true>(F.lds + RING_OFF, g, S, E); }
        for (int u = bid; u < 64; u += F.G)
            sgemm_unit(WSP(bf16, WS_MIX2), WSP(bf16, WS_W4T), u, F.wave, F.lane, SE4{p});
        if (BOTH(10)) GRID_BAR();
    }
    if (IN(11)) p11_final(F);
#undef IN
#undef BOTH
}

extern "C" void kernel_launch(void* const* d_in, const int* in_sizes, int n_in, void* d_out, int out_size, void* d_ws, size_t ws_size, hipStream_t stream) {
    static int grid = 0;
    if (grid == 0) {
        if (n_in != 21 || out_size != (int)O_END || ws_size < WS_END) { fprintf(stderr, "kernel_launch: unexpected problem (n_in %d out %d ws %zu)\n", n_in, out_size, ws_size); grid = -1; return; }
        int dev = 0, cus = 0, per_cu = 0;
        if (hipGetDevice(&dev) != hipSuccess || hipDeviceGetAttribute(&cus, hipDeviceAttributeMultiprocessorCount, dev) != hipSuccess) { grid = -1; return; }
        if (hipFuncSetAttribute((const void*)hybrid_fwd, hipFuncAttributeMaxDynamicSharedMemorySize, LDS_BYTES) != hipSuccess) { fprintf(stderr, "kernel_launch: hipFuncSetAttribute failed\n"); grid = -1; return; }
        if (hipOccupancyMaxActiveBlocksPerMultiprocessor(&per_cu, (const void*)hybrid_fwd, NWAVES * 64, LDS_BYTES) != hipSuccess || per_cu < 1)
            fprintf(stderr, "kernel_launch: occupancy query reports %d workgroups per CU\n", per_cu);
        (void)hipGetLastError();
        grid = cus;
    }
    if (grid < 0) return;
    if (hipMemsetAsync((char*)d_ws + WS_CTL, 0, CTL_ZERO_BYTES, stream) != hipSuccess) { fprintf(stderr, "kernel_launch: memset failed\n"); return; }
    Args a{};
    for (int i = 0; i < 21; ++i) a.in[i] = d_in[i];
    a.out = (float*)d_out; a.ws = (unsigned char*)d_ws;
    for (int li = 0; li < N_LAUNCHES; ++li) {
        a.ph_lo = (N_LAUNCHES == 1) ? 0 : li; a.ph_hi = (N_LAUNCHES == 1) ? N_PHASES : li + 1;
        hipLaunchKernelGGL(hybrid_fwd, dim3(grid), dim3(NWAVES * 64), LDS_BYTES, stream, a);
        const hipError_t le = hipPeekAtLastError();
        if (le != hipSuccess) { fprintf(stderr, "kernel_launch: launch %d failed: %s\n", li, hipGetErrorName(le)); break; }
    }
}
```

```cpp
#include <hip/hip_runtime.h>
#include <hip/hip_bf16.h>
#include <cstdio>
#include <cstdint>

constexpr int DM = 1024;
constexpr int SEQ = 8192, NB = 2;
constexpr int MP = NB * SEQ;
constexpr int DB = 32, DT = 4;
constexpr int MS = DB * DT;
constexpr int MT = MP + MS;
constexpr int MTP = 16640;
constexpr int EVEN_IN = 4100, ODD_IN = 3088;
constexpr int NH = 4, HD = 128;
constexpr int PAST = 8192, PAGE = 128, NPAGES = PAST / PAGE;
constexpr float EPS = 1e-6f;
constexpr float ATT_SCALE = 0.08838834764831845f;
constexpr float LOG2E = 1.4426950408889634f;

constexpr size_t O_Y = 0;
constexpr size_t O_KP = (size_t)MT * DM;
constexpr size_t O_VP = O_KP + (size_t)MP * 512;
constexpr size_t O_LFP = O_VP + (size_t)MP * 512;
constexpr size_t O_HSP = O_LFP + (size_t)MP * 4;
constexpr size_t O_GSP = O_HSP + (size_t)NB * NH * 128 * 128;
constexpr size_t O_KS = O_GSP + (size_t)NB * NH * 128 * 256;
constexpr size_t O_VS = O_KS + (size_t)MS * 512;
constexpr size_t O_LFS = O_VS + (size_t)MS * 512;
constexpr size_t O_HSS = O_LFS + (size_t)MS * 4;
constexpr size_t O_GSS = O_HSS + (size_t)DB * NH * 128 * 128;
constexpr size_t O_END = O_GSS + (size_t)DB * NH * 128 * 256;
static_assert(O_END == 40567296, "output size");

constexpr size_t MiB = 1u << 20;
constexpr size_t WS_CTL = 0, CTL_ZERO_BYTES = 1 * MiB;
constexpr size_t WS_W1T = 2 * MiB;
constexpr size_t WS_W2T = 10 * MiB;
constexpr size_t WS_W3T = 12 * MiB;
constexpr size_t WS_W4T = 18 * MiB;
constexpr size_t WS_LB = 20 * MiB;
constexpr size_t WS_LFB = 20 * MiB + 65536;
constexpr size_t WS_CB = 21 * MiB;
constexpr size_t WS_SUFX = 22 * MiB;
constexpr size_t WS_PML = 26 * MiB;
constexpr size_t WS_PO = 26 * MiB + 65536;
constexpr size_t WS_BTOT = 28 * MiB;
constexpr size_t WS_WR = 29 * MiB;
constexpr size_t WS_XN = 32 * MiB;
constexpr size_t WS_QA = 66 * MiB;
constexpr size_t WS_IA = 84 * MiB;
constexpr size_t WS_GA = 102 * MiB;
constexpr size_t WS_GB = 120 * MiB;
constexpr size_t WS_GF = 138 * MiB;
constexpr size_t WS_QBH = 172 * MiB;
constexpr size_t WS_KBH = 188 * MiB;
constexpr size_t WS_VBH = 204 * MiB;
constexpr size_t WS_QS = 220 * MiB;
constexpr size_t WS_MIX = 224 * MiB;
constexpr size_t WS_CBP = 258 * MiB;
constexpr size_t WS_SLOC = 324 * MiB;
constexpr size_t WS_Q3 = 342 * MiB;
constexpr size_t WS_K3 = 360 * MiB;
constexpr size_t WS_V3 = 378 * MiB;
constexpr size_t WS_G3 = 412 * MiB;
constexpr size_t WS_GF3 = 446 * MiB;
constexpr size_t WS_SLOC3 = 480 * MiB;
constexpr size_t WS_MIX2 = 512 * MiB;
constexpr size_t WS_END = 546 * MiB;
constexpr int CW_TMO = 0;
constexpr int CW_BAR = 4096;
constexpr int CW_FLAG = 8192;
constexpr int CW_TAIL = 8192 + 64;
constexpr int CW_BAR2 = 12288;
constexpr int CW_SS1 = 16384;
constexpr int CW_SS2 = 40960;
static_assert((CW_SS2 + MT) * 4 <= (int)CTL_ZERO_BYTES, "CTL");

constexpr int RING_OFF = 0, RING_BYTES = 131072;
constexpr int LDSCTL_OFF = 146944, MISC_OFF = LDSCTL_OFF + 320;
constexpr int LDS_BYTES = 147456;
constexpr int NWAVES = 8;
namespace pg8 {
#define PG8_LAS __attribute__((address_space(3)))
typedef unsigned short bf16_t;
typedef short bf16x8 __attribute__((ext_vector_type(8)));
typedef float f32x4 __attribute__((ext_vector_type(4)));
typedef unsigned u32x4 __attribute__((ext_vector_type(4)));
constexpr int BM = 256, BK = 64, HALF = 128, HTB = HALF * BK * 2  , STAGE_BYTES = 8 * HTB, NXCD = 8, WGM = 8;

__host__ __device__ __forceinline__ int lds_byte(int r, int c) { const int st = (r >> 4) * 2 + (c >> 5), rr = r & 15, cc = c & 31, ob = rr * 64 + cc * 2; return st * 1024 + (ob ^ (((ob >> 9) & 1) << 5)); }
__host__ __device__ __forceinline__ void stage_rc(int b, int& R, int& C) { const int st = b / 1024, sb = b % 1024, swz = sb ^ (((sb >> 9) & 1) << 5); R = (st >> 1) * 16 + swz / 64; C = (st & 1) * 32 + (swz % 64) / 2; }
__host__ __device__ __forceinline__ int perm32(int rho) { const int n = rho >> 4, i = rho & 15; return 8 * (i >> 2) + 4 * n + (i & 3); }

struct Unit { int pm, pn; };
struct Gemm { const bf16_t* A; const bf16_t* Bt; int M, N, K; };

struct StaticOrder {
    int nM, nN, nwg, G, c;
    __host__ __device__ void init(int M, int N, int G_, int c_) { nM = M / BM; nN = N / BM; nwg = nM * nN; G = G_; c = c_; }
    __host__ __device__ bool next(int i, Unit& u) const {
        const long L = (long)i * G + c; if (L >= nwg) return false;
        int wgid = (int)L; { const int q = nwg / NXCD, r = nwg % NXCD, xcd = wgid % NXCD, off = wgid / NXCD; wgid = (xcd < r ? xcd * (q + 1) : r * (q + 1) + (xcd - r) * q) + off; }
        const int nig = WGM * nN, gid = wgid / nig, fm = gid * WGM, gsz = (nM - fm) < WGM ? (nM - fm) : WGM;
        u.pm = fm + ((wgid % nig) % gsz); u.pn = (wgid % nig) / gsz; return true;
    }
    __device__ __forceinline__ void a_ready(const Unit&) const {}
    __device__ __forceinline__ void done(const Unit&) const {}
};

__device__ __forceinline__ unsigned cvt_pk_bf16(float lo, float hi) { unsigned r; asm volatile("v_cvt_pk_bf16_f32 %0, %1, %2" : "=v"(r) : "v"(lo), "v"(hi)); return r; }
typedef float f32x2 __attribute__((ext_vector_type(2)));
template <class Epi, class Sched, bool ALIGN_EPI = false, bool SP2 = false>
__device__ __forceinline__ void gemm_phase(PG8_LAS unsigned char* lds, const Gemm g, const Sched& S, const Epi& E) {
    const int tid = threadIdx.x, wid = __builtin_amdgcn_readfirstlane(tid >> 6), lane = tid & 63, wr = wid >> 2, wc = wid & 3, fr = lane & 15, fq = lane >> 4;
    const int K = g.K, nt = K / BK;
    unsigned voffA[2], voffB[2];
#pragma unroll
    for (int i = 0; i < 2; ++i) { int R, C; stage_rc(tid * 16 + i * 8192, R, C); const int Rb = Epi::PERM ? ((R & ~31) + perm32(R & 31)) : R;
        voffA[i] = (unsigned)(R * K + C) * 2u; voffB[i] = (unsigned)(Rb * K + C) * 2u; }
    const size_t kstep = (size_t)(BK * 2);
    const size_t hstep = (size_t)HALF * K * 2;
    const size_t tstep = 2 * hstep;
    const unsigned ldsw = (unsigned)wid * 1024u;
    const int aoff = lds_byte(wr * 64 + fr, fq * 8), boff = lds_byte(wc * 32 + fr, fq * 8);
#define PG8_SA(b, h) (((b) * 2 + (h)) * HTB)
#define PG8_SB(b, h) ((4 + (b) * 2 + (h)) * HTB)
#define PG8_STAGE(bufoff, gbase, voff) do { _Pragma("unroll") for (int _i = 0; _i < 2; ++_i) \
        __builtin_amdgcn_global_load_lds((const unsigned*)((const char*)(gbase) + (voff)[_i]), (PG8_LAS unsigned*)(lds + (bufoff) + ldsw + _i * 8192), 16, 0, 0); } while (0)
#define PG8_LDA(dst, b, h) do { _Pragma("unroll") for (int m = 0; m < 4; ++m) _Pragma("unroll") for (int k = 0; k < 2; ++k) dst[m][k] = *(const PG8_LAS bf16x8*)(lds + PG8_SA(b, h) + aoff + m * 2048 + k * 1024); } while (0)
#define PG8_LDB(dst, b, h) do { _Pragma("unroll") for (int n = 0; n < 2; ++n) _Pragma("unroll") for (int k = 0; k < 2; ++k) dst[n][k] = *(const PG8_LAS bf16x8*)(lds + PG8_SB(b, h) + boff + n * 2048 + k * 1024); } while (0)
#define PG8_MMA(ai, bj, At, Bt) do { __builtin_amdgcn_s_setprio(1); _Pragma("unroll") for (int m = 0; m < 4; ++m) _Pragma("unroll") for (int n = 0; n < 2; ++n) _Pragma("unroll") for (int k = 0; k < 2; ++k) \
        acc[ai][bj][m][n] = __builtin_amdgcn_mfma_f32_16x16x32_bf16(Bt[n][k], At[m][k], acc[ai][bj][m][n], 0, 0, 0); __builtin_amdgcn_s_setprio(0); } while (0)
#define PG8_WAIT_V(n) asm volatile("s_waitcnt vmcnt(" #n ")" ::: "memory")
#define PG8_WAIT_L(n) asm volatile("s_waitcnt lgkmcnt(" #n ")" ::: "memory")
#define PG8_BAR __builtin_amdgcn_s_barrier()
#define PG8_SCHED __builtin_amdgcn_sched_barrier(0)
    Unit cur, nxt; int ui = 0;
    if (!S.next(0, cur)) return;
    f32x4 acc[2][2][4][2];
#pragma unroll
    for (int a = 0; a < 2; ++a)
#pragma unroll
        for (int b = 0; b < 2; ++b)
#pragma unroll
            for (int m = 0; m < 4; ++m)
#pragma unroll
                for (int n = 0; n < 2; ++n) acc[a][b][m][n] = (f32x4){0.f, 0.f, 0.f, 0.f};
    bf16x8 At[4][2], B0[2][2], B1[2][2];
    const char* cA = (const char*)g.A + (size_t)cur.pm * tstep; const char* cB = (const char*)g.Bt + (size_t)cur.pn * tstep;
    S.a_ready(cur);
    if constexpr (SP2) {
        PG8_STAGE(PG8_SB(0, 0), cB, voffB); PG8_STAGE(PG8_SB(0, 1), cB + hstep, voffB); PG8_STAGE(PG8_SA(0, 0), cA, voffA); PG8_STAGE(PG8_SA(0, 1), cA + hstep, voffA);
        if (wr == 1) PG8_BAR;
        PG8_WAIT_V(2); PG8_BAR;
        PG8_STAGE(PG8_SB(1, 0), cB + kstep, voffB); PG8_STAGE(PG8_SA(1, 0), cA + kstep, voffA); PG8_STAGE(PG8_SB(1, 1), cB + hstep + kstep, voffB);
        PG8_WAIT_V(6); PG8_BAR;
    } else {
        PG8_STAGE(PG8_SB(0, 0), cB, voffB); PG8_STAGE(PG8_SA(0, 0), cA, voffA); PG8_STAGE(PG8_SB(0, 1), cB + hstep, voffB); PG8_STAGE(PG8_SA(0, 1), cA + hstep, voffA);
        if (wr == 1) PG8_BAR;
        PG8_WAIT_V(4); PG8_BAR;
        PG8_STAGE(PG8_SB(1, 0), cB + kstep, voffB); PG8_STAGE(PG8_SA(1, 0), cA + kstep, voffA); PG8_STAGE(PG8_SB(1, 1), cB + hstep + kstep, voffB);
        PG8_WAIT_V(6); PG8_BAR;
    }
    for (;;) {
        const bool has_next = S.next(ui + 1, nxt);
        const char* nA = has_next ? (const char*)g.A + (size_t)nxt.pm * tstep : cA; const char* nB = has_next ? (const char*)g.Bt + (size_t)nxt.pn * tstep : cB;
        for (int t = 0; t < nt; t += 2) {
            const bool last = (t == nt - 2);
            const char* a1 = cA + (size_t)(t + 1) * kstep;
            const char* a2 = last ? nA : cA + (size_t)(t + 2) * kstep; const char* b2 = last ? nB : cB + (size_t)(t + 2) * kstep;
            const char* a3 = a2 + kstep; const char* b3 = b2 + kstep;
            if (last && has_next) S.a_ready(nxt);
            if constexpr (SP2) {
            PG8_LDB(B0, 0, 0); PG8_LDB(B1, 0, 1); PG8_SCHED; PG8_LDA(At, 0, 0); PG8_STAGE(PG8_SA(1, 1), a1 + hstep, voffA);
            PG8_WAIT_V(8); PG8_WAIT_L(0); PG8_BAR; PG8_MMA(0, 0, At, B0); PG8_MMA(0, 1, At, B1); PG8_BAR; PG8_SCHED;
            PG8_LDA(At, 0, 1); PG8_STAGE(PG8_SB(0, 0), b2, voffB); PG8_STAGE(PG8_SB(0, 1), b2 + hstep, voffB); PG8_STAGE(PG8_SA(0, 0), a2, voffA);
            PG8_WAIT_V(8); PG8_WAIT_L(0); PG8_BAR; PG8_MMA(1, 0, At, B0); PG8_MMA(1, 1, At, B1); PG8_BAR; PG8_SCHED;
            PG8_LDB(B0, 1, 0); PG8_LDB(B1, 1, 1); PG8_SCHED; PG8_LDA(At, 1, 0); PG8_STAGE(PG8_SA(0, 1), a2 + hstep, voffA);
            PG8_WAIT_V(8); PG8_WAIT_L(0); PG8_BAR; PG8_MMA(0, 0, At, B0); PG8_MMA(0, 1, At, B1); PG8_BAR; PG8_SCHED;
            PG8_LDA(At, 1, 1); PG8_STAGE(PG8_SB(1, 0), b3, voffB); PG8_STAGE(PG8_SB(1, 1), b3 + hstep, voffB); PG8_STAGE(PG8_SA(1, 0), a3, voffA);
            PG8_WAIT_V(8); PG8_WAIT_L(0); PG8_BAR; PG8_MMA(1, 0, At, B0); PG8_MMA(1, 1, At, B1); PG8_BAR; PG8_SCHED;
            } else {
            PG8_LDB(B0, 0, 0); PG8_SCHED; PG8_LDA(At, 0, 0); PG8_STAGE(PG8_SA(1, 1), a1 + hstep, voffA);
            PG8_WAIT_L(8); PG8_BAR; PG8_WAIT_L(0); PG8_MMA(0, 0, At, B0); PG8_BAR; PG8_SCHED;
            PG8_LDB(B1, 0, 1); PG8_STAGE(PG8_SB(0, 0), b2, voffB);
            PG8_BAR; PG8_WAIT_L(0); PG8_MMA(0, 1, At, B1); PG8_BAR;
            PG8_LDA(At, 0, 1); PG8_STAGE(PG8_SA(0, 0), a2, voffA);
            PG8_BAR; PG8_WAIT_L(0); PG8_MMA(1, 0, At, B0); PG8_BAR; PG8_SCHED;
            PG8_STAGE(PG8_SB(0, 1), b2 + hstep, voffB);
            PG8_WAIT_V(6); PG8_BAR; PG8_MMA(1, 1, At, B1); PG8_BAR;
            PG8_LDB(B0, 1, 0); PG8_SCHED; PG8_LDA(At, 1, 0); PG8_STAGE(PG8_SA(0, 1), a2 + hstep, voffA);
            PG8_WAIT_L(8); PG8_BAR; PG8_WAIT_L(0); PG8_MMA(0, 0, At, B0); PG8_BAR; PG8_SCHED;
            PG8_LDB(B1, 1, 1); PG8_STAGE(PG8_SB(1, 0), b3, voffB);
            PG8_BAR; PG8_WAIT_L(0); PG8_MMA(0, 1, At, B1); PG8_BAR;
            PG8_LDA(At, 1, 1); PG8_STAGE(PG8_SA(1, 0), a3, voffA);
            PG8_BAR; PG8_WAIT_L(0); PG8_MMA(1, 0, At, B0); PG8_BAR; PG8_SCHED;
            PG8_STAGE(PG8_SB(1, 1), b3 + hstep, voffB);
            PG8_WAIT_V(6); PG8_BAR; PG8_MMA(1, 1, At, B1); PG8_BAR;
            }
        }
        if constexpr (ALIGN_EPI) { if (wr == 0) PG8_BAR; }
        if constexpr (!Epi::AFTER_DRAIN) { E(acc, cur, wr, wc, fr, fq); S.done(cur); }
        if (!has_next) break;
#pragma unroll
        for (int a = 0; a < 2; ++a)
#pragma unroll
            for (int b = 0; b < 2; ++b)
#pragma unroll
                for (int m = 0; m < 4; ++m)
#pragma unroll
                    for (int n = 0; n < 2; ++n) acc[a][b][m][n] = (f32x4){0.f, 0.f, 0.f, 0.f};
        cur = nxt; cA = nA; cB = nB; ++ui;
        if constexpr (ALIGN_EPI) { if (wr == 1) PG8_BAR; }
    }
    PG8_WAIT_V(0);
    if constexpr (!ALIGN_EPI) { if (wr == 0) PG8_BAR; }
    PG8_BAR;
    if constexpr (Epi::AFTER_DRAIN) { E.fused(acc, cur, wr, wc, fr, fq, lds, wid, lane); S.done(cur); }
#undef PG8_SA
#undef PG8_SB
#undef PG8_STAGE
#undef PG8_LDA
#undef PG8_LDB
#undef PG8_MMA
#undef PG8_WAIT_V
#undef PG8_WAIT_L
#undef PG8_BAR
#undef PG8_SCHED
}
}
#define GAS __attribute__((address_space(1)))
#define LAS __attribute__((address_space(3)))
typedef unsigned short bf16;
typedef unsigned v4u __attribute__((ext_vector_type(4)));
typedef float f32x4 __attribute__((ext_vector_type(4)));
typedef short bf16x8 __attribute__((ext_vector_type(8)));
typedef GAS unsigned gu32;
typedef GAS unsigned long long gu64;
#define RLX_AGENT __ATOMIC_RELAXED, __HIP_MEMORY_SCOPE_AGENT
#define LDS_WAIT() asm volatile("s_waitcnt lgkmcnt(0)" ::: "memory")
#define VM_WAIT() asm volatile("s_waitcnt vmcnt(0)" ::: "memory")
__device__ __forceinline__ unsigned long long rt() { return __builtin_amdgcn_s_memrealtime(); }
__device__ __forceinline__ unsigned f2bf(float f) { unsigned u = __builtin_bit_cast(unsigned, f); return (u + 0x7fffu + ((u >> 16) & 1u)) >> 16; }
__device__ __forceinline__ unsigned pk2(float lo, float hi) { return f2bf(lo) | (f2bf(hi) << 16); }

#define XB_TMO      128
#define XB_XCNT(j)  (256  + 64 * (j))
#define XB_XSUB(j)  (1280 + 64 * (j))
#define XB_XGEN(j)  (2304 + 64 * (j))
#define XB_TOP      3328
#define XB_TOPGEN   3392
#define XCD_BAR_WORDS 3456
#define XB_SPIN_CAP (1u << 18)

__device__ __forceinline__ unsigned xb_ld(unsigned* p)              { return __hip_atomic_load(p, __ATOMIC_RELAXED, __HIP_MEMORY_SCOPE_AGENT); }
__device__ __forceinline__ unsigned xb_add(unsigned* p, unsigned v) { return __hip_atomic_fetch_add(p, v, __ATOMIC_RELAXED, __HIP_MEMORY_SCOPE_AGENT); }
__device__ __forceinline__ unsigned xb_xcc_id() { return (unsigned)__builtin_amdgcn_s_getreg((3 << 11) | 20) & 0xFu; }
#define XB_SPIN(cond, bar) do { unsigned _sp = 0; while (cond) { __builtin_amdgcn_s_sleep(1); \
    if ((++_sp & 255u) == 0u) { if (xb_ld(&(bar)[XB_TMO])) break; if (_sp > XB_SPIN_CAP) { atomicAdd(&(bar)[XB_TMO], 1u); break; } } } } while (0)

struct XcdBarrier {
    unsigned* bar; unsigned x;
    volatile LAS unsigned* st;
    unsigned total;
};

__device__ __forceinline__ XcdBarrier xcd_barrier_post(unsigned* bar, volatile LAS unsigned* st) {
    XcdBarrier b; b.bar = bar; b.x = xb_xcc_id(); b.st = st; b.total = 0u;
    if (threadIdx.x == 0) (void)xb_add(&bar[XB_XCNT(b.x)], 1u);
    return b;
}
__device__ __forceinline__ void xcd_barrier_complete(unsigned* bar, unsigned x, unsigned& nloc, unsigned& nx, unsigned total) {
    const unsigned G = total ? total : gridDim.x * gridDim.y * gridDim.z;
    unsigned sum, cnt, mine, sp = 0u;
    for (;;) {
        sum = 0u; cnt = 0u; mine = 0u;
#pragma unroll
        for (unsigned j = 0; j < 16; ++j) { const unsigned c = xb_ld(&bar[XB_XCNT(j)]); sum += c; cnt += (c > 0u) ? 1u : 0u; mine = (j == x) ? c : mine; }
        if (sum == G) break;
        __builtin_amdgcn_s_sleep(1);
        if ((++sp & 255u) == 0u) { if (xb_ld(&bar[XB_TMO])) break; if (sp > XB_SPIN_CAP) { atomicAdd(&bar[XB_TMO], 1u); break; } }
    }
    nloc = mine > 0u ? mine : 1u; nx = cnt > 0u ? cnt : 1u;
}

__device__ __forceinline__ void xcd_barrier(const XcdBarrier& b) {
    asm volatile("s_waitcnt vmcnt(0)" ::: "memory");
    __syncthreads();
    if (threadIdx.x == 0) {
        unsigned* bar = b.bar;
        __builtin_amdgcn_s_waitcnt(0);
        unsigned nloc = b.st[0], nx = b.st[1];
        if (nloc == 0u) { xcd_barrier_complete(bar, b.x, nloc, nx, b.total); b.st[0] = nloc; b.st[1] = nx; }
        const unsigned old = xb_add(&bar[XB_XSUB(b.x)], 1u);
        const unsigned gen = old / nloc;
        if (old + 1u == (gen + 1u) * nloc) {
            __builtin_amdgcn_fence(__ATOMIC_RELEASE, "agent");
            asm volatile("s_waitcnt vmcnt(0)" ::: "memory");
            const unsigned og = xb_add(&bar[XB_TOP], 1u);
            const unsigned tg = og / nx;
            if (og + 1u == (tg + 1u) * nx) xb_add(&bar[XB_TOPGEN], 1u);
            else XB_SPIN(xb_ld(&bar[XB_TOPGEN]) == tg, bar);
            __builtin_amdgcn_fence(__ATOMIC_ACQUIRE, "agent");
            xb_add(&bar[XB_XGEN(b.x)], 1u);
            asm volatile("s_waitcnt vmcnt(0)" ::: "memory");
        } else {
            XB_SPIN(xb_ld(&bar[XB_XGEN(b.x)]) == gen, bar);
            __builtin_amdgcn_fence(__ATOMIC_ACQUIRE, "agent");
            asm volatile("s_waitcnt vmcnt(0)" ::: "memory");
        }
    }
    __syncthreads();
}

typedef unsigned u32x2v __attribute__((ext_vector_type(2)));
struct Frame {
    LAS unsigned char* lds;
    volatile LAS unsigned* MISC;
    gu32* ctl;
    int tid, lane, wave;
    int G;
    unsigned char* ws;
    float* out;
    const float *xp, *xs, *ck, *cv, *clf, *sh, *sg; const int* pt;
    const float *norm_even, *w_in_even, *b_fox, *lb_logits, *hgrn_gain, *w_out_even, *norm_odd, *w_in_odd, *w_gla_gate, *b_gla_gate, *gla_gain, *w_out_odd, *final_norm;
};
#define WSP(T, off) ((T*)(F.ws + (off)))

template <int CTRL> __device__ __forceinline__ float dppf(float x) { return __builtin_bit_cast(float, __builtin_amdgcn_mov_dpp(__builtin_bit_cast(int, x), CTRL, 0xf, 0xf, true)); }
__device__ __forceinline__ float row16_sum(float v) { v += dppf<0xB1>(v); v += dppf<0x4E>(v); v += dppf<0x141>(v); v += dppf<0x140>(v); return v; }
__device__ __forceinline__ float wave_sum(float v) {
    v = row16_sum(v);
    auto s = __builtin_amdgcn_permlane16_swap(__float_as_uint(v), __float_as_uint(v), false, false); v = __uint_as_float(s[0]) + __uint_as_float(s[1]);
    auto t = __builtin_amdgcn_permlane32_swap(__float_as_uint(v), __float_as_uint(v), false, false); return __uint_as_float(t[0]) + __uint_as_float(t[1]);
}
__device__ __forceinline__ float fast_exp(float x) { return __builtin_amdgcn_exp2f(x * LOG2E); }
__device__ __forceinline__ float sigmoidf_(float x) { return __builtin_amdgcn_rcpf(1.0f + fast_exp(-x)); }
__device__ __forceinline__ float siluf_(float x) { return x * sigmoidf_(x); }
__device__ __forceinline__ float log_sigmoidf_(float x) {
    const float e = __builtin_amdgcn_exp2f(-fabsf(x) * LOG2E);
    return fminf(x, 0.f) - __builtin_amdgcn_logf(1.0f + e) * 0.6931471805599453f;
}
typedef float f32x2_t __attribute__((ext_vector_type(2)));
typedef __bf16 bf16x2_t __attribute__((ext_vector_type(2)));
__device__ __forceinline__ unsigned cvtpk_s(float lo, float hi) { f32x2_t v = {lo, hi}; bf16x2_t b = __builtin_convertvector(v, bf16x2_t); return __builtin_bit_cast(unsigned, b); }
__device__ __forceinline__ bf16x8 pack8f(f32x4 a, f32x4 b) { v4u w = {cvtpk_s(a[0], a[1]), cvtpk_s(a[2], a[3]), cvtpk_s(b[0], b[1]), cvtpk_s(b[2], b[3])}; return __builtin_bit_cast(bf16x8, w); }
__device__ __forceinline__ float bf2f(unsigned short b) { return __builtin_bit_cast(float, (unsigned)b << 16); }
__device__ __forceinline__ void st_bf4(bf16* p, f32x4 v) { u32x2v w; w.x = cvtpk_s(v[0], v[1]); w.y = cvtpk_s(v[2], v[3]); *(GAS u32x2v*)p = w; }
__device__ __forceinline__ void st_bf8(bf16* p, f32x4 a, f32x4 b) { v4u w = {cvtpk_s(a[0], a[1]), cvtpk_s(a[2], a[3]), cvtpk_s(b[0], b[1]), cvtpk_s(b[2], b[3])}; *(GAS v4u*)p = w; }

__device__ __forceinline__ void p0_transpose_item(const float* W, int K, int ld, int N, bf16* WT, LAS float* scr, int item, int lane, const float* gain) {
    const int nblk = N / 32, kb = item / nblk, nb = item % nblk, k0 = 64 * kb, n0 = 32 * nb;
    float wv[32];
#pragma unroll
    for (int i = 0; i < 32; ++i) { const int kk = 2 * i + (lane >> 5); wv[i] = W[(size_t)(k0 + kk) * ld + n0 + (lane & 31)]; }
#pragma unroll
    for (int i = 0; i < 32; ++i) { const int kk = 2 * i + (lane >> 5); float w = wv[i]; if (gain) w *= gain[k0 + kk]; scr[kk * 33 + (lane & 31)] = w; }
    LDS_WAIT(); asm volatile("" ::: "memory");
    const int c = lane & 7;
#pragma unroll
    for (int j = 0; j < 4; ++j) { const int n = (lane >> 3) + 8 * j; const LAS float* s = scr + (8 * c) * 33 + n;
        v4u o; o.x = pk2(s[0 * 33], s[1 * 33]); o.y = pk2(s[2 * 33], s[3 * 33]); o.z = pk2(s[4 * 33], s[5 * 33]); o.w = pk2(s[6 * 33], s[7 * 33]);
        *(GAS v4u*)(WT + (size_t)(n0 + n) * K + k0 + 8 * c) = o; }
    LDS_WAIT(); asm volatile("" ::: "memory");
}

__device__ __forceinline__ float block_excl_scan(float v, LAS float* scr, int lane, int wave, float* total) {
    float inc = v;
#pragma unroll
    for (int o = 1; o < 64; o <<= 1) { const float t = __shfl_up(inc, o); if (lane >= o) inc += t; }
    if (lane == 63) scr[wave] = inc;
    __syncthreads();
    float pre = 0.f, tot = 0.f;
#pragma unroll
    for (int w = 0; w < 8; ++w) { const float t = scr[w]; if (w < wave) pre += t; tot += t; }
    __syncthreads();
    *total = tot;
    return pre + inc - v;
}

__device__ __forceinline__ void p0_prologue(Frame& F, int sub) {
    LAS float* scr = (LAS float*)(F.lds + RING_OFF + F.wave * 16384);
    const int gw = (int)blockIdx.x * NWAVES + F.wave, NGW = F.G * NWAVES;
    constexpr int I1 = 16 * (4096 / 32);
    if (sub & 1) for (int it = gw; it < I1; it += NGW) p0_transpose_item(F.w_in_even, DM, EVEN_IN, 4096, WSP(bf16, WS_W1T), scr, it, F.lane, nullptr);
    if (blockIdx.x == 0) { float* LB = WSP(float, WS_LB); const int c = F.tid; LB[c] = 1.0f / (1.0f + __expf(F.lb_logits[512 + c] - F.lb_logits[c])); }
    { bf16* WRB = WSP(bf16, WS_WR); bf16* WGB = WSP(bf16, WS_WR + 65536); const int gt = (int)blockIdx.x * 512 + F.tid;
      for (int e = gt; e < 16 * 1024; e += F.G * 512) { const int j = e >> 10, k = e & 1023; WRB[e] = (bf16)(cvtpk_s(F.w_in_odd[(size_t)k * ODD_IN + 3072 + j] * F.norm_odd[k], 0.f) & 0xffffu); }
      for (int e = gt; e < 512 * 16; e += F.G * 512) { const int c = e >> 4, j = e & 15; WGB[e] = (bf16)(cvtpk_s(F.w_gla_gate[j * 512 + c], 0.f) & 0xffffu); } }
    __syncthreads();
    if ((sub & 2) && blockIdx.x < DB) {
        const int b = blockIdx.x; float* SUFX = WSP(float, WS_SUFX);
        LAS float* sscr = (LAS float*)(F.lds + RING_OFF);
        const int i = F.tid; f32x4 v[16];
#pragma unroll
        for (int j = 0; j < 16; ++j) { const int s = 8191 - (16 * i + j); const int pg = F.pt[b * NPAGES + (s >> 7)]; v[j] = *(const GAS f32x4*)(F.clf + ((size_t)pg * PAGE + (s & 127)) * 4); }
        f32x4 run = {0.f, 0.f, 0.f, 0.f};
#pragma unroll
        for (int j = 0; j < 16; ++j) { const f32x4 t = v[j]; v[j] = run; run += t; }
        f32x4 pre;
        {
            f32x4 inc = run;
#pragma unroll
            for (int o = 1; o < 64; o <<= 1) { f32x4 t; t.x = __shfl_up(inc.x, o); t.y = __shfl_up(inc.y, o); t.z = __shfl_up(inc.z, o); t.w = __shfl_up(inc.w, o); if (F.lane >= o) inc += t; }
            if (F.lane == 63) *(LAS f32x4*)(sscr + 4 * F.wave) = inc;
            __syncthreads();
            f32x4 p = {0.f, 0.f, 0.f, 0.f};
#pragma unroll
            for (int w = 0; w < 8; ++w) { const f32x4 t = *(const LAS f32x4*)(sscr + 4 * w); if (w < F.wave) p += t; }
            pre = p + inc - run; }
        const int sb = 8191 - (16 * i + 15);
#pragma unroll
        for (int q = 0; q < 4; ++q) {
            const f32x4 o3 = (v[15 - 4 * q] + pre) * LOG2E, o2 = (v[14 - 4 * q] + pre) * LOG2E, o1 = (v[13 - 4 * q] + pre) * LOG2E, o0 = (v[12 - 4 * q] + pre) * LOG2E;
            *(GAS f32x4*)(SUFX + (size_t)(b * 4 + 0) * PAST + sb + 4 * q) = (f32x4){o3.x, o2.x, o1.x, o0.x};
            *(GAS f32x4*)(SUFX + (size_t)(b * 4 + 1) * PAST + sb + 4 * q) = (f32x4){o3.y, o2.y, o1.y, o0.y};
            *(GAS f32x4*)(SUFX + (size_t)(b * 4 + 2) * PAST + sb + 4 * q) = (f32x4){o3.z, o2.z, o1.z, o0.z};
            *(GAS f32x4*)(SUFX + (size_t)(b * 4 + 3) * PAST + sb + 4 * q) = (f32x4){o3.w, o2.w, o1.w, o0.w}; }
    }
    LAS float* wfb = (LAS float*)(F.lds + RING_OFF);
    __syncthreads();
    for (int k = F.tid; k < 1024; k += 512) *(LAS f32x4*)(wfb + 4 * k) = *(const GAS f32x4*)(F.w_in_even + (size_t)k * EVEN_IN + 4096);
    __syncthreads();
    bf16* XN = WSP(bf16, WS_XN); float* LFB = WSP(float, WS_LFB);
    const float bfl = F.b_fox[F.lane & 3];
    f32x4 gn[4];
#pragma unroll
    for (int j = 0; j < 4; ++j) gn[j] = *(const GAS f32x4*)(F.norm_even + 4 * F.lane + 256 * j);
    constexpr int NSW = DB * NWAVES, RSPLIT = MT - 5 * NSW;
    int m0r = gw, mstep = NGW, mend = MT;
    if (NGW > NSW) { if (gw < NSW) { m0r = RSPLIT + gw; mstep = NSW; mend = MT; } else { m0r = gw - NSW; mstep = NGW - NSW; mend = RSPLIT; } }
    f32x4 vn[4];
    if (m0r < mend) { const float* xrow = m0r < MP ? F.xp + (size_t)m0r * DM : F.xs + (size_t)(m0r - MP) * DM; const GAS f32x4* xr = (const GAS f32x4*)xrow + F.lane;
#pragma unroll
        for (int j = 0; j < 4; ++j) vn[j] = xr[64 * j]; }
    if (sub & 4) for (int m = m0r; m < mend; m += mstep) {
        f32x4 v[4]; float s = 0.f;
#pragma unroll
        for (int j = 0; j < 4; ++j) v[j] = vn[j];
        { const int mn = (m + mstep < mend) ? m + mstep : m; const float* xrow = mn < MP ? F.xp + (size_t)mn * DM : F.xs + (size_t)(mn - MP) * DM; const GAS f32x4* xr = (const GAS f32x4*)xrow + F.lane;
#pragma unroll
            for (int j = 0; j < 4; ++j) vn[j] = xr[64 * j]; }
#pragma unroll
        for (int j = 0; j < 4; ++j) s += (v[j].x * v[j].x + v[j].y * v[j].y) + (v[j].z * v[j].z + v[j].w * v[j].w);
        const float rstd = 1.0f / sqrtf(wave_sum(s) * (1.f / DM) + EPS);
        f32x4 d = {0.f, 0.f, 0.f, 0.f};
        GAS unsigned long long* o8 = (GAS unsigned long long*)(XN + (size_t)m * DM) + F.lane;
#pragma unroll
        for (int j = 0; j < 4; ++j) { const int c0 = 4 * F.lane + 256 * j;
            const f32x4 h = v[j] * rstd * gn[j];
            o8[64 * j] = (unsigned long long)cvtpk_s(h.x, h.y) | ((unsigned long long)cvtpk_s(h.z, h.w) << 32);
            d += h.x * *(LAS f32x4*)(wfb + 4 * c0) + h.y * *(LAS f32x4*)(wfb + 4 * c0 + 4) + h.z * *(LAS f32x4*)(wfb + 4 * c0 + 8) + h.w * *(LAS f32x4*)(wfb + 4 * c0 + 12); }
        d.x = wave_sum(d.x); d.y = wave_sum(d.y); d.z = wave_sum(d.z); d.w = wave_sum(d.w);
        if (F.lane < 4) { const float dj = F.lane == 0 ? d.x : F.lane == 1 ? d.y : F.lane == 2 ? d.z : d.w; const float lf = log_sigmoidf_(dj + bfl);
            LFB[(size_t)m * 4 + F.lane] = lf;
            float* o = m < MP ? F.out + O_LFP + (size_t)m * 4 : F.out + O_LFS + (size_t)(m - MP) * 4; o[F.lane] = lf; }
    }
    __syncthreads();
}

__device__ __forceinline__ void late_weights(Frame& F, int gwi, int nw) {
    LAS float* scr = (LAS float*)(F.lds + RING_OFF + F.wave * 16384);
    constexpr int I2 = 16 * (1024 / 32), I3 = 16 * (3072 / 32), I4 = I2;
    for (int it = gwi; it < I2 + I3 + I4 && it < nw; it += NWAVES) {
        int r = it;
        if (r < I2) { p0_transpose_item(F.w_out_even, DM, DM, 1024, WSP(bf16, WS_W2T), scr, r, F.lane, nullptr); continue; } r -= I2;
        if (r < I3) { p0_transpose_item(F.w_in_odd, DM, ODD_IN, 3072, WSP(bf16, WS_W3T), scr, r, F.lane, F.norm_odd); continue; } r -= I3;
        p0_transpose_item(F.w_out_odd, DM, DM, 1024, WSP(bf16, WS_W4T), scr, r, F.lane, nullptr);
    }
}
__device__ __forceinline__ void fox_cumsum_private(Frame& F, int b, int h, float* dst) {
    const float* LFB = WSP(float, WS_LFB) + h;
    LAS float* sscr = (LAS float*)(F.lds + RING_OFF);
    int tz = F.tid; asm volatile("" : "+v"(tz));
    const int ln = tz & 63, wv = tz >> 6;
    float v[16]; float run = 0.f;
#pragma unroll
    for (int j = 0; j < 16; ++j) v[j] = LFB[(size_t)(b * SEQ + 16 * tz + j) * 4];
#pragma unroll
    for (int j = 0; j < 16; ++j) { run += v[j]; v[j] = run; }
    float pre;
    {   float inc = run;
#pragma unroll
        for (int o = 1; o < 64; o <<= 1) { const float t = __builtin_bit_cast(float, __builtin_amdgcn_ds_bpermute(((ln - o) & 63) << 2, __builtin_bit_cast(int, inc))); if (ln >= o) inc += t; }
        if (ln == 63) sscr[wv] = inc;
        __syncthreads();
        float p = 0.f;
#pragma unroll
        for (int w = 0; w < 8; ++w) { const float t = sscr[w]; if (w < wv) p += t; }
        pre = p + inc - run; }
    const float ns = -1.0f / ATT_SCALE;
#pragma unroll
    for (int q = 0; q < 4; ++q) *(GAS f32x4*)(dst + (size_t)16 * tz + 4 * q) = (f32x4){(v[4 * q] + pre) * ns, (v[4 * q + 1] + pre) * ns, (v[4 * q + 2] + pre) * ns, (v[4 * q + 3] + pre) * ns};
    asm volatile("s_waitcnt vmcnt(0)" ::: "memory");
    __syncthreads();
}

struct P1 { bf16 *QA, *IA, *GA, *GB, *QBH, *KBH, *VBH, *GF; float *QS; const float* LB; float* out; };
__device__ __forceinline__ void epi1_4(const P1& p, int m, int c, f32x4 v) {
    const int sec = c >> 9, cs = c & 511;
    const size_t rc = (size_t)m * 512 + cs;
    switch (sec) {
    case 0: st_bf4(p.QA + rc, v); break;
    case 1: { const f32x4 lb = *(const GAS f32x4*)(p.LB + cs); f32x4 g;
#pragma unroll
        for (int i = 0; i < 4; ++i) { const float f = lb[i] + (1.0f - lb[i]) * sigmoidf_(v[i]); g[i] = __logf(f); }
        st_bf4(p.GF + rc, g); } break;
    case 2: st_bf4(p.IA + rc, v); break;
    case 3: { f32x4 g; for (int i = 0; i < 4; ++i) g[i] = siluf_(v[i]); st_bf4(p.GA + rc, g); } break;
    case 4: if (m < MP) { const int b = m >> 13, s = m & 8191, h = cs >> 7, d = cs & 127; st_bf4(p.QBH + ((size_t)((b * 4 + h) * SEQ + s) * HD + d), v); }
            else *(GAS f32x4*)(p.QS + (size_t)(m - MP) * 512 + cs) = v;
            break;
    case 5: if (m < MP) { const int b = m >> 13, s = m & 8191, h = cs >> 7, d = cs & 127; st_bf4(p.KBH + ((size_t)((b * 4 + h) * SEQ + s) * HD + d), v); *(GAS f32x4*)(p.out + O_KP + rc) = v; }
            else *(GAS f32x4*)(p.out + O_KS + (size_t)(m - MP) * 512 + cs) = v;
            break;
    case 6: if (m < MP) { const int b = m >> 13, s = m & 8191, h = cs >> 7, d = cs & 127; st_bf4(p.VBH + ((size_t)((b * 4 + h) * SEQ + s) * HD + d), v); *(GAS f32x4*)(p.out + O_VP + rc) = v; }
            else *(GAS f32x4*)(p.out + O_VS + (size_t)(m - MP) * 512 + cs) = v;
            break;
    default: { f32x4 g; for (int i = 0; i < 4; ++i) g[i] = siluf_(v[i]); st_bf4(p.GB + rc, g); } break;
    }
}
struct P2 { const float *xp, *xs; bf16* X1B; float* SS; };
__device__ __forceinline__ float epi2_4(const P2& p, int m, int c, f32x4 v) {
    const float* xr = m < MP ? p.xp + (size_t)m * DM : p.xs + (size_t)(m - MP) * DM;
    const f32x4 o = *(const GAS f32x4*)(xr + c) + v;
    st_bf4(p.X1B + (size_t)m * DM + c, o);
    return (o.x * o.x + o.y * o.y) + (o.z * o.z + o.w * o.w);
}
struct P3 { bf16 *Q3, *K3, *V3, *G3; const float* SS; };
__device__ __forceinline__ void epi3_4(const P3& p, int m, int c, f32x4 v, float rstd) {
    v = v * rstd;
    if (c < 512) { st_bf4(p.Q3 + (size_t)m * 512 + c, v * ATT_SCALE); }
    else if (c < 1024) { st_bf4(p.K3 + (size_t)m * 512 + (c - 512), v); }
    else if (c < 2048) { st_bf4(p.V3 + (size_t)m * 1024 + (c - 1024), v); }
    else { f32x4 g; for (int i = 0; i < 4; ++i) g[i] = siluf_(v[i]); st_bf4(p.G3 + (size_t)m * 1024 + (c - 2048), g); }
}
struct P4 { const bf16* X1B; float* Y; float* SS; };
__device__ __forceinline__ float epi4_4(const P4& p, int m, int c, f32x4 v) {
    const u32x2v xb = *(const GAS u32x2v*)(p.X1B + (size_t)m * DM + c);
    const f32x4 o = (f32x4){__uint_as_float(xb.x << 16), __uint_as_float(xb.x & 0xffff0000u), __uint_as_float(xb.y << 16), __uint_as_float(xb.y & 0xffff0000u)} + v;
    *(GAS f32x4*)(p.Y + (size_t)m * DM + c) = o;
    return (o.x * o.x + o.y * o.y) + (o.z * o.z + o.w * o.w);
}

__device__ __forceinline__ f32x4 silu4(f32x4 v) { f32x4 g; g.x = siluf_(v.x); g.y = siluf_(v.y); g.z = siluf_(v.z); g.w = siluf_(v.w); return g; }
struct Epi1 { static constexpr bool PERM = true, AFTER_DRAIN = false; P1 p; int skip;
    __device__ __forceinline__ void operator()(const pg8::f32x4 (&acc)[2][2][4][2], const pg8::Unit& u, int wr, int wc, int fr, int fq) const {
        if (skip == 1) { asm volatile("" :: "v"(acc[0][0][0][0][0]), "v"(acc[1][1][3][1][3])); return; }
        if (skip == 2) {
            const int lane_ = threadIdx.x & 63, wv_ = threadIdx.x >> 6; const int sec_ = u.pn >> 1;
            bf16* sb = p.QA + ((size_t)((u.pm * 16 + u.pn) & 255) * 8 + wv_) * 65536;
            int n_ = 0;
#pragma unroll
            for (int ai = 0; ai < 2; ++ai)
#pragma unroll
                for (int m = 0; m < 4; ++m)
#pragma unroll
                    for (int bj = 0; bj < 2; ++bj) { st_bf8(sb + (size_t)n_ * 512 + lane_ * 8, acc[ai][bj][m][0], acc[ai][bj][m][1]); ++n_;
                        if (sec_ == 5 || sec_ == 6 || sec_ == 1) { float* fp = (float*)(sb + 16384) + (size_t)(2 * n_) * 256 + lane_ * 4; *(GAS f32x4*)fp = acc[ai][bj][m][0]; *(GAS f32x4*)(fp + 256) = acc[ai][bj][m][1]; } }
            return; }
        const int sec = u.pn >> 1, row0 = u.pm * 256 + wr * 64 + fr, cs0 = (u.pn & 1) * 256 + wc * 32 + 8 * fq;
#define EPI1_LOOP(...) _Pragma("unroll") for (int ai = 0; ai < 2; ++ai) _Pragma("unroll") for (int m = 0; m < 4; ++m) { const int row = row0 + ai * 128 + m * 16; \
            _Pragma("unroll") for (int bj = 0; bj < 2; ++bj) { const int cs = cs0 + bj * 128; const f32x4 v0 = acc[ai][bj][m][0], v1 = acc[ai][bj][m][1]; __VA_ARGS__ } }
        if (sec == 0) { EPI1_LOOP( st_bf8(p.QA + (size_t)row * 512 + cs, v0, v1); ) }
        else if (sec == 2) { EPI1_LOOP( st_bf8(p.IA + (size_t)row * 512 + cs, v0, v1); ) }
        else if (sec == 3) { EPI1_LOOP( st_bf8(p.GA + (size_t)row * 512 + cs, silu4(v0), silu4(v1)); ) }
        else if (sec == 7) { EPI1_LOOP( st_bf8(p.GB + (size_t)row * 512 + cs, silu4(v0), silu4(v1)); ) }
        else if (sec == 1) {
            f32x4 lb[2][2];
#pragma unroll
            for (int bj = 0; bj < 2; ++bj) { lb[bj][0] = *(const GAS f32x4*)(p.LB + cs0 + bj * 128); lb[bj][1] = *(const GAS f32x4*)(p.LB + cs0 + bj * 128 + 4); }
            EPI1_LOOP( f32x4 g0, g1;
                _Pragma("unroll") for (int i = 0; i < 4; ++i) { g0[i] = __logf(lb[bj][0][i] + (1.0f - lb[bj][0][i]) * sigmoidf_(v0[i])); g1[i] = __logf(lb[bj][1][i] + (1.0f - lb[bj][1][i]) * sigmoidf_(v1[i])); }
                st_bf8(p.GF + (size_t)row * 512 + cs, g0, g1); )
        } else {
            bf16* hb = sec == 4 ? p.QBH : sec == 5 ? p.KBH : p.VBH;
            float* fo = sec == 5 ? p.out + O_KP : p.out + O_VP;
            const int hbase = (u.pn & 1) * 2, d = wc * 32 + 8 * fq;
            EPI1_LOOP( const int b = row >> 13, s = row & 8191;
                st_bf8(hb + ((size_t)((b * 4 + hbase + bj) * SEQ + s) * HD + d), v0, v1);
                if (sec != 4) { float* op = fo + (size_t)row * 512 + cs; __builtin_nontemporal_store(v0, (GAS f32x4*)op); __builtin_nontemporal_store(v1, (GAS f32x4*)(op + 4)); } )
        }
#undef EPI1_LOOP
    } };
struct Epi2 { static constexpr bool PERM = true, AFTER_DRAIN = false; P2 p;
    __device__ __forceinline__ void operator()(const pg8::f32x4 (&acc)[2][2][4][2], const pg8::Unit& u, int wr, int wc, int fr, int fq) const {
        const int row0 = u.pm * 256 + wr * 64 + fr, c0 = u.pn * 256 + wc * 32 + 8 * fq;
#pragma unroll
        for (int ai = 0; ai < 2; ++ai)
#pragma unroll
            for (int m = 0; m < 4; ++m) { const int row = row0 + ai * 128 + m * 16; float ss = 0.f;
#pragma unroll
                for (int bj = 0; bj < 2; ++bj) { const size_t off = (size_t)row * DM + c0 + bj * 128;
                    const f32x4 o0 = *(const GAS f32x4*)(p.xp + off) + acc[ai][bj][m][0], o1 = *(const GAS f32x4*)(p.xp + off + 4) + acc[ai][bj][m][1];
                    st_bf8(p.X1B + off, o0, o1);
                    ss += ((o0.x * o0.x + o0.y * o0.y) + (o0.z * o0.z + o0.w * o0.w)) + ((o1.x * o1.x + o1.y * o1.y) + (o1.z * o1.z + o1.w * o1.w)); }
                ss += __shfl_xor(ss, 16); ss += __shfl_xor(ss, 32);
                if (fq == 0) atomicAdd(p.SS + row, ss); }
    } };
struct Epi3 { static constexpr bool PERM = true, AFTER_DRAIN = false; P3 p; int skip;
    __device__ __forceinline__ void operator()(const pg8::f32x4 (&acc)[2][2][4][2], const pg8::Unit& u, int wr, int wc, int fr, int fq) const {
        if (skip) { asm volatile("" :: "v"(acc[0][0][0][0][0]), "v"(acc[1][1][3][1][3])); return; }
        const int row0 = u.pm * 256 + wr * 64 + fr, cl = (u.pn * 256 + wc * 32 + 8 * fq);
        const int kind = u.pn < 2 ? 0 : u.pn < 4 ? 1 : u.pn < 8 ? 2 : 3;
        bf16* dst = kind == 0 ? p.Q3 : kind == 1 ? p.K3 : kind == 2 ? p.V3 : p.G3;
        const int ld = kind < 2 ? 512 : 1024, cb = kind == 0 ? cl : kind == 1 ? cl - 512 : kind == 2 ? cl - 1024 : cl - 2048;
#pragma unroll
        for (int ai = 0; ai < 2; ++ai)
#pragma unroll
            for (int m = 0; m < 4; ++m) { const int row = row0 + ai * 128 + m * 16;
                float rstd = 1.0f / sqrtf(__hip_atomic_load(p.SS + row, __ATOMIC_RELAXED, __HIP_MEMORY_SCOPE_AGENT) * (1.f / DM) + EPS);
                if (kind == 0) rstd *= ATT_SCALE;
#pragma unroll
                for (int bj = 0; bj < 2; ++bj) { f32x4 v0 = acc[ai][bj][m][0] * rstd, v1 = acc[ai][bj][m][1] * rstd;
                    if (kind == 3) { v0 = silu4(v0); v1 = silu4(v1); }
                    st_bf8(dst + (size_t)row * ld + cb + bj * 128, v0, v1); } }
    } };
struct Epi4 { static constexpr bool PERM = true, AFTER_DRAIN = false; P4 p;
    __device__ __forceinline__ void operator()(const pg8::f32x4 (&acc)[2][2][4][2], const pg8::Unit& u, int wr, int wc, int fr, int fq) const {
        const int row0 = u.pm * 256 + wr * 64 + fr, c0 = u.pn * 256 + wc * 32 + 8 * fq;
#pragma unroll
        for (int ai = 0; ai < 2; ++ai)
#pragma unroll
            for (int m = 0; m < 4; ++m) { const int row = row0 + ai * 128 + m * 16; float ss = 0.f;
#pragma unroll
                for (int bj = 0; bj < 2; ++bj) { const size_t off = (size_t)row * DM + c0 + bj * 128;
                    const v4u xb = *(const GAS v4u*)(p.X1B + off);
                    const f32x4 o0 = (f32x4){__uint_as_float(xb.x << 16), __uint_as_float(xb.x & 0xffff0000u), __uint_as_float(xb.y << 16), __uint_as_float(xb.y & 0xffff0000u)} + acc[ai][bj][m][0];
                    const f32x4 o1 = (f32x4){__uint_as_float(xb.z << 16), __uint_as_float(xb.z & 0xffff0000u), __uint_as_float(xb.w << 16), __uint_as_float(xb.w & 0xffff0000u)} + acc[ai][bj][m][1];
                    *(GAS f32x4*)(p.Y + off) = o0; *(GAS f32x4*)(p.Y + off + 4) = o1;
                    ss += ((o0.x * o0.x + o0.y * o0.y) + (o0.z * o0.z + o0.w * o0.w)) + ((o1.x * o1.x + o1.y * o1.y) + (o1.z * o1.z + o1.w * o1.w)); }
                ss += __shfl_xor(ss, 16); ss += __shfl_xor(ss, 32);
                if (fq == 0) atomicAdd(p.SS + row, ss); }
    } };

struct Epi4F { static constexpr bool PERM = true, AFTER_DRAIN = true; P4 p; const float* gain; const XcdBarrier* bar;
    __device__ __forceinline__ void fused(pg8::f32x4 (&acc)[2][2][4][2], const pg8::Unit& u, int wr, int wc, int fr, int fq, PG8_LAS unsigned char* lds, int wid, int lane) const {
        const int row0 = u.pm * 256 + wr * 64 + fr, c0 = u.pn * 256 + wc * 32 + 8 * fq;
#pragma unroll
        for (int ai = 0; ai < 2; ++ai)
#pragma unroll
            for (int m = 0; m < 4; ++m) { const int row = row0 + ai * 128 + m * 16; float ss = 0.f;
#pragma unroll
                for (int bj = 0; bj < 2; ++bj) { const size_t off = (size_t)row * DM + c0 + bj * 128;
                    const v4u xb = *(const GAS v4u*)(p.X1B + off);
                    const f32x4 o0 = (f32x4){__uint_as_float(xb.x << 16), __uint_as_float(xb.x & 0xffff0000u), __uint_as_float(xb.y << 16), __uint_as_float(xb.y & 0xffff0000u)} + acc[ai][bj][m][0];
                    const f32x4 o1 = (f32x4){__uint_as_float(xb.z << 16), __uint_as_float(xb.z & 0xffff0000u), __uint_as_float(xb.w << 16), __uint_as_float(xb.w & 0xffff0000u)} + acc[ai][bj][m][1];
                    acc[ai][bj][m][0] = o0; acc[ai][bj][m][1] = o1;
                    ss += ((o0.x * o0.x + o0.y * o0.y) + (o0.z * o0.z + o0.w * o0.w)) + ((o1.x * o1.x + o1.y * o1.y) + (o1.z * o1.z + o1.w * o1.w)); }
                ss += __shfl_xor(ss, 16); ss += __shfl_xor(ss, 32);
                if (fq == 0) atomicAdd(p.SS + row, ss); }
        xcd_barrier(*bar);
        f32x4 g[2][2];
#pragma unroll
        for (int bj = 0; bj < 2; ++bj) { g[bj][0] = *(const GAS f32x4*)(gain + c0 + bj * 128); g[bj][1] = *(const GAS f32x4*)(gain + c0 + bj * 128 + 4); }
#pragma unroll
        for (int ai = 0; ai < 2; ++ai)
#pragma unroll
            for (int m = 0; m < 4; ++m) { const int row = row0 + ai * 128 + m * 16;
                const float rstd = 1.0f / sqrtf(__hip_atomic_load(p.SS + row, __ATOMIC_RELAXED, __HIP_MEMORY_SCOPE_AGENT) * (1.f / DM) + EPS);
#pragma unroll
                for (int bj = 0; bj < 2; ++bj) { const size_t off = (size_t)row * DM + c0 + bj * 128;
                    *(GAS f32x4*)(p.Y + off) = acc[ai][bj][m][0] * rstd * g[bj][0]; *(GAS f32x4*)(p.Y + off + 4) = acc[ai][bj][m][1] * rstd * g[bj][1]; } }
    } };

template <class EpiF>
__device__ __forceinline__ void sgemm_unit(const bf16* A, const bf16* WT, int u, int wave, int lane, const EpiF& epi) {
    const int fr = lane & 15, fq = lane >> 4;
    const GAS bf16x8* wp = (const GAS bf16x8*)(WT + (size_t)(16 * u + fr) * DM + 8 * fq);
    const GAS bf16x8* ap = (const GAS bf16x8*)(A + (size_t)(MP + 16 * wave + fr) * DM + 8 * fq);
    pg8::f32x4 acc = {0.f, 0.f, 0.f, 0.f};
#pragma unroll 1
    for (int k0 = 0; k0 < 32; k0 += 16) {
        bf16x8 wv[16], av[16];
#pragma unroll
        for (int i = 0; i < 16; ++i) { wv[i] = wp[(k0 + i) * 4]; av[i] = ap[(k0 + i) * 4]; }
#pragma unroll
        for (int i = 0; i < 16; ++i) acc = __builtin_amdgcn_mfma_f32_16x16x32_bf16(wv[i], av[i], acc, 0, 0, 0);
    }
    epi(MP + 16 * wave + fr, 16 * u + 4 * fq, acc);
}

typedef short s16x4 __attribute__((ext_vector_type(4)));

struct LaArgs {
    const bf16* Q; const bf16* Kp; const bf16* G;
    const bf16* V; const bf16* GATE; int ldv;
    const float* gain;
    bf16* MIXo; int mixoff;
    bf16* SBUF; float* BTOT;
    const float* S0; float* S1;
};
template <int DV, bool HAS_K, int MODE>
__device__ __forceinline__ void la_unit(LAS unsigned char* lds, const LaArgs& a, int m0, int h, int tid, int wave, int lane) {
    constexpr int NVT = DV / 128, NCH = 4, TV = 64; static_assert(MODE == 0 || MODE == 1, "la_unit modes");
    constexpr bool FULL = MODE != 0;
    constexpr int VS = DV + 8;
    constexpr int R0 = 0;
    constexpr int R1 = 17408;
    constexpr int R2 = 34816, R2_SZ = (DV * 144 > 33792) ? DV * 144 : 33792;
    constexpr int R3 = R2 + R2_SZ, R3_SZ = 64 * VS * 2;
    constexpr int K2T_OFF = R3 + R3_SZ;
    constexpr int P_OFF = K2T_OFF + 18432;
    constexpr int TOT_OFF = P_OFF + 9216, EBR_OFF = TOT_OFF + 4096, EBL_OFF = EBR_OFF + 512, SSQ_OFF = EBL_OFF + 512;
    static_assert(SSQ_OFF + 2048 <= LDSCTL_OFF, "LA LDS");
    constexpr int A1_OFF = R0, K1_OFF = R1, VT_OFF = R2;
    LAS float* TOT = (LAS float*)(lds + TOT_OFF); LAS float* EBR = (LAS float*)(lds + EBR_OFF); LAS float* EBL = (LAS float*)(lds + EBL_OFF); LAS float* SSQ = (LAS float*)(lds + SSQ_OFF);
    f32x4 S[8][NVT];
#pragma unroll
    for (int kp = 0; kp < 4; ++kp)
#pragma unroll
        for (int vt = 0; vt < NVT; ++vt) {
            if (MODE == 0) { S[2 * kp][vt] = (f32x4){0.f, 0.f, 0.f, 0.f}; S[2 * kp + 1][vt] = (f32x4){0.f, 0.f, 0.f, 0.f}; }
            else { const v4u sv = *(const GAS v4u*)(a.SBUF + ((size_t)((wave * 4 + kp) * NVT + vt) * 64 + lane) * 8);
                S[2 * kp][vt] = (f32x4){__uint_as_float(sv.x << 16), __uint_as_float(sv.x & 0xffff0000u), __uint_as_float(sv.y << 16), __uint_as_float(sv.y & 0xffff0000u)};
                S[2 * kp + 1][vt] = (f32x4){__uint_as_float(sv.z << 16), __uint_as_float(sv.z & 0xffff0000u), __uint_as_float(sv.w << 16), __uint_as_float(sv.w & 0xffff0000u)}; }
        }
    constexpr int NV = NVT * 2, VCH = DV / 8;
    v4u rg[2], rq[2], rk[2], rv[NV];
#define TZ(name) int name = tid; asm volatile("" : "+v"(name))
#define LB(name, off) LAS unsigned char* name = lds + (off); asm volatile("" : "+v"(name))
#define LA_LOAD(chn) do { const int mr_ = m0 + 64 * (chn); TZ(tz_);                                                                                            \
        const bf16* gb_ = a.G + (size_t)mr_ * 512 + h * 128;  const bf16* qb_ = a.Q + (size_t)mr_ * 512 + h * 128; const bf16* kb_ = HAS_K ? a.Kp + (size_t)mr_ * 512 + h * 128 : nullptr; \
        const bf16* vb_ = a.V + (size_t)mr_ * a.ldv + h * DV;                                                                                                 \
        _Pragma("unroll") for (int i_ = 0; i_ < 2; ++i_) { const int e_ = tz_ + 512 * i_; const unsigned o_ = (unsigned)((e_ >> 4) * 512 + 8 * (e_ & 15));   \
            rg[i_] = *(const GAS v4u*)(gb_ + o_); if (FULL) rq[i_] = *(const GAS v4u*)(qb_ + o_); if (HAS_K) rk[i_] = *(const GAS v4u*)(kb_ + o_); }                                              \
        _Pragma("unroll") for (int i_ = 0; i_ < NV; ++i_) { const int e_ = tz_ + 512 * i_; rv[i_] = *(const GAS v4u*)(vb_ + (unsigned)((e_ / VCH) * a.ldv + 8 * (e_ % VCH))); } } while (0)
    LA_LOAD(0);
    float btot_run_A = 0.f, btot_run_B = 0.f;
#pragma unroll 1
    for (int ch = 0; ch < NCH; ++ch) {
        const int mr0 = m0 + 64 * ch;
        v4u gt[NV];
        { TZ(tz);
#pragma unroll
        for (int i = 0; i < 2; ++i) { const int e = tz + 512 * i, row = e >> 4;
            { LAS f32x4* gp = (LAS f32x4*)(lds + R2 + (row * 132 + 8 * (e & 15)) * 4);
              gp[0] = (f32x4){__uint_as_float(rg[i].x << 16), __uint_as_float(rg[i].x & 0xffff0000u), __uint_as_float(rg[i].y << 16), __uint_as_float(rg[i].y & 0xffff0000u)};
              gp[1] = (f32x4){__uint_as_float(rg[i].z << 16), __uint_as_float(rg[i].z & 0xffff0000u), __uint_as_float(rg[i].w << 16), __uint_as_float(rg[i].w & 0xffff0000u)}; }
            if (FULL) *(LAS v4u*)(lds + R0 + (row * 136 + 8 * (e & 15)) * 2) = rq[i];
            if (HAS_K) *(LAS v4u*)(lds + R1 + (row * 136 + 8 * (e & 15)) * 2) = rk[i]; }
#pragma unroll
        for (int i = 0; i < NV; ++i) { const int e = tz + 512 * i, row = e / VCH; *(LAS v4u*)(lds + R3 + (row * VS + 8 * (e % VCH)) * 2) = rv[i]; } }
        __syncthreads();
        if (NCH > 1) { const int chn = ch + 1 < NCH ? ch + 1 : ch; LA_LOAD(chn); }
        if (FULL) { const bf16* gtb = a.GATE + (size_t)mr0 * a.ldv + h * DV; TZ(tz);
#pragma unroll
            for (int i = 0; i < NV; ++i) { const int e = tz + 512 * i; gt[i] = *(const GAS v4u*)(gtb + (unsigned)((e / VCH) * a.ldv + 8 * (e % VCH))); } }
        {
        TZ(tzb); const int c2 = tzb & 63, seg = tzb >> 6, cA = 2 * c2;
        float gA[8], gB[8], kA[8], kB[8], qA[8], qB[8];
        LB(bG, R2 + (8 * seg * 132 + cA) * 4); LB(bQ, R0 + (8 * seg * 136 + cA) * 2); LB(bK, R1 + (8 * seg * 136 + cA) * 2);
#pragma unroll
        for (int i = 0; i < 8; ++i) {
            const f32x2_t gg = *(const LAS f32x2_t*)(bG + i * 528); gA[i] = gg.x; gB[i] = gg.y;
            if (FULL) { const unsigned qq = *(const LAS unsigned*)(bQ + i * 272); qA[i] = __uint_as_float(qq << 16); qB[i] = __uint_as_float(qq & 0xffff0000u); }
            if (HAS_K) { const unsigned kk = *(const LAS unsigned*)(bK + i * 272); kA[i] = __uint_as_float(kk << 16); kB[i] = __uint_as_float(kk & 0xffff0000u); } }
#pragma unroll
        for (int i = 0; i < 8; ++i) { if (!HAS_K) { kA[i] = 1.0f - __expf(gA[i]); kB[i] = 1.0f - __expf(gB[i]); } if (i) { gA[i] += gA[i - 1]; gB[i] += gB[i - 1]; } }
        LB(bT, TOT_OFF + cA * 4);
        *(LAS f32x2_t*)(bT + seg * 512) = (f32x2_t){gA[7], gB[7]};
        __syncthreads();
        float preA = 0.f, preB = 0.f, brA = 0.f, brB = 0.f, blA = 0.f, blB = 0.f;
#pragma unroll
        for (int q = 0; q < 8; ++q) { const f32x2_t tt_ = *(const LAS f32x2_t*)(bT + q * 512);
            if (q < seg) { preA += tt_.x; preB += tt_.y; } if (q < 4) { brA += tt_.x; brB += tt_.y; } blA += tt_.x; blB += tt_.y; }
        if (seg == 0) { *(LAS f32x2_t*)(bT + (EBR_OFF - TOT_OFF)) = (f32x2_t){__expf(brA), __expf(brB)}; *(LAS f32x2_t*)(bT + (EBL_OFF - TOT_OFF)) = (f32x2_t){__expf(blA), __expf(blB)}; btot_run_A += blA; btot_run_B += blB; }
        {   unsigned k2a[4], k2b[4];
#pragma unroll
            for (int i = 0; i < 8; i += 2) { const float a0 = gA[i] + preA, a1 = gA[i + 1] + preA, b0 = gB[i] + preB, b1 = gB[i + 1] + preB;
                k2a[i >> 1] = cvtpk_s(kA[i] * __expf(blA - a0), kA[i + 1] * __expf(blA - a1));
                k2b[i >> 1] = cvtpk_s(kB[i] * __expf(blB - b0), kB[i + 1] * __expf(blB - b1));
                if (FULL) {
                    *(LAS unsigned*)(bQ + i * 272) = cvtpk_s(qA[i] * __expf(a0 - brA), qB[i] * __expf(b0 - brB));
                    *(LAS unsigned*)(bQ + (i + 1) * 272) = cvtpk_s(qA[i + 1] * __expf(a1 - brA), qB[i + 1] * __expf(b1 - brB));
                    *(LAS unsigned*)(bK + i * 272) = cvtpk_s(kA[i] * __expf(brA - a0), kB[i] * __expf(brB - b0));
                    *(LAS unsigned*)(bK + (i + 1) * 272) = cvtpk_s(kA[i + 1] * __expf(brA - a1), kB[i + 1] * __expf(brB - b1)); } }
            LB(bK2, K2T_OFF + (cA * 72 + 8 * seg) * 2);
            *(LAS v4u*)(bK2) = (v4u){k2a[0], k2a[1], k2a[2], k2a[3]};
            *(LAS v4u*)(bK2 + 144) = (v4u){k2b[0], k2b[1], k2b[2], k2b[3]}; }
        LB(bVr, R3 + (8 * seg * VS + cA) * 2); LB(bVw, VT_OFF + (cA * 72 + 8 * seg) * 2);
#pragma unroll
        for (int ps = 0; ps < NVT; ++ps) { unsigned vv[8];
#pragma unroll
            for (int i = 0; i < 8; ++i) vv[i] = *(const LAS unsigned*)(bVr + (i * VS + 128 * ps) * 2);
            v4u wa, wb;
            wa.x = (vv[0] & 0xffffu) | (vv[1] << 16); wa.y = (vv[2] & 0xffffu) | (vv[3] << 16); wa.z = (vv[4] & 0xffffu) | (vv[5] << 16); wa.w = (vv[6] & 0xffffu) | (vv[7] << 16);
            wb.x = (vv[0] >> 16) | (vv[1] & 0xffff0000u); wb.y = (vv[2] >> 16) | (vv[3] & 0xffff0000u); wb.z = (vv[4] >> 16) | (vv[5] & 0xffff0000u); wb.w = (vv[6] >> 16) | (vv[7] & 0xffff0000u);
            *(LAS v4u*)(bVw + 128 * ps * 144) = wa; *(LAS v4u*)(bVw + 128 * ps * 144 + 144) = wb; }
        }
        __syncthreads();
        if (FULL) {
            TZ(tzc); const int lc = tzc & 63, fr = lc & 15, fq = lc >> 4, wv = __builtin_amdgcn_readfirstlane(tzc >> 6);
            const int tt = wv >> 1, st0 = 2 * (wv & 1);
            f32x4 p0 = {0.f, 0.f, 0.f, 0.f}, p1 = {0.f, 0.f, 0.f, 0.f};
            LB(bA, A1_OFF + ((16 * tt + fr) * 136 + 8 * fq) * 2); LB(bB, K1_OFF + ((16 * st0 + fr) * 136 + 8 * fq) * 2);
#pragma unroll
            for (int ks = 0; ks < 4; ++ks) {
                const bf16x8 av = *(const LAS bf16x8*)(bA + ks * 64);
                const bf16x8 b0 = *(const LAS bf16x8*)(bB + ks * 64);
                const bf16x8 b1 = *(const LAS bf16x8*)(bB + 16 * 272 + ks * 64);
                p0 = __builtin_amdgcn_mfma_f32_16x16x32_bf16(av, b0, p0, 0, 0, 0);
                p1 = __builtin_amdgcn_mfma_f32_16x16x32_bf16(av, b1, p1, 0, 0, 0);
            }
            LB(bP, P_OFF + ((16 * tt + 4 * fq) * 72 + 16 * st0 + fr) * 2);
#pragma unroll
            for (int j = 0; j < 4; ++j) { const int t = 16 * tt + 4 * fq + j, s0 = 16 * st0 + fr, s1 = s0 + 16;
                const float x0 = (s0 <= t) ? p0[j] : 0.f, x1 = (s1 <= t) ? p1[j] : 0.f;
                *(LAS bf16*)(bP + j * 144) = (bf16)(cvtpk_s(x0, 0.f) & 0xffffu);
                *(LAS bf16*)(bP + j * 144 + 32) = (bf16)(cvtpk_s(x1, 0.f) & 0xffffu); }
            __syncthreads();
        }
        TZ(tzd); const int ld_ = tzd & 63, fr = ld_ & 15, fq = ld_ >> 4, wave_d = __builtin_amdgcn_readfirstlane(tzd >> 6), vbase = wave_d * (DV / 8);
        bf16x8 vb[NVT][2];
        LB(bVT, VT_OFF + ((vbase + fr) * 72 + 8 * fq) * 2);
#pragma unroll
        for (int vt = 0; vt < NVT; ++vt)
#pragma unroll
            for (int ks = 0; ks < 2; ++ks) vb[vt][ks] = *(const LAS bf16x8*)(bVT + vt * 16 * 144 + ks * 64);
        f32x4 o[4][NVT];
        if (FULL) {
            LB(bPr, P_OFF + (fr * 72 + 8 * fq) * 2); LB(bE, EBR_OFF + 16 * fq); LB(bA4, A1_OFF + (fr * 136 + 4 * fq) * 2);
#pragma unroll
            for (int tt = 0; tt < 4; ++tt)
#pragma unroll
                for (int vt = 0; vt < NVT; ++vt) o[tt][vt] = (f32x4){0.f, 0.f, 0.f, 0.f};
#pragma unroll
            for (int tt = 0; tt < 4; ++tt)
#pragma unroll
                for (int ks = 0; ks < 2; ++ks) { const bf16x8 pa = *(const LAS bf16x8*)(bPr + tt * 16 * 144 + ks * 64);
#pragma unroll
                    for (int vt = 0; vt < NVT; ++vt) o[tt][vt] = __builtin_amdgcn_mfma_f32_16x16x32_bf16(pa, vb[vt][ks], o[tt][vt], 0, 0, 0); }
#pragma unroll
            for (int ks = 0; ks < 4; ++ks) {
                const f32x4 e0 = *(const LAS f32x4*)(bE + ks * 128), e1 = *(const LAS f32x4*)(bE + ks * 128 + 64);
                bf16x8 sb[NVT];
#pragma unroll
                for (int vt = 0; vt < NVT; ++vt) sb[vt] = pack8f(S[2 * ks][vt] * e0, S[2 * ks + 1][vt] * e1);
#pragma unroll
                for (int tt = 0; tt < 4; ++tt) {
                    const s16x4 alo = *(const LAS s16x4*)(bA4 + tt * 16 * 272 + ks * 64);
                    const s16x4 ahi = *(const LAS s16x4*)(bA4 + tt * 16 * 272 + ks * 64 + 32);
                    const bf16x8 aa = __builtin_shufflevector(alo, ahi, 0, 1, 2, 3, 4, 5, 6, 7);
#pragma unroll
                    for (int vt = 0; vt < NVT; ++vt) o[tt][vt] = __builtin_amdgcn_mfma_f32_16x16x32_bf16(aa, sb[vt], o[tt][vt], 0, 0, 0);
                }
            }
        }
        LB(bL, EBL_OFF + 16 * fq); LB(bK2r, K2T_OFF + (fr * 72 + 8 * fq) * 2);
#pragma unroll
        for (int kt = 0; kt < 8; ++kt) {
            const f32x4 el = *(const LAS f32x4*)(bL + kt * 64);
#pragma unroll
            for (int vt = 0; vt < NVT; ++vt) S[kt][vt] = S[kt][vt] * el;
#pragma unroll
            for (int ks = 0; ks < 2; ++ks) { const bf16x8 ka = *(const LAS bf16x8*)(bK2r + kt * 16 * 144 + ks * 64);
#pragma unroll
                for (int vt = 0; vt < NVT; ++vt) S[kt][vt] = __builtin_amdgcn_mfma_f32_16x16x32_bf16(ka, vb[vt][ks], S[kt][vt], 0, 0, 0); }
        }
        if (FULL) {
            LB(bS, SSQ_OFF + (wave_d * 64 + 4 * fq) * 4); LB(bR, TOT_OFF + 16 * fq); LB(bO, R3 + ((4 * fq) * VS + vbase + fr) * 2);
#pragma unroll
            for (int tt = 0; tt < 4; ++tt) { f32x4 ss = {0.f, 0.f, 0.f, 0.f};
#pragma unroll
                for (int vt = 0; vt < NVT; ++vt) ss += o[tt][vt] * o[tt][vt];
#pragma unroll
                for (int j = 0; j < 4; ++j) ss[j] = row16_sum(ss[j]);
                if (fr == 0) *(LAS f32x4*)(bS + tt * 64) = ss; }
            __syncthreads();
            if (ld_ < 8) { const int t = 8 * wave_d + ld_; float tot = 0.f;
#pragma unroll
                for (int w = 0; w < 8; ++w) tot += SSQ[w * 64 + t];
                TOT[t] = 1.0f / sqrtf(tot * (1.0f / DV) + EPS); }
            float gn[NVT];
#pragma unroll
            for (int vt = 0; vt < NVT; ++vt) gn[vt] = a.gain[h * DV + vbase + 16 * vt + fr];
            __syncthreads();
#pragma unroll
            for (int tt = 0; tt < 4; ++tt) {
                const f32x4 rs = *(const LAS f32x4*)(bR + tt * 64);
#pragma unroll
                for (int j = 0; j < 4; ++j) { const int t = 16 * tt + 4 * fq + j;
#pragma unroll
                    for (int vt = 0; vt < NVT; ++vt) { const float val = o[tt][vt][j] * rs[j] * gn[vt]; const float vn = dppf<0xB1>(val);
                        if ((fr & 1) == 0) *(LAS unsigned*)(bO + ((16 * tt + j) * VS + 16 * vt) * 2) = cvtpk_s(val, vn); } }
            }
            __syncthreads();
            TZ(tze);
#pragma unroll
            for (int i = 0; i < NV; ++i) { const int e = tze + 512 * i, row = e / VCH;
                { const v4u ov = *(const LAS v4u*)(lds + R3 + (row * VS + 8 * (e % VCH)) * 2); v4u w;
#pragma unroll
                    for (int k = 0; k < 4; ++k) w[k] = cvtpk_s(__uint_as_float(ov[k] << 16) * __uint_as_float(gt[i][k] << 16), __uint_as_float(ov[k] & 0xffff0000u) * __uint_as_float(gt[i][k] & 0xffff0000u));
                    *(GAS v4u*)(a.MIXo + (size_t)(mr0 + row) * 1024 + a.mixoff + h * DV + 8 * (e % VCH)) = w; } }
        }
        __syncthreads();
    }
#undef LA_LOAD
#undef TZ
#undef LB
    if (MODE == 0) {
#pragma unroll
        for (int kp = 0; kp < 4; ++kp)
#pragma unroll
            for (int vt = 0; vt < NVT; ++vt) st_bf8(a.SBUF + ((size_t)((wave * 4 + kp) * NVT + vt) * 64 + lane) * 8, S[2 * kp][vt], S[2 * kp + 1][vt]);
        if ((tid >> 6) == 0) { a.BTOT[2 * (tid & 63)] = btot_run_A; a.BTOT[2 * (tid & 63) + 1] = btot_run_B; }
    }
}

template <int DV, bool HAS_K>
__device__ __forceinline__ void la_sample_unit(LAS unsigned char* lds, const LaArgs& a, int u, int tid, int wave, int lane) {
    constexpr int KS = 512 / DV, KPT = 128 / KS, NOUT = 4 * DV / 512;
    const int b = u >> 2, h = u & 3, m0 = MP + b * 4;
    LAS float* EG = (LAS float*)lds; LAS float* KK = EG + 512; LAS float* QQ = KK + 512; LAS float* RED = QQ + 512; LAS float* WS = RED + 4 * KS * DV;
    { const int t = tid >> 7, k = tid & 127; const size_t off = (size_t)(m0 + t) * 512 + h * 128 + k;
      const float g = bf2f(a.G[off]), eg = __expf(g); EG[tid] = eg; KK[tid] = HAS_K ? bf2f(a.Kp[off]) : 1.0f - eg; QQ[tid] = bf2f(a.Q[off]); }
    __syncthreads();
    const int v = tid % DV, ks = tid / DV, k0 = ks * KPT;
    float S[KPT];
    { const float* sp = a.S0 + (size_t)k0 * DV + v;
#pragma unroll
      for (int i0 = 0; i0 < KPT; i0 += 4) { asm volatile("" : "+v"(sp));
#pragma unroll
          for (int i = 0; i < 4; ++i) S[i0 + i] = sp[i * DV];
          sp += 4 * DV; } }
#pragma unroll
    for (int t = 0; t < 4; ++t) {
        const float vt = bf2f(a.V[(size_t)(m0 + t) * a.ldv + h * DV + v]); float o = 0.f;
#pragma unroll
        for (int i = 0; i < KPT; ++i) { S[i] = S[i] * EG[t * 128 + k0 + i] + KK[t * 128 + k0 + i] * vt; o += S[i] * QQ[t * 128 + k0 + i]; }
        RED[(t * KS + ks) * DV + v] = o;
    }
    { float* sp = a.S1 + (size_t)k0 * DV + v;
#pragma unroll
      for (int i0 = 0; i0 < KPT; i0 += 4) { asm volatile("" : "+v"(sp));
#pragma unroll
          for (int i = 0; i < 4; ++i) sp[i * DV] = S[i0 + i];
          sp += 4 * DV; } }
    __syncthreads();
    float ov[NOUT];
#pragma unroll
    for (int j = 0; j < NOUT; ++j) { const int idx = tid + 512 * j, t = idx / DV, vv = idx % DV; float o = 0.f;
#pragma unroll
        for (int q = 0; q < KS; ++q) o += RED[(t * KS + q) * DV + vv];
        ov[j] = o; const float ss = wave_sum(o * o); if (lane == 0) WS[j * 8 + wave] = ss; }
    __syncthreads();
#pragma unroll
    for (int j = 0; j < NOUT; ++j) { const int idx = tid + 512 * j, t = idx / DV, vv = idx % DV;
        constexpr int WPT = DV / 64;
        const int w0 = (wave / WPT) * WPT; float tot = 0.f;
#pragma unroll
        for (int q = 0; q < WPT; ++q) tot += WS[j * 8 + w0 + q];
        const float rstd = 1.0f / sqrtf(tot * (1.0f / DV) + EPS); const size_t row = (size_t)(m0 + t);
        const float val = ov[j] * rstd * a.gain[h * DV + vv] * bf2f(a.GATE[row * a.ldv + h * DV + vv]);
        a.MIXo[row * 1024 + a.mixoff + h * DV + vv] = (bf16)(cvtpk_s(val, 0.f) & 0xffffu); }
    __syncthreads();
}

template <int DV>
__device__ __forceinline__ void la_scan(bf16* SLOC, const float* BTOT, float* outstate, int gtid, int gthreads) {
    constexpr int NVT = DV / 128, LP = 8192 * NVT;
    GAS unsigned* SW = (GAS unsigned*)SLOC;
    for (int eg = gtid; eg < 8 * LP; eg += gthreads) {
        const int bh = eg / LP, e = eg % LP;
        const int jj = e & 1, kk = (e >> 1) & 1, ln = (e >> 2) & 63, rest = e >> 8, vt = rest % NVT, kp = (rest / NVT) & 3, w = rest / (NVT * 4);
        const int k = 16 * (2 * kp + kk) + 4 * (ln >> 4) + 2 * jj, v = w * (DV / 8) + 16 * vt + (ln & 15);
        float c0 = 0.f, c1 = 0.f;
#pragma unroll 1
        for (int s0 = 0; s0 < 32; s0 += 16) {
            unsigned loc[16]; f32x2_t dec[16];
#pragma unroll
            for (int sc = 0; sc < 16; ++sc) { loc[sc] = SW[(size_t)(bh * 32 + s0 + sc) * LP + e]; dec[sc] = *(const GAS f32x2_t*)(BTOT + (size_t)(bh * 32 + s0 + sc) * 128 + k); }
#pragma unroll
            for (int sc = 0; sc < 16; ++sc) { SW[(size_t)(bh * 32 + s0 + sc) * LP + e] = cvtpk_s(c0, c1);
                c0 = c0 * __expf(dec[sc].x) + __uint_as_float(loc[sc] << 16); c1 = c1 * __expf(dec[sc].y) + __uint_as_float(loc[sc] & 0xffff0000u); }
        }
        outstate[(size_t)(bh * 128 + k) * DV + v] = c0; outstate[(size_t)(bh * 128 + k + 1) * DV + v] = c1;
    }
}

namespace fox {
using TIN = __hip_bfloat16; using TOUT = __hip_bfloat16;
constexpr int D = 128, SKV = 8192, WINDOW = SKV; constexpr float THR = 8.f; constexpr bool WSKIP = false;
constexpr int OSTR = 1024, GSTR = 512;
constexpr float SCALE = 0.08838834764831845f;
constexpr int NW = 8, QBLK = 32, KVBLK = 64, QB = NW * QBLK;
constexpr int SHM_V = KVBLK * D * 2, SHM_K = KVBLK * D * 2;
constexpr int LDS_BIAS = 2 * SHM_V + 2 * SHM_K + NW * 64 * 4;
constexpr int LDS_BYTES = LDS_BIAS + 512;
constexpr int ORS = 136, OST_WAVE = 32 * ORS * 2, OST_OFF = 69632;

using bf16 = __hip_bfloat16;
typedef short bf16x8 __attribute__((ext_vector_type(8)));
typedef short s16x4 __attribute__((ext_vector_type(4)));
typedef float f32x16 __attribute__((ext_vector_type(16)));
typedef float f32x4 __attribute__((ext_vector_type(4)));
typedef unsigned u32x4 __attribute__((ext_vector_type(4)));
template <class A, class Bt> struct same_t { static constexpr bool v = false; };
template <class A> struct same_t<A, A> { static constexpr bool v = true; };

#define KSWZ(row, colB) ((row) * 256 + ((colB) ^ (((row) & 7) << 4)))
#define SBAR() __builtin_amdgcn_sched_barrier(0)
__device__ __forceinline__ int v_st(int k, int c) { const int kk = (k & ~0xC) | ((k & 4) << 1) | ((k & 8) >> 1); return ((kk >> 3) * 4 + (c >> 5)) * 512 + ((kk & 7) * 32 + (c & 31)) * 2; }
__device__ __forceinline__ int v_rd_base(int lane) { return ((lane & 3) << 3) | (((lane >> 2) & 3) << 6) | (((lane >> 4) & 1) << 5) | (((lane >> 5) & 1) << 8); }
constexpr int v_rd_off(int d0, int ks, int half) { return d0 * 512 + ks * 4096 + half * 2048; }
__device__ __forceinline__ int crow(int r, int hi) { return (r & 3) + 8 * (r >> 2) + 4 * hi; }
__device__ __forceinline__ unsigned cvtpk(float lo, float hi) {
    unsigned r; asm volatile("v_cvt_pk_bf16_f32 %0, %1, %2" : "=v"(r) : "v"(lo), "v"(hi)); return r;
}
__device__ __forceinline__ bf16x8 pack8(f32x4 a, f32x4 b) {
    u32x4 w = {cvtpk(a[0], a[1]), cvtpk(a[2], a[3]), cvtpk(b[0], b[1]), cvtpk(b[2], b[3])};
    return *reinterpret_cast<bf16x8*>(&w);
}
template <class T> __device__ __forceinline__ bf16x8 load8(const T* p) {
    if constexpr (same_t<T, float>::v) { return pack8(*(const f32x4*)p, *(const f32x4*)(p + 4)); }
    else { return *reinterpret_cast<const bf16x8*>(p); }
}
__device__ __forceinline__ void mask_tile(f32x16& p0, f32x16& p1, int dq, unsigned W) {
    const float NEG = -__builtin_inff();
#pragma unroll
    for (int r = 0; r < 16; ++r) {
        const int c = (r & 3) + 8 * (r >> 2);
        if ((unsigned)(dq - c) >= W) p0[r] = NEG;
        if ((unsigned)(dq - c - 32) >= W) p1[r] = NEG;
    }
}
__device__ __forceinline__ void partialSM(f32x16& p0, f32x16& p1, float& m_reg, float& mn, float& alpha) {
    float pmax = p0[0]; for (int r = 1; r < 16; ++r) pmax = fmaxf(pmax, p0[r]); for (int r = 0; r < 16; ++r) pmax = fmaxf(pmax, p1[r]);
    { auto rr = __builtin_amdgcn_permlane32_swap(__float_as_uint(pmax), __float_as_uint(pmax), false, false);
      pmax = fmaxf(__uint_as_float(rr[0]), __uint_as_float(rr[1])); }
    constexpr float C2 = 1.4426950408889634f * SCALE;
    if (__builtin_expect(__all((pmax - m_reg) * SCALE <= THR), 1)) { mn = m_reg; alpha = 1.f; }
    else { mn = fmaxf(m_reg, pmax); alpha = __builtin_amdgcn_exp2f((m_reg - mn) * C2); m_reg = mn; }
    const float mnL = -mn * C2;
    for (int r = 0; r < 16; ++r) p0[r] = fmaf(p0[r], C2, mnL); for (int r = 0; r < 16; ++r) p1[r] = fmaf(p1[r], C2, mnL);
    for (int r = 0; r < 16; ++r) p0[r] = __builtin_amdgcn_exp2f(p0[r]);
}
__device__ __forceinline__ void finishSM(f32x16& p0, f32x16& p1, float alpha, float& l_reg, bf16x8& pa0, bf16x8& pa1, bf16x8& pa2, bf16x8& pa3) {
    for (int r = 0; r < 16; ++r) p1[r] = __builtin_amdgcn_exp2f(p1[r]);
    float ps = 0; for (int r = 0; r < 16; ++r) ps += p0[r]; for (int r = 0; r < 16; ++r) ps += p1[r];
    { auto rr = __builtin_amdgcn_permlane32_swap(__float_as_uint(ps), __float_as_uint(ps), false, false);
      ps = __uint_as_float(rr[0]) + __uint_as_float(rr[1]); }
    l_reg = l_reg * alpha + ps;
#define PK4(P, B_, OUT) do { unsigned a0 = cvtpk(P[B_+0], P[B_+1]), a1 = cvtpk(P[B_+2], P[B_+3]);                          \
        unsigned b0 = cvtpk(P[B_+4], P[B_+5]), b1 = cvtpk(P[B_+6], P[B_+7]);                                             \
        auto r0 = __builtin_amdgcn_permlane32_swap(a0, b0, false, false); auto r1 = __builtin_amdgcn_permlane32_swap(a1, b1, false, false); \
        u32x4 w = {r0[0], r1[0], r0[1], r1[1]}; OUT = *reinterpret_cast<bf16x8*>(&w); } while (0)
    PK4(p0, 0, pa0); PK4(p0, 8, pa1); PK4(p1, 0, pa2); PK4(p1, 8, pa3);
#undef PK4
}
constexpr int NQR = 8;
template <int KB, bool SK>
__device__ __forceinline__ void qkt(f32x16& p0, f32x16& p1, const char* K_lds, int r32, int hi, const char* qs, const bf16x8* qrh, bool act) {
    if (SK && !act) { const float NEG = -__builtin_inff();
#pragma unroll
        for (int r = 0; r < 16; ++r) { p0[r] = NEG; p1[r] = NEG; } return; }
    { const float* bl = (const float*)(K_lds + 2 * SHM_K + NW * 64 * 4 + KB * 256) + 4 * hi;
#pragma unroll
      for (int g = 0; g < 4; ++g) { const f32x4 b0 = *(const f32x4*)(bl + 8 * g), b1 = *(const f32x4*)(bl + 32 + 8 * g);
          p0[4 * g] = b0[0]; p0[4 * g + 1] = b0[1]; p0[4 * g + 2] = b0[2]; p0[4 * g + 3] = b0[3]; p1[4 * g] = b1[0]; p1[4 * g + 1] = b1[1]; p1[4 * g + 2] = b1[2]; p1[4 * g + 3] = b1[3]; } }
    const char* kb[4];
#pragma unroll
    for (int dd = 0; dd < 4; ++dd) kb[dd] = K_lds + KB * SHM_K + KSWZ(r32, (dd * 16 + hi * 8) * 2);
#pragma unroll
    for (int d0 = 0; d0 < 8; ++d0) { const char* a = kb[d0 & 3] + (d0 >> 2) * 128;
        bf16x8 b0 = *reinterpret_cast<const bf16x8*>(a);
        bf16x8 b1 = *reinterpret_cast<const bf16x8*>(a + 32 * 256);
        const bf16x8 qv = d0 < NQR ? qrh[d0] : *reinterpret_cast<const bf16x8*>(qs + d0 * 32);
        p0 = __builtin_amdgcn_mfma_f32_32x32x16_bf16(b0, qv, p0, 0, 0, 0);
        p1 = __builtin_amdgcn_mfma_f32_32x32x16_bf16(b1, qv, p1, 0, 0, 0); }
}
template <int VB, bool SK>
__device__ __forceinline__ void pv_tile(f32x16* o, int vb0, bf16x8 pa0, bf16x8 pa1, bf16x8 pa2, bf16x8 pa3, bool act) {
    if (SK && !act) return;
#define TRRD(dst, off) asm volatile("ds_read_b64_tr_b16 %0, %1 offset:%2" : "=&v"(dst) : "v"(vb0), "i"(off) : "memory")
#define PV_D0(d0) do { s16x4 l0, l1, l2, l3, h0, h1, h2, h3; constexpr int b_ = VB * SHM_V + v_rd_off(d0, 0, 0);     \
        TRRD(l0, b_); TRRD(h0, b_ + 2048); TRRD(l1, b_ + 4096); TRRD(h1, b_ + 6144); TRRD(l2, b_ + 8192); TRRD(h2, b_ + 10240); TRRD(l3, b_ + 12288); TRRD(h3, b_ + 14336); \
        asm volatile("s_waitcnt lgkmcnt(0)" ::: "memory"); SBAR();                 \
        o[d0] = __builtin_amdgcn_mfma_f32_32x32x16_bf16(pa0, (bf16x8){l0[0], l0[1], l0[2], l0[3], h0[0], h0[1], h0[2], h0[3]}, o[d0], 0, 0, 0);   \
        o[d0] = __builtin_amdgcn_mfma_f32_32x32x16_bf16(pa1, (bf16x8){l1[0], l1[1], l1[2], l1[3], h1[0], h1[1], h1[2], h1[3]}, o[d0], 0, 0, 0);   \
        o[d0] = __builtin_amdgcn_mfma_f32_32x32x16_bf16(pa2, (bf16x8){l2[0], l2[1], l2[2], l2[3], h2[0], h2[1], h2[2], h2[3]}, o[d0], 0, 0, 0);   \
        o[d0] = __builtin_amdgcn_mfma_f32_32x32x16_bf16(pa3, (bf16x8){l3[0], l3[1], l3[2], l3[3], h3[0], h3[1], h3[2], h3[3]}, o[d0], 0, 0, 0); } while (0)
    PV_D0(0); PV_D0(1); PV_D0(2); PV_D0(3);
#undef PV_D0
#undef TRRD
}

template <class TIn, class TOut> struct BlockRef { const TIn* Q; const TIn* K; const TIn* V; TOut* O; int P0; const float* CB; const TIn* G; };
template <class TIn> struct Seam {
    bf16x8 qr[8];
    bf16x8 st_v0, st_v1, st_k0, st_k1; f32x4 sf0, sf1, sf2, sf3; float st_b;
    f32x4 tq[16];
};
__device__ __forceinline__ int swa_jlo(int P0, int W) { const int lowk = P0 - W + 1; return lowk > 0 ? lowk / KVBLK : 0; }
#define ROW(p, k0, rr) ((p) + (size_t)(k0) * D + (unsigned)((rr) * D + sc))
#define VMW() asm volatile("s_waitcnt vmcnt(0)" ::: "memory")
#define VMWN(n) asm volatile("s_waitcnt vmcnt(%0)" :: "i"(n) : "memory")
#define SLOAD_H(Kp, Vp, Cp, k0) do { S.st_v0 = load8<TIn>(ROW(Vp, k0, sr)); S.st_v1 = load8<TIn>(ROW(Vp, k0, 32 + sr));              \
                         S.st_k0 = load8<TIn>(ROW(Kp, k0, sr)); S.st_k1 = load8<TIn>(ROW(Kp, k0, 32 + sr)); { int tb_ = tid; asm volatile("" : "+v"(tb_)); S.st_b = ((Cp) + (k0))[(unsigned)(tb_ & 63)]; } } while (0)
#define SWRITE_HK(bf) do { *(bf16x8*)(K_lds + (bf) * SHM_K + kws) = S.st_k0; *(bf16x8*)(K_lds + (bf) * SHM_K + kws + 32 * 256) = S.st_k1; if (tid < 64) *(float*)(K_lds + 2 * SHM_K + NW * 64 * 4 + (bf) * 256 + tid * 4) = S.st_b; } while (0)
#define SWRITE_HV(bf) do { *(bf16x8*)(V_lds + (bf) * SHM_V + vst0) = S.st_v0; *(bf16x8*)(V_lds + (bf) * SHM_V + vst1) = S.st_v1; } while (0)
#define SWRITE_H(bf) do { SWRITE_HV(bf); SWRITE_HK(bf); } while (0)
#define SLOAD_F(p, k0) do { S.sf0 = *(const f32x4*)ROW(p, k0, sr); S.sf1 = *(const f32x4*)(ROW(p, k0, sr) + 4);                \
                            S.sf2 = *(const f32x4*)ROW(p, k0, 32 + sr); S.sf3 = *(const f32x4*)(ROW(p, k0, 32 + sr) + 4); } while (0)
#define SWRITE_KF(bf) do { *(bf16x8*)(K_lds + (bf) * SHM_K + kws) = pack8(S.sf0, S.sf1); *(bf16x8*)(K_lds + (bf) * SHM_K + kws + 32 * 256) = pack8(S.sf2, S.sf3); } while (0)
#define SWRITE_VF(bf) do { *(bf16x8*)(V_lds + (bf) * SHM_V + vst0) = pack8(S.sf0, S.sf1); *(bf16x8*)(V_lds + (bf) * SHM_V + vst1) = pack8(S.sf2, S.sf3); } while (0)
template <class TIn, class TOut>
__device__ __forceinline__ void causal_swa_prime(const BlockRef<TIn, TOut>& cur, int W, char* lds, Seam<TIn>& S) {
    constexpr bool F32 = same_t<TIn, float>::v;
    const int tid = threadIdx.x, wid = __builtin_amdgcn_readfirstlane(tid >> 6), lane = tid & 63, r32 = lane & 31, hi = lane >> 5;
    const int sr = tid >> 4, sc = (tid & 15) * 8, kws = KSWZ(sr, sc * 2); char* K_lds = lds + 2 * SHM_V;
    const int kb0 = swa_jlo(cur.P0, W) * KVBLK;
    for (int d0 = 0; d0 < 8; ++d0) S.qr[d0] = load8<TIn>(cur.Q + (size_t)(wid * QBLK + r32) * D + d0 * 16 + hi * 8);
    if constexpr (F32) { SLOAD_F((const float*)cur.K, kb0); VMW(); SWRITE_KF(0); SBAR(); SLOAD_F((const float*)cur.V, kb0); }
    else { SLOAD_H(cur.K, cur.V, cur.CB, kb0); VMW(); SWRITE_HK(0); }
    { char* const qsw = lds + OST_OFF + wid * OST_WAVE + r32 * ORS * 2 + hi * 16;
#pragma unroll
      for (int d0 = 0; d0 < 8; ++d0) *reinterpret_cast<bf16x8*>(qsw + d0 * 32) = S.qr[d0]; }
    __syncthreads();
}
template <class TIn, class TOut>
__device__ __forceinline__ void causal_swa_block(const BlockRef<TIn, TOut>& cur, const BlockRef<TIn, TOut>& nxt, int skv, int W, char* lds, Seam<TIn>& S) {
    constexpr bool F32 = same_t<TIn, float>::v;
    const int tid = threadIdx.x, wid = __builtin_amdgcn_readfirstlane(tid >> 6), lane = tid & 63, r32 = lane & 31, hi = lane >> 5;
    const int j_lo = swa_jlo(cur.P0, W);
    int j_hi = (cur.P0 + QB - 1) / KVBLK + 1; if (j_hi > skv / KVBLK) j_hi = skv / KVBLK;
    const int NT = j_hi - j_lo;
    const int kbn = swa_jlo(nxt.P0, W) * KVBLK;
    const int qlo = cur.P0 + wid * QBLK, qm = qlo + r32 - 4 * hi;
    char* V_lds = lds; char* K_lds = lds + 2 * SHM_V;
    float* ws = (float*)(lds + 2 * SHM_V + 2 * SHM_K) + wid * 64; float* li_l = ws, * al_l = ws + 32;
    float m_reg = -1e30f, l_reg = 0; f32x16 o[4] = {};
    const int sr = tid >> 4, sc = (tid & 15) * 8, vst0 = v_st(sr, sc), vst1 = v_st(32 + sr, sc), kws = KSWZ(sr, sc * 2);
    const int vb0 = (int)(uintptr_t)V_lds + v_rd_base(lane);
    char* const qs = lds + OST_OFF + wid * OST_WAVE + r32 * ORS * 2 + hi * 16;
    bf16x8 qrh[NQR];
#pragma unroll
    for (int d0 = 0; d0 < NQR; ++d0) qrh[d0] = *reinterpret_cast<const bf16x8*>(qs + d0 * 32);
    const TIn* Kh = cur.K; const TIn* Vh = cur.V; const float* Ch = cur.CB;
#define RESC(a) do { if (__any((a) < 1.f)) { if (hi == 0) al_l[r32] = (a); asm volatile("s_waitcnt lgkmcnt(0)" ::: "memory");              \
                     for (int d_ = 0; d_ < 4; ++d_) for (int r = 0; r < 16; ++r) o[d_][r] *= al_l[crow(r, hi)]; } } while (0)
#define KBASE(t) ((j_lo + (t)) * KVBLK)
#define ACT(t) (KBASE(t) <= qlo + QBLK - 1 && KBASE(t) + KVBLK - 1 >= qlo - W + 1)
#define MASKT(P0_, P1_, t) do { const int kb_ = KBASE(t); if ((!SK || ACT(t)) && (kb_ + KVBLK - 1 > qlo || kb_ <= qlo + QBLK - 1 - W)) mask_tile(P0_, P1_, qm - kb_, (unsigned)W); } while (0)
#define BIASADD(P0_, P1_, KB_) do { const float* bl_ = (const float*)(K_lds + 2 * SHM_K + NW * 64 * 4 + (KB_) * 256) + 4 * hi;                    \
        _Pragma("unroll") for (int g_ = 0; g_ < 4; ++g_) { const f32x4 b0_ = *(const f32x4*)(bl_ + 8 * g_), b1_ = *(const f32x4*)(bl_ + 32 + 8 * g_); \
            _Pragma("unroll") for (int i_ = 0; i_ < 4; ++i_) { P0_[4 * g_ + i_] += b0_[i_]; P1_[4 * g_ + i_] += b1_[i_]; } } } while (0)
    constexpr int NQL = F32 ? 16 : 0;
    constexpr bool SK = WSKIP && !F32;
#define SEAM_K0() do { VMWN(NQL); if constexpr (F32) { SWRITE_KF(0); SBAR(); SLOAD_F((const float*)nxt.V, kbn); } else { SWRITE_HK(0); } SBAR(); } while (0)
    f32x16 pA0, pA1, pB0, pB1; float mnA, mnB, alA, alB; bf16x8 pa0, pa1, pa2, pa3;
    if constexpr (F32) { VMW(); SWRITE_VF(0); SBAR(); } else { SWRITE_HV(0); SBAR(); }
    if (NT > 1) { if constexpr (F32) SLOAD_F((const float*)Kh, KBASE(1)); else SLOAD_H(Kh, Vh, Ch, KBASE(1)); }
    SBAR(); qkt<0, SK>(pA0, pA1, K_lds, r32, hi, qs, qrh, ACT(0));
    if constexpr (F32) { if (NT > 1) { VMW(); SWRITE_KF(1); SBAR(); SLOAD_F((const float*)Vh, KBASE(1)); } }
    MASKT(pA0, pA1, 0); partialSM(pA0, pA1, m_reg, mnA, alA);
    if (NT > 1) { VMW(); if constexpr (F32) { SWRITE_VF(1); SBAR(); if (NT > 2) SLOAD_F((const float*)Kh, KBASE(2)); } else SWRITE_H(1); }
    __syncthreads();
#define HALF_STEP(PX0, PX1, mnX, alX, PY0, PY1, alY, t, KB, VB, SB) do {                                                      \
        SBAR(); qkt<KB, SK>(PX0, PX1, K_lds, r32, hi, qs, qrh, ACT(t));                                             \
        finishSM(PY0, PY1, alY, l_reg, pa0, pa1, pa2, pa3); SBAR();                                                           \
        if ((t) + 1 < NT) { if constexpr (F32) { VMW(); SWRITE_KF(SB); SBAR(); SLOAD_F((const float*)Vh, KBASE((t) + 1)); }  \
                            else { SLOAD_H(Kh, Vh, Ch, KBASE((t) + 1)); } SBAR(); }                                               \
        pv_tile<VB, SK>(o, vb0, pa0, pa1, pa2, pa3, ACT((t) - 1)); MASKT(PX0, PX1, (t)); partialSM(PX0, PX1, m_reg, mnX, alX);                                        \
        __syncthreads();                                                                                                      \
        if ((t) + 1 < NT) { VMW(); if constexpr (F32) { SWRITE_VF(SB); SBAR(); if ((t) + 2 < NT) SLOAD_F((const float*)Kh, KBASE((t) + 2)); } \
                            else { SWRITE_H(SB); } }                                                                          \
        RESC(alX); __syncthreads(); } while (0)
    for (int t = 1; t + 1 < NT; t += 2) {
        HALF_STEP(pB0, pB1, mnB, alB, pA0, pA1, alA, t, 1, 0, 0);
        HALF_STEP(pA0, pA1, mnA, alA, pB0, pB1, alB, t + 1, 0, 1, 1);
    }
    const bool even = (NT & 1) == 0;
    if (even) { SBAR(); qkt<1, SK>(pB0, pB1, K_lds, r32, hi, qs, qrh, ACT(NT - 1)); SBAR(); }
#define QROW(e) (nxt.Q + (size_t)(wid * QBLK + r32) * D + ((e) >> 1) * 16 + hi * 8 + ((e) & 1) * 4)
    if constexpr (F32) { SLOAD_F((const float*)nxt.K, kbn); SBAR();
#pragma unroll
        for (int e = 0; e < 8; ++e) S.tq[e] = *(const f32x4*)QROW(e); }
    else { SLOAD_H(nxt.K, nxt.V, nxt.CB, kbn); SBAR(); }
    SBAR();
    finishSM(pA0, pA1, alA, l_reg, pa0, pa1, pa2, pa3); SBAR();
    if constexpr (F32) {
#pragma unroll
        for (int e = 8; e < 16; ++e) S.tq[e] = *(const f32x4*)QROW(e); SBAR(); }
#undef QROW
    pv_tile<0, SK>(o, vb0, pa0, pa1, pa2, pa3, ACT(even ? NT - 2 : NT - 1));
    if (even) { MASKT(pB0, pB1, NT - 1); partialSM(pB0, pB1, m_reg, mnB, alB); __syncthreads(); RESC(alB);
        finishSM(pB0, pB1, alB, l_reg, pa0, pa1, pa2, pa3); SBAR(); pv_tile<1, SK>(o, vb0, pa0, pa1, pa2, pa3, ACT(NT - 1)); }
    SBAR(); SEAM_K0();
    {
    int tz = threadIdx.x; asm volatile("" : "+v"(tz));
    const int lane_e = tz & 63, wid_e = __builtin_amdgcn_readfirstlane(tz >> 6), r32_e = lane_e & 31, hi_e = lane_e >> 5;
    float* li_e = (float*)(lds + 2 * SHM_V + 2 * SHM_K) + wid_e * 64;
    if (hi_e == 0) li_e[r32_e] = l_reg; asm volatile("s_waitcnt lgkmcnt(0)" ::: "memory");
    float rli[16];
#pragma unroll
    for (int r = 0; r < 16; ++r) rli[r] = __builtin_amdgcn_rcpf(li_e[crow(r, hi_e)]);
    char* ost = lds + OST_OFF + wid_e * OST_WAVE;
    {   char* ob = ost + (4 * hi_e * ORS + r32_e) * 2;
#pragma unroll
        for (int r = 0; r < 16; ++r) {
#pragma unroll
            for (int d0 = 0; d0 < 4; ++d0) { const float v = o[d0][r] * rli[r]; const float vn = __shfl_xor(v, 1);
                if ((r32_e & 1) == 0) *(unsigned*)(ob + (((r & 3) + 8 * (r >> 2)) * ORS + d0 * 32) * 2) = cvtpk(v, vn); } } }
    asm volatile("s_waitcnt lgkmcnt(0)" ::: "memory");
    if constexpr (!F32) {
        const TIn* qn = nxt.Q + (size_t)(wid_e * QBLK + r32_e) * D + hi_e * 8;
#pragma unroll
        for (int d0 = 0; d0 < 8; ++d0) S.qr[d0] = load8<TIn>(qn + d0 * 16); }
    {   const int orow = lane_e >> 4, och = lane_e & 15;
        const TOut* Ow_c = cur.O + (size_t)(wid_e * QBLK + orow) * OSTR + och * 8; TOut* Ow = const_cast<TOut*>(Ow_c);
        const TIn* Gw = cur.G + (size_t)(wid_e * QBLK + orow) * GSTR + och * 8;
#pragma unroll
        for (int i = 0; i < 8; ++i) {
            const u32x4 ov = *(const u32x4*)(ost + (4 * i + orow) * ORS * 2 + och * 16);
            const u32x4 gv = *(const u32x4*)(Gw + (size_t)(4 * i) * GSTR);
            u32x4 w;
#pragma unroll
            for (int k = 0; k < 4; ++k) w[k] = cvtpk(__uint_as_float(ov[k] << 16) * __uint_as_float(gv[k] << 16), __uint_as_float(ov[k] & 0xffff0000u) * __uint_as_float(gv[k] & 0xffff0000u));
            *(u32x4*)(Ow + (size_t)(4 * i) * OSTR) = w; } }
    if constexpr (!F32) {
        char* qsw = ost + r32_e * ORS * 2 + hi_e * 16;
#pragma unroll
        for (int d0 = 0; d0 < 8; ++d0) *reinterpret_cast<bf16x8*>(qsw + d0 * 32) = S.qr[d0]; }
    }
    if constexpr (F32) {
#pragma unroll
        for (int d0 = 0; d0 < 8; ++d0) S.qr[d0] = pack8(S.tq[2 * d0], S.tq[2 * d0 + 1]); }
    __syncthreads();
#undef RESC
#undef KBASE
#undef ACT
#undef MASKT
#undef SEAM_K0
#undef BIASADD
#undef HALF_STEP
}
#undef ROW
#undef VMW
#undef VMWN
#undef SLOAD_H
#undef SWRITE_HK
#undef SWRITE_HV
#undef SWRITE_H
#undef SLOAD_F
#undef SWRITE_KF
#undef SWRITE_VF


}

namespace dec {
constexpr int D = 128, PG16 = 16, WAVES = 4, GE = 4, GEP = 4, HPL = 1, NSPLIT = 4, TOK_STRIDE = 512;
constexpr int PPW = (PAST / PG16) / NSPLIT / WAVES;
constexpr int LDS_P = 0, LDS_MRG = WAVES * 64 * HPL, MRG_REC = 4 + D, LDS_FLOATS = LDS_MRG + WAVES * GEP * MRG_REC + 4;
using bf16x2 = __attribute__((ext_vector_type(2))) __bf16;
using u32x4  = __attribute__((ext_vector_type(4))) unsigned;
using f32x4  = __attribute__((ext_vector_type(4))) float;
using f32x8  = __attribute__((ext_vector_type(8))) float;
__device__ __forceinline__ float dot2(unsigned k, unsigned q, float acc) { return __builtin_amdgcn_fdot2_f32_bf16(__builtin_bit_cast(bf16x2, k), __builtin_bit_cast(bf16x2, q), acc, false); }
__device__ __forceinline__ unsigned cvtpk(float lo, float hi) { unsigned r; asm volatile("v_cvt_pk_bf16_f32 %0, %1, %2" : "=v"(r) : "v"(lo), "v"(hi)); return r; }
template <int CTRL> __device__ __forceinline__ float dpp(float x) { return __builtin_bit_cast(float, __builtin_amdgcn_mov_dpp(__builtin_bit_cast(int, x), CTRL, 0xf, 0xf, true)); }
constexpr int XOR1 = 0xB1, XOR2 = 0x4E, XOR7 = 0x141, XOR8 = 0x128, ROR4 = 0x124;
__device__ __forceinline__ float xrow16_max(float x) {
  auto s = __builtin_amdgcn_permlane16_swap(__float_as_uint(x), __float_as_uint(x), false, false);
  x = fmaxf(__uint_as_float(s[0]), __uint_as_float(s[1]));
  auto t = __builtin_amdgcn_permlane32_swap(__float_as_uint(x), __float_as_uint(x), false, false);
  return fmaxf(__uint_as_float(t[0]), __uint_as_float(t[1]));
}
__device__ __forceinline__ float xrow16_sum(float x) {
  auto s = __builtin_amdgcn_permlane16_swap(__float_as_uint(x), __float_as_uint(x), false, false);
  x = __uint_as_float(s[0]) + __uint_as_float(s[1]);
  auto t = __builtin_amdgcn_permlane32_swap(__float_as_uint(x), __float_as_uint(x), false, false);
  return __uint_as_float(t[0]) + __uint_as_float(t[1]);
}
__device__ __forceinline__ f32x8 ld8(const float* p) { const f32x4 lo = __builtin_nontemporal_load(reinterpret_cast<const f32x4*>(p)), hi = __builtin_nontemporal_load(reinterpret_cast<const f32x4*>(p + 64));
  return f32x8{lo[0], lo[1], lo[2], lo[3], hi[0], hi[1], hi[2], hi[3]}; }
__device__ __forceinline__ u32x4 tobf(f32x8 x) { u32x4 w = {cvtpk(x[0], x[1]), cvtpk(x[2], x[3]), cvtpk(x[4], x[5]), cvtpk(x[6], x[7])}; return w; }

struct DecArgs { const float* q; const float* k; const float* v; const int* pt; const float* sufx; float* pml; float* po; };

__device__ __forceinline__ void decode_unit(const DecArgs& a, int b, int kvh, int s, float* lds, int wave, int lane) {
  const int r = lane >> 4, c = lane & 15;
  constexpr float C2 = ATT_SCALE * 1.4426950408889634f;
  const int sp0 = s * (PAST / PG16 / NSPLIT);
  int btv = 0;
  if (lane < PPW) { const int sp = sp0 + wave + 4 * lane; btv = a.pt[b * NPAGES + (sp >> 3)] * 8 + (sp & 7); }
  u32x4 qpk[GEP];
#pragma unroll
  for (int g = 0; g < GEP; ++g) { const float* qp = a.q + ((size_t)(b * 4 + g) * 512 + kvh * D + 4 * c); const f32x4 lo = *reinterpret_cast<const f32x4*>(qp), hi = *reinterpret_cast<const f32x4*>(qp + 64);
    qpk[g] = tobf(f32x8{lo[0], lo[1], lo[2], lo[3], hi[0], hi[1], hi[2], hi[3]}); }
  const unsigned loff = (unsigned)(r * TOK_STRIDE + 4 * c);
  const float* sufx = a.sufx + (size_t)(b * 4 + kvh) * PAST; const unsigned soff = (unsigned)(r + 4 * (c >> 2));
#define PAGE_BASE(spid) ((size_t)(spid) * (PG16 * TOK_STRIDE) + (size_t)kvh * D)
#define ISSUE_K(KBUF, BV, i_) do { const int ii_ = (i_) < PPW ? (i_) : PPW - 1; const int phys_ = __builtin_amdgcn_readlane(btv, ii_); const float* kb_ = a.k + PAGE_BASE(phys_); \
    _Pragma("unroll") for (int t_ = 0; t_ < 4; ++t_) KBUF[t_] = ld8(kb_ + (loff + (unsigned)(t_ * 4 * TOK_STRIDE))); BV = sufx[(unsigned)((sp0 + wave + 4 * ii_) * PG16) + soff]; } while (0)
#define ISSUE_V(i_) do { const int ii_ = (i_) < PPW ? (i_) : PPW - 1; const int phys_ = __builtin_amdgcn_readlane(btv, ii_); const float* vb_ = a.v + PAGE_BASE(phys_); \
    _Pragma("unroll") for (int t_ = 0; t_ < 4; ++t_) Vn[t_] = ld8(vb_ + (loff + (unsigned)(t_ * 4 * TOK_STRIDE))); } while (0)
  f32x8 KA[4], KB[4], Vn[4]; float bA, bB;
  float m[HPL], l[HPL], acc[GEP * 8];
#pragma unroll
  for (int j = 0; j < HPL; ++j) { m[j] = -INFINITY; l[j] = 0.f; }
#pragma unroll
  for (int k = 0; k < GEP * 8; ++k) acc[k] = 0.f;
  ISSUE_K(KA, bA, 0); ISSUE_V(0); ISSUE_K(KB, bB, 1);
#define TR_STEP(HALF, CTRL, BIT) _Pragma("unroll") for (int h = 0; h < (HALF); ++h) _Pragma("unroll") for (int j = 0; j < HPL; ++j) { \
      const float lo_ = x[h * HPL + j], hi_ = x[(h + (HALF)) * HPL + j]; const float t1_ = lo_ + dpp<CTRL>(lo_), t2_ = hi_ + dpp<CTRL>(hi_); \
      x[h * HPL + j] = (c & (BIT)) ? t2_ : t1_; }
#define DEC_STEP(KBUF, BV, i_) do {                                                                                              \
    u32x4 Kc[4], Vc[4];                                                                                                          \
    _Pragma("unroll") for (int t = 0; t < 4; ++t) { Kc[t] = tobf(KBUF[t]); Vc[t] = tobf(Vn[t]); }                                \
    const float bias = BV;                                                                                                       \
    ISSUE_V((i_) + 1); ISSUE_K(KBUF, BV, (i_) + 2);                                                                              \
    float x[4 * GEP];                                                                                                            \
    _Pragma("unroll") for (int t = 0; t < 4; ++t) _Pragma("unroll") for (int g = 0; g < GEP; ++g) { float d = 0.f;              \
        _Pragma("unroll") for (int k = 0; k < 4; ++k) d = dot2(Kc[t][k], qpk[g][k], d);                                          \
        x[t * GEP + g] = d; }                                                                                                    \
    TR_STEP(8, XOR8, 8) TR_STEP(4, XOR7, 4) TR_STEP(2, XOR2, 2) TR_STEP(1, XOR1, 1)                                              \
    float p[HPL], alpha[HPL];                                                                                                    \
    _Pragma("unroll") for (int j = 0; j < HPL; ++j) {                                                                            \
      const float sc = x[j] * C2 + bias;                                                                                         \
      float pm = sc; pm = fmaxf(pm, dpp<ROR4>(pm)); pm = fmaxf(pm, dpp<XOR8>(pm)); pm = xrow16_max(pm);                          \
      const float mn = fmaxf(m[j], pm), msub = (mn == -INFINITY) ? 0.f : mn;                                                     \
      alpha[j] = __builtin_amdgcn_exp2f(m[j] - msub); p[j] = __builtin_amdgcn_exp2f(sc - msub);                                  \
      l[j] = fmaf(l[j], alpha[j], p[j]); m[j] = mn; }                                                                            \
    _Pragma("unroll") for (int q4 = 0; q4 < 4; ++q4) _Pragma("unroll") for (int j = 0; j < HPL; ++j) {                           \
        const float al = q4 == 0 ? dpp<0x00>(alpha[j]) : q4 == 1 ? dpp<0x55>(alpha[j]) : q4 == 2 ? dpp<0xAA>(alpha[j]) : dpp<0xFF>(alpha[j]); \
        _Pragma("unroll") for (int k = 0; k < 8; ++k) acc[(q4 * HPL + j) * 8 + k] *= al; }                                       \
    float* prow = lds + LDS_P + (wave * 4 + r) * 16 * HPL;                                                                       \
    _Pragma("unroll") for (int j = 0; j < HPL; ++j) prow[c * HPL + j] = p[j];                                                    \
    asm volatile("s_waitcnt lgkmcnt(0)" ::: "memory");                                                                           \
    f32x4 pr[GEP];                                                                                                               \
    _Pragma("unroll") for (int u = 0; u < GEP; ++u) pr[u] = *reinterpret_cast<const f32x4*>(prow + 4 * u);                       \
    _Pragma("unroll") for (int t = 0; t < 4; ++t) { float vf[8];                                                                 \
      _Pragma("unroll") for (int k = 0; k < 4; ++k) { vf[2 * k] = __builtin_bit_cast(float, Vc[t][k] << 16); vf[2 * k + 1] = __builtin_bit_cast(float, Vc[t][k] & 0xffff0000u); } \
      _Pragma("unroll") for (int g = 0; g < GE; ++g) { const float pg_ = pr[(t * GEP + g) >> 2][(t * GEP + g) & 3];              \
        _Pragma("unroll") for (int k = 0; k < 8; ++k) acc[g * 8 + k] = fmaf(pg_, vf[k], acc[g * 8 + k]); } } } while (0)
#pragma unroll 1
  for (int i = 0; i < PPW; i += 2) { DEC_STEP(KA, bA, i); DEC_STEP(KB, bB, i + 1); }
#undef DEC_STEP
#undef TR_STEP
#undef ISSUE_K
#undef ISSUE_V
#undef PAGE_BASE
#pragma unroll
  for (int k = 0; k < GE * 8; ++k) acc[k] = xrow16_sum(acc[k]);
#pragma unroll
  for (int j = 0; j < HPL; ++j) { float t = l[j]; t += dpp<ROR4>(t); t += dpp<XOR8>(t); l[j] = xrow16_sum(t); }
  float* mrg = lds + LDS_MRG;
  if (r == 0) {
#pragma unroll
    for (int g = 0; g < GE; ++g) {
      float* rec = mrg + (wave * GEP + g) * MRG_REC;
#pragma unroll
      for (int k = 0; k < 8; k += 4) *reinterpret_cast<f32x4*>(rec + 4 + 4 * c + 16 * k) = f32x4{acc[g * 8 + k], acc[g * 8 + k + 1], acc[g * 8 + k + 2], acc[g * 8 + k + 3]};
      if (c == g / HPL) { rec[0] = m[g % HPL]; rec[1] = l[g % HPL]; } } }
  __syncthreads();
  {
    const int g = wave, d0 = 2 * lane;
    const size_t row = (size_t)(b * 4 + kvh) * 4 + g;
    float M = -INFINITY;
#pragma unroll
    for (int w = 0; w < WAVES; ++w) M = fmaxf(M, mrg[(w * GEP + g) * MRG_REC]);
    float L = 0.f, o0 = 0.f, o1 = 0.f;
#pragma unroll
    for (int w = 0; w < WAVES; ++w) { const float* rec = mrg + (w * GEP + g) * MRG_REC; const float lw = rec[1];
      const float wt = (lw > 0.f) ? __builtin_amdgcn_exp2f(rec[0] - M) : 0.f;
      L = fmaf(wt, lw, L); o0 = fmaf(wt, rec[4 + d0], o0); o1 = fmaf(wt, rec[4 + d0 + 1], o1); }
    const size_t slot = row * NSPLIT + s;
    *reinterpret_cast<float2*>(a.po + slot * D + d0) = make_float2(o0, o1);
    if (lane == 0) *reinterpret_cast<float2*>(a.pml + 2 * slot) = make_float2(M, L);
  }
  __syncthreads();
}

struct CombArgs { const float* pml; const float* po; const float* q; const float* knew; const float* vnew; const float* lfb; const unsigned short* gate; unsigned short* mix; };
__device__ __forceinline__ void combine_row(const CombArgs& a, int b, int h, int t, int lane) {
  constexpr float C2 = ATT_SCALE * 1.4426950408889634f;
  const size_t row = (size_t)(b * 4 + h) * 4 + t; const int d0 = 2 * lane;
  const float* pml = a.pml + row * NSPLIT * 2; const float* po = a.po + row * NSPLIT * D;
  const float2 qv = *reinterpret_cast<const float2*>(a.q + (size_t)(b * 4 + t) * 512 + h * D + d0);
  float scn[4]; float cum = 0.f;
#pragma unroll
  for (int s = 0; s < 4; ++s) {
    const float2 kv = *reinterpret_cast<const float2*>(a.knew + (size_t)(b * 4 + s) * 512 + h * D + d0);
    float d = qv.x * kv.x + qv.y * kv.y;
#pragma unroll
    for (int o = 1; o < 64; o <<= 1) d += __shfl_xor(d, o);
    cum += a.lfb[(size_t)(MP + b * 4 + s) * 4 + h];
    scn[s] = (s <= t) ? d * C2 - cum * LOG2E : -INFINITY;
  }
  float M = -INFINITY;
#pragma unroll
  for (int s = 0; s < NSPLIT; ++s) M = fmaxf(M, pml[2 * s]);
#pragma unroll
  for (int s = 0; s < 4; ++s) M = fmaxf(M, scn[s]);
  float L = 0.f, o0 = 0.f, o1 = 0.f;
#pragma unroll
  for (int s = 0; s < NSPLIT; ++s) { const float ls = pml[2 * s + 1], w = (ls > 0.f) ? __builtin_amdgcn_exp2f(pml[2 * s] - M) : 0.f;
    const float2 av = *reinterpret_cast<const float2*>(po + (size_t)s * D + d0);
    L = fmaf(w, ls, L); o0 = fmaf(w, av.x, o0); o1 = fmaf(w, av.y, o1); }
#pragma unroll
  for (int s = 0; s < 4; ++s) { const float w = __builtin_amdgcn_exp2f(scn[s] - M);
    const float2 vv = *reinterpret_cast<const float2*>(a.vnew + (size_t)(b * 4 + s) * 512 + h * D + d0);
    L += w; o0 = fmaf(w, vv.x, o0); o1 = fmaf(w, vv.y, o1); }
  const float inv = 1.f / L;
  const size_t ms = (size_t)(MP + b * 4 + t);
  const unsigned gp = *reinterpret_cast<const unsigned*>(a.gate + ms * 512 + h * D + d0);
  const float g0 = __uint_as_float(gp << 16), g1 = __uint_as_float(gp & 0xffff0000u);
  *reinterpret_cast<unsigned*>(a.mix + ms * 1024 + 512 + h * D + d0) = cvtpk(o0 * inv * g0, o1 * inv * g1);
}
}

__device__ __forceinline__ void p6_rpass(Frame& F, int part) {
    const int gw = (int)blockIdx.x * NWAVES + F.wave, NGW = F.G * NWAVES, fr = F.lane & 15, fq = F.lane >> 4;
    const bf16* X1B = WSP(bf16, WS_XN); const bf16* WRB = WSP(bf16, WS_WR); const bf16* WGB = WSP(bf16, WS_WR + 65536);
    bf16* GF3 = WSP(bf16, WS_GF3); const float* SS1 = (const float*)(F.ctl + CW_SS1);
    LAS unsigned char* rt = F.lds + RING_OFF + F.wave * 512;
    constexpr int NU = MT / 8;
    for (int it = (NGW == 2048 && part == 1) ? 1 : 0; ; ++it) {
        int u;
        if (NGW == 2048) { if (it == 0) u = gw; else if (it == 1 && part != 0 && F.wave == 0 && blockIdx.x >= 192 && (int)blockIdx.x < 192 + (NU - 2048)) u = 2048 + (int)blockIdx.x - 192; else break; }
        else { if (part == 1) break; u = gw + it * NGW; if (u >= NU) break; }
        const int g = u >> 1, hh = u & 1, row0 = 16 * g;
        const GAS bf16x8* wp = (const GAS bf16x8*)(WRB + (size_t)fr * DM + 8 * fq);
        const GAS bf16x8* ap = (const GAS bf16x8*)(X1B + (size_t)(row0 + fr) * DM + 8 * fq);
        pg8::f32x4 acc = {0.f, 0.f, 0.f, 0.f};
#pragma unroll 1
        for (int k0 = 0; k0 < 32; k0 += 16) {
            bf16x8 wv[16], av[16];
#pragma unroll
            for (int i = 0; i < 16; ++i) { wv[i] = wp[(k0 + i) * 4]; av[i] = ap[(k0 + i) * 4]; }
#pragma unroll
            for (int i = 0; i < 16; ++i) acc = __builtin_amdgcn_mfma_f32_16x16x32_bf16(wv[i], av[i], acc, 0, 0, 0);
        }
        const float rstd = 1.0f / sqrtf(SS1[row0 + fr] * (1.f / DM) + EPS);
        acc = acc * rstd;
        { u32x2v w; w.x = cvtpk_s(acc[0], acc[1]); w.y = cvtpk_s(acc[2], acc[3]); *(LAS u32x2v*)(rt + (fr * 16 + 4 * fq) * 2) = w; }
        LDS_WAIT(); asm volatile("" ::: "memory");
        bf16x8 rb = {0, 0, 0, 0, 0, 0, 0, 0};
        if (fq < 2) rb = *(const LAS bf16x8*)(rt + (fr * 16 + 8 * fq) * 2);
        LDS_WAIT(); asm volatile("" ::: "memory");
#pragma unroll 4
        for (int ct = 16 * hh; ct < 16 * hh + 16; ++ct) {
            bf16x8 wa = {0, 0, 0, 0, 0, 0, 0, 0};
            if (fq < 2) wa = *(const GAS bf16x8*)(WGB + (size_t)(16 * ct + fr) * 16 + 8 * fq);
            const pg8::f32x4 z = {0.f, 0.f, 0.f, 0.f};
            const pg8::f32x4 d = __builtin_amdgcn_mfma_f32_16x16x32_bf16(wa, rb, z, 0, 0, 0);
            const f32x4 bg = *(const GAS f32x4*)(F.b_gla_gate + 16 * ct + 4 * fq);
            f32x4 lf; lf.x = log_sigmoidf_(d[0] + bg.x) * 0.0625f; lf.y = log_sigmoidf_(d[1] + bg.y) * 0.0625f; lf.z = log_sigmoidf_(d[2] + bg.z) * 0.0625f; lf.w = log_sigmoidf_(d[3] + bg.w) * 0.0625f;
            st_bf4(GF3 + (size_t)(row0 + fr) * 512 + 16 * ct + 4 * fq, lf);
        }
    }
    __syncthreads();
}
__device__ __forceinline__ void p11_final(Frame& F) {
    const int gw = (int)blockIdx.x * NWAVES + F.wave, NGW = F.G * NWAVES;
    const float* SS2 = (const float*)(F.ctl + CW_SS2);
    for (int m = gw; m < MT; m += NGW) {
        int ln = F.lane; asm volatile("" : "+v"(ln));
        GAS f32x4* yr = (GAS f32x4*)(F.out + O_Y + (size_t)m * DM) + ln;
        const float rstd = 1.0f / sqrtf(SS2[m] * (1.f / DM) + EPS);
#pragma unroll
        for (int j = 0; j < 4; ++j) { const f32x4 g = *(const GAS f32x4*)(F.final_norm + 4 * ln + 256 * j); yr[64 * j] = yr[64 * j] * rstd * g; }
    }
}

struct SE1 { P1 p; __device__ __forceinline__ void operator()(int m, int c, f32x4 v) const { epi1_4(p, m, c, v); } };
struct SE2 { P2 p; __device__ __forceinline__ void operator()(int m, int c, f32x4 v) const { float ss = epi2_4(p, m, c, v); ss += __shfl_xor(ss, 16); ss += __shfl_xor(ss, 32); if (((c >> 2) & 3) == 0) atomicAdd(p.SS + m, ss); } };
struct SE3 { P3 p; __device__ __forceinline__ void operator()(int m, int c, f32x4 v) const { const float rstd = 1.0f / sqrtf(p.SS[m] * (1.f / DM) + EPS); epi3_4(p, m, c, v, rstd); } };
struct SE4 { P4 p; __device__ __forceinline__ void operator()(int m, int c, f32x4 v) const { float ss = epi4_4(p, m, c, v); ss += __shfl_xor(ss, 16); ss += __shfl_xor(ss, 32); if (((c >> 2) & 3) == 0) atomicAdd(p.SS + m, ss); } };
typedef fox::BlockRef<fox::TIN, fox::TOUT> FoxRef;
__device__ __forceinline__ FoxRef fox_ref(unsigned char* ws, int bh, int qb) {
    const fox::TIN* Q = (const fox::TIN*)(ws + WS_QBH); const fox::TIN* K = (const fox::TIN*)(ws + WS_KBH); const fox::TIN* V = (const fox::TIN*)(ws + WS_VBH);
    const int b = bh >> 2, h = bh & 3; FoxRef r;
    r.Q = Q + ((size_t)bh * SEQ + (size_t)qb * 256) * 128; r.K = K + (size_t)bh * SEQ * 128; r.V = V + (size_t)bh * SEQ * 128;
    r.O = (fox::TOUT*)(ws + WS_MIX) + ((size_t)(b * SEQ + qb * 256)) * 1024 + 512 + h * 128; r.G = (const fox::TIN*)(ws + WS_GB) + ((size_t)(b * SEQ + qb * 256)) * 512 + h * 128;
    r.CB = (const float*)(ws + WS_CBP) + (size_t)blockIdx.x * SEQ; r.P0 = qb * 256; return r;
}


__device__ __forceinline__ void sub_barrier(unsigned* cnt, unsigned n, unsigned& gen) {
    asm volatile("s_waitcnt vmcnt(0)" ::: "memory");
    __syncthreads();
    if (threadIdx.x == 0) {
        __builtin_amdgcn_fence(__ATOMIC_RELEASE, "agent");
        asm volatile("s_waitcnt vmcnt(0)" ::: "memory");
        (void)__hip_atomic_fetch_add(cnt, 1u, __ATOMIC_RELAXED, __HIP_MEMORY_SCOPE_AGENT);
        const unsigned target = (gen + 1u) * n; unsigned sp = 0;
        while (__hip_atomic_load(cnt, __ATOMIC_RELAXED, __HIP_MEMORY_SCOPE_AGENT) < target) { __builtin_amdgcn_s_sleep(1); if (++sp > (1u << 22)) break; }
        __builtin_amdgcn_fence(__ATOMIC_ACQUIRE, "agent");
        asm volatile("s_waitcnt vmcnt(0)" ::: "memory");
    }
    __syncthreads();
    ++gen;
}

#ifndef MK_N_LAUNCHES
#define MK_N_LAUNCHES 1
#endif
constexpr int N_LAUNCHES = MK_N_LAUNCHES;
constexpr int N_PHASES = 12;
struct Args { const void* in[21]; float* out; unsigned char* ws; int ph_lo, ph_hi, sub, pad; };
__global__ void __launch_bounds__(NWAVES * 64, 2) hybrid_fwd(Args args) {
    extern __shared__ __attribute__((aligned(16))) unsigned char lds[];
    Frame F;
    F.lds = (LAS unsigned char*)lds;
    F.MISC = (volatile LAS unsigned*)(F.lds + MISC_OFF);
    F.tid = threadIdx.x; F.lane = F.tid & 63; F.wave = __builtin_amdgcn_readfirstlane(F.tid >> 6);
    F.G = gridDim.x;
    F.ws = args.ws; F.out = args.out; F.ctl = (gu32*)(args.ws + WS_CTL);
    F.xp = (const float*)args.in[0]; F.xs = (const float*)args.in[1]; F.ck = (const float*)args.in[2]; F.cv = (const float*)args.in[3]; F.clf = (const float*)args.in[4];
    F.sh = (const float*)args.in[5]; F.sg = (const float*)args.in[6]; F.pt = (const int*)args.in[7];
    F.norm_even = (const float*)args.in[8]; F.w_in_even = (const float*)args.in[9]; F.b_fox = (const float*)args.in[10]; F.lb_logits = (const float*)args.in[11];
    F.hgrn_gain = (const float*)args.in[12]; F.w_out_even = (const float*)args.in[13]; F.norm_odd = (const float*)args.in[14]; F.w_in_odd = (const float*)args.in[15];
    F.w_gla_gate = (const float*)args.in[16]; F.b_gla_gate = (const float*)args.in[17]; F.gla_gain = (const float*)args.in[18]; F.w_out_odd = (const float*)args.in[19]; F.final_norm = (const float*)args.in[20];
    for (int u = F.tid; u < (LDS_BYTES - LDSCTL_OFF) / 4; u += NWAVES * 64) ((LAS unsigned*)(F.lds + LDSCTL_OFF))[u] = 0u;
    __syncthreads();
    XcdBarrier bar; bar.bar = (unsigned*)(F.ctl + CW_BAR); bar.x = 0; bar.st = nullptr; bar.total = 0u;
    if (N_LAUNCHES == 1) bar = xcd_barrier_post((unsigned*)(F.ctl + CW_BAR), F.MISC + 8);
    XcdBarrier bar2; bar2.bar = (unsigned*)(F.ctl + CW_BAR2); bar2.x = 0; bar2.st = nullptr; bar2.total = 0u;
    if ((int)blockIdx.x >= (int)gridDim.x / 2) { bar2 = xcd_barrier_post((unsigned*)(F.ctl + CW_BAR2), F.MISC + 12); bar2.total = gridDim.x - gridDim.x / 2; }
#define GRID_BAR() do { if (N_LAUNCHES == 1) xcd_barrier(bar); } while (0)
    const int lo = args.ph_lo, hi = args.ph_hi;
#ifndef REP_MASK
#define REP_MASK 0
#endif
#if REP_MASK
#define REPS(k) for (int rep_ = 0; rep_ <= (((REP_MASK) >> (k)) & 1); ++rep_)
#else
#define REPS(k)
#endif
#ifndef SUB_MASK
#define SUB_MASK 7
#endif
#ifndef PH_MASK
#define PH_MASK 0xFFF
#endif
#define IN(k) ((((PH_MASK) >> (k)) & 1) && lo <= (k) && (k) < hi)
#define BOTH(k) (IN(k) && IN((k) + 1))
    const int bid = blockIdx.x;

    REPS(0) if (IN(0)) { p0_prologue(F, args.sub); if (BOTH(0)) GRID_BAR(); }

    REPS(1) if (IN(1)) {
        const bool late1 = (xb_xcc_id() & 4u) != 0u;
        P1 p{WSP(bf16, WS_QA), WSP(bf16, WS_IA), WSP(bf16, WS_GA), WSP(bf16, WS_GB), WSP(bf16, WS_QBH), WSP(bf16, WS_KBH), WSP(bf16, WS_VBH), WSP(bf16, WS_GF), WSP(float, WS_QS), WSP(float, WS_LB), F.out};
        { pg8::Gemm g{WSP(bf16, WS_XN), WSP(bf16, WS_W1T), MP, 4096, DM}; pg8::StaticOrder S; S.init(MP, 4096, F.G, bid);
          Epi1 E{p, (args.sub >> 4) & 1 ? 1 : ((args.sub >> 7) & 1 ? 2 : 0)};
          if (!late1 && !(args.sub & 32)) for (int u = bid; u < 256; u += F.G)
              sgemm_unit(WSP(bf16, WS_XN), WSP(bf16, WS_W1T), u, F.wave, F.lane, SE1{p});
          pg8::gemm_phase<Epi1, pg8::StaticOrder, true, true>(F.lds + RING_OFF, g, S, E); }
        if (late1 && !(args.sub & 32)) for (int u = bid; u < 256; u += F.G)
            sgemm_unit(WSP(bf16, WS_XN), WSP(bf16, WS_W1T), u, F.wave, F.lane, SE1{p});
        if (BOTH(1)) GRID_BAR();
    }

    REPS(2) if (IN(2)) {
        const int half = F.G / 2;
        if (args.sub & 8) {
            dec::DecArgs da{WSP(float, WS_QS), F.ck, F.cv, F.pt, WSP(float, WS_SUFX), WSP(float, WS_PML), WSP(float, WS_PO)};
            float* dl = (float*)(lds + RING_OFF) + (F.wave >> 2) * dec::LDS_FLOATS;
            for (int wu = bid; wu < 256; wu += F.G) { const int du = 2 * wu + (F.wave >> 2); dec::decode_unit(da, du >> 4, (du >> 2) & 3, du & 3, dl, F.wave & 3, F.lane); }
        } else if (bid < half) {
            if ((SUB_MASK & 1) && (args.sub & 1)) for (int L = bid; L < 128; L += half) {
                const int bh = L & 7, x = L >> 3;
                fox_cumsum_private(F, bh >> 2, bh & 3, WSP(float, WS_CBP) + (size_t)blockIdx.x * SEQ);
                const FoxRef b0 = fox_ref(F.ws, bh, 31 - x), b1 = fox_ref(F.ws, bh, x);
                fox::Seam<fox::TIN> S;
                fox::causal_swa_prime<fox::TIN, fox::TOUT>(b0, fox::WINDOW, (char*)lds + RING_OFF, S);
                FoxRef cur = b0; int pass = 0;
                for (;;) { const bool last = pass == 1; const FoxRef nxt = last ? cur : b1;
                    fox::causal_swa_block<fox::TIN, fox::TOUT>(cur, nxt, fox::SKV, fox::WINDOW, (char*)lds + RING_OFF, S);
                    if (last) break; cur = nxt; pass = 1; }
            }
        } else {
            const int cb = bid - half, nb = F.G - half;
            if ((SUB_MASK & 2) && (args.sub & 2)) { dec::DecArgs da{WSP(float, WS_QS), F.ck, F.cv, F.pt, WSP(float, WS_SUFX), WSP(float, WS_PML), WSP(float, WS_PO)};
              float* dl = (float*)(lds + RING_OFF) + (F.wave >> 2) * dec::LDS_FLOATS;
              for (int wu = cb; wu < 256; wu += nb) { const int du = 2 * wu + (F.wave >> 2); dec::decode_unit(da, du >> 4, du & 3, (du >> 2) & 3, dl, F.wave & 3, F.lane); } }
            __syncthreads();
            LaArgs a{}; a.Q = WSP(bf16, WS_QA); a.Kp = nullptr; a.G = WSP(bf16, WS_GF); a.V = WSP(bf16, WS_IA); a.GATE = WSP(bf16, WS_GA); a.ldv = 512; a.gain = F.hgrn_gain; a.MIXo = WSP(bf16, WS_MIX); a.mixoff = 0;
            if ((SUB_MASK & 4) && (args.sub & 4)) {
              for (int u = cb; u < 256; u += nb) { const int bh = u >> 5, sc = u & 31; a.SBUF = WSP(bf16, WS_SLOC) + (size_t)u * 16384; a.BTOT = WSP(float, WS_BTOT) + (size_t)u * 128;
                  la_unit<128, false, 0>(F.lds + RING_OFF, a, (bh >> 2) * SEQ + sc * 256, bh & 3, F.tid, F.wave, F.lane); }
            }
            if (args.sub == 7) {
              xcd_barrier(bar2);
              if (cb == 0 && F.tid == 0) __hip_atomic_store((unsigned*)(F.ctl + CW_FLAG), 1u, __ATOMIC_RELAXED, __HIP_MEMORY_SCOPE_AGENT);
              la_scan<128>(WSP(bf16, WS_SLOC), WSP(float, WS_BTOT), F.out + O_HSP, cb * 512 + F.tid, nb * 512);
              xcd_barrier(bar2);
              for (int u = cb; u < 256; u += nb) { const int bh = u >> 5, sc = u & 31; a.SBUF = WSP(bf16, WS_SLOC) + (size_t)u * 16384; a.BTOT = nullptr;
                  la_unit<128, false, 1>(F.lds + RING_OFF, a, (bh >> 2) * SEQ + sc * 256, bh & 3, F.tid, F.wave, F.lane); }
            }
        }
        if (args.sub == 7) {
            constexpr int T_S = 128, T_C = 64, T_W = 160, T_ALL = T_S + T_C + T_W;
            LaArgs a{}; a.Q = WSP(bf16, WS_QA); a.Kp = nullptr; a.G = WSP(bf16, WS_GF); a.V = WSP(bf16, WS_IA); a.GATE = WSP(bf16, WS_GA); a.ldv = 512; a.gain = F.hgrn_gain; a.MIXo = WSP(bf16, WS_MIX); a.mixoff = 0;
            dec::CombArgs ca{WSP(float, WS_PML), WSP(float, WS_PO), WSP(float, WS_QS), F.out + O_KS, F.out + O_VS, WSP(float, WS_LFB), WSP(bf16, WS_GB), WSP(bf16, WS_MIX)};
            bool flagged = bid >= half; unsigned nxt = 0u; int par = 0;
            __syncthreads();
            if (F.tid == 0) nxt = __hip_atomic_fetch_add((unsigned*)(F.ctl + CW_TAIL), 1u, __ATOMIC_RELAXED, __HIP_MEMORY_SCOPE_AGENT);
            for (;;) {
                if (F.tid == 0) F.MISC[16 + par] = nxt;
                __syncthreads();
                const int it = __builtin_amdgcn_readfirstlane((int)F.MISC[16 + par]); par ^= 1;
                if (it >= T_ALL) break;
                if (F.tid == 0) nxt = __hip_atomic_fetch_add((unsigned*)(F.ctl + CW_TAIL), 1u, __ATOMIC_RELAXED, __HIP_MEMORY_SCOPE_AGENT);
                if (it < T_S) { a.S0 = F.sh + (size_t)it * 16384; a.S1 = F.out + O_HSS + (size_t)it * 16384;
                    la_sample_unit<128, false>(F.lds + RING_OFF, a, it, F.tid, F.wave, F.lane); }
                else if (it < T_S + T_C) {
                    if (!flagged) { flagged = true;
                        if (F.tid == 0) { unsigned sp = 0; while (__hip_atomic_load((unsigned*)(F.ctl + CW_FLAG), __ATOMIC_RELAXED, __HIP_MEMORY_SCOPE_AGENT) == 0u) { __builtin_amdgcn_s_sleep(2); if (++sp > (1u << 22)) break; }
                            __builtin_amdgcn_fence(__ATOMIC_ACQUIRE, "agent"); asm volatile("s_waitcnt vmcnt(0)" ::: "memory"); }
                        __syncthreads(); }
                    const int r = (it - T_S) * NWAVES + F.wave; dec::combine_row(ca, r >> 4, (r >> 2) & 3, r & 3, F.lane); }
                else { __syncthreads(); late_weights(F, (it - T_S - T_C) * 16 + F.wave, (it - T_S - T_C) * 16 + 16); }
            }
        }
        if (BOTH(2)) GRID_BAR();
    }


    REPS(5) if (IN(5)) {
        P2 p{F.xp, F.xs, WSP(bf16, WS_XN), (float*)(F.ctl + CW_SS1)};
        { pg8::Gemm g{WSP(bf16, WS_MIX), WSP(bf16, WS_W2T), MP, 1024, DM}; pg8::StaticOrder S; S.init(MP, 1024, F.G, bid);
          Epi2 E{p};
          pg8::gemm_phase<Epi2, pg8::StaticOrder, true, true>(F.lds + RING_OFF, g, S, E); }
        for (int u = bid; u < 64; u += F.G)
            sgemm_unit(WSP(bf16, WS_MIX), WSP(bf16, WS_W2T), u, F.wave, F.lane, SE2{p});
        if (BOTH(5)) GRID_BAR();
    }

    REPS(6) if (IN(6)) {
        const bool late6 = (xb_xcc_id() & 4u) != 0u;
        if ((SUB_MASK & 1) && !(args.sub & 64) && !late6) p6_rpass(F, 0);
        P3 p{WSP(bf16, WS_Q3), WSP(bf16, WS_K3), WSP(bf16, WS_V3), WSP(bf16, WS_G3), (const float*)(F.ctl + CW_SS1)};
        if (SUB_MASK & 2) { pg8::Gemm g{WSP(bf16, WS_XN), WSP(bf16, WS_W3T), MP, 3072, DM}; pg8::StaticOrder S; S.init(MP, 3072, F.G, bid);
          Epi3 E{p, (args.sub >> 4) & 1};
          pg8::gemm_phase<Epi3, pg8::StaticOrder, true, true>(F.lds + RING_OFF, g, S, E); }
        if ((SUB_MASK & 4) && !(args.sub & 32)) for (int u = bid; u < 192; u += F.G)
            sgemm_unit(WSP(bf16, WS_XN), WSP(bf16, WS_W3T), u, F.wave, F.lane, SE3{p});
        if ((SUB_MASK & 1) && !(args.sub & 64)) { __syncthreads(); p6_rpass(F, late6 ? 2 : 1); }
        if (BOTH(6)) GRID_BAR();
    }

    REPS(7) if (IN(7)) {
        LaArgs a{}; a.Q = WSP(bf16, WS_Q3); a.Kp = WSP(bf16, WS_K3); a.G = WSP(bf16, WS_GF3); a.V = WSP(bf16, WS_V3); a.GATE = WSP(bf16, WS_G3); a.ldv = 1024; a.gain = F.gla_gain; a.MIXo = WSP(bf16, WS_MIX2); a.mixoff = 0;
        for (int u = bid; u < 256; u += F.G) { const int bh = u >> 5, sc = u & 31; a.SBUF = WSP(bf16, WS_SLOC3) + (size_t)u * 32768; a.BTOT = WSP(float, WS_BTOT) + 32768 + (size_t)u * 128;
            la_unit<256, true, 0>(F.lds + RING_OFF, a, (bh >> 2) * SEQ + sc * 256, bh & 3, F.tid, F.wave, F.lane); }
        for (int u = bid; u < 128; u += F.G) { a.S0 = F.sg + (size_t)u * 32768; a.S1 = F.out + O_GSS + (size_t)u * 32768;
            la_sample_unit<256, true>(F.lds + RING_OFF, a, u, F.tid, F.wave, F.lane); }
        if (BOTH(7)) GRID_BAR();
    }
    REPS(8) if (IN(8)) {
        la_scan<256>(WSP(bf16, WS_SLOC3), WSP(float, WS_BTOT) + 32768, F.out + O_GSP, bid * 512 + F.tid, F.G * 512);
        if (F.G == 256) { P4 p{WSP(bf16, WS_XN), F.out + O_Y, (float*)(F.ctl + CW_SS2)};
            for (int u = 255 - bid; u < 64; u += F.G) sgemm_unit(WSP(bf16, WS_MIX2), WSP(bf16, WS_W4T), u, F.wave, F.lane, SE4{p}); }
        if (BOTH(8)) GRID_BAR();
    }
    REPS(9) if (IN(9)) {
        LaArgs a{}; a.Q = WSP(bf16, WS_Q3); a.Kp = WSP(bf16, WS_K3); a.G = WSP(bf16, WS_GF3); a.V = WSP(bf16, WS_V3); a.GATE = WSP(bf16, WS_G3); a.ldv = 1024; a.gain = F.gla_gain; a.MIXo = WSP(bf16, WS_MIX2); a.mixoff = 0;
        for (int u = bid; u < 256; u += F.G) { const int bh = u >> 5, sc = u & 31; a.SBUF = WSP(bf16, WS_SLOC3) + (size_t)u * 32768; a.BTOT = nullptr;
            la_unit<256, true, 1>(F.lds + RING_OFF, a, (bh >> 2) * SEQ + sc * 256, bh & 3, F.tid, F.wave, F.lane); }
        if (BOTH(9)) GRID_BAR();
    }
    REPS(10) if (IN(10)) {
        P4 p{WSP(bf16, WS_XN), F.out + O_Y, (float*)(F.ctl + CW_SS2)};
        pg8::Gemm g{WSP(bf16, WS_MIX2), WSP(bf16, WS_W4T), MP, 1024, DM}; pg8::StaticOrder S; S.init(MP, 1024, F.G, bid);
        if (F.G == 256) {
            Epi4F E{p, F.final_norm, &bar};
            pg8::gemm_phase<Epi4F, pg8::StaticOrder, false, true>(F.lds + RING_OFF, g, S, E);
            const int gw = bid * NWAVES + F.wave;
            if (gw < MS) { const int m = MP + gw; int ln = F.lane; asm volatile("" : "+v"(ln)); GAS f32x4* yr = (GAS f32x4*)(F.out + O_Y + (size_t)m * DM) + ln;
                const float rstd = 1.0f / sqrtf(__hip_atomic_load(p.SS + m, __ATOMIC_RELAXED, __HIP_MEMORY_SCOPE_AGENT) * (1.f / DM) + EPS);
#pragma unroll
                for (int j = 0; j < 4; ++j) { const f32x4 gg = *(const GAS f32x4*)(F.final_norm + 4 * ln + 256 * j); yr[64 * j] = yr[64 * j] * rstd * gg; } }
        } else {
            Epi4 E{p};
            pg8::gemm_phase<Epi4, pg8::StaticOrder, true, true>(F.lds + RING_OFF, g, S, E);
            for (int u = bid; u < 64; u += F.G) sgemm_unit(WSP(bf16, WS_MIX2), WSP(bf16, WS_W4T), u, F.wave, F.lane, SE4{p});
            if (BOTH(10)) GRID_BAR();
        }
    }
    if (IN(11) && F.G != 256) p11_final(F);
#undef IN
#undef BOTH
}

extern "C" void kernel_launch(void* const* d_in, const int* in_sizes, int n_in, void* d_out, int out_size, void* d_ws, size_t ws_size, hipStream_t stream) {
    static int grid = 0;
    if (grid == 0) {
        if (n_in != 21 || out_size != (int)O_END || ws_size < WS_END) { fprintf(stderr, "kernel_launch: unexpected problem (n_in %d out %d ws %zu)\n", n_in, out_size, ws_size); grid = -1; return; }
        int dev = 0, cus = 0, per_cu = 0;
        if (hipGetDevice(&dev) != hipSuccess || hipDeviceGetAttribute(&cus, hipDeviceAttributeMultiprocessorCount, dev) != hipSuccess) { grid = -1; return; }
        if (hipFuncSetAttribute((const void*)hybrid_fwd, hipFuncAttributeMaxDynamicSharedMemorySize, LDS_BYTES) != hipSuccess) { fprintf(stderr, "kernel_launch: hipFuncSetAttribute failed\n"); grid = -1; return; }
        if (hipOccupancyMaxActiveBlocksPerMultiprocessor(&per_cu, (const void*)hybrid_fwd, NWAVES * 64, LDS_BYTES) != hipSuccess || per_cu < 1)
            fprintf(stderr, "kernel_launch: occupancy query reports %d workgroups per CU\n", per_cu);
        (void)hipGetLastError();
        grid = cus;
    }
    if (grid < 0) return;
    if (hipMemsetAsync((char*)d_ws + WS_CTL, 0, CTL_ZERO_BYTES, stream) != hipSuccess) { fprintf(stderr, "kernel_launch: memset failed\n"); return; }
    Args a{};
    for (int i = 0; i < 21; ++i) a.in[i] = d_in[i];
    a.out = (float*)d_out; a.ws = (unsigned char*)d_ws; a.sub = 7;
    for (int li = 0; li < N_LAUNCHES; ++li) {
        a.ph_lo = (N_LAUNCHES == 1) ? 0 : li; a.ph_hi = (N_LAUNCHES == 1) ? N_PHASES : li + 1;
        hipLaunchKernelGGL(hybrid_fwd, dim3(grid), dim3(NWAVES * 64), LDS_BYTES, stream, a);
        const hipError_t le = hipPeekAtLastError();
        if (le != hipSuccess) { fprintf(stderr, "kernel_launch: launch %d failed: %s\n", li, hipGetErrorName(le)); break; }
    }
#if defined(PROBE_LO)
    for (int r = 0; r < PROBE_REPS; ++r)
        for (int ph = PROBE_LO; ph < PROBE_HI; ++ph) { (void)hipMemsetAsync((char*)d_ws + WS_CTL + (size_t)CW_BAR * 4, 0, (size_t)(CW_SS1 - CW_BAR) * 4, stream); a.sub = PROBE_SUB; a.ph_lo = ph; a.ph_hi = ph + 1; hipLaunchKernelGGL(hybrid_fwd, dim3(grid), dim3(NWAVES * 64), LDS_BYTES, stream, a); }
#endif
}
```

```cpp
#include <hip/hip_runtime.h>
#include <hip/hip_bf16.h>
#include <cstdio>
#include <cstdint>

constexpr int DM = 1024;
constexpr int SEQ = 8192, NB = 2;
constexpr int MP = NB * SEQ;
constexpr int DB = 32, DT = 4;
constexpr int MS = DB * DT;
constexpr int MT = MP + MS;
constexpr int MTP = 16640;
constexpr int EVEN_IN = 4100, ODD_IN = 3088;
constexpr int NH = 4, HD = 128;
constexpr int PAST = 8192, PAGE = 128, NPAGES = PAST / PAGE;
constexpr float EPS = 1e-6f;
constexpr float ATT_SCALE = 0.08838834764831845f;
constexpr float LOG2E = 1.4426950408889634f;

constexpr size_t O_Y = 0;
constexpr size_t O_KP = (size_t)MT * DM;
constexpr size_t O_VP = O_KP + (size_t)MP * 512;
constexpr size_t O_LFP = O_VP + (size_t)MP * 512;
constexpr size_t O_HSP = O_LFP + (size_t)MP * 4;
constexpr size_t O_GSP = O_HSP + (size_t)NB * NH * 128 * 128;
constexpr size_t O_KS = O_GSP + (size_t)NB * NH * 128 * 256;
constexpr size_t O_VS = O_KS + (size_t)MS * 512;
constexpr size_t O_LFS = O_VS + (size_t)MS * 512;
constexpr size_t O_HSS = O_LFS + (size_t)MS * 4;
constexpr size_t O_GSS = O_HSS + (size_t)DB * NH * 128 * 128;
constexpr size_t O_END = O_GSS + (size_t)DB * NH * 128 * 256;
static_assert(O_END == 40567296, "output size");

constexpr size_t MiB = 1u << 20;
constexpr size_t WS_CTL = 0, CTL_ZERO_BYTES = 1 * MiB;
constexpr size_t WS_W1T = 2 * MiB;
constexpr size_t WS_W2T = 10 * MiB;
constexpr size_t WS_W3T = 12 * MiB;
constexpr size_t WS_W4T = 18 * MiB;
constexpr size_t WS_LB = 20 * MiB;
constexpr size_t WS_LFB = 20 * MiB + 65536;
constexpr size_t WS_CB = 21 * MiB;
constexpr size_t WS_SUFX = 22 * MiB;
constexpr size_t WS_PML = 26 * MiB;
constexpr size_t WS_PO = 26 * MiB + 65536;
constexpr size_t WS_BTOT = 28 * MiB;
constexpr size_t WS_WR = 29 * MiB;
constexpr size_t WS_XN = 32 * MiB;
constexpr size_t WS_QA = 66 * MiB;
constexpr size_t WS_IA = 84 * MiB;
constexpr size_t WS_GA = 102 * MiB;
constexpr size_t WS_GB = 120 * MiB;
constexpr size_t WS_GF = 138 * MiB;
constexpr size_t WS_QBH = 172 * MiB;
constexpr size_t WS_KBH = 188 * MiB;
constexpr size_t WS_VBH = 204 * MiB;
constexpr size_t WS_QS = 220 * MiB;
constexpr size_t WS_MIX = 224 * MiB;
constexpr size_t WS_X1 = 258 * MiB;
constexpr size_t WS_SLOC = 324 * MiB;
constexpr size_t WS_Q3 = 342 * MiB;
constexpr size_t WS_K3 = 360 * MiB;
constexpr size_t WS_V3 = 378 * MiB;
constexpr size_t WS_G3 = 412 * MiB;
constexpr size_t WS_GF3 = 446 * MiB;
constexpr size_t WS_SLOC3 = 480 * MiB;
constexpr size_t WS_MIX2 = 512 * MiB;
constexpr size_t WS_END = 546 * MiB;
constexpr int CW_TMO = 0;
constexpr int CW_BAR = 4096;
constexpr int CW_FLAG = 8192;
constexpr int CW_TAIL = 8192 + 64;
constexpr int CW_BAR2 = 12288;
constexpr int CW_SS1 = 16384;
constexpr int CW_SS2 = 40960;
static_assert((CW_SS2 + MT) * 4 <= (int)CTL_ZERO_BYTES, "CTL");

constexpr int RING_OFF = 0, RING_BYTES = 131072;
constexpr int LDSCTL_OFF = 146944, MISC_OFF = LDSCTL_OFF + 320;
constexpr int LDS_BYTES = 147456;
constexpr int NWAVES = 8;
namespace pg8 {
#define PG8_LAS __attribute__((address_space(3)))
typedef unsigned short bf16_t;
typedef short bf16x8 __attribute__((ext_vector_type(8)));
typedef float f32x4 __attribute__((ext_vector_type(4)));
typedef unsigned u32x4 __attribute__((ext_vector_type(4)));
constexpr int BM = 256, BK = 64, HALF = 128, HTB = HALF * BK * 2  , STAGE_BYTES = 8 * HTB, NXCD = 8, WGM = 8;

__host__ __device__ __forceinline__ int lds_byte(int r, int c) { const int st = (r >> 4) * 2 + (c >> 5), rr = r & 15, cc = c & 31, ob = rr * 64 + cc * 2; return st * 1024 + (ob ^ (((ob >> 9) & 1) << 5)); }
__host__ __device__ __forceinline__ void stage_rc(int b, int& R, int& C) { const int st = b / 1024, sb = b % 1024, swz = sb ^ (((sb >> 9) & 1) << 5); R = (st >> 1) * 16 + swz / 64; C = (st & 1) * 32 + (swz % 64) / 2; }
__host__ __device__ __forceinline__ int perm32(int rho) { const int n = rho >> 4, i = rho & 15; return 8 * (i >> 2) + 4 * n + (i & 3); }

struct Unit { int pm, pn; };
struct Gemm { const bf16_t* A; const bf16_t* Bt; int M, N, K; };

struct StaticOrder {
    int nM, nN, nwg, G, c;
    __host__ __device__ void init(int M, int N, int G_, int c_) { nM = M / BM; nN = N / BM; nwg = nM * nN; G = G_; c = c_; }
    __host__ __device__ bool next(int i, Unit& u) const {
        const long L = (long)i * G + c; if (L >= nwg) return false;
        int wgid = (int)L; { const int q = nwg / NXCD, r = nwg % NXCD, xcd = wgid % NXCD, off = wgid / NXCD; wgid = (xcd < r ? xcd * (q + 1) : r * (q + 1) + (xcd - r) * q) + off; }
        const int nig = WGM * nN, gid = wgid / nig, fm = gid * WGM, gsz = (nM - fm) < WGM ? (nM - fm) : WGM;
        u.pm = fm + ((wgid % nig) % gsz); u.pn = (wgid % nig) / gsz; return true;
    }
    __device__ __forceinline__ void a_ready(const Unit&) const {}
    __device__ __forceinline__ void done(const Unit&) const {}
};

__device__ __forceinline__ unsigned cvt_pk_bf16(float lo, float hi) { unsigned r; asm volatile("v_cvt_pk_bf16_f32 %0, %1, %2" : "=v"(r) : "v"(lo), "v"(hi)); return r; }
typedef float f32x2 __attribute__((ext_vector_type(2)));
template <class Epi, class Sched, bool ALIGN_EPI = false, bool SP2 = false>
__device__ __forceinline__ void gemm_phase(PG8_LAS unsigned char* lds, const Gemm g, const Sched& S, const Epi& E) {
    const int tid = threadIdx.x, wid = __builtin_amdgcn_readfirstlane(tid >> 6), lane = tid & 63, wr = wid >> 2, wc = wid & 3, fr = lane & 15, fq = lane >> 4;
    const int K = g.K, nt = K / BK;
    unsigned voffA[2], voffB[2];
#pragma unroll
    for (int i = 0; i < 2; ++i) { int R, C; stage_rc(tid * 16 + i * 8192, R, C); const int Rb = Epi::PERM ? ((R & ~31) + perm32(R & 31)) : R;
        voffA[i] = (unsigned)(R * K + C) * 2u; voffB[i] = (unsigned)(Rb * K + C) * 2u; }
    const size_t kstep = (size_t)(BK * 2);
    const size_t hstep = (size_t)HALF * K * 2;
    const size_t tstep = 2 * hstep;
    const unsigned ldsw = (unsigned)wid * 1024u;
    const int aoff = lds_byte(wr * 64 + fr, fq * 8), boff = lds_byte(wc * 32 + fr, fq * 8);
#define PG8_SA(b, h) (((b) * 2 + (h)) * HTB)
#define PG8_SB(b, h) ((4 + (b) * 2 + (h)) * HTB)
#define PG8_STAGE(bufoff, gbase, voff) do { _Pragma("unroll") for (int _i = 0; _i < 2; ++_i) \
        __builtin_amdgcn_global_load_lds((const unsigned*)((const char*)(gbase) + (voff)[_i]), (PG8_LAS unsigned*)(lds + (bufoff) + ldsw + _i * 8192), 16, 0, 0); } while (0)
#define PG8_LDA(dst, b, h) do { _Pragma("unroll") for (int m = 0; m < 4; ++m) _Pragma("unroll") for (int k = 0; k < 2; ++k) dst[m][k] = *(const PG8_LAS bf16x8*)(lds + PG8_SA(b, h) + aoff + m * 2048 + k * 1024); } while (0)
#define PG8_LDB(dst, b, h) do { _Pragma("unroll") for (int n = 0; n < 2; ++n) _Pragma("unroll") for (int k = 0; k < 2; ++k) dst[n][k] = *(const PG8_LAS bf16x8*)(lds + PG8_SB(b, h) + boff + n * 2048 + k * 1024); } while (0)
#define PG8_MMA(ai, bj, At, Bt) do { __builtin_amdgcn_s_setprio(1); _Pragma("unroll") for (int m = 0; m < 4; ++m) _Pragma("unroll") for (int n = 0; n < 2; ++n) _Pragma("unroll") for (int k = 0; k < 2; ++k) \
        acc[ai][bj][m][n] = __builtin_amdgcn_mfma_f32_16x16x32_bf16(Bt[n][k], At[m][k], acc[ai][bj][m][n], 0, 0, 0); __builtin_amdgcn_s_setprio(0); } while (0)
#define PG8_WAIT_V(n) asm volatile("s_waitcnt vmcnt(" #n ")" ::: "memory")
#define PG8_WAIT_L(n) asm volatile("s_waitcnt lgkmcnt(" #n ")" ::: "memory")
#define PG8_BAR __builtin_amdgcn_s_barrier()
#define PG8_SCHED __builtin_amdgcn_sched_barrier(0)
    Unit cur, nxt; int ui = 0;
    if (!S.next(0, cur)) return;
    f32x4 acc[2][2][4][2];
#pragma unroll
    for (int a = 0; a < 2; ++a)
#pragma unroll
        for (int b = 0; b < 2; ++b)
#pragma unroll
            for (int m = 0; m < 4; ++m)
#pragma unroll
                for (int n = 0; n < 2; ++n) acc[a][b][m][n] = (f32x4){0.f, 0.f, 0.f, 0.f};
    bf16x8 At[4][2], B0[2][2], B1[2][2];
    const char* cA = (const char*)g.A + (size_t)cur.pm * tstep; const char* cB = (const char*)g.Bt + (size_t)cur.pn * tstep;
    S.a_ready(cur);
    if constexpr (SP2) {
        PG8_STAGE(PG8_SB(0, 0), cB, voffB); PG8_STAGE(PG8_SB(0, 1), cB + hstep, voffB); PG8_STAGE(PG8_SA(0, 0), cA, voffA); PG8_STAGE(PG8_SA(0, 1), cA + hstep, voffA);
        if (wr == 1) PG8_BAR;
        PG8_WAIT_V(2); PG8_BAR;
        PG8_STAGE(PG8_SB(1, 0), cB + kstep, voffB); PG8_STAGE(PG8_SA(1, 0), cA + kstep, voffA); PG8_STAGE(PG8_SB(1, 1), cB + hstep + kstep, voffB);
        PG8_WAIT_V(6); PG8_BAR;
    } else {
        PG8_STAGE(PG8_SB(0, 0), cB, voffB); PG8_STAGE(PG8_SA(0, 0), cA, voffA); PG8_STAGE(PG8_SB(0, 1), cB + hstep, voffB); PG8_STAGE(PG8_SA(0, 1), cA + hstep, voffA);
        if (wr == 1) PG8_BAR;
        PG8_WAIT_V(4); PG8_BAR;
        PG8_STAGE(PG8_SB(1, 0), cB + kstep, voffB); PG8_STAGE(PG8_SA(1, 0), cA + kstep, voffA); PG8_STAGE(PG8_SB(1, 1), cB + hstep + kstep, voffB);
        PG8_WAIT_V(6); PG8_BAR;
    }
    for (;;) {
        const bool has_next = S.next(ui + 1, nxt);
        const char* nA = has_next ? (const char*)g.A + (size_t)nxt.pm * tstep : cA; const char* nB = has_next ? (const char*)g.Bt + (size_t)nxt.pn * tstep : cB;
        for (int t = 0; t < nt; t += 2) {
            const bool last = (t == nt - 2);
            const char* a1 = cA + (size_t)(t + 1) * kstep;
            const char* a2 = last ? nA : cA + (size_t)(t + 2) * kstep; const char* b2 = last ? nB : cB + (size_t)(t + 2) * kstep;
            const char* a3 = a2 + kstep; const char* b3 = b2 + kstep;
            if (last && has_next) S.a_ready(nxt);
            if constexpr (SP2) {
            PG8_LDB(B0, 0, 0); PG8_LDB(B1, 0, 1); PG8_SCHED; PG8_LDA(At, 0, 0); PG8_STAGE(PG8_SA(1, 1), a1 + hstep, voffA);
            PG8_WAIT_V(8); PG8_WAIT_L(0); PG8_BAR; PG8_MMA(0, 0, At, B0); PG8_MMA(0, 1, At, B1); PG8_BAR; PG8_SCHED;
            PG8_LDA(At, 0, 1); PG8_STAGE(PG8_SB(0, 0), b2, voffB); PG8_STAGE(PG8_SB(0, 1), b2 + hstep, voffB); PG8_STAGE(PG8_SA(0, 0), a2, voffA);
            PG8_WAIT_V(8); PG8_WAIT_L(0); PG8_BAR; PG8_MMA(1, 0, At, B0); PG8_MMA(1, 1, At, B1); PG8_BAR; PG8_SCHED;
            PG8_LDB(B0, 1, 0); PG8_LDB(B1, 1, 1); PG8_SCHED; PG8_LDA(At, 1, 0); PG8_STAGE(PG8_SA(0, 1), a2 + hstep, voffA);
            PG8_WAIT_V(8); PG8_WAIT_L(0); PG8_BAR; PG8_MMA(0, 0, At, B0); PG8_MMA(0, 1, At, B1); PG8_BAR; PG8_SCHED;
            PG8_LDA(At, 1, 1); PG8_STAGE(PG8_SB(1, 0), b3, voffB); PG8_STAGE(PG8_SB(1, 1), b3 + hstep, voffB); PG8_STAGE(PG8_SA(1, 0), a3, voffA);
            PG8_WAIT_V(8); PG8_WAIT_L(0); PG8_BAR; PG8_MMA(1, 0, At, B0); PG8_MMA(1, 1, At, B1); PG8_BAR; PG8_SCHED;
            } else {
            PG8_LDB(B0, 0, 0); PG8_SCHED; PG8_LDA(At, 0, 0); PG8_STAGE(PG8_SA(1, 1), a1 + hstep, voffA);
            PG8_WAIT_L(8); PG8_BAR; PG8_WAIT_L(0); PG8_MMA(0, 0, At, B0); PG8_BAR; PG8_SCHED;
            PG8_LDB(B1, 0, 1); PG8_STAGE(PG8_SB(0, 0), b2, voffB);
            PG8_BAR; PG8_WAIT_L(0); PG8_MMA(0, 1, At, B1); PG8_BAR;
            PG8_LDA(At, 0, 1); PG8_STAGE(PG8_SA(0, 0), a2, voffA);
            PG8_BAR; PG8_WAIT_L(0); PG8_MMA(1, 0, At, B0); PG8_BAR; PG8_SCHED;
            PG8_STAGE(PG8_SB(0, 1), b2 + hstep, voffB);
            PG8_WAIT_V(6); PG8_BAR; PG8_MMA(1, 1, At, B1); PG8_BAR;
            PG8_LDB(B0, 1, 0); PG8_SCHED; PG8_LDA(At, 1, 0); PG8_STAGE(PG8_SA(0, 1), a2 + hstep, voffA);
            PG8_WAIT_L(8); PG8_BAR; PG8_WAIT_L(0); PG8_MMA(0, 0, At, B0); PG8_BAR; PG8_SCHED;
            PG8_LDB(B1, 1, 1); PG8_STAGE(PG8_SB(1, 0), b3, voffB);
            PG8_BAR; PG8_WAIT_L(0); PG8_MMA(0, 1, At, B1); PG8_BAR;
            PG8_LDA(At, 1, 1); PG8_STAGE(PG8_SA(1, 0), a3, voffA);
            PG8_BAR; PG8_WAIT_L(0); PG8_MMA(1, 0, At, B0); PG8_BAR; PG8_SCHED;
            PG8_STAGE(PG8_SB(1, 1), b3 + hstep, voffB);
            PG8_WAIT_V(6); PG8_BAR; PG8_MMA(1, 1, At, B1); PG8_BAR;
            }
        }
        if constexpr (ALIGN_EPI) { if (wr == 0) PG8_BAR; }
        if constexpr (!Epi::AFTER_DRAIN) { E(acc, cur, wr, wc, fr, fq); S.done(cur); }
        if (!has_next) break;
#pragma unroll
        for (int a = 0; a < 2; ++a)
#pragma unroll
            for (int b = 0; b < 2; ++b)
#pragma unroll
                for (int m = 0; m < 4; ++m)
#pragma unroll
                    for (int n = 0; n < 2; ++n) acc[a][b][m][n] = (f32x4){0.f, 0.f, 0.f, 0.f};
        cur = nxt; cA = nA; cB = nB; ++ui;
        if constexpr (ALIGN_EPI) { if (wr == 1) PG8_BAR; }
    }
    PG8_WAIT_V(0);
    if constexpr (!ALIGN_EPI) { if (wr == 0) PG8_BAR; }
    PG8_BAR;
    if constexpr (Epi::AFTER_DRAIN) { E.fused(acc, cur, wr, wc, fr, fq, lds, wid, lane); S.done(cur); }
#undef PG8_SA
#undef PG8_SB
#undef PG8_STAGE
#undef PG8_LDA
#undef PG8_LDB
#undef PG8_MMA
#undef PG8_WAIT_V
#undef PG8_WAIT_L
#undef PG8_BAR
#undef PG8_SCHED
}
}
#define GAS __attribute__((address_space(1)))
#define LAS __attribute__((address_space(3)))
typedef unsigned short bf16;
typedef unsigned v4u __attribute__((ext_vector_type(4)));
typedef float f32x4 __attribute__((ext_vector_type(4)));
typedef short bf16x8 __attribute__((ext_vector_type(8)));
typedef GAS unsigned gu32;
typedef GAS unsigned long long gu64;
#define RLX_AGENT __ATOMIC_RELAXED, __HIP_MEMORY_SCOPE_AGENT
#define LDS_WAIT() asm volatile("s_waitcnt lgkmcnt(0)" ::: "memory")
#define VM_WAIT() asm volatile("s_waitcnt vmcnt(0)" ::: "memory")
__device__ __forceinline__ unsigned long long rt() { return __builtin_amdgcn_s_memrealtime(); }
__device__ __forceinline__ unsigned f2bf(float f) { unsigned u = __builtin_bit_cast(unsigned, f); return (u + 0x7fffu + ((u >> 16) & 1u)) >> 16; }
__device__ __forceinline__ unsigned pk2(float lo, float hi) { return f2bf(lo) | (f2bf(hi) << 16); }

#define XB_TMO      128
#define XB_XCNT(j)  (256  + 64 * (j))
#define XB_XSUB(j)  (1280 + 64 * (j))
#define XB_XGEN(j)  (2304 + 64 * (j))
#define XB_TOP      3328
#define XB_TOPGEN   3392
#define XCD_BAR_WORDS 3456
#define XB_SPIN_CAP (1u << 18)

__device__ __forceinline__ unsigned xb_ld(unsigned* p)              { return __hip_atomic_load(p, __ATOMIC_RELAXED, __HIP_MEMORY_SCOPE_AGENT); }
__device__ __forceinline__ unsigned xb_add(unsigned* p, unsigned v) { return __hip_atomic_fetch_add(p, v, __ATOMIC_RELAXED, __HIP_MEMORY_SCOPE_AGENT); }
__device__ __forceinline__ unsigned xb_xcc_id() { return (unsigned)__builtin_amdgcn_s_getreg((3 << 11) | 20) & 0xFu; }
#define XB_SPIN(cond, bar) do { unsigned _sp = 0; while (cond) { __builtin_amdgcn_s_sleep(1); \
    if ((++_sp & 255u) == 0u) { if (xb_ld(&(bar)[XB_TMO])) break; if (_sp > XB_SPIN_CAP) { atomicAdd(&(bar)[XB_TMO], 1u); break; } } } } while (0)

struct XcdBarrier {
    unsigned* bar; unsigned x;
    volatile LAS unsigned* st;
    unsigned total;
};

__device__ __forceinline__ XcdBarrier xcd_barrier_post(unsigned* bar, volatile LAS unsigned* st) {
    XcdBarrier b; b.bar = bar; b.x = xb_xcc_id(); b.st = st; b.total = 0u;
    if (threadIdx.x == 0) (void)xb_add(&bar[XB_XCNT(b.x)], 1u);
    return b;
}
__device__ __forceinline__ void xcd_barrier_complete(unsigned* bar, unsigned x, unsigned& nloc, unsigned& nx, unsigned total) {
    const unsigned G = total ? total : gridDim.x * gridDim.y * gridDim.z;
    unsigned sum, cnt, mine, sp = 0u;
    for (;;) {
        sum = 0u; cnt = 0u; mine = 0u;
#pragma unroll
        for (unsigned j = 0; j < 16; ++j) { const unsigned c = xb_ld(&bar[XB_XCNT(j)]); sum += c; cnt += (c > 0u) ? 1u : 0u; mine = (j == x) ? c : mine; }
        if (sum == G) break;
        __builtin_amdgcn_s_sleep(1);
        if ((++sp & 255u) == 0u) { if (xb_ld(&bar[XB_TMO])) break; if (sp > XB_SPIN_CAP) { atomicAdd(&bar[XB_TMO], 1u); break; } }
    }
    nloc = mine > 0u ? mine : 1u; nx = cnt > 0u ? cnt : 1u;
}

__device__ __forceinline__ void xcd_barrier(const XcdBarrier& b) {
    asm volatile("s_waitcnt vmcnt(0)" ::: "memory");
    __syncthreads();
    if (threadIdx.x == 0) {
        unsigned* bar = b.bar;
        __builtin_amdgcn_s_waitcnt(0);
        unsigned nloc = b.st[0], nx = b.st[1];
        if (nloc == 0u) { xcd_barrier_complete(bar, b.x, nloc, nx, b.total); b.st[0] = nloc; b.st[1] = nx; }
        const unsigned old = xb_add(&bar[XB_XSUB(b.x)], 1u);
        const unsigned gen = old / nloc;
        if (old + 1u == (gen + 1u) * nloc) {
            __builtin_amdgcn_fence(__ATOMIC_RELEASE, "agent");
            asm volatile("s_waitcnt vmcnt(0)" ::: "memory");
            const unsigned og = xb_add(&bar[XB_TOP], 1u);
            const unsigned tg = og / nx;
            if (og + 1u == (tg + 1u) * nx) xb_add(&bar[XB_TOPGEN], 1u);
            else XB_SPIN(xb_ld(&bar[XB_TOPGEN]) == tg, bar);
            __builtin_amdgcn_fence(__ATOMIC_ACQUIRE, "agent");
            xb_add(&bar[XB_XGEN(b.x)], 1u);
            asm volatile("s_waitcnt vmcnt(0)" ::: "memory");
        } else {
            XB_SPIN(xb_ld(&bar[XB_XGEN(b.x)]) == gen, bar);
            __builtin_amdgcn_fence(__ATOMIC_ACQUIRE, "agent");
            asm volatile("s_waitcnt vmcnt(0)" ::: "memory");
        }
    }
    __syncthreads();
}

typedef unsigned u32x2v __attribute__((ext_vector_type(2)));
struct Frame {
    LAS unsigned char* lds;
    volatile LAS unsigned* MISC;
    gu32* ctl;
    int tid, lane, wave;
    int G;
    unsigned char* ws;
    float* out;
    const float *xp, *xs, *ck, *cv, *clf, *sh, *sg; const int* pt;
    const float *norm_even, *w_in_even, *b_fox, *lb_logits, *hgrn_gain, *w_out_even, *norm_odd, *w_in_odd, *w_gla_gate, *b_gla_gate, *gla_gain, *w_out_odd, *final_norm;
};
#define WSP(T, off) ((T*)(F.ws + (off)))

template <int CTRL> __device__ __forceinline__ float dppf(float x) { return __builtin_bit_cast(float, __builtin_amdgcn_mov_dpp(__builtin_bit_cast(int, x), CTRL, 0xf, 0xf, true)); }
__device__ __forceinline__ float row16_sum(float v) { v += dppf<0xB1>(v); v += dppf<0x4E>(v); v += dppf<0x141>(v); v += dppf<0x140>(v); return v; }
__device__ __forceinline__ float wave_sum(float v) {
    v = row16_sum(v);
    auto s = __builtin_amdgcn_permlane16_swap(__float_as_uint(v), __float_as_uint(v), false, false); v = __uint_as_float(s[0]) + __uint_as_float(s[1]);
    auto t = __builtin_amdgcn_permlane32_swap(__float_as_uint(v), __float_as_uint(v), false, false); return __uint_as_float(t[0]) + __uint_as_float(t[1]);
}
__device__ __forceinline__ float fast_exp(float x) { return __builtin_amdgcn_exp2f(x * LOG2E); }
__device__ __forceinline__ float sigmoidf_(float x) { return __builtin_amdgcn_rcpf(1.0f + fast_exp(-x)); }
__device__ __forceinline__ float siluf_(float x) { return x * sigmoidf_(x); }
__device__ __forceinline__ float log_sigmoidf_(float x) {
    const float e = __builtin_amdgcn_exp2f(-fabsf(x) * LOG2E);
    return fminf(x, 0.f) - __builtin_amdgcn_logf(1.0f + e) * 0.6931471805599453f;
}
typedef float f32x2_t __attribute__((ext_vector_type(2)));
typedef __bf16 bf16x2_t __attribute__((ext_vector_type(2)));
__device__ __forceinline__ unsigned cvtpk_s(float lo, float hi) { f32x2_t v = {lo, hi}; bf16x2_t b = __builtin_convertvector(v, bf16x2_t); return __builtin_bit_cast(unsigned, b); }
__device__ __forceinline__ bf16x8 pack8f(f32x4 a, f32x4 b) { v4u w = {cvtpk_s(a[0], a[1]), cvtpk_s(a[2], a[3]), cvtpk_s(b[0], b[1]), cvtpk_s(b[2], b[3])}; return __builtin_bit_cast(bf16x8, w); }
__device__ __forceinline__ float bf2f(unsigned short b) { return __builtin_bit_cast(float, (unsigned)b << 16); }
__device__ __forceinline__ void st_bf4(bf16* p, f32x4 v) { u32x2v w; w.x = cvtpk_s(v[0], v[1]); w.y = cvtpk_s(v[2], v[3]); *(GAS u32x2v*)p = w; }
__device__ __forceinline__ void st_bf8(bf16* p, f32x4 a, f32x4 b) { v4u w = {cvtpk_s(a[0], a[1]), cvtpk_s(a[2], a[3]), cvtpk_s(b[0], b[1]), cvtpk_s(b[2], b[3])}; *(GAS v4u*)p = w; }

__device__ __forceinline__ void p0_transpose_item(const float* W, int K, int ld, int N, bf16* WT, LAS float* scr, int item, int lane, const float* gain) {
    const int nblk = N / 32, kb = item / nblk, nb = item % nblk, k0 = 64 * kb, n0 = 32 * nb;
    float wv[32];
#pragma unroll
    for (int i = 0; i < 32; ++i) { const int kk = 2 * i + (lane >> 5); wv[i] = W[(size_t)(k0 + kk) * ld + n0 + (lane & 31)]; }
#pragma unroll
    for (int i = 0; i < 32; ++i) { const int kk = 2 * i + (lane >> 5); float w = wv[i]; if (gain) w *= gain[k0 + kk]; scr[kk * 33 + (lane & 31)] = w; }
    LDS_WAIT(); asm volatile("" ::: "memory");
    const int c = lane & 7;
#pragma unroll
    for (int j = 0; j < 4; ++j) { const int n = (lane >> 3) + 8 * j; const LAS float* s = scr + (8 * c) * 33 + n;
        v4u o; o.x = pk2(s[0 * 33], s[1 * 33]); o.y = pk2(s[2 * 33], s[3 * 33]); o.z = pk2(s[4 * 33], s[5 * 33]); o.w = pk2(s[6 * 33], s[7 * 33]);
        *(GAS v4u*)(WT + (size_t)(n0 + n) * K + k0 + 8 * c) = o; }
    LDS_WAIT(); asm volatile("" ::: "memory");
}

__device__ __forceinline__ float block_excl_scan(float v, LAS float* scr, int lane, int wave, float* total) {
    float inc = v;
#pragma unroll
    for (int o = 1; o < 64; o <<= 1) { const float t = __shfl_up(inc, o); if (lane >= o) inc += t; }
    if (lane == 63) scr[wave] = inc;
    __syncthreads();
    float pre = 0.f, tot = 0.f;
#pragma unroll
    for (int w = 0; w < 8; ++w) { const float t = scr[w]; if (w < wave) pre += t; tot += t; }
    __syncthreads();
    *total = tot;
    return pre + inc - v;
}

__device__ __forceinline__ void p0_prologue(Frame& F, int sub) {
    LAS float* scr = (LAS float*)(F.lds + RING_OFF + F.wave * 16384);
    const int gw = (int)blockIdx.x * NWAVES + F.wave, NGW = F.G * NWAVES;
    constexpr int I1 = 16 * (4096 / 32);
    if (sub & 1) for (int it = gw; it < I1; it += NGW) p0_transpose_item(F.w_in_even, DM, EVEN_IN, 4096, WSP(bf16, WS_W1T), scr, it, F.lane, nullptr);
    if (blockIdx.x == 0) { float* LB = WSP(float, WS_LB); const int c = F.tid; LB[c] = 1.0f / (1.0f + __expf(F.lb_logits[512 + c] - F.lb_logits[c])); }
    { bf16* WRB = WSP(bf16, WS_WR); bf16* WGB = WSP(bf16, WS_WR + 65536); const int gt = (int)blockIdx.x * 512 + F.tid;
      for (int e = gt; e < 16 * 1024; e += F.G * 512) { const int j = e >> 10, k = e & 1023; WRB[e] = (bf16)(cvtpk_s(F.w_in_odd[(size_t)k * ODD_IN + 3072 + j] * F.norm_odd[k], 0.f) & 0xffffu); }
      for (int e = gt; e < 512 * 16; e += F.G * 512) { const int c = e >> 4, j = e & 15; WGB[e] = (bf16)(cvtpk_s(F.w_gla_gate[j * 512 + c], 0.f) & 0xffffu); } }
    __syncthreads();
    if ((sub & 2) && blockIdx.x < DB) {
        const int b = blockIdx.x; float* SUFX = WSP(float, WS_SUFX);
        LAS float* sscr = (LAS float*)(F.lds + RING_OFF);
        const int i = F.tid; f32x4 v[16];
#pragma unroll
        for (int j = 0; j < 16; ++j) { const int s = 8191 - (16 * i + j); const int pg = F.pt[b * NPAGES + (s >> 7)]; v[j] = *(const GAS f32x4*)(F.clf + ((size_t)pg * PAGE + (s & 127)) * 4); }
        f32x4 run = {0.f, 0.f, 0.f, 0.f};
#pragma unroll
        for (int j = 0; j < 16; ++j) { const f32x4 t = v[j]; v[j] = run; run += t; }
        f32x4 pre;
        {
            f32x4 inc = run;
#pragma unroll
            for (int o = 1; o < 64; o <<= 1) { f32x4 t; t.x = __shfl_up(inc.x, o); t.y = __shfl_up(inc.y, o); t.z = __shfl_up(inc.z, o); t.w = __shfl_up(inc.w, o); if (F.lane >= o) inc += t; }
            if (F.lane == 63) *(LAS f32x4*)(sscr + 4 * F.wave) = inc;
            __syncthreads();
            f32x4 p = {0.f, 0.f, 0.f, 0.f};
#pragma unroll
            for (int w = 0; w < 8; ++w) { const f32x4 t = *(const LAS f32x4*)(sscr + 4 * w); if (w < F.wave) p += t; }
            pre = p + inc - run; }
        const int sb = 8191 - (16 * i + 15);
#pragma unroll
        for (int q = 0; q < 4; ++q) {
            const f32x4 o3 = (v[15 - 4 * q] + pre) * LOG2E, o2 = (v[14 - 4 * q] + pre) * LOG2E, o1 = (v[13 - 4 * q] + pre) * LOG2E, o0 = (v[12 - 4 * q] + pre) * LOG2E;
            *(GAS f32x4*)(SUFX + (size_t)(b * 4 + 0) * PAST + sb + 4 * q) = (f32x4){o3.x, o2.x, o1.x, o0.x};
            *(GAS f32x4*)(SUFX + (size_t)(b * 4 + 1) * PAST + sb + 4 * q) = (f32x4){o3.y, o2.y, o1.y, o0.y};
            *(GAS f32x4*)(SUFX + (size_t)(b * 4 + 2) * PAST + sb + 4 * q) = (f32x4){o3.z, o2.z, o1.z, o0.z};
            *(GAS f32x4*)(SUFX + (size_t)(b * 4 + 3) * PAST + sb + 4 * q) = (f32x4){o3.w, o2.w, o1.w, o0.w}; }
    }
    LAS float* wfb = (LAS float*)(F.lds + RING_OFF);
    __syncthreads();
    for (int k = F.tid; k < 1024; k += 512) *(LAS f32x4*)(wfb + 4 * k) = *(const GAS f32x4*)(F.w_in_even + (size_t)k * EVEN_IN + 4096);
    __syncthreads();
    bf16* XN = WSP(bf16, WS_XN); float* LFB = WSP(float, WS_LFB);
    const float bfl = F.b_fox[F.lane & 3];
    f32x4 gn[4];
#pragma unroll
    for (int j = 0; j < 4; ++j) gn[j] = *(const GAS f32x4*)(F.norm_even + 4 * F.lane + 256 * j);
    constexpr int NSW = DB * NWAVES, RSPLIT = MT - 5 * NSW;
    int m0r = gw, mstep = NGW, mend = MT;
    if (NGW > NSW) { if (gw < NSW) { m0r = RSPLIT + gw; mstep = NSW; mend = MT; } else { m0r = gw - NSW; mstep = NGW - NSW; mend = RSPLIT; } }
    f32x4 vn[4];
    if (m0r < mend) { const float* xrow = m0r < MP ? F.xp + (size_t)m0r * DM : F.xs + (size_t)(m0r - MP) * DM; const GAS f32x4* xr = (const GAS f32x4*)xrow + F.lane;
#pragma unroll
        for (int j = 0; j < 4; ++j) vn[j] = xr[64 * j]; }
    if (sub & 4) for (int m = m0r; m < mend; m += mstep) {
        f32x4 v[4]; float s = 0.f;
#pragma unroll
        for (int j = 0; j < 4; ++j) v[j] = vn[j];
        { const int mn = (m + mstep < mend) ? m + mstep : m; const float* xrow = mn < MP ? F.xp + (size_t)mn * DM : F.xs + (size_t)(mn - MP) * DM; const GAS f32x4* xr = (const GAS f32x4*)xrow + F.lane;
#pragma unroll
            for (int j = 0; j < 4; ++j) vn[j] = xr[64 * j]; }
#pragma unroll
        for (int j = 0; j < 4; ++j) s += (v[j].x * v[j].x + v[j].y * v[j].y) + (v[j].z * v[j].z + v[j].w * v[j].w);
        const float rstd = 1.0f / sqrtf(wave_sum(s) * (1.f / DM) + EPS);
        f32x4 d = {0.f, 0.f, 0.f, 0.f};
        GAS unsigned long long* o8 = (GAS unsigned long long*)(XN + (size_t)m * DM) + F.lane;
#pragma unroll
        for (int j = 0; j < 4; ++j) { const int c0 = 4 * F.lane + 256 * j;
            const f32x4 h = v[j] * rstd * gn[j];
            o8[64 * j] = (unsigned long long)cvtpk_s(h.x, h.y) | ((unsigned long long)cvtpk_s(h.z, h.w) << 32);
            d += h.x * *(LAS f32x4*)(wfb + 4 * c0) + h.y * *(LAS f32x4*)(wfb + 4 * c0 + 4) + h.z * *(LAS f32x4*)(wfb + 4 * c0 + 8) + h.w * *(LAS f32x4*)(wfb + 4 * c0 + 12); }
        d.x = wave_sum(d.x); d.y = wave_sum(d.y); d.z = wave_sum(d.z); d.w = wave_sum(d.w);
        if (F.lane < 4) { const float dj = F.lane == 0 ? d.x : F.lane == 1 ? d.y : F.lane == 2 ? d.z : d.w; const float lf = log_sigmoidf_(dj + bfl);
            LFB[(size_t)m * 4 + F.lane] = lf;
            float* o = m < MP ? F.out + O_LFP + (size_t)m * 4 : F.out + O_LFS + (size_t)(m - MP) * 4; o[F.lane] = lf; }
    }
    __syncthreads();
}

__device__ __forceinline__ void late_weights(Frame& F, int gwi, int nw) {
    LAS float* scr = (LAS float*)(F.lds + RING_OFF + F.wave * 16384);
    constexpr int I2 = 16 * (1024 / 32), I3 = 16 * (3072 / 32), I4 = I2;
    for (int it = gwi; it < I2 + I3 + I4 && it < nw; it += NWAVES) {
        int r = it;
        if (r < I2) { p0_transpose_item(F.w_out_even, DM, DM, 1024, WSP(bf16, WS_W2T), scr, r, F.lane, nullptr); continue; } r -= I2;
        if (r < I3) { p0_transpose_item(F.w_in_odd, DM, ODD_IN, 3072, WSP(bf16, WS_W3T), scr, r, F.lane, F.norm_odd); continue; } r -= I3;
        p0_transpose_item(F.w_out_odd, DM, DM, 1024, WSP(bf16, WS_W4T), scr, r, F.lane, nullptr);
    }
}
__device__ __forceinline__ void fox_cumsum_unit(Frame& F, int b) {
    const float* LFB = WSP(float, WS_LFB); float* CB = WSP(float, WS_CB);
    LAS float* sscr = (LAS float*)(F.lds + RING_OFF);
    f32x4 v[16]; f32x4 run = {0.f, 0.f, 0.f, 0.f};
#pragma unroll
    for (int j = 0; j < 16; ++j) v[j] = *(const GAS f32x4*)(LFB + (size_t)(b * SEQ + 16 * F.tid + j) * 4);
#pragma unroll
    for (int j = 0; j < 16; ++j) { run += v[j]; v[j] = run; }
    f32x4 pre;
    {   f32x4 inc = run;
#pragma unroll
        for (int o = 1; o < 64; o <<= 1) { f32x4 t; t.x = __shfl_up(inc.x, o); t.y = __shfl_up(inc.y, o); t.z = __shfl_up(inc.z, o); t.w = __shfl_up(inc.w, o); if (F.lane >= o) inc += t; }
        if (F.lane == 63) *(LAS f32x4*)(sscr + 4 * F.wave) = inc;
        __syncthreads();
        f32x4 p = {0.f, 0.f, 0.f, 0.f};
#pragma unroll
        for (int w = 0; w < 8; ++w) { const f32x4 t = *(const LAS f32x4*)(sscr + 4 * w); if (w < F.wave) p += t; }
        pre = p + inc - run;
        __syncthreads(); }
    const float ns = -1.0f / ATT_SCALE;
#pragma unroll
    for (int q = 0; q < 4; ++q) { const f32x4 o0 = (v[4 * q] + pre) * ns, o1 = (v[4 * q + 1] + pre) * ns, o2 = (v[4 * q + 2] + pre) * ns, o3 = (v[4 * q + 3] + pre) * ns;
        const size_t off = (size_t)16 * F.tid + 4 * q;
        *(GAS f32x4*)(CB + (size_t)(b * 4 + 0) * SEQ + off) = (f32x4){o0.x, o1.x, o2.x, o3.x};
        *(GAS f32x4*)(CB + (size_t)(b * 4 + 1) * SEQ + off) = (f32x4){o0.y, o1.y, o2.y, o3.y};
        *(GAS f32x4*)(CB + (size_t)(b * 4 + 2) * SEQ + off) = (f32x4){o0.z, o1.z, o2.z, o3.z};
        *(GAS f32x4*)(CB + (size_t)(b * 4 + 3) * SEQ + off) = (f32x4){o0.w, o1.w, o2.w, o3.w}; }
}

struct P1 { bf16 *QA, *IA, *GA, *GB, *QBH, *KBH, *VBH, *GF; float *QS; const float* LB; float* out; };
__device__ __forceinline__ void epi1_4(const P1& p, int m, int c, f32x4 v) {
    const int sec = c >> 9, cs = c & 511;
    const size_t rc = (size_t)m * 512 + cs;
    switch (sec) {
    case 0: st_bf4(p.QA + rc, v); break;
    case 1: { const f32x4 lb = *(const GAS f32x4*)(p.LB + cs); f32x4 g;
#pragma unroll
        for (int i = 0; i < 4; ++i) { const float f = lb[i] + (1.0f - lb[i]) * sigmoidf_(v[i]); g[i] = __logf(f); }
        st_bf4(p.GF + rc, g); } break;
    case 2: st_bf4(p.IA + rc, v); break;
    case 3: { f32x4 g; for (int i = 0; i < 4; ++i) g[i] = siluf_(v[i]); st_bf4(p.GA + rc, g); } break;
    case 4: if (m < MP) { const int b = m >> 13, s = m & 8191, h = cs >> 7, d = cs & 127; st_bf4(p.QBH + ((size_t)((b * 4 + h) * SEQ + s) * HD + d), v); }
            else *(GAS f32x4*)(p.QS + (size_t)(m - MP) * 512 + cs) = v;
            break;
    case 5: if (m < MP) { const int b = m >> 13, s = m & 8191, h = cs >> 7, d = cs & 127; st_bf4(p.KBH + ((size_t)((b * 4 + h) * SEQ + s) * HD + d), v); *(GAS f32x4*)(p.out + O_KP + rc) = v; }
            else *(GAS f32x4*)(p.out + O_KS + (size_t)(m - MP) * 512 + cs) = v;
            break;
    case 6: if (m < MP) { const int b = m >> 13, s = m & 8191, h = cs >> 7, d = cs & 127; st_bf4(p.VBH + ((size_t)((b * 4 + h) * SEQ + s) * HD + d), v); *(GAS f32x4*)(p.out + O_VP + rc) = v; }
            else *(GAS f32x4*)(p.out + O_VS + (size_t)(m - MP) * 512 + cs) = v;
            break;
    default: { f32x4 g; for (int i = 0; i < 4; ++i) g[i] = siluf_(v[i]); st_bf4(p.GB + rc, g); } break;
    }
}
struct P2 { const float *xp, *xs; bf16* X1B; float* SS; };
__device__ __forceinline__ float epi2_4(const P2& p, int m, int c, f32x4 v) {
    const float* xr = m < MP ? p.xp + (size_t)m * DM : p.xs + (size_t)(m - MP) * DM;
    const f32x4 o = *(const GAS f32x4*)(xr + c) + v;
    st_bf4(p.X1B + (size_t)m * DM + c, o);
    return (o.x * o.x + o.y * o.y) + (o.z * o.z + o.w * o.w);
}
struct P3 { bf16 *Q3, *K3, *V3, *G3; const float* SS; };
__device__ __forceinline__ void epi3_4(const P3& p, int m, int c, f32x4 v, float rstd) {
    v = v * rstd;
    if (c < 512) { st_bf4(p.Q3 + (size_t)m * 512 + c, v * ATT_SCALE); }
    else if (c < 1024) { st_bf4(p.K3 + (size_t)m * 512 + (c - 512), v); }
    else if (c < 2048) { st_bf4(p.V3 + (size_t)m * 1024 + (c - 1024), v); }
    else { f32x4 g; for (int i = 0; i < 4; ++i) g[i] = siluf_(v[i]); st_bf4(p.G3 + (size_t)m * 1024 + (c - 2048), g); }
}
struct P4 { const bf16* X1B; float* Y; float* SS; };
__device__ __forceinline__ float epi4_4(const P4& p, int m, int c, f32x4 v) {
    const u32x2v xb = *(const GAS u32x2v*)(p.X1B + (size_t)m * DM + c);
    const f32x4 o = (f32x4){__uint_as_float(xb.x << 16), __uint_as_float(xb.x & 0xffff0000u), __uint_as_float(xb.y << 16), __uint_as_float(xb.y & 0xffff0000u)} + v;
    *(GAS f32x4*)(p.Y + (size_t)m * DM + c) = o;
    return (o.x * o.x + o.y * o.y) + (o.z * o.z + o.w * o.w);
}

__device__ __forceinline__ f32x4 silu4(f32x4 v) { f32x4 g; g.x = siluf_(v.x); g.y = siluf_(v.y); g.z = siluf_(v.z); g.w = siluf_(v.w); return g; }
struct Epi1 { static constexpr bool PERM = true, AFTER_DRAIN = false; P1 p; int skip;
    __device__ __forceinline__ void operator()(const pg8::f32x4 (&acc)[2][2][4][2], const pg8::Unit& u, int wr, int wc, int fr, int fq) const {
        if (skip == 1) { asm volatile("" :: "v"(acc[0][0][0][0][0]), "v"(acc[1][1][3][1][3])); return; }
        if (skip == 2) {
            const int lane_ = threadIdx.x & 63, wv_ = threadIdx.x >> 6; const int sec_ = u.pn >> 1;
            bf16* sb = p.QA + ((size_t)((u.pm * 16 + u.pn) & 255) * 8 + wv_) * 65536;
            int n_ = 0;
#pragma unroll
            for (int ai = 0; ai < 2; ++ai)
#pragma unroll
                for (int m = 0; m < 4; ++m)
#pragma unroll
                    for (int bj = 0; bj < 2; ++bj) { st_bf8(sb + (size_t)n_ * 512 + lane_ * 8, acc[ai][bj][m][0], acc[ai][bj][m][1]); ++n_;
                        if (sec_ == 5 || sec_ == 6 || sec_ == 1) { float* fp = (float*)(sb + 16384) + (size_t)(2 * n_) * 256 + lane_ * 4; *(GAS f32x4*)fp = acc[ai][bj][m][0]; *(GAS f32x4*)(fp + 256) = acc[ai][bj][m][1]; } }
            return; }
        const int sec = u.pn >> 1, row0 = u.pm * 256 + wr * 64 + fr, cs0 = (u.pn & 1) * 256 + wc * 32 + 8 * fq;
#define EPI1_LOOP(...) _Pragma("unroll") for (int ai = 0; ai < 2; ++ai) _Pragma("unroll") for (int m = 0; m < 4; ++m) { const int row = row0 + ai * 128 + m * 16; \
            _Pragma("unroll") for (int bj = 0; bj < 2; ++bj) { const int cs = cs0 + bj * 128; const f32x4 v0 = acc[ai][bj][m][0], v1 = acc[ai][bj][m][1]; __VA_ARGS__ } }
        if (sec == 0) { EPI1_LOOP( st_bf8(p.QA + (size_t)row * 512 + cs, v0, v1); ) }
        else if (sec == 2) { EPI1_LOOP( st_bf8(p.IA + (size_t)row * 512 + cs, v0, v1); ) }
        else if (sec == 3) { EPI1_LOOP( st_bf8(p.GA + (size_t)row * 512 + cs, silu4(v0), silu4(v1)); ) }
        else if (sec == 7) { EPI1_LOOP( st_bf8(p.GB + (size_t)row * 512 + cs, silu4(v0), silu4(v1)); ) }
        else if (sec == 1) {
            f32x4 lb[2][2];
#pragma unroll
            for (int bj = 0; bj < 2; ++bj) { lb[bj][0] = *(const GAS f32x4*)(p.LB + cs0 + bj * 128); lb[bj][1] = *(const GAS f32x4*)(p.LB + cs0 + bj * 128 + 4); }
            EPI1_LOOP( f32x4 g0, g1;
                _Pragma("unroll") for (int i = 0; i < 4; ++i) { g0[i] = __logf(lb[bj][0][i] + (1.0f - lb[bj][0][i]) * sigmoidf_(v0[i])); g1[i] = __logf(lb[bj][1][i] + (1.0f - lb[bj][1][i]) * sigmoidf_(v1[i])); }
                st_bf8(p.GF + (size_t)row * 512 + cs, g0, g1); )
        } else {
            bf16* hb = sec == 4 ? p.QBH : sec == 5 ? p.KBH : p.VBH;
            float* fo = sec == 5 ? p.out + O_KP : p.out + O_VP;
            const int hbase = (u.pn & 1) * 2, d = wc * 32 + 8 * fq;
            EPI1_LOOP( const int b = row >> 13, s = row & 8191;
                st_bf8(hb + ((size_t)((b * 4 + hbase + bj) * SEQ + s) * HD + d), v0, v1);
                if (sec != 4) { float* op = fo + (size_t)row * 512 + cs; __builtin_nontemporal_store(v0, (GAS f32x4*)op); __builtin_nontemporal_store(v1, (GAS f32x4*)(op + 4)); } )
        }
#undef EPI1_LOOP
    } };
struct Epi2 { static constexpr bool PERM = true, AFTER_DRAIN = false; P2 p;
    __device__ __forceinline__ void operator()(const pg8::f32x4 (&acc)[2][2][4][2], const pg8::Unit& u, int wr, int wc, int fr, int fq) const {
        const int row0 = u.pm * 256 + wr * 64 + fr, c0 = u.pn * 256 + wc * 32 + 8 * fq;
#pragma unroll
        for (int ai = 0; ai < 2; ++ai)
#pragma unroll
            for (int m = 0; m < 4; ++m) { const int row = row0 + ai * 128 + m * 16; float ss = 0.f;
#pragma unroll
                for (int bj = 0; bj < 2; ++bj) { const size_t off = (size_t)row * DM + c0 + bj * 128;
                    const f32x4 o0 = *(const GAS f32x4*)(p.xp + off) + acc[ai][bj][m][0], o1 = *(const GAS f32x4*)(p.xp + off + 4) + acc[ai][bj][m][1];
                    st_bf8(p.X1B + off, o0, o1);
                    ss += ((o0.x * o0.x + o0.y * o0.y) + (o0.z * o0.z + o0.w * o0.w)) + ((o1.x * o1.x + o1.y * o1.y) + (o1.z * o1.z + o1.w * o1.w)); }
                ss += __shfl_xor(ss, 16); ss += __shfl_xor(ss, 32);
                if (fq == 0) atomicAdd(p.SS + row, ss); }
    } };
struct Epi3 { static constexpr bool PERM = true, AFTER_DRAIN = false; P3 p; int skip;
    __device__ __forceinline__ void operator()(const pg8::f32x4 (&acc)[2][2][4][2], const pg8::Unit& u, int wr, int wc, int fr, int fq) const {
        if (skip) { asm volatile("" :: "v"(acc[0][0][0][0][0]), "v"(acc[1][1][3][1][3])); return; }
        const int row0 = u.pm * 256 + wr * 64 + fr, cl = (u.pn * 256 + wc * 32 + 8 * fq);
        const int kind = u.pn < 2 ? 0 : u.pn < 4 ? 1 : u.pn < 8 ? 2 : 3;
        bf16* dst = kind == 0 ? p.Q3 : kind == 1 ? p.K3 : kind == 2 ? p.V3 : p.G3;
        const int ld = kind < 2 ? 512 : 1024, cb = kind == 0 ? cl : kind == 1 ? cl - 512 : kind == 2 ? cl - 1024 : cl - 2048;
#pragma unroll
        for (int ai = 0; ai < 2; ++ai)
#pragma unroll
            for (int m = 0; m < 4; ++m) { const int row = row0 + ai * 128 + m * 16;
                float rstd = 1.0f / sqrtf(__hip_atomic_load(p.SS + row, __ATOMIC_RELAXED, __HIP_MEMORY_SCOPE_AGENT) * (1.f / DM) + EPS);
                if (kind == 0) rstd *= ATT_SCALE;
#pragma unroll
                for (int bj = 0; bj < 2; ++bj) { f32x4 v0 = acc[ai][bj][m][0] * rstd, v1 = acc[ai][bj][m][1] * rstd;
                    if (kind == 3) { v0 = silu4(v0); v1 = silu4(v1); }
                    st_bf8(dst + (size_t)row * ld + cb + bj * 128, v0, v1); } }
    } };
struct Epi4 { static constexpr bool PERM = true, AFTER_DRAIN = false; P4 p;
    __device__ __forceinline__ void operator()(const pg8::f32x4 (&acc)[2][2][4][2], const pg8::Unit& u, int wr, int wc, int fr, int fq) const {
        const int row0 = u.pm * 256 + wr * 64 + fr, c0 = u.pn * 256 + wc * 32 + 8 * fq;
#pragma unroll
        for (int ai = 0; ai < 2; ++ai)
#pragma unroll
            for (int m = 0; m < 4; ++m) { const int row = row0 + ai * 128 + m * 16; float ss = 0.f;
#pragma unroll
                for (int bj = 0; bj < 2; ++bj) { const size_t off = (size_t)row * DM + c0 + bj * 128;
                    const v4u xb = *(const GAS v4u*)(p.X1B + off);
                    const f32x4 o0 = (f32x4){__uint_as_float(xb.x << 16), __uint_as_float(xb.x & 0xffff0000u), __uint_as_float(xb.y << 16), __uint_as_float(xb.y & 0xffff0000u)} + acc[ai][bj][m][0];
                    const f32x4 o1 = (f32x4){__uint_as_float(xb.z << 16), __uint_as_float(xb.z & 0xffff0000u), __uint_as_float(xb.w << 16), __uint_as_float(xb.w & 0xffff0000u)} + acc[ai][bj][m][1];
                    *(GAS f32x4*)(p.Y + off) = o0; *(GAS f32x4*)(p.Y + off + 4) = o1;
                    ss += ((o0.x * o0.x + o0.y * o0.y) + (o0.z * o0.z + o0.w * o0.w)) + ((o1.x * o1.x + o1.y * o1.y) + (o1.z * o1.z + o1.w * o1.w)); }
                ss += __shfl_xor(ss, 16); ss += __shfl_xor(ss, 32);
                if (fq == 0) atomicAdd(p.SS + row, ss); }
    } };

struct Epi4F { static constexpr bool PERM = true, AFTER_DRAIN = true; P4 p; const float* gain; const XcdBarrier* bar;
    __device__ __forceinline__ void fused(pg8::f32x4 (&acc)[2][2][4][2], const pg8::Unit& u, int wr, int wc, int fr, int fq, PG8_LAS unsigned char* lds, int wid, int lane) const {
        const int row0 = u.pm * 256 + wr * 64 + fr, c0 = u.pn * 256 + wc * 32 + 8 * fq;
#pragma unroll
        for (int ai = 0; ai < 2; ++ai)
#pragma unroll
            for (int m = 0; m < 4; ++m) { const int row = row0 + ai * 128 + m * 16; float ss = 0.f;
#pragma unroll
                for (int bj = 0; bj < 2; ++bj) { const size_t off = (size_t)row * DM + c0 + bj * 128;
                    const v4u xb = *(const GAS v4u*)(p.X1B + off);
                    const f32x4 o0 = (f32x4){__uint_as_float(xb.x << 16), __uint_as_float(xb.x & 0xffff0000u), __uint_as_float(xb.y << 16), __uint_as_float(xb.y & 0xffff0000u)} + acc[ai][bj][m][0];
                    const f32x4 o1 = (f32x4){__uint_as_float(xb.z << 16), __uint_as_float(xb.z & 0xffff0000u), __uint_as_float(xb.w << 16), __uint_as_float(xb.w & 0xffff0000u)} + acc[ai][bj][m][1];
                    acc[ai][bj][m][0] = o0; acc[ai][bj][m][1] = o1;
                    ss += ((o0.x * o0.x + o0.y * o0.y) + (o0.z * o0.z + o0.w * o0.w)) + ((o1.x * o1.x + o1.y * o1.y) + (o1.z * o1.z + o1.w * o1.w)); }
                ss += __shfl_xor(ss, 16); ss += __shfl_xor(ss, 32);
                if (fq == 0) atomicAdd(p.SS + row, ss); }
        xcd_barrier(*bar);
        f32x4 g[2][2];
#pragma unroll
        for (int bj = 0; bj < 2; ++bj) { g[bj][0] = *(const GAS f32x4*)(gain + c0 + bj * 128); g[bj][1] = *(const GAS f32x4*)(gain + c0 + bj * 128 + 4); }
#pragma unroll
        for (int ai = 0; ai < 2; ++ai)
#pragma unroll
            for (int m = 0; m < 4; ++m) { const int row = row0 + ai * 128 + m * 16;
                const float rstd = 1.0f / sqrtf(__hip_atomic_load(p.SS + row, __ATOMIC_RELAXED, __HIP_MEMORY_SCOPE_AGENT) * (1.f / DM) + EPS);
#pragma unroll
                for (int bj = 0; bj < 2; ++bj) { const size_t off = (size_t)row * DM + c0 + bj * 128;
                    *(GAS f32x4*)(p.Y + off) = acc[ai][bj][m][0] * rstd * g[bj][0]; *(GAS f32x4*)(p.Y + off + 4) = acc[ai][bj][m][1] * rstd * g[bj][1]; } }
    } };

template <class EpiF>
__device__ __forceinline__ void sgemm_unit(const bf16* A, const bf16* WT, int u, int wave, int lane, const EpiF& epi) {
    const int fr = lane & 15, fq = lane >> 4;
    const GAS bf16x8* wp = (const GAS bf16x8*)(WT + (size_t)(16 * u + fr) * DM + 8 * fq);
    const GAS bf16x8* ap = (const GAS bf16x8*)(A + (size_t)(MP + 16 * wave + fr) * DM + 8 * fq);
    pg8::f32x4 acc = {0.f, 0.f, 0.f, 0.f};
#pragma unroll 1
    for (int k0 = 0; k0 < 32; k0 += 16) {
        bf16x8 wv[16], av[16];
#pragma unroll
        for (int i = 0; i < 16; ++i) { wv[i] = wp[(k0 + i) * 4]; av[i] = ap[(k0 + i) * 4]; }
#pragma unroll
        for (int i = 0; i < 16; ++i) acc = __builtin_amdgcn_mfma_f32_16x16x32_bf16(wv[i], av[i], acc, 0, 0, 0);
    }
    epi(MP + 16 * wave + fr, 16 * u + 4 * fq, acc);
}

typedef short s16x4 __attribute__((ext_vector_type(4)));

struct LaArgs {
    const bf16* Q; const bf16* Kp; const bf16* G;
    const bf16* V; const bf16* GATE; int ldv;
    const float* gain;
    bf16* MIXo; int mixoff;
    bf16* SBUF; float* BTOT;
    const float* S0; float* S1;
};
template <int DV, bool HAS_K, int MODE>
__device__ __forceinline__ void la_unit(LAS unsigned char* lds, const LaArgs& a, int m0, int h, int tid, int wave, int lane) {
    constexpr int NVT = DV / 128, NCH = 4, TV = 64; static_assert(MODE == 0 || MODE == 1, "la_unit modes");
    constexpr bool FULL = MODE != 0;
    constexpr int VS = DV + 8;
    constexpr int R0 = 0;
    constexpr int R1 = 17408;
    constexpr int R2 = 34816, R2_SZ = (DV * 144 > 33792) ? DV * 144 : 33792;
    constexpr int R3 = R2 + R2_SZ, R3_SZ = 64 * VS * 2;
    constexpr int K2T_OFF = R3 + R3_SZ;
    constexpr int P_OFF = K2T_OFF + 18432;
    constexpr int TOT_OFF = P_OFF + 9216, EBR_OFF = TOT_OFF + 4096, EBL_OFF = EBR_OFF + 512, SSQ_OFF = EBL_OFF + 512;
    static_assert(SSQ_OFF + 2048 <= LDSCTL_OFF, "LA LDS");
    constexpr int A1_OFF = R0, K1_OFF = R1, VT_OFF = R2;
    LAS float* TOT = (LAS float*)(lds + TOT_OFF); LAS float* EBR = (LAS float*)(lds + EBR_OFF); LAS float* EBL = (LAS float*)(lds + EBL_OFF); LAS float* SSQ = (LAS float*)(lds + SSQ_OFF);
    f32x4 S[8][NVT];
#pragma unroll
    for (int kp = 0; kp < 4; ++kp)
#pragma unroll
        for (int vt = 0; vt < NVT; ++vt) {
            if (MODE == 0) { S[2 * kp][vt] = (f32x4){0.f, 0.f, 0.f, 0.f}; S[2 * kp + 1][vt] = (f32x4){0.f, 0.f, 0.f, 0.f}; }
            else { const v4u sv = *(const GAS v4u*)(a.SBUF + ((size_t)((wave * 4 + kp) * NVT + vt) * 64 + lane) * 8);
                S[2 * kp][vt] = (f32x4){__uint_as_float(sv.x << 16), __uint_as_float(sv.x & 0xffff0000u), __uint_as_float(sv.y << 16), __uint_as_float(sv.y & 0xffff0000u)};
                S[2 * kp + 1][vt] = (f32x4){__uint_as_float(sv.z << 16), __uint_as_float(sv.z & 0xffff0000u), __uint_as_float(sv.w << 16), __uint_as_float(sv.w & 0xffff0000u)}; }
        }
    constexpr int NV = NVT * 2, VCH = DV / 8;
    v4u rg[2], rq[2], rk[2], rv[NV];
#define TZ(name) int name = tid; asm volatile("" : "+v"(name))
#define LB(name, off) LAS unsigned char* name = lds + (off); asm volatile("" : "+v"(name))
#define LA_LOAD(chn) do { const int mr_ = m0 + 64 * (chn); TZ(tz_);                                                                                            \
        const bf16* gb_ = a.G + (size_t)mr_ * 512 + h * 128;  const bf16* qb_ = a.Q + (size_t)mr_ * 512 + h * 128; const bf16* kb_ = HAS_K ? a.Kp + (size_t)mr_ * 512 + h * 128 : nullptr; \
        const bf16* vb_ = a.V + (size_t)mr_ * a.ldv + h * DV;                                                                                                 \
        _Pragma("unroll") for (int i_ = 0; i_ < 2; ++i_) { const int e_ = tz_ + 512 * i_; const unsigned o_ = (unsigned)((e_ >> 4) * 512 + 8 * (e_ & 15));   \
            rg[i_] = *(const GAS v4u*)(gb_ + o_); if (FULL) rq[i_] = *(const GAS v4u*)(qb_ + o_); if (HAS_K) rk[i_] = *(const GAS v4u*)(kb_ + o_); }                                              \
        _Pragma("unroll") for (int i_ = 0; i_ < NV; ++i_) { const int e_ = tz_ + 512 * i_; rv[i_] = *(const GAS v4u*)(vb_ + (unsigned)((e_ / VCH) * a.ldv + 8 * (e_ % VCH))); } } while (0)
    LA_LOAD(0);
    float btot_run_A = 0.f, btot_run_B = 0.f;
#pragma unroll 1
    for (int ch = 0; ch < NCH; ++ch) {
        const int mr0 = m0 + 64 * ch;
        v4u gt[NV];
        { TZ(tz);
#pragma unroll
        for (int i = 0; i < 2; ++i) { const int e = tz + 512 * i, row = e >> 4;
            { LAS f32x4* gp = (LAS f32x4*)(lds + R2 + (row * 132 + 8 * (e & 15)) * 4);
              gp[0] = (f32x4){__uint_as_float(rg[i].x << 16), __uint_as_float(rg[i].x & 0xffff0000u), __uint_as_float(rg[i].y << 16), __uint_as_float(rg[i].y & 0xffff0000u)};
              gp[1] = (f32x4){__uint_as_float(rg[i].z << 16), __uint_as_float(rg[i].z & 0xffff0000u), __uint_as_float(rg[i].w << 16), __uint_as_float(rg[i].w & 0xffff0000u)}; }
            if (FULL) *(LAS v4u*)(lds + R0 + (row * 136 + 8 * (e & 15)) * 2) = rq[i];
            if (HAS_K) *(LAS v4u*)(lds + R1 + (row * 136 + 8 * (e & 15)) * 2) = rk[i]; }
#pragma unroll
        for (int i = 0; i < NV; ++i) { const int e = tz + 512 * i, row = e / VCH; *(LAS v4u*)(lds + R3 + (row * VS + 8 * (e % VCH)) * 2) = rv[i]; } }
        __syncthreads();
        if (NCH > 1) { const int chn = ch + 1 < NCH ? ch + 1 : ch; LA_LOAD(chn); }
        if (FULL) { const bf16* gtb = a.GATE + (size_t)mr0 * a.ldv + h * DV; TZ(tz);
#pragma unroll
            for (int i = 0; i < NV; ++i) { const int e = tz + 512 * i; gt[i] = *(const GAS v4u*)(gtb + (unsigned)((e / VCH) * a.ldv + 8 * (e % VCH))); } }
        {
        TZ(tzb); const int c2 = tzb & 63, seg = tzb >> 6, cA = 2 * c2;
        float gA[8], gB[8], kA[8], kB[8], qA[8], qB[8];
        LB(bG, R2 + (8 * seg * 132 + cA) * 4); LB(bQ, R0 + (8 * seg * 136 + cA) * 2); LB(bK, R1 + (8 * seg * 136 + cA) * 2);
#pragma unroll
        for (int i = 0; i < 8; ++i) {
            const f32x2_t gg = *(const LAS f32x2_t*)(bG + i * 528); gA[i] = gg.x; gB[i] = gg.y;
            if (FULL) { const unsigned qq = *(const LAS unsigned*)(bQ + i * 272); qA[i] = __uint_as_float(qq << 16); qB[i] = __uint_as_float(qq & 0xffff0000u); }
            if (HAS_K) { const unsigned kk = *(const LAS unsigned*)(bK + i * 272); kA[i] = __uint_as_float(kk << 16); kB[i] = __uint_as_float(kk & 0xffff0000u); } }
#pragma unroll
        for (int i = 0; i < 8; ++i) { if (!HAS_K) { kA[i] = 1.0f - __expf(gA[i]); kB[i] = 1.0f - __expf(gB[i]); } if (i) { gA[i] += gA[i - 1]; gB[i] += gB[i - 1]; } }
        LB(bT, TOT_OFF + cA * 4);
        *(LAS f32x2_t*)(bT + seg * 512) = (f32x2_t){gA[7], gB[7]};
        __syncthreads();
        float preA = 0.f, preB = 0.f, brA = 0.f, brB = 0.f, blA = 0.f, blB = 0.f;
#pragma unroll
        for (int q = 0; q < 8; ++q) { const f32x2_t tt_ = *(const LAS f32x2_t*)(bT + q * 512);
            if (q < seg) { preA += tt_.x; preB += tt_.y; } if (q < 4) { brA += tt_.x; brB += tt_.y; } blA += tt_.x; blB += tt_.y; }
        if (seg == 0) { *(LAS f32x2_t*)(bT + (EBR_OFF - TOT_OFF)) = (f32x2_t){__expf(brA), __expf(brB)}; *(LAS f32x2_t*)(bT + (EBL_OFF - TOT_OFF)) = (f32x2_t){__expf(blA), __expf(blB)}; btot_run_A += blA; btot_run_B += blB; }
        {   unsigned k2a[4], k2b[4];
#pragma unroll
            for (int i = 0; i < 8; i += 2) { const float a0 = gA[i] + preA, a1 = gA[i + 1] + preA, b0 = gB[i] + preB, b1 = gB[i + 1] + preB;
                k2a[i >> 1] = cvtpk_s(kA[i] * __expf(blA - a0), kA[i + 1] * __expf(blA - a1));
                k2b[i >> 1] = cvtpk_s(kB[i] * __expf(blB - b0), kB[i + 1] * __expf(blB - b1));
                if (FULL) {
                    *(LAS unsigned*)(bQ + i * 272) = cvtpk_s(qA[i] * __expf(a0 - brA), qB[i] * __expf(b0 - brB));
                    *(LAS unsigned*)(bQ + (i + 1) * 272) = cvtpk_s(qA[i + 1] * __expf(a1 - brA), qB[i + 1] * __expf(b1 - brB));
                    *(LAS unsigned*)(bK + i * 272) = cvtpk_s(kA[i] * __expf(brA - a0), kB[i] * __expf(brB - b0));
                    *(LAS unsigned*)(bK + (i + 1) * 272) = cvtpk_s(kA[i + 1] * __expf(brA - a1), kB[i + 1] * __expf(brB - b1)); } }
            LB(bK2, K2T_OFF + (cA * 72 + 8 * seg) * 2);
            *(LAS v4u*)(bK2) = (v4u){k2a[0], k2a[1], k2a[2], k2a[3]};
            *(LAS v4u*)(bK2 + 144) = (v4u){k2b[0], k2b[1], k2b[2], k2b[3]}; }
        LB(bVr, R3 + (8 * seg * VS + cA) * 2); LB(bVw, VT_OFF + (cA * 72 + 8 * seg) * 2);
#pragma unroll
        for (int ps = 0; ps < NVT; ++ps) { unsigned vv[8];
#pragma unroll
            for (int i = 0; i < 8; ++i) vv[i] = *(const LAS unsigned*)(bVr + (i * VS + 128 * ps) * 2);
            v4u wa, wb;
            wa.x = (vv[0] & 0xffffu) | (vv[1] << 16); wa.y = (vv[2] & 0xffffu) | (vv[3] << 16); wa.z = (vv[4] & 0xffffu) | (vv[5] << 16); wa.w = (vv[6] & 0xffffu) | (vv[7] << 16);
            wb.x = (vv[0] >> 16) | (vv[1] & 0xffff0000u); wb.y = (vv[2] >> 16) | (vv[3] & 0xffff0000u); wb.z = (vv[4] >> 16) | (vv[5] & 0xffff0000u); wb.w = (vv[6] >> 16) | (vv[7] & 0xffff0000u);
            *(LAS v4u*)(bVw + 128 * ps * 144) = wa; *(LAS v4u*)(bVw + 128 * ps * 144 + 144) = wb; }
        }
        __syncthreads();
        if (FULL) {
            TZ(tzc); const int lc = tzc & 63, fr = lc & 15, fq = lc >> 4, wv = __builtin_amdgcn_readfirstlane(tzc >> 6);
            const int tt = wv >> 1, st0 = 2 * (wv & 1);
            f32x4 p0 = {0.f, 0.f, 0.f, 0.f}, p1 = {0.f, 0.f, 0.f, 0.f};
            LB(bA, A1_OFF + ((16 * tt + fr) * 136 + 8 * fq) * 2); LB(bB, K1_OFF + ((16 * st0 + fr) * 136 + 8 * fq) * 2);
#pragma unroll
            for (int ks = 0; ks < 4; ++ks) {
                const bf16x8 av = *(const LAS bf16x8*)(bA + ks * 64);
                const bf16x8 b0 = *(const LAS bf16x8*)(bB + ks * 64);
                const bf16x8 b1 = *(const LAS bf16x8*)(bB + 16 * 272 + ks * 64);
                p0 = __builtin_amdgcn_mfma_f32_16x16x32_bf16(av, b0, p0, 0, 0, 0);
                p1 = __builtin_amdgcn_mfma_f32_16x16x32_bf16(av, b1, p1, 0, 0, 0);
            }
            LB(bP, P_OFF + ((16 * tt + 4 * fq) * 72 + 16 * st0 + fr) * 2);
#pragma unroll
            for (int j = 0; j < 4; ++j) { const int t = 16 * tt + 4 * fq + j, s0 = 16 * st0 + fr, s1 = s0 + 16;
                const float x0 = (s0 <= t) ? p0[j] : 0.f, x1 = (s1 <= t) ? p1[j] : 0.f;
                *(LAS bf16*)(bP + j * 144) = (bf16)(cvtpk_s(x0, 0.f) & 0xffffu);
                *(LAS bf16*)(bP + j * 144 + 32) = (bf16)(cvtpk_s(x1, 0.f) & 0xffffu); }
            __syncthreads();
        }
        TZ(tzd); const int ld_ = tzd & 63, fr = ld_ & 15, fq = ld_ >> 4, wave_d = __builtin_amdgcn_readfirstlane(tzd >> 6), vbase = wave_d * (DV / 8);
        bf16x8 vb[NVT][2];
        LB(bVT, VT_OFF + ((vbase + fr) * 72 + 8 * fq) * 2);
#pragma unroll
        for (int vt = 0; vt < NVT; ++vt)
#pragma unroll
            for (int ks = 0; ks < 2; ++ks) vb[vt][ks] = *(const LAS bf16x8*)(bVT + vt * 16 * 144 + ks * 64);
        f32x4 o[4][NVT];
        if (FULL) {
            LB(bPr, P_OFF + (fr * 72 + 8 * fq) * 2); LB(bE, EBR_OFF + 16 * fq); LB(bA4, A1_OFF + (fr * 136 + 4 * fq) * 2);
#pragma unroll
            for (int tt = 0; tt < 4; ++tt)
#pragma unroll
                for (int vt = 0; vt < NVT; ++vt) o[tt][vt] = (f32x4){0.f, 0.f, 0.f, 0.f};
#pragma unroll
            for (int tt = 0; tt < 4; ++tt)
#pragma unroll
                for (int ks = 0; ks < 2; ++ks) { const bf16x8 pa = *(const LAS bf16x8*)(bPr + tt * 16 * 144 + ks * 64);
#pragma unroll
                    for (int vt = 0; vt < NVT; ++vt) o[tt][vt] = __builtin_amdgcn_mfma_f32_16x16x32_bf16(pa, vb[vt][ks], o[tt][vt], 0, 0, 0); }
#pragma unroll
            for (int ks = 0; ks < 4; ++ks) {
                const f32x4 e0 = *(const LAS f32x4*)(bE + ks * 128), e1 = *(const LAS f32x4*)(bE + ks * 128 + 64);
                bf16x8 sb[NVT];
#pragma unroll
                for (int vt = 0; vt < NVT; ++vt) sb[vt] = pack8f(S[2 * ks][vt] * e0, S[2 * ks + 1][vt] * e1);
#pragma unroll
                for (int tt = 0; tt < 4; ++tt) {
                    const s16x4 alo = *(const LAS s16x4*)(bA4 + tt * 16 * 272 + ks * 64);
                    const s16x4 ahi = *(const LAS s16x4*)(bA4 + tt * 16 * 272 + ks * 64 + 32);
                    const bf16x8 aa = __builtin_shufflevector(alo, ahi, 0, 1, 2, 3, 4, 5, 6, 7);
#pragma unroll
                    for (int vt = 0; vt < NVT; ++vt) o[tt][vt] = __builtin_amdgcn_mfma_f32_16x16x32_bf16(aa, sb[vt], o[tt][vt], 0, 0, 0);
                }
            }
        }
        LB(bL, EBL_OFF + 16 * fq); LB(bK2r, K2T_OFF + (fr * 72 + 8 * fq) * 2);
#pragma unroll
        for (int kt = 0; kt < 8; ++kt) {
            const f32x4 el = *(const LAS f32x4*)(bL + kt * 64);
#pragma unroll
            for (int vt = 0; vt < NVT; ++vt) S[kt][vt] = S[kt][vt] * el;
#pragma unroll
            for (int ks = 0; ks < 2; ++ks) { const bf16x8 ka = *(const LAS bf16x8*)(bK2r + kt * 16 * 144 + ks * 64);
#pragma unroll
                for (int vt = 0; vt < NVT; ++vt) S[kt][vt] = __builtin_amdgcn_mfma_f32_16x16x32_bf16(ka, vb[vt][ks], S[kt][vt], 0, 0, 0); }
        }
        if (FULL) {
            LB(bS, SSQ_OFF + (wave_d * 64 + 4 * fq) * 4); LB(bR, TOT_OFF + 16 * fq); LB(bO, R3 + ((4 * fq) * VS + vbase + fr) * 2);
#pragma unroll
            for (int tt = 0; tt < 4; ++tt) { f32x4 ss = {0.f, 0.f, 0.f, 0.f};
#pragma unroll
                for (int vt = 0; vt < NVT; ++vt) ss += o[tt][vt] * o[tt][vt];
#pragma unroll
                for (int j = 0; j < 4; ++j) ss[j] = row16_sum(ss[j]);
                if (fr == 0) *(LAS f32x4*)(bS + tt * 64) = ss; }
            __syncthreads();
            if (ld_ < 8) { const int t = 8 * wave_d + ld_; float tot = 0.f;
#pragma unroll
                for (int w = 0; w < 8; ++w) tot += SSQ[w * 64 + t];
                TOT[t] = 1.0f / sqrtf(tot * (1.0f / DV) + EPS); }
            float gn[NVT];
#pragma unroll
            for (int vt = 0; vt < NVT; ++vt) gn[vt] = a.gain[h * DV + vbase + 16 * vt + fr];
            __syncthreads();
#pragma unroll
            for (int tt = 0; tt < 4; ++tt) {
                const f32x4 rs = *(const LAS f32x4*)(bR + tt * 64);
#pragma unroll
                for (int j = 0; j < 4; ++j) { const int t = 16 * tt + 4 * fq + j;
#pragma unroll
                    for (int vt = 0; vt < NVT; ++vt) { const float val = o[tt][vt][j] * rs[j] * gn[vt]; const float vn = dppf<0xB1>(val);
                        if ((fr & 1) == 0) *(LAS unsigned*)(bO + ((16 * tt + j) * VS + 16 * vt) * 2) = cvtpk_s(val, vn); } }
            }
            __syncthreads();
            TZ(tze);
#pragma unroll
            for (int i = 0; i < NV; ++i) { const int e = tze + 512 * i, row = e / VCH;
                { const v4u ov = *(const LAS v4u*)(lds + R3 + (row * VS + 8 * (e % VCH)) * 2); v4u w;
#pragma unroll
                    for (int k = 0; k < 4; ++k) w[k] = cvtpk_s(__uint_as_float(ov[k] << 16) * __uint_as_float(gt[i][k] << 16), __uint_as_float(ov[k] & 0xffff0000u) * __uint_as_float(gt[i][k] & 0xffff0000u));
                    *(GAS v4u*)(a.MIXo + (size_t)(mr0 + row) * 1024 + a.mixoff + h * DV + 8 * (e % VCH)) = w; } }
        }
        __syncthreads();
    }
#undef LA_LOAD
#undef TZ
#undef LB
    if (MODE == 0) {
#pragma unroll
        for (int kp = 0; kp < 4; ++kp)
#pragma unroll
            for (int vt = 0; vt < NVT; ++vt) st_bf8(a.SBUF + ((size_t)((wave * 4 + kp) * NVT + vt) * 64 + lane) * 8, S[2 * kp][vt], S[2 * kp + 1][vt]);
        if ((tid >> 6) == 0) { a.BTOT[2 * (tid & 63)] = btot_run_A; a.BTOT[2 * (tid & 63) + 1] = btot_run_B; }
    }
}

template <int DV, bool HAS_K>
__device__ __forceinline__ void la_sample_unit(LAS unsigned char* lds, const LaArgs& a, int u, int tid, int wave, int lane) {
    constexpr int KS = 512 / DV, KPT = 128 / KS, NOUT = 4 * DV / 512;
    const int b = u >> 2, h = u & 3, m0 = MP + b * 4;
    LAS float* EG = (LAS float*)lds; LAS float* KK = EG + 512; LAS float* QQ = KK + 512; LAS float* RED = QQ + 512; LAS float* WS = RED + 4 * KS * DV;
    { const int t = tid >> 7, k = tid & 127; const size_t off = (size_t)(m0 + t) * 512 + h * 128 + k;
      const float g = bf2f(a.G[off]), eg = __expf(g); EG[tid] = eg; KK[tid] = HAS_K ? bf2f(a.Kp[off]) : 1.0f - eg; QQ[tid] = bf2f(a.Q[off]); }
    __syncthreads();
    const int v = tid % DV, ks = tid / DV, k0 = ks * KPT;
    float S[KPT];
    { const float* sp = a.S0 + (size_t)k0 * DV + v;
#pragma unroll
      for (int i0 = 0; i0 < KPT; i0 += 4) { asm volatile("" : "+v"(sp));
#pragma unroll
          for (int i = 0; i < 4; ++i) S[i0 + i] = sp[i * DV];
          sp += 4 * DV; } }
#pragma unroll
    for (int t = 0; t < 4; ++t) {
        const float vt = bf2f(a.V[(size_t)(m0 + t) * a.ldv + h * DV + v]); float o = 0.f;
#pragma unroll
        for (int i = 0; i < KPT; ++i) { S[i] = S[i] * EG[t * 128 + k0 + i] + KK[t * 128 + k0 + i] * vt; o += S[i] * QQ[t * 128 + k0 + i]; }
        RED[(t * KS + ks) * DV + v] = o;
    }
    { float* sp = a.S1 + (size_t)k0 * DV + v;
#pragma unroll
      for (int i0 = 0; i0 < KPT; i0 += 4) { asm volatile("" : "+v"(sp));
#pragma unroll
          for (int i = 0; i < 4; ++i) sp[i * DV] = S[i0 + i];
          sp += 4 * DV; } }
    __syncthreads();
    float ov[NOUT];
#pragma unroll
    for (int j = 0; j < NOUT; ++j) { const int idx = tid + 512 * j, t = idx / DV, vv = idx % DV; float o = 0.f;
#pragma unroll
        for (int q = 0; q < KS; ++q) o += RED[(t * KS + q) * DV + vv];
        ov[j] = o; const float ss = wave_sum(o * o); if (lane == 0) WS[j * 8 + wave] = ss; }
    __syncthreads();
#pragma unroll
    for (int j = 0; j < NOUT; ++j) { const int idx = tid + 512 * j, t = idx / DV, vv = idx % DV;
        constexpr int WPT = DV / 64;
        const int w0 = (wave / WPT) * WPT; float tot = 0.f;
#pragma unroll
        for (int q = 0; q < WPT; ++q) tot += WS[j * 8 + w0 + q];
        const float rstd = 1.0f / sqrtf(tot * (1.0f / DV) + EPS); const size_t row = (size_t)(m0 + t);
        const float val = ov[j] * rstd * a.gain[h * DV + vv] * bf2f(a.GATE[row * a.ldv + h * DV + vv]);
        a.MIXo[row * 1024 + a.mixoff + h * DV + vv] = (bf16)(cvtpk_s(val, 0.f) & 0xffffu); }
    __syncthreads();
}

template <int DV>
__device__ __forceinline__ void la_scan(bf16* SLOC, const float* BTOT, float* outstate, int gtid, int gthreads) {
    constexpr int NVT = DV / 128, LP = 8192 * NVT;
    GAS unsigned* SW = (GAS unsigned*)SLOC;
    for (int eg = gtid; eg < 8 * LP; eg += gthreads) {
        const int bh = eg / LP, e = eg % LP;
        const int jj = e & 1, kk = (e >> 1) & 1, ln = (e >> 2) & 63, rest = e >> 8, vt = rest % NVT, kp = (rest / NVT) & 3, w = rest / (NVT * 4);
        const int k = 16 * (2 * kp + kk) + 4 * (ln >> 4) + 2 * jj, v = w * (DV / 8) + 16 * vt + (ln & 15);
        float c0 = 0.f, c1 = 0.f;
        {   constexpr int s0 = 0;
            unsigned loc[32]; f32x2_t dec[32];
#pragma unroll
            for (int sc = 0; sc < 32; ++sc) { loc[sc] = SW[(size_t)(bh * 32 + s0 + sc) * LP + e]; dec[sc] = *(const GAS f32x2_t*)(BTOT + (size_t)(bh * 32 + s0 + sc) * 128 + k); }
#pragma unroll
            for (int sc = 0; sc < 32; ++sc) { SW[(size_t)(bh * 32 + s0 + sc) * LP + e] = cvtpk_s(c0, c1);
                c0 = c0 * __expf(dec[sc].x) + __uint_as_float(loc[sc] << 16); c1 = c1 * __expf(dec[sc].y) + __uint_as_float(loc[sc] & 0xffff0000u); }
        }
        outstate[(size_t)(bh * 128 + k) * DV + v] = c0; outstate[(size_t)(bh * 128 + k + 1) * DV + v] = c1;
    }
}

namespace fox {
using TIN = __hip_bfloat16; using TOUT = __hip_bfloat16;
constexpr int D = 128, SKV = 8192, WINDOW = SKV; constexpr float THR = 8.f; constexpr bool WSKIP = false;
constexpr int OSTR = 1024, GSTR = 512;
constexpr float SCALE = 0.08838834764831845f;
constexpr int NW = 8, QBLK = 32, KVBLK = 64, QB = NW * QBLK;
constexpr int SHM_V = KVBLK * D * 2, SHM_K = KVBLK * D * 2;
constexpr int LDS_BIAS = 2 * SHM_V + 2 * SHM_K + NW * 64 * 4;
constexpr int LDS_BYTES = LDS_BIAS + 512;
constexpr int ORS = 136, OST_WAVE = 32 * ORS * 2, OST_OFF = 69632;

using bf16 = __hip_bfloat16;
typedef short bf16x8 __attribute__((ext_vector_type(8)));
typedef short s16x4 __attribute__((ext_vector_type(4)));
typedef float f32x16 __attribute__((ext_vector_type(16)));
typedef float f32x4 __attribute__((ext_vector_type(4)));
typedef unsigned u32x4 __attribute__((ext_vector_type(4)));
template <class A, class Bt> struct same_t { static constexpr bool v = false; };
template <class A> struct same_t<A, A> { static constexpr bool v = true; };

#define KSWZ(row, colB) ((row) * 256 + ((colB) ^ (((row) & 7) << 4)))
#define SBAR() __builtin_amdgcn_sched_barrier(0)
__device__ __forceinline__ int v_st(int k, int c) { const int kk = (k & ~0xC) | ((k & 4) << 1) | ((k & 8) >> 1); return ((kk >> 3) * 4 + (c >> 5)) * 512 + ((kk & 7) * 32 + (c & 31)) * 2; }
__device__ __forceinline__ int v_rd_base(int lane) { return ((lane & 3) << 3) | (((lane >> 2) & 3) << 6) | (((lane >> 4) & 1) << 5) | (((lane >> 5) & 1) << 8); }
constexpr int v_rd_off(int d0, int ks, int half) { return d0 * 512 + ks * 4096 + half * 2048; }
__device__ __forceinline__ int crow(int r, int hi) { return (r & 3) + 8 * (r >> 2) + 4 * hi; }
__device__ __forceinline__ unsigned cvtpk(float lo, float hi) {
    unsigned r; asm volatile("v_cvt_pk_bf16_f32 %0, %1, %2" : "=v"(r) : "v"(lo), "v"(hi)); return r;
}
__device__ __forceinline__ bf16x8 pack8(f32x4 a, f32x4 b) {
    u32x4 w = {cvtpk(a[0], a[1]), cvtpk(a[2], a[3]), cvtpk(b[0], b[1]), cvtpk(b[2], b[3])};
    return *reinterpret_cast<bf16x8*>(&w);
}
template <class T> __device__ __forceinline__ bf16x8 load8(const T* p) {
    if constexpr (same_t<T, float>::v) { return pack8(*(const f32x4*)p, *(const f32x4*)(p + 4)); }
    else { return *reinterpret_cast<const bf16x8*>(p); }
}
__device__ __forceinline__ void mask_tile(f32x16& p0, f32x16& p1, int dq, unsigned W) {
    const float NEG = -__builtin_inff();
#pragma unroll
    for (int r = 0; r < 16; ++r) {
        const int c = (r & 3) + 8 * (r >> 2);
        if ((unsigned)(dq - c) >= W) p0[r] = NEG;
        if ((unsigned)(dq - c - 32) >= W) p1[r] = NEG;
    }
}
__device__ __forceinline__ void partialSM(f32x16& p0, f32x16& p1, float& m_reg, float& mn, float& alpha) {
    float pmax = p0[0]; for (int r = 1; r < 16; ++r) pmax = fmaxf(pmax, p0[r]); for (int r = 0; r < 16; ++r) pmax = fmaxf(pmax, p1[r]);
    { auto rr = __builtin_amdgcn_permlane32_swap(__float_as_uint(pmax), __float_as_uint(pmax), false, false);
      pmax = fmaxf(__uint_as_float(rr[0]), __uint_as_float(rr[1])); }
    constexpr float C2 = 1.4426950408889634f * SCALE;
    if (__builtin_expect(__all((pmax - m_reg) * SCALE <= THR), 1)) { mn = m_reg; alpha = 1.f; }
    else { mn = fmaxf(m_reg, pmax); alpha = __builtin_amdgcn_exp2f((m_reg - mn) * C2); m_reg = mn; }
    const float mnL = -mn * C2;
    for (int r = 0; r < 16; ++r) p0[r] = fmaf(p0[r], C2, mnL); for (int r = 0; r < 16; ++r) p1[r] = fmaf(p1[r], C2, mnL);
    for (int r = 0; r < 16; ++r) p0[r] = __builtin_amdgcn_exp2f(p0[r]);
}
__device__ __forceinline__ void finishSM(f32x16& p0, f32x16& p1, float alpha, float& l_reg, bf16x8& pa0, bf16x8& pa1, bf16x8& pa2, bf16x8& pa3) {
    for (int r = 0; r < 16; ++r) p1[r] = __builtin_amdgcn_exp2f(p1[r]);
    float ps = 0; for (int r = 0; r < 16; ++r) ps += p0[r]; for (int r = 0; r < 16; ++r) ps += p1[r];
    { auto rr = __builtin_amdgcn_permlane32_swap(__float_as_uint(ps), __float_as_uint(ps), false, false);
      ps = __uint_as_float(rr[0]) + __uint_as_float(rr[1]); }
    l_reg = l_reg * alpha + ps;
#define PK4(P, B_, OUT) do { unsigned a0 = cvtpk(P[B_+0], P[B_+1]), a1 = cvtpk(P[B_+2], P[B_+3]);                          \
        unsigned b0 = cvtpk(P[B_+4], P[B_+5]), b1 = cvtpk(P[B_+6], P[B_+7]);                                             \
        auto r0 = __builtin_amdgcn_permlane32_swap(a0, b0, false, false); auto r1 = __builtin_amdgcn_permlane32_swap(a1, b1, false, false); \
        u32x4 w = {r0[0], r1[0], r0[1], r1[1]}; OUT = *reinterpret_cast<bf16x8*>(&w); } while (0)
    PK4(p0, 0, pa0); PK4(p0, 8, pa1); PK4(p1, 0, pa2); PK4(p1, 8, pa3);
#undef PK4
}
constexpr int NQR = 8;
template <int KB, bool SK>
__device__ __forceinline__ void qkt(f32x16& p0, f32x16& p1, const char* K_lds, int r32, int hi, const char* qs, const bf16x8* qrh, bool act) {
    if (SK && !act) { const float NEG = -__builtin_inff();
#pragma unroll
        for (int r = 0; r < 16; ++r) { p0[r] = NEG; p1[r] = NEG; } return; }
    { const float* bl = (const float*)(K_lds + 2 * SHM_K + NW * 64 * 4 + KB * 256) + 4 * hi;
#pragma unroll
      for (int g = 0; g < 4; ++g) { const f32x4 b0 = *(const f32x4*)(bl + 8 * g), b1 = *(const f32x4*)(bl + 32 + 8 * g);
          p0[4 * g] = b0[0]; p0[4 * g + 1] = b0[1]; p0[4 * g + 2] = b0[2]; p0[4 * g + 3] = b0[3]; p1[4 * g] = b1[0]; p1[4 * g + 1] = b1[1]; p1[4 * g + 2] = b1[2]; p1[4 * g + 3] = b1[3]; } }
    const char* kb[4];
#pragma unroll
    for (int dd = 0; dd < 4; ++dd) kb[dd] = K_lds + KB * SHM_K + KSWZ(r32, (dd * 16 + hi * 8) * 2);
#pragma unroll
    for (int d0 = 0; d0 < 8; ++d0) { const char* a = kb[d0 & 3] + (d0 >> 2) * 128;
        bf16x8 b0 = *reinterpret_cast<const bf16x8*>(a);
        bf16x8 b1 = *reinterpret_cast<const bf16x8*>(a + 32 * 256);
        const bf16x8 qv = d0 < NQR ? qrh[d0] : *reinterpret_cast<const bf16x8*>(qs + d0 * 32);
        p0 = __builtin_amdgcn_mfma_f32_32x32x16_bf16(b0, qv, p0, 0, 0, 0);
        p1 = __builtin_amdgcn_mfma_f32_32x32x16_bf16(b1, qv, p1, 0, 0, 0); }
}
template <int VB, bool SK>
__device__ __forceinline__ void pv_tile(f32x16* o, int vb0, bf16x8 pa0, bf16x8 pa1, bf16x8 pa2, bf16x8 pa3, bool act) {
    if (SK && !act) return;
#define TRRD(dst, off) asm volatile("ds_read_b64_tr_b16 %0, %1 offset:%2" : "=&v"(dst) : "v"(vb0), "i"(off) : "memory")
#define PV_D0(d0) do { s16x4 l0, l1, l2, l3, h0, h1, h2, h3; constexpr int b_ = VB * SHM_V + v_rd_off(d0, 0, 0);     \
        TRRD(l0, b_); TRRD(h0, b_ + 2048); TRRD(l1, b_ + 4096); TRRD(h1, b_ + 6144); TRRD(l2, b_ + 8192); TRRD(h2, b_ + 10240); TRRD(l3, b_ + 12288); TRRD(h3, b_ + 14336); \
        asm volatile("s_waitcnt lgkmcnt(0)" ::: "memory"); SBAR();                 \
        o[d0] = __builtin_amdgcn_mfma_f32_32x32x16_bf16(pa0, (bf16x8){l0[0], l0[1], l0[2], l0[3], h0[0], h0[1], h0[2], h0[3]}, o[d0], 0, 0, 0);   \
        o[d0] = __builtin_amdgcn_mfma_f32_32x32x16_bf16(pa1, (bf16x8){l1[0], l1[1], l1[2], l1[3], h1[0], h1[1], h1[2], h1[3]}, o[d0], 0, 0, 0);   \
        o[d0] = __builtin_amdgcn_mfma_f32_32x32x16_bf16(pa2, (bf16x8){l2[0], l2[1], l2[2], l2[3], h2[0], h2[1], h2[2], h2[3]}, o[d0], 0, 0, 0);   \
        o[d0] = __builtin_amdgcn_mfma_f32_32x32x16_bf16(pa3, (bf16x8){l3[0], l3[1], l3[2], l3[3], h3[0], h3[1], h3[2], h3[3]}, o[d0], 0, 0, 0); } while (0)
    PV_D0(0); PV_D0(1); PV_D0(2); PV_D0(3);
#undef PV_D0
#undef TRRD
}

template <class TIn, class TOut> struct BlockRef { const TIn* Q; const TIn* K; const TIn* V; TOut* O; int P0; const float* CB; const TIn* G; };
template <class TIn> struct Seam {
    bf16x8 qr[8];
    bf16x8 st_v0, st_v1, st_k0, st_k1; f32x4 sf0, sf1, sf2, sf3; float st_b;
    f32x4 tq[16];
};
__device__ __forceinline__ int swa_jlo(int P0, int W) { const int lowk = P0 - W + 1; return lowk > 0 ? lowk / KVBLK : 0; }
#define ROW(p, k0, rr) ((p) + (size_t)(k0) * D + (unsigned)((rr) * D + sc))
#define VMW() asm volatile("s_waitcnt vmcnt(0)" ::: "memory")
#define VMWN(n) asm volatile("s_waitcnt vmcnt(%0)" :: "i"(n) : "memory")
#define SLOAD_H(Kp, Vp, Cp, k0) do { S.st_v0 = load8<TIn>(ROW(Vp, k0, sr)); S.st_v1 = load8<TIn>(ROW(Vp, k0, 32 + sr));              \
                         S.st_k0 = load8<TIn>(ROW(Kp, k0, sr)); S.st_k1 = load8<TIn>(ROW(Kp, k0, 32 + sr)); { int tb_ = tid; asm volatile("" : "+v"(tb_)); S.st_b = ((Cp) + (k0))[(unsigned)(tb_ & 63)]; } } while (0)
#define SWRITE_HK(bf) do { *(bf16x8*)(K_lds + (bf) * SHM_K + kws) = S.st_k0; *(bf16x8*)(K_lds + (bf) * SHM_K + kws + 32 * 256) = S.st_k1; if (tid < 64) *(float*)(K_lds + 2 * SHM_K + NW * 64 * 4 + (bf) * 256 + tid * 4) = S.st_b; } while (0)
#define SWRITE_HV(bf) do { *(bf16x8*)(V_lds + (bf) * SHM_V + vst0) = S.st_v0; *(bf16x8*)(V_lds + (bf) * SHM_V + vst1) = S.st_v1; } while (0)
#define SWRITE_H(bf) do { SWRITE_HV(bf); SWRITE_HK(bf); } while (0)
#define SLOAD_F(p, k0) do { S.sf0 = *(const f32x4*)ROW(p, k0, sr); S.sf1 = *(const f32x4*)(ROW(p, k0, sr) + 4);                \
                            S.sf2 = *(const f32x4*)ROW(p, k0, 32 + sr); S.sf3 = *(const f32x4*)(ROW(p, k0, 32 + sr) + 4); } while (0)
#define SWRITE_KF(bf) do { *(bf16x8*)(K_lds + (bf) * SHM_K + kws) = pack8(S.sf0, S.sf1); *(bf16x8*)(K_lds + (bf) * SHM_K + kws + 32 * 256) = pack8(S.sf2, S.sf3); } while (0)
#define SWRITE_VF(bf) do { *(bf16x8*)(V_lds + (bf) * SHM_V + vst0) = pack8(S.sf0, S.sf1); *(bf16x8*)(V_lds + (bf) * SHM_V + vst1) = pack8(S.sf2, S.sf3); } while (0)
template <class TIn, class TOut>
__device__ __forceinline__ void causal_swa_prime(const BlockRef<TIn, TOut>& cur, int W, char* lds, Seam<TIn>& S) {
    constexpr bool F32 = same_t<TIn, float>::v;
    const int tid = threadIdx.x, wid = __builtin_amdgcn_readfirstlane(tid >> 6), lane = tid & 63, r32 = lane & 31, hi = lane >> 5;
    const int sr = tid >> 4, sc = (tid & 15) * 8, kws = KSWZ(sr, sc * 2); char* K_lds = lds + 2 * SHM_V;
    const int kb0 = swa_jlo(cur.P0, W) * KVBLK;
    for (int d0 = 0; d0 < 8; ++d0) S.qr[d0] = load8<TIn>(cur.Q + (size_t)(wid * QBLK + r32) * D + d0 * 16 + hi * 8);
    if constexpr (F32) { SLOAD_F((const float*)cur.K, kb0); VMW(); SWRITE_KF(0); SBAR(); SLOAD_F((const float*)cur.V, kb0); }
    else { SLOAD_H(cur.K, cur.V, cur.CB, kb0); VMW(); SWRITE_HK(0); }
    { char* const qsw = lds + OST_OFF + wid * OST_WAVE + r32 * ORS * 2 + hi * 16;
#pragma unroll
      for (int d0 = 0; d0 < 8; ++d0) *reinterpret_cast<bf16x8*>(qsw + d0 * 32) = S.qr[d0]; }
    __syncthreads();
}
template <class TIn, class TOut>
__device__ __forceinline__ void causal_swa_block(const BlockRef<TIn, TOut>& cur, const BlockRef<TIn, TOut>& nxt, int skv, int W, char* lds, Seam<TIn>& S) {
    constexpr bool F32 = same_t<TIn, float>::v;
    const int tid = threadIdx.x, wid = __builtin_amdgcn_readfirstlane(tid >> 6), lane = tid & 63, r32 = lane & 31, hi = lane >> 5;
    const int j_lo = swa_jlo(cur.P0, W);
    int j_hi = (cur.P0 + QB - 1) / KVBLK + 1; if (j_hi > skv / KVBLK) j_hi = skv / KVBLK;
    const int NT = j_hi - j_lo;
    const int kbn = swa_jlo(nxt.P0, W) * KVBLK;
    const int qlo = cur.P0 + wid * QBLK, qm = qlo + r32 - 4 * hi;
    char* V_lds = lds; char* K_lds = lds + 2 * SHM_V;
    float* ws = (float*)(lds + 2 * SHM_V + 2 * SHM_K) + wid * 64; float* li_l = ws, * al_l = ws + 32;
    float m_reg = -1e30f, l_reg = 0; f32x16 o[4] = {};
    const int sr = tid >> 4, sc = (tid & 15) * 8, vst0 = v_st(sr, sc), vst1 = v_st(32 + sr, sc), kws = KSWZ(sr, sc * 2);
    const int vb0 = (int)(uintptr_t)V_lds + v_rd_base(lane);
    char* const qs = lds + OST_OFF + wid * OST_WAVE + r32 * ORS * 2 + hi * 16;
    bf16x8 qrh[NQR];
#pragma unroll
    for (int d0 = 0; d0 < NQR; ++d0) qrh[d0] = *reinterpret_cast<const bf16x8*>(qs + d0 * 32);
    const TIn* Kh = cur.K; const TIn* Vh = cur.V; const float* Ch = cur.CB;
#define RESC(a) do { if (__any((a) < 1.f)) { if (hi == 0) al_l[r32] = (a); asm volatile("s_waitcnt lgkmcnt(0)" ::: "memory");              \
                     for (int d_ = 0; d_ < 4; ++d_) for (int r = 0; r < 16; ++r) o[d_][r] *= al_l[crow(r, hi)]; } } while (0)
#define KBASE(t) ((j_lo + (t)) * KVBLK)
#define ACT(t) (KBASE(t) <= qlo + QBLK - 1 && KBASE(t) + KVBLK - 1 >= qlo - W + 1)
#define MASKT(P0_, P1_, t) do { const int kb_ = KBASE(t); if ((!SK || ACT(t)) && (kb_ + KVBLK - 1 > qlo || kb_ <= qlo + QBLK - 1 - W)) mask_tile(P0_, P1_, qm - kb_, (unsigned)W); } while (0)
#define BIASADD(P0_, P1_, KB_) do { const float* bl_ = (const float*)(K_lds + 2 * SHM_K + NW * 64 * 4 + (KB_) * 256) + 4 * hi;                    \
        _Pragma("unroll") for (int g_ = 0; g_ < 4; ++g_) { const f32x4 b0_ = *(const f32x4*)(bl_ + 8 * g_), b1_ = *(const f32x4*)(bl_ + 32 + 8 * g_); \
            _Pragma("unroll") for (int i_ = 0; i_ < 4; ++i_) { P0_[4 * g_ + i_] += b0_[i_]; P1_[4 * g_ + i_] += b1_[i_]; } } } while (0)
    constexpr int NQL = F32 ? 16 : 0;
    constexpr bool SK = WSKIP && !F32;
#define SEAM_K0() do { VMWN(NQL); if constexpr (F32) { SWRITE_KF(0); SBAR(); SLOAD_F((const float*)nxt.V, kbn); } else { SWRITE_HK(0); } SBAR(); } while (0)
    f32x16 pA0, pA1, pB0, pB1; float mnA, mnB, alA, alB; bf16x8 pa0, pa1, pa2, pa3;
    if constexpr (F32) { VMW(); SWRITE_VF(0); SBAR(); } else { SWRITE_HV(0); SBAR(); }
    if (NT > 1) { if constexpr (F32) SLOAD_F((const float*)Kh, KBASE(1)); else SLOAD_H(Kh, Vh, Ch, KBASE(1)); }
    SBAR(); qkt<0, SK>(pA0, pA1, K_lds, r32, hi, qs, qrh, ACT(0));
    if constexpr (F32) { if (NT > 1) { VMW(); SWRITE_KF(1); SBAR(); SLOAD_F((const float*)Vh, KBASE(1)); } }
    MASKT(pA0, pA1, 0); partialSM(pA0, pA1, m_reg, mnA, alA);
    if (NT > 1) { VMW(); if constexpr (F32) { SWRITE_VF(1); SBAR(); if (NT > 2) SLOAD_F((const float*)Kh, KBASE(2)); } else SWRITE_H(1); }
    __syncthreads();
#define HALF_STEP(PX0, PX1, mnX, alX, PY0, PY1, alY, t, KB, VB, SB) do {                                                      \
        SBAR(); qkt<KB, SK>(PX0, PX1, K_lds, r32, hi, qs, qrh, ACT(t));                                             \
        finishSM(PY0, PY1, alY, l_reg, pa0, pa1, pa2, pa3); SBAR();                                                           \
        if ((t) + 1 < NT) { if constexpr (F32) { VMW(); SWRITE_KF(SB); SBAR(); SLOAD_F((const float*)Vh, KBASE((t) + 1)); }  \
                            else { SLOAD_H(Kh, Vh, Ch, KBASE((t) + 1)); } SBAR(); }                                               \
        pv_tile<VB, SK>(o, vb0, pa0, pa1, pa2, pa3, ACT((t) - 1)); MASKT(PX0, PX1, (t)); partialSM(PX0, PX1, m_reg, mnX, alX);                                        \
        __syncthreads();                                                                                                      \
        if ((t) + 1 < NT) { VMW(); if constexpr (F32) { SWRITE_VF(SB); SBAR(); if ((t) + 2 < NT) SLOAD_F((const float*)Kh, KBASE((t) + 2)); } \
                            else { SWRITE_H(SB); } }                                                                          \
        RESC(alX); __syncthreads(); } while (0)
    for (int t = 1; t + 1 < NT; t += 2) {
        HALF_STEP(pB0, pB1, mnB, alB, pA0, pA1, alA, t, 1, 0, 0);
        HALF_STEP(pA0, pA1, mnA, alA, pB0, pB1, alB, t + 1, 0, 1, 1);
    }
    const bool even = (NT & 1) == 0;
    if (even) { SBAR(); qkt<1, SK>(pB0, pB1, K_lds, r32, hi, qs, qrh, ACT(NT - 1)); SBAR(); }
#define QROW(e) (nxt.Q + (size_t)(wid * QBLK + r32) * D + ((e) >> 1) * 16 + hi * 8 + ((e) & 1) * 4)
    if constexpr (F32) { SLOAD_F((const float*)nxt.K, kbn); SBAR();
#pragma unroll
        for (int e = 0; e < 8; ++e) S.tq[e] = *(const f32x4*)QROW(e); }
    else { SLOAD_H(nxt.K, nxt.V, nxt.CB, kbn); SBAR(); }
    SBAR();
    finishSM(pA0, pA1, alA, l_reg, pa0, pa1, pa2, pa3); SBAR();
    if constexpr (F32) {
#pragma unroll
        for (int e = 8; e < 16; ++e) S.tq[e] = *(const f32x4*)QROW(e); SBAR(); }
#undef QROW
    pv_tile<0, SK>(o, vb0, pa0, pa1, pa2, pa3, ACT(even ? NT - 2 : NT - 1));
    if (even) { MASKT(pB0, pB1, NT - 1); partialSM(pB0, pB1, m_reg, mnB, alB); __syncthreads(); RESC(alB);
        finishSM(pB0, pB1, alB, l_reg, pa0, pa1, pa2, pa3); SBAR(); pv_tile<1, SK>(o, vb0, pa0, pa1, pa2, pa3, ACT(NT - 1)); }
    SBAR(); SEAM_K0();
    {
    int tz = threadIdx.x; asm volatile("" : "+v"(tz));
    const int lane_e = tz & 63, wid_e = __builtin_amdgcn_readfirstlane(tz >> 6), r32_e = lane_e & 31, hi_e = lane_e >> 5;
    float* li_e = (float*)(lds + 2 * SHM_V + 2 * SHM_K) + wid_e * 64;
    if (hi_e == 0) li_e[r32_e] = l_reg; asm volatile("s_waitcnt lgkmcnt(0)" ::: "memory");
    float rli[16];
#pragma unroll
    for (int r = 0; r < 16; ++r) rli[r] = __builtin_amdgcn_rcpf(li_e[crow(r, hi_e)]);
    char* ost = lds + OST_OFF + wid_e * OST_WAVE;
    {   char* ob = ost + (4 * hi_e * ORS + r32_e) * 2;
#pragma unroll
        for (int r = 0; r < 16; ++r) {
#pragma unroll
            for (int d0 = 0; d0 < 4; ++d0) { const float v = o[d0][r] * rli[r]; const float vn = __shfl_xor(v, 1);
                if ((r32_e & 1) == 0) *(unsigned*)(ob + (((r & 3) + 8 * (r >> 2)) * ORS + d0 * 32) * 2) = cvtpk(v, vn); } } }
    asm volatile("s_waitcnt lgkmcnt(0)" ::: "memory");
    if constexpr (!F32) {
        const TIn* qn = nxt.Q + (size_t)(wid_e * QBLK + r32_e) * D + hi_e * 8;
#pragma unroll
        for (int d0 = 0; d0 < 8; ++d0) S.qr[d0] = load8<TIn>(qn + d0 * 16); }
    {   const int orow = lane_e >> 4, och = lane_e & 15;
        const TOut* Ow_c = cur.O + (size_t)(wid_e * QBLK + orow) * OSTR + och * 8; TOut* Ow = const_cast<TOut*>(Ow_c);
        const TIn* Gw = cur.G + (size_t)(wid_e * QBLK + orow) * GSTR + och * 8;
#pragma unroll
        for (int i = 0; i < 8; ++i) {
            const u32x4 ov = *(const u32x4*)(ost + (4 * i + orow) * ORS * 2 + och * 16);
            const u32x4 gv = *(const u32x4*)(Gw + (size_t)(4 * i) * GSTR);
            u32x4 w;
#pragma unroll
            for (int k = 0; k < 4; ++k) w[k] = cvtpk(__uint_as_float(ov[k] << 16) * __uint_as_float(gv[k] << 16), __uint_as_float(ov[k] & 0xffff0000u) * __uint_as_float(gv[k] & 0xffff0000u));
            *(u32x4*)(Ow + (size_t)(4 * i) * OSTR) = w; } }
    if constexpr (!F32) {
        char* qsw = ost + r32_e * ORS * 2 + hi_e * 16;
#pragma unroll
        for (int d0 = 0; d0 < 8; ++d0) *reinterpret_cast<bf16x8*>(qsw + d0 * 32) = S.qr[d0]; }
    }
    if constexpr (F32) {
#pragma unroll
        for (int d0 = 0; d0 < 8; ++d0) S.qr[d0] = pack8(S.tq[2 * d0], S.tq[2 * d0 + 1]); }
    __syncthreads();
#undef RESC
#undef KBASE
#undef ACT
#undef MASKT
#undef SEAM_K0
#undef BIASADD
#undef HALF_STEP
}
#undef ROW
#undef VMW
#undef VMWN
#undef SLOAD_H
#undef SWRITE_HK
#undef SWRITE_HV
#undef SWRITE_H
#undef SLOAD_F
#undef SWRITE_KF
#undef SWRITE_VF


}

namespace dec {
constexpr int D = 128, PG16 = 16, WAVES = 4, GE = 4, GEP = 4, HPL = 1, NSPLIT = 4, TOK_STRIDE = 512;
constexpr int PPW = (PAST / PG16) / NSPLIT / WAVES;
constexpr int LDS_P = 0, LDS_MRG = WAVES * 64 * HPL, MRG_REC = 4 + D, LDS_FLOATS = LDS_MRG + WAVES * GEP * MRG_REC + 4;
using bf16x2 = __attribute__((ext_vector_type(2))) __bf16;
using u32x4  = __attribute__((ext_vector_type(4))) unsigned;
using f32x4  = __attribute__((ext_vector_type(4))) float;
using f32x8  = __attribute__((ext_vector_type(8))) float;
__device__ __forceinline__ float dot2(unsigned k, unsigned q, float acc) { return __builtin_amdgcn_fdot2_f32_bf16(__builtin_bit_cast(bf16x2, k), __builtin_bit_cast(bf16x2, q), acc, false); }
__device__ __forceinline__ unsigned cvtpk(float lo, float hi) { unsigned r; asm volatile("v_cvt_pk_bf16_f32 %0, %1, %2" : "=v"(r) : "v"(lo), "v"(hi)); return r; }
template <int CTRL> __device__ __forceinline__ float dpp(float x) { return __builtin_bit_cast(float, __builtin_amdgcn_mov_dpp(__builtin_bit_cast(int, x), CTRL, 0xf, 0xf, true)); }
constexpr int XOR1 = 0xB1, XOR2 = 0x4E, XOR7 = 0x141, XOR8 = 0x128, ROR4 = 0x124;
__device__ __forceinline__ float xrow16_max(float x) {
  auto s = __builtin_amdgcn_permlane16_swap(__float_as_uint(x), __float_as_uint(x), false, false);
  x = fmaxf(__uint_as_float(s[0]), __uint_as_float(s[1]));
  auto t = __builtin_amdgcn_permlane32_swap(__float_as_uint(x), __float_as_uint(x), false, false);
  return fmaxf(__uint_as_float(t[0]), __uint_as_float(t[1]));
}
__device__ __forceinline__ float xrow16_sum(float x) {
  auto s = __builtin_amdgcn_permlane16_swap(__float_as_uint(x), __float_as_uint(x), false, false);
  x = __uint_as_float(s[0]) + __uint_as_float(s[1]);
  auto t = __builtin_amdgcn_permlane32_swap(__float_as_uint(x), __float_as_uint(x), false, false);
  return __uint_as_float(t[0]) + __uint_as_float(t[1]);
}
__device__ __forceinline__ f32x8 ld8(const float* p) { const f32x4 lo = __builtin_nontemporal_load(reinterpret_cast<const f32x4*>(p)), hi = __builtin_nontemporal_load(reinterpret_cast<const f32x4*>(p + 64));
  return f32x8{lo[0], lo[1], lo[2], lo[3], hi[0], hi[1], hi[2], hi[3]}; }
__device__ __forceinline__ u32x4 tobf(f32x8 x) { u32x4 w = {cvtpk(x[0], x[1]), cvtpk(x[2], x[3]), cvtpk(x[4], x[5]), cvtpk(x[6], x[7])}; return w; }

struct DecArgs { const float* q; const float* k; const float* v; const int* pt; const float* sufx; float* pml; float* po; };

__device__ __forceinline__ void decode_unit(const DecArgs& a, int b, int kvh, int s, float* lds, int wave, int lane) {
  const int r = lane >> 4, c = lane & 15;
  constexpr float C2 = ATT_SCALE * 1.4426950408889634f;
  const int sp0 = s * (PAST / PG16 / NSPLIT);
  int btv = 0;
  if (lane < PPW) { const int sp = sp0 + wave + 4 * lane; btv = a.pt[b * NPAGES + (sp >> 3)] * 8 + (sp & 7); }
  u32x4 qpk[GEP];
#pragma unroll
  for (int g = 0; g < GEP; ++g) { const float* qp = a.q + ((size_t)(b * 4 + g) * 512 + kvh * D + 4 * c); const f32x4 lo = *reinterpret_cast<const f32x4*>(qp), hi = *reinterpret_cast<const f32x4*>(qp + 64);
    qpk[g] = tobf(f32x8{lo[0], lo[1], lo[2], lo[3], hi[0], hi[1], hi[2], hi[3]}); }
  const unsigned loff = (unsigned)(r * TOK_STRIDE + 4 * c);
  const float* sufx = a.sufx + (size_t)(b * 4 + kvh) * PAST; const unsigned soff = (unsigned)(r + 4 * (c >> 2));
#define PAGE_BASE(spid) ((size_t)(spid) * (PG16 * TOK_STRIDE) + (size_t)kvh * D)
#define ISSUE_K(KBUF, BV, i_) do { const int ii_ = (i_) < PPW ? (i_) : PPW - 1; const int phys_ = __builtin_amdgcn_readlane(btv, ii_); const float* kb_ = a.k + PAGE_BASE(phys_); \
    _Pragma("unroll") for (int t_ = 0; t_ < 4; ++t_) KBUF[t_] = ld8(kb_ + (loff + (unsigned)(t_ * 4 * TOK_STRIDE))); BV = sufx[(unsigned)((sp0 + wave + 4 * ii_) * PG16) + soff]; } while (0)
#define ISSUE_V(i_) do { const int ii_ = (i_) < PPW ? (i_) : PPW - 1; const int phys_ = __builtin_amdgcn_readlane(btv, ii_); const float* vb_ = a.v + PAGE_BASE(phys_); \
    _Pragma("unroll") for (int t_ = 0; t_ < 4; ++t_) Vn[t_] = ld8(vb_ + (loff + (unsigned)(t_ * 4 * TOK_STRIDE))); } while (0)
  f32x8 KA[4], KB[4], Vn[4]; float bA, bB;
  float m[HPL], l[HPL], acc[GEP * 8];
#pragma unroll
  for (int j = 0; j < HPL; ++j) { m[j] = -INFINITY; l[j] = 0.f; }
#pragma unroll
  for (int k = 0; k < GEP * 8; ++k) acc[k] = 0.f;
  ISSUE_K(KA, bA, 0); ISSUE_V(0); ISSUE_K(KB, bB, 1);
#define TR_STEP(HALF, CTRL, BIT) _Pragma("unroll") for (int h = 0; h < (HALF); ++h) _Pragma("unroll") for (int j = 0; j < HPL; ++j) { \
      const float lo_ = x[h * HPL + j], hi_ = x[(h + (HALF)) * HPL + j]; const float t1_ = lo_ + dpp<CTRL>(lo_), t2_ = hi_ + dpp<CTRL>(hi_); \
      x[h * HPL + j] = (c & (BIT)) ? t2_ : t1_; }
#define DEC_STEP(KBUF, BV, i_) do {                                                                                              \
    u32x4 Kc[4], Vc[4];                                                                                                          \
    _Pragma("unroll") for (int t = 0; t < 4; ++t) { Kc[t] = tobf(KBUF[t]); Vc[t] = tobf(Vn[t]); }                                \
    const float bias = BV;                                                                                                       \
    ISSUE_V((i_) + 1); ISSUE_K(KBUF, BV, (i_) + 2);                                                                              \
    float x[4 * GEP];                                                                                                            \
    _Pragma("unroll") for (int t = 0; t < 4; ++t) _Pragma("unroll") for (int g = 0; g < GEP; ++g) { float d = 0.f;              \
        _Pragma("unroll") for (int k = 0; k < 4; ++k) d = dot2(Kc[t][k], qpk[g][k], d);                                          \
        x[t * GEP + g] = d; }                                                                                                    \
    TR_STEP(8, XOR8, 8) TR_STEP(4, XOR7, 4) TR_STEP(2, XOR2, 2) TR_STEP(1, XOR1, 1)                                              \
    float p[HPL], alpha[HPL];                                                                                                    \
    _Pragma("unroll") for (int j = 0; j < HPL; ++j) {                                                                            \
      const float sc = x[j] * C2 + bias;                                                                                         \
      float pm = sc; pm = fmaxf(pm, dpp<ROR4>(pm)); pm = fmaxf(pm, dpp<XOR8>(pm)); pm = xrow16_max(pm);                          \
      const float mn = fmaxf(m[j], pm), msub = (mn == -INFINITY) ? 0.f : mn;                                                     \
      alpha[j] = __builtin_amdgcn_exp2f(m[j] - msub); p[j] = __builtin_amdgcn_exp2f(sc - msub);                                  \
      l[j] = fmaf(l[j], alpha[j], p[j]); m[j] = mn; }                                                                            \
    _Pragma("unroll") for (int q4 = 0; q4 < 4; ++q4) _Pragma("unroll") for (int j = 0; j < HPL; ++j) {                           \
        const float al = q4 == 0 ? dpp<0x00>(alpha[j]) : q4 == 1 ? dpp<0x55>(alpha[j]) : q4 == 2 ? dpp<0xAA>(alpha[j]) : dpp<0xFF>(alpha[j]); \
        _Pragma("unroll") for (int k = 0; k < 8; ++k) acc[(q4 * HPL + j) * 8 + k] *= al; }                                       \
    float* prow = lds + LDS_P + (wave * 4 + r) * 16 * HPL;                                                                       \
    _Pragma("unroll") for (int j = 0; j < HPL; ++j) prow[c * HPL + j] = p[j];                                                    \
    asm volatile("s_waitcnt lgkmcnt(0)" ::: "memory");                                                                           \
    f32x4 pr[GEP];                                                                                                               \
    _Pragma("unroll") for (int u = 0; u < GEP; ++u) pr[u] = *reinterpret_cast<const f32x4*>(prow + 4 * u);                       \
    _Pragma("unroll") for (int t = 0; t < 4; ++t) { float vf[8];                                                                 \
      _Pragma("unroll") for (int k = 0; k < 4; ++k) { vf[2 * k] = __builtin_bit_cast(float, Vc[t][k] << 16); vf[2 * k + 1] = __builtin_bit_cast(float, Vc[t][k] & 0xffff0000u); } \
      _Pragma("unroll") for (int g = 0; g < GE; ++g) { const float pg_ = pr[(t * GEP + g) >> 2][(t * GEP + g) & 3];              \
        _Pragma("unroll") for (int k = 0; k < 8; ++k) acc[g * 8 + k] = fmaf(pg_, vf[k], acc[g * 8 + k]); } } } while (0)
#pragma unroll 1
  for (int i = 0; i < PPW; i += 2) { DEC_STEP(KA, bA, i); DEC_STEP(KB, bB, i + 1); }
#undef DEC_STEP
#undef TR_STEP
#undef ISSUE_K
#undef ISSUE_V
#undef PAGE_BASE
#pragma unroll
  for (int k = 0; k < GE * 8; ++k) acc[k] = xrow16_sum(acc[k]);
#pragma unroll
  for (int j = 0; j < HPL; ++j) { float t = l[j]; t += dpp<ROR4>(t); t += dpp<XOR8>(t); l[j] = xrow16_sum(t); }
  float* mrg = lds + LDS_MRG;
  if (r == 0) {
#pragma unroll
    for (int g = 0; g < GE; ++g) {
      float* rec = mrg + (wave * GEP + g) * MRG_REC;
#pragma unroll
      for (int k = 0; k < 8; k += 4) *reinterpret_cast<f32x4*>(rec + 4 + 4 * c + 16 * k) = f32x4{acc[g * 8 + k], acc[g * 8 + k + 1], acc[g * 8 + k + 2], acc[g * 8 + k + 3]};
      if (c == g / HPL) { rec[0] = m[g % HPL]; rec[1] = l[g % HPL]; } } }
  __syncthreads();
  {
    const int g = wave, d0 = 2 * lane;
    const size_t row = (size_t)(b * 4 + kvh) * 4 + g;
    float M = -INFINITY;
#pragma unroll
    for (int w = 0; w < WAVES; ++w) M = fmaxf(M, mrg[(w * GEP + g) * MRG_REC]);
    float L = 0.f, o0 = 0.f, o1 = 0.f;
#pragma unroll
    for (int w = 0; w < WAVES; ++w) { const float* rec = mrg + (w * GEP + g) * MRG_REC; const float lw = rec[1];
      const float wt = (lw > 0.f) ? __builtin_amdgcn_exp2f(rec[0] - M) : 0.f;
      L = fmaf(wt, lw, L); o0 = fmaf(wt, rec[4 + d0], o0); o1 = fmaf(wt, rec[4 + d0 + 1], o1); }
    const size_t slot = row * NSPLIT + s;
    *reinterpret_cast<float2*>(a.po + slot * D + d0) = make_float2(o0, o1);
    if (lane == 0) *reinterpret_cast<float2*>(a.pml + 2 * slot) = make_float2(M, L);
  }
  __syncthreads();
}

struct CombArgs { const float* pml; const float* po; const float* q; const float* knew; const float* vnew; const float* lfb; const unsigned short* gate; unsigned short* mix; };
__device__ __forceinline__ void combine_row(const CombArgs& a, int b, int h, int t, int lane) {
  constexpr float C2 = ATT_SCALE * 1.4426950408889634f;
  const size_t row = (size_t)(b * 4 + h) * 4 + t; const int d0 = 2 * lane;
  const float* pml = a.pml + row * NSPLIT * 2; const float* po = a.po + row * NSPLIT * D;
  const float2 qv = *reinterpret_cast<const float2*>(a.q + (size_t)(b * 4 + t) * 512 + h * D + d0);
  float scn[4]; float cum = 0.f;
#pragma unroll
  for (int s = 0; s < 4; ++s) {
    const float2 kv = *reinterpret_cast<const float2*>(a.knew + (size_t)(b * 4 + s) * 512 + h * D + d0);
    float d = qv.x * kv.x + qv.y * kv.y;
#pragma unroll
    for (int o = 1; o < 64; o <<= 1) d += __shfl_xor(d, o);
    cum += a.lfb[(size_t)(MP + b * 4 + s) * 4 + h];
    scn[s] = (s <= t) ? d * C2 - cum * LOG2E : -INFINITY;
  }
  float M = -INFINITY;
#pragma unroll
  for (int s = 0; s < NSPLIT; ++s) M = fmaxf(M, pml[2 * s]);
#pragma unroll
  for (int s = 0; s < 4; ++s) M = fmaxf(M, scn[s]);
  float L = 0.f, o0 = 0.f, o1 = 0.f;
#pragma unroll
  for (int s = 0; s < NSPLIT; ++s) { const float ls = pml[2 * s + 1], w = (ls > 0.f) ? __builtin_amdgcn_exp2f(pml[2 * s] - M) : 0.f;
    const float2 av = *reinterpret_cast<const float2*>(po + (size_t)s * D + d0);
    L = fmaf(w, ls, L); o0 = fmaf(w, av.x, o0); o1 = fmaf(w, av.y, o1); }
#pragma unroll
  for (int s = 0; s < 4; ++s) { const float w = __builtin_amdgcn_exp2f(scn[s] - M);
    const float2 vv = *reinterpret_cast<const float2*>(a.vnew + (size_t)(b * 4 + s) * 512 + h * D + d0);
    L += w; o0 = fmaf(w, vv.x, o0); o1 = fmaf(w, vv.y, o1); }
  const float inv = 1.f / L;
  const size_t ms = (size_t)(MP + b * 4 + t);
  const unsigned gp = *reinterpret_cast<const unsigned*>(a.gate + ms * 512 + h * D + d0);
  const float g0 = __uint_as_float(gp << 16), g1 = __uint_as_float(gp & 0xffff0000u);
  *reinterpret_cast<unsigned*>(a.mix + ms * 1024 + 512 + h * D + d0) = cvtpk(o0 * inv * g0, o1 * inv * g1);
}
}

__device__ __forceinline__ void p6_rpass(Frame& F, int part) {
    const int gw = (int)blockIdx.x * NWAVES + F.wave, NGW = F.G * NWAVES, fr = F.lane & 15, fq = F.lane >> 4;
    const bf16* X1B = WSP(bf16, WS_XN); const bf16* WRB = WSP(bf16, WS_WR); const bf16* WGB = WSP(bf16, WS_WR + 65536);
    bf16* GF3 = WSP(bf16, WS_GF3); const float* SS1 = (const float*)(F.ctl + CW_SS1);
    LAS unsigned char* rt = F.lds + RING_OFF + F.wave * 512;
    constexpr int NU = MT / 8;
    for (int it = (NGW == 2048 && part == 1) ? 1 : 0; ; ++it) {
        int u;
        if (NGW == 2048) { if (it == 0) u = gw; else if (it == 1 && part != 0 && F.wave == 0 && blockIdx.x >= 192 && (int)blockIdx.x < 192 + (NU - 2048)) u = 2048 + (int)blockIdx.x - 192; else break; }
        else { if (part == 1) break; u = gw + it * NGW; if (u >= NU) break; }
        const int g = u >> 1, hh = u & 1, row0 = 16 * g;
        const GAS bf16x8* wp = (const GAS bf16x8*)(WRB + (size_t)fr * DM + 8 * fq);
        const GAS bf16x8* ap = (const GAS bf16x8*)(X1B + (size_t)(row0 + fr) * DM + 8 * fq);
        pg8::f32x4 acc = {0.f, 0.f, 0.f, 0.f};
#pragma unroll 1
        for (int k0 = 0; k0 < 32; k0 += 16) {
            bf16x8 wv[16], av[16];
#pragma unroll
            for (int i = 0; i < 16; ++i) { wv[i] = wp[(k0 + i) * 4]; av[i] = ap[(k0 + i) * 4]; }
#pragma unroll
            for (int i = 0; i < 16; ++i) acc = __builtin_amdgcn_mfma_f32_16x16x32_bf16(wv[i], av[i], acc, 0, 0, 0);
        }
        const float rstd = 1.0f / sqrtf(SS1[row0 + fr] * (1.f / DM) + EPS);
        acc = acc * rstd;
        { u32x2v w; w.x = cvtpk_s(acc[0], acc[1]); w.y = cvtpk_s(acc[2], acc[3]); *(LAS u32x2v*)(rt + (fr * 16 + 4 * fq) * 2) = w; }
        LDS_WAIT(); asm volatile("" ::: "memory");
        bf16x8 rb = {0, 0, 0, 0, 0, 0, 0, 0};
        if (fq < 2) rb = *(const LAS bf16x8*)(rt + (fr * 16 + 8 * fq) * 2);
        LDS_WAIT(); asm volatile("" ::: "memory");
#pragma unroll 4
        for (int ct = 16 * hh; ct < 16 * hh + 16; ++ct) {
            bf16x8 wa = {0, 0, 0, 0, 0, 0, 0, 0};
            if (fq < 2) wa = *(const GAS bf16x8*)(WGB + (size_t)(16 * ct + fr) * 16 + 8 * fq);
            const pg8::f32x4 z = {0.f, 0.f, 0.f, 0.f};
            const pg8::f32x4 d = __builtin_amdgcn_mfma_f32_16x16x32_bf16(wa, rb, z, 0, 0, 0);
            const f32x4 bg = *(const GAS f32x4*)(F.b_gla_gate + 16 * ct + 4 * fq);
            f32x4 lf; lf.x = log_sigmoidf_(d[0] + bg.x) * 0.0625f; lf.y = log_sigmoidf_(d[1] + bg.y) * 0.0625f; lf.z = log_sigmoidf_(d[2] + bg.z) * 0.0625f; lf.w = log_sigmoidf_(d[3] + bg.w) * 0.0625f;
            st_bf4(GF3 + (size_t)(row0 + fr) * 512 + 16 * ct + 4 * fq, lf);
        }
    }
    __syncthreads();
}
__device__ __forceinline__ void p11_final(Frame& F) {
    const int gw = (int)blockIdx.x * NWAVES + F.wave, NGW = F.G * NWAVES;
    const float* SS2 = (const float*)(F.ctl + CW_SS2);
    for (int m = gw; m < MT; m += NGW) {
        GAS f32x4* yr = (GAS f32x4*)(F.out + O_Y + (size_t)m * DM) + F.lane;
        const float rstd = 1.0f / sqrtf(SS2[m] * (1.f / DM) + EPS);
#pragma unroll
        for (int j = 0; j < 4; ++j) { const f32x4 g = *(const GAS f32x4*)(F.final_norm + 4 * F.lane + 256 * j); yr[64 * j] = yr[64 * j] * rstd * g; }
    }
}

struct SE1 { P1 p; __device__ __forceinline__ void operator()(int m, int c, f32x4 v) const { epi1_4(p, m, c, v); } };
struct SE2 { P2 p; __device__ __forceinline__ void operator()(int m, int c, f32x4 v) const { float ss = epi2_4(p, m, c, v); ss += __shfl_xor(ss, 16); ss += __shfl_xor(ss, 32); if (((c >> 2) & 3) == 0) atomicAdd(p.SS + m, ss); } };
struct SE3 { P3 p; __device__ __forceinline__ void operator()(int m, int c, f32x4 v) const { const float rstd = 1.0f / sqrtf(p.SS[m] * (1.f / DM) + EPS); epi3_4(p, m, c, v, rstd); } };
struct SE4 { P4 p; __device__ __forceinline__ void operator()(int m, int c, f32x4 v) const { float ss = epi4_4(p, m, c, v); ss += __shfl_xor(ss, 16); ss += __shfl_xor(ss, 32); if (((c >> 2) & 3) == 0) atomicAdd(p.SS + m, ss); } };
typedef fox::BlockRef<fox::TIN, fox::TOUT> FoxRef;
__device__ __forceinline__ FoxRef fox_ref(unsigned char* ws, int bh, int qb) {
    const fox::TIN* Q = (const fox::TIN*)(ws + WS_QBH); const fox::TIN* K = (const fox::TIN*)(ws + WS_KBH); const fox::TIN* V = (const fox::TIN*)(ws + WS_VBH);
    const int b = bh >> 2, h = bh & 3; FoxRef r;
    r.Q = Q + ((size_t)bh * SEQ + (size_t)qb * 256) * 128; r.K = K + (size_t)bh * SEQ * 128; r.V = V + (size_t)bh * SEQ * 128;
    r.O = (fox::TOUT*)(ws + WS_MIX) + ((size_t)(b * SEQ + qb * 256)) * 1024 + 512 + h * 128; r.G = (const fox::TIN*)(ws + WS_GB) + ((size_t)(b * SEQ + qb * 256)) * 512 + h * 128;
    r.CB = (const float*)(ws + WS_CB) + (size_t)bh * SEQ; r.P0 = qb * 256; return r;
}


__device__ __forceinline__ void sub_barrier(unsigned* cnt, unsigned n, unsigned& gen) {
    asm volatile("s_waitcnt vmcnt(0)" ::: "memory");
    __syncthreads();
    if (threadIdx.x == 0) {
        __builtin_amdgcn_fence(__ATOMIC_RELEASE, "agent");
        asm volatile("s_waitcnt vmcnt(0)" ::: "memory");
        (void)__hip_atomic_fetch_add(cnt, 1u, __ATOMIC_RELAXED, __HIP_MEMORY_SCOPE_AGENT);
        const unsigned target = (gen + 1u) * n; unsigned sp = 0;
        while (__hip_atomic_load(cnt, __ATOMIC_RELAXED, __HIP_MEMORY_SCOPE_AGENT) < target) { __builtin_amdgcn_s_sleep(1); if (++sp > (1u << 22)) break; }
        __builtin_amdgcn_fence(__ATOMIC_ACQUIRE, "agent");
        asm volatile("s_waitcnt vmcnt(0)" ::: "memory");
    }
    __syncthreads();
    ++gen;
}

#ifndef MK_N_LAUNCHES
#define MK_N_LAUNCHES 1
#endif
constexpr int N_LAUNCHES = MK_N_LAUNCHES;
constexpr int N_PHASES = 12;
struct Args { const void* in[21]; float* out; unsigned char* ws; int ph_lo, ph_hi, sub, pad; };
__global__ void __launch_bounds__(NWAVES * 64, 2) hybrid_fwd(Args args) {
    extern __shared__ __attribute__((aligned(16))) unsigned char lds[];
    Frame F;
    F.lds = (LAS unsigned char*)lds;
    F.MISC = (volatile LAS unsigned*)(F.lds + MISC_OFF);
    F.tid = threadIdx.x; F.lane = F.tid & 63; F.wave = __builtin_amdgcn_readfirstlane(F.tid >> 6);
    F.G = gridDim.x;
    F.ws = args.ws; F.out = args.out; F.ctl = (gu32*)(args.ws + WS_CTL);
    F.xp = (const float*)args.in[0]; F.xs = (const float*)args.in[1]; F.ck = (const float*)args.in[2]; F.cv = (const float*)args.in[3]; F.clf = (const float*)args.in[4];
    F.sh = (const float*)args.in[5]; F.sg = (const float*)args.in[6]; F.pt = (const int*)args.in[7];
    F.norm_even = (const float*)args.in[8]; F.w_in_even = (const float*)args.in[9]; F.b_fox = (const float*)args.in[10]; F.lb_logits = (const float*)args.in[11];
    F.hgrn_gain = (const float*)args.in[12]; F.w_out_even = (const float*)args.in[13]; F.norm_odd = (const float*)args.in[14]; F.w_in_odd = (const float*)args.in[15];
    F.w_gla_gate = (const float*)args.in[16]; F.b_gla_gate = (const float*)args.in[17]; F.gla_gain = (const float*)args.in[18]; F.w_out_odd = (const float*)args.in[19]; F.final_norm = (const float*)args.in[20];
    for (int u = F.tid; u < (LDS_BYTES - LDSCTL_OFF) / 4; u += NWAVES * 64) ((LAS unsigned*)(F.lds + LDSCTL_OFF))[u] = 0u;
    __syncthreads();
    XcdBarrier bar; bar.bar = (unsigned*)(F.ctl + CW_BAR); bar.x = 0; bar.st = nullptr; bar.total = 0u;
    if (N_LAUNCHES == 1) bar = xcd_barrier_post((unsigned*)(F.ctl + CW_BAR), F.MISC + 8);
    XcdBarrier bar2; bar2.bar = (unsigned*)(F.ctl + CW_BAR2); bar2.x = 0; bar2.st = nullptr; bar2.total = 0u;
    if ((int)blockIdx.x >= (int)gridDim.x / 2) { bar2 = xcd_barrier_post((unsigned*)(F.ctl + CW_BAR2), F.MISC + 12); bar2.total = gridDim.x - gridDim.x / 2; }
#define GRID_BAR() do { if (N_LAUNCHES == 1) xcd_barrier(bar); } while (0)
    const int lo = args.ph_lo, hi = args.ph_hi;
#ifndef REP_MASK
#define REP_MASK 0
#endif
#if REP_MASK
#define REPS(k) for (int rep_ = 0; rep_ <= (((REP_MASK) >> (k)) & 1); ++rep_)
#else
#define REPS(k)
#endif
#ifndef SUB_MASK
#define SUB_MASK 7
#endif
#ifndef PH_MASK
#define PH_MASK 0xFFF
#endif
#define IN(k) ((((PH_MASK) >> (k)) & 1) && lo <= (k) && (k) < hi)
#define BOTH(k) (IN(k) && IN((k) + 1))
    const int bid = blockIdx.x;

    REPS(0) if (IN(0)) { p0_prologue(F, args.sub); if (BOTH(0)) GRID_BAR(); }

    REPS(1) if (IN(1)) {
        const bool late1 = (xb_xcc_id() & 4u) != 0u;
        if (bid < NB && !(args.sub & 32)) fox_cumsum_unit(F, bid);
        P1 p{WSP(bf16, WS_QA), WSP(bf16, WS_IA), WSP(bf16, WS_GA), WSP(bf16, WS_GB), WSP(bf16, WS_QBH), WSP(bf16, WS_KBH), WSP(bf16, WS_VBH), WSP(bf16, WS_GF), WSP(float, WS_QS), WSP(float, WS_LB), F.out};
        { pg8::Gemm g{WSP(bf16, WS_XN), WSP(bf16, WS_W1T), MP, 4096, DM}; pg8::StaticOrder S; S.init(MP, 4096, F.G, bid);
          Epi1 E{p, (args.sub >> 4) & 1 ? 1 : ((args.sub >> 7) & 1 ? 2 : 0)};
          if (!late1 && !(args.sub & 32)) for (int u = bid; u < 256; u += F.G)
              sgemm_unit(WSP(bf16, WS_XN), WSP(bf16, WS_W1T), u, F.wave, F.lane, SE1{p});
          pg8::gemm_phase<Epi1, pg8::StaticOrder, true, true>(F.lds + RING_OFF, g, S, E); }
        if (late1 && !(args.sub & 32)) for (int u = bid; u < 256; u += F.G)
            sgemm_unit(WSP(bf16, WS_XN), WSP(bf16, WS_W1T), u, F.wave, F.lane, SE1{p});
        if (BOTH(1)) GRID_BAR();
    }

    REPS(2) if (IN(2)) {
        const int half = F.G / 2;
        if (args.sub & 8) {
            dec::DecArgs da{WSP(float, WS_QS), F.ck, F.cv, F.pt, WSP(float, WS_SUFX), WSP(float, WS_PML), WSP(float, WS_PO)};
            float* dl = (float*)(lds + RING_OFF) + (F.wave >> 2) * dec::LDS_FLOATS;
            for (int wu = bid; wu < 256; wu += F.G) { const int du = 2 * wu + (F.wave >> 2); dec::decode_unit(da, du >> 4, (du >> 2) & 3, du & 3, dl, F.wave & 3, F.lane); }
        } else if (bid < half) {
            if ((SUB_MASK & 1) && (args.sub & 1)) for (int L = bid; L < 128; L += half) {
                const int bh = L & 7, x = L >> 3;
                const FoxRef b0 = fox_ref(F.ws, bh, 31 - x), b1 = fox_ref(F.ws, bh, x);
                fox::Seam<fox::TIN> S;
                fox::causal_swa_prime<fox::TIN, fox::TOUT>(b0, fox::WINDOW, (char*)lds + RING_OFF, S);
                FoxRef cur = b0; int pass = 0;
                for (;;) { const bool last = pass == 1; const FoxRef nxt = last ? cur : b1;
                    fox::causal_swa_block<fox::TIN, fox::TOUT>(cur, nxt, fox::SKV, fox::WINDOW, (char*)lds + RING_OFF, S);
                    if (last) break; cur = nxt; pass = 1; }
            }
        } else {
            const int cb = bid - half, nb = F.G - half;
            if ((SUB_MASK & 2) && (args.sub & 2)) { dec::DecArgs da{WSP(float, WS_QS), F.ck, F.cv, F.pt, WSP(float, WS_SUFX), WSP(float, WS_PML), WSP(float, WS_PO)};
              float* dl = (float*)(lds + RING_OFF) + (F.wave >> 2) * dec::LDS_FLOATS;
              for (int wu = cb; wu < 256; wu += nb) { const int du = 2 * wu + (F.wave >> 2); dec::decode_unit(da, du >> 4, du & 3, (du >> 2) & 3, dl, F.wave & 3, F.lane); } }
            __syncthreads();
            LaArgs a{}; a.Q = WSP(bf16, WS_QA); a.Kp = nullptr; a.G = WSP(bf16, WS_GF); a.V = WSP(bf16, WS_IA); a.GATE = WSP(bf16, WS_GA); a.ldv = 512; a.gain = F.hgrn_gain; a.MIXo = WSP(bf16, WS_MIX); a.mixoff = 0;
            if ((SUB_MASK & 4) && (args.sub & 4)) {
              for (int u = cb; u < 256; u += nb) { const int bh = u >> 5, sc = u & 31; a.SBUF = WSP(bf16, WS_SLOC) + (size_t)u * 16384; a.BTOT = WSP(float, WS_BTOT) + (size_t)u * 128;
                  la_unit<128, false, 0>(F.lds + RING_OFF, a, (bh >> 2) * SEQ + sc * 256, bh & 3, F.tid, F.wave, F.lane); }
            }
            if (args.sub == 7) {
              xcd_barrier(bar2);
              if (cb == 0 && F.tid == 0) __hip_atomic_store((unsigned*)(F.ctl + CW_FLAG), 1u, __ATOMIC_RELAXED, __HIP_MEMORY_SCOPE_AGENT);
              la_scan<128>(WSP(bf16, WS_SLOC), WSP(float, WS_BTOT), F.out + O_HSP, cb * 512 + F.tid, nb * 512);
              xcd_barrier(bar2);
              for (int u = cb; u < 256; u += nb) { const int bh = u >> 5, sc = u & 31; a.SBUF = WSP(bf16, WS_SLOC) + (size_t)u * 16384; a.BTOT = nullptr;
                  la_unit<128, false, 1>(F.lds + RING_OFF, a, (bh >> 2) * SEQ + sc * 256, bh & 3, F.tid, F.wave, F.lane); }
            }
        }
        if (args.sub == 7) {
            constexpr int T_S = 128, T_C = 64, T_W = 160, T_ALL = T_S + T_C + T_W;
            LaArgs a{}; a.Q = WSP(bf16, WS_QA); a.Kp = nullptr; a.G = WSP(bf16, WS_GF); a.V = WSP(bf16, WS_IA); a.GATE = WSP(bf16, WS_GA); a.ldv = 512; a.gain = F.hgrn_gain; a.MIXo = WSP(bf16, WS_MIX); a.mixoff = 0;
            dec::CombArgs ca{WSP(float, WS_PML), WSP(float, WS_PO), WSP(float, WS_QS), F.out + O_KS, F.out + O_VS, WSP(float, WS_LFB), WSP(bf16, WS_GB), WSP(bf16, WS_MIX)};
            bool flagged = bid >= half; unsigned nxt = 0u; int par = 0;
            __syncthreads();
            if (F.tid == 0) nxt = __hip_atomic_fetch_add((unsigned*)(F.ctl + CW_TAIL), 1u, __ATOMIC_RELAXED, __HIP_MEMORY_SCOPE_AGENT);
            for (;;) {
                if (F.tid == 0) F.MISC[16 + par] = nxt;
                __syncthreads();
                const int it = __builtin_amdgcn_readfirstlane((int)F.MISC[16 + par]); par ^= 1;
                if (it >= T_ALL) break;
                if (F.tid == 0) nxt = __hip_atomic_fetch_add((unsigned*)(F.ctl + CW_TAIL), 1u, __ATOMIC_RELAXED, __HIP_MEMORY_SCOPE_AGENT);
                if (it < T_S) { a.S0 = F.sh + (size_t)it * 16384; a.S1 = F.out + O_HSS + (size_t)it * 16384;
                    la_sample_unit<128, false>(F.lds + RING_OFF, a, it, F.tid, F.wave, F.lane); }
                else if (it < T_S + T_C) {
                    if (!flagged) { flagged = true;
                        if (F.tid == 0) { unsigned sp = 0; while (__hip_atomic_load((unsigned*)(F.ctl + CW_FLAG), __ATOMIC_RELAXED, __HIP_MEMORY_SCOPE_AGENT) == 0u) { __builtin_amdgcn_s_sleep(2); if (++sp > (1u << 22)) break; }
                            __builtin_amdgcn_fence(__ATOMIC_ACQUIRE, "agent"); asm volatile("s_waitcnt vmcnt(0)" ::: "memory"); }
                        __syncthreads(); }
                    const int r = (it - T_S) * NWAVES + F.wave; dec::combine_row(ca, r >> 4, (r >> 2) & 3, r & 3, F.lane); }
                else { __syncthreads(); late_weights(F, (it - T_S - T_C) * 16 + F.wave, (it - T_S - T_C) * 16 + 16); }
            }
        }
        if (BOTH(2)) GRID_BAR();
    }


    REPS(5) if (IN(5)) {
        P2 p{F.xp, F.xs, WSP(bf16, WS_XN), (float*)(F.ctl + CW_SS1)};
        { pg8::Gemm g{WSP(bf16, WS_MIX), WSP(bf16, WS_W2T), MP, 1024, DM}; pg8::StaticOrder S; S.init(MP, 1024, F.G, bid);
          Epi2 E{p};
          pg8::gemm_phase<Epi2, pg8::StaticOrder, true, true>(F.lds + RING_OFF, g, S, E); }
        for (int u = bid; u < 64; u += F.G)
            sgemm_unit(WSP(bf16, WS_MIX), WSP(bf16, WS_W2T), u, F.wave, F.lane, SE2{p});
        if (BOTH(5)) GRID_BAR();
    }

    REPS(6) if (IN(6)) {
        const bool late6 = (xb_xcc_id() & 4u) != 0u;
        if ((SUB_MASK & 1) && !(args.sub & 64) && !late6) p6_rpass(F, 0);
        P3 p{WSP(bf16, WS_Q3), WSP(bf16, WS_K3), WSP(bf16, WS_V3), WSP(bf16, WS_G3), (const float*)(F.ctl + CW_SS1)};
        if (SUB_MASK & 2) { pg8::Gemm g{WSP(bf16, WS_XN), WSP(bf16, WS_W3T), MP, 3072, DM}; pg8::StaticOrder S; S.init(MP, 3072, F.G, bid);
          Epi3 E{p, (args.sub >> 4) & 1};
          pg8::gemm_phase<Epi3, pg8::StaticOrder, true, true>(F.lds + RING_OFF, g, S, E); }
        if ((SUB_MASK & 4) && !(args.sub & 32)) for (int u = bid; u < 192; u += F.G)
            sgemm_unit(WSP(bf16, WS_XN), WSP(bf16, WS_W3T), u, F.wave, F.lane, SE3{p});
        if ((SUB_MASK & 1) && !(args.sub & 64)) { __syncthreads(); p6_rpass(F, late6 ? 2 : 1); }
        if (BOTH(6)) GRID_BAR();
    }

    REPS(7) if (IN(7)) {
        LaArgs a{}; a.Q = WSP(bf16, WS_Q3); a.Kp = WSP(bf16, WS_K3); a.G = WSP(bf16, WS_GF3); a.V = WSP(bf16, WS_V3); a.GATE = WSP(bf16, WS_G3); a.ldv = 1024; a.gain = F.gla_gain; a.MIXo = WSP(bf16, WS_MIX2); a.mixoff = 0;
        for (int u = bid; u < 256; u += F.G) { const int bh = u >> 5, sc = u & 31; a.SBUF = WSP(bf16, WS_SLOC3) + (size_t)u * 32768; a.BTOT = WSP(float, WS_BTOT) + 32768 + (size_t)u * 128;
            la_unit<256, true, 0>(F.lds + RING_OFF, a, (bh >> 2) * SEQ + sc * 256, bh & 3, F.tid, F.wave, F.lane); }
        for (int u = bid; u < 128; u += F.G) { a.S0 = F.sg + (size_t)u * 32768; a.S1 = F.out + O_GSS + (size_t)u * 32768;
            la_sample_unit<256, true>(F.lds + RING_OFF, a, u, F.tid, F.wave, F.lane); }
        if (BOTH(7)) GRID_BAR();
    }
    REPS(8) if (IN(8)) {
        la_scan<256>(WSP(bf16, WS_SLOC3), WSP(float, WS_BTOT) + 32768, F.out + O_GSP, bid * 512 + F.tid, F.G * 512);
        if (F.G == 256) { P4 p{WSP(bf16, WS_XN), F.out + O_Y, (float*)(F.ctl + CW_SS2)};
            for (int u = 255 - bid; u < 64; u += F.G) sgemm_unit(WSP(bf16, WS_MIX2), WSP(bf16, WS_W4T), u, F.wave, F.lane, SE4{p}); }
        if (BOTH(8)) GRID_BAR();
    }
    REPS(9) if (IN(9)) {
        LaArgs a{}; a.Q = WSP(bf16, WS_Q3); a.Kp = WSP(bf16, WS_K3); a.G = WSP(bf16, WS_GF3); a.V = WSP(bf16, WS_V3); a.GATE = WSP(bf16, WS_G3); a.ldv = 1024; a.gain = F.gla_gain; a.MIXo = WSP(bf16, WS_MIX2); a.mixoff = 0;
        for (int u = bid; u < 256; u += F.G) { const int bh = u >> 5, sc = u & 31; a.SBUF = WSP(bf16, WS_SLOC3) + (size_t)u * 32768; a.BTOT = nullptr;
            la_unit<256, true, 1>(F.lds + RING_OFF, a, (bh >> 2) * SEQ + sc * 256, bh & 3, F.tid, F.wave, F.lane); }
        if (BOTH(9)) GRID_BAR();
    }
    REPS(10) if (IN(10)) {
        P4 p{WSP(bf16, WS_XN), F.out + O_Y, (float*)(F.ctl + CW_SS2)};
        pg8::Gemm g{WSP(bf16, WS_MIX2), WSP(bf16, WS_W4T), MP, 1024, DM}; pg8::StaticOrder S; S.init(MP, 1024, F.G, bid);
        if (F.G == 256) {
            Epi4F E{p, F.final_norm, &bar};
            pg8::gemm_phase<Epi4F, pg8::StaticOrder, false, true>(F.lds + RING_OFF, g, S, E);
            const int gw = bid * NWAVES + F.wave;
            if (gw < MS) { const int m = MP + gw; GAS f32x4* yr = (GAS f32x4*)(F.out + O_Y + (size_t)m * DM) + F.lane;
                const float rstd = 1.0f / sqrtf(__hip_atomic_load(p.SS + m, __ATOMIC_RELAXED, __HIP_MEMORY_SCOPE_AGENT) * (1.f / DM) + EPS);
#pragma unroll
                for (int j = 0; j < 4; ++j) { const f32x4 gg = *(const GAS f32x4*)(F.final_norm + 4 * F.lane + 256 * j); yr[64 * j] = yr[64 * j] * rstd * gg; } }
        } else {
            Epi4 E{p};
            pg8::gemm_phase<Epi4, pg8::StaticOrder, true, true>(F.lds + RING_OFF, g, S, E);
            for (int u = bid; u < 64; u += F.G) sgemm_unit(WSP(bf16, WS_MIX2), WSP(bf16, WS_W4T), u, F.wave, F.lane, SE4{p});
            if (BOTH(10)) GRID_BAR();
        }
    }
    if (IN(11) && F.G != 256) p11_final(F);
#undef IN
#undef BOTH
}

extern "C" void kernel_launch(void* const* d_in, const int* in_sizes, int n_in, void* d_out, int out_size, void* d_ws, size_t ws_size, hipStream_t stream) {
    static int grid = 0;
    if (grid == 0) {
        if (n_in != 21 || out_size != (int)O_END || ws_size < WS_END) { fprintf(stderr, "kernel_launch: unexpected problem (n_in %d out %d ws %zu)\n", n_in, out_size, ws_size); grid = -1; return; }
        int dev = 0, cus = 0, per_cu = 0;
        if (hipGetDevice(&dev) != hipSuccess || hipDeviceGetAttribute(&cus, hipDeviceAttributeMultiprocessorCount, dev) != hipSuccess) { grid = -1; return; }
        if (hipFuncSetAttribute((const void*)hybrid_fwd, hipFuncAttributeMaxDynamicSharedMemorySize, LDS_BYTES) != hipSuccess) { fprintf(stderr, "kernel_launch: hipFuncSetAttribute failed\n"); grid = -1; return; }
        if (hipOccupancyMaxActiveBlocksPerMultiprocessor(&per_cu, (const void*)hybrid_fwd, NWAVES * 64, LDS_BYTES) != hipSuccess || per_cu < 1)
            fprintf(stderr, "kernel_launch: occupancy query reports %d workgroups per CU\n", per_cu);
        (void)hipGetLastError();
        grid = cus;
    }
    if (grid < 0) return;
    if (hipMemsetAsync((char*)d_ws + WS_CTL, 0, CTL_ZERO_BYTES, stream) != hipSuccess) { fprintf(stderr, "kernel_launch: memset failed\n"); return; }
    Args a{};
    for (int i = 0; i < 21; ++i) a.in[i] = d_in[i];
    a.out = (float*)d_out; a.ws = (unsigned char*)d_ws; a.sub = 7;
    for (int li = 0; li < N_LAUNCHES; ++li) {
        a.ph_lo = (N_LAUNCHES == 1) ? 0 : li; a.ph_hi = (N_LAUNCHES == 1) ? N_PHASES : li + 1;
        hipLaunchKernelGGL(hybrid_fwd, dim3(grid), dim3(NWAVES * 64), LDS_BYTES, stream, a);
        const hipError_t le = hipPeekAtLastError();
        if (le != hipSuccess) { fprintf(stderr, "kernel_launch: launch %d failed: %s\n", li, hipGetErrorName(le)); break; }
    }
#if defined(PROBE_LO)
    for (int r = 0; r < PROBE_REPS; ++r)
        for (int ph = PROBE_LO; ph < PROBE_HI; ++ph) { (void)hipMemsetAsync((char*)d_ws + WS_CTL + (size_t)CW_BAR * 4, 0, (size_t)(CW_SS1 - CW_BAR) * 4, stream); a.sub = PROBE_SUB; a.ph_lo = ph; a.ph_hi = ph + 1; hipLaunchKernelGGL(hybrid_fwd, dim3(grid), dim3(NWAVES * 64), LDS_BYTES, stream, a); }
#endif
}
```

```cpp
#include <hip/hip_runtime.h>
#include <hip/hip_bf16.h>
#include <cstdio>
#include <cstdint>

constexpr int DM = 1024;
constexpr int SEQ = 8192, NB = 2;
constexpr int MP = NB * SEQ;
constexpr int DB = 32, DT = 4;
constexpr int MS = DB * DT;
constexpr int MT = MP + MS;
constexpr int MTP = 16640;
constexpr int EVEN_IN = 4100, ODD_IN = 3088;
constexpr int NH = 4, HD = 128;
constexpr int PAST = 8192, PAGE = 128, NPAGES = PAST / PAGE;
constexpr float EPS = 1e-6f;
constexpr float ATT_SCALE = 0.08838834764831845f;
constexpr float LOG2E = 1.4426950408889634f;

constexpr size_t O_Y = 0;
constexpr size_t O_KP = (size_t)MT * DM;
constexpr size_t O_VP = O_KP + (size_t)MP * 512;
constexpr size_t O_LFP = O_VP + (size_t)MP * 512;
constexpr size_t O_HSP = O_LFP + (size_t)MP * 4;
constexpr size_t O_GSP = O_HSP + (size_t)NB * NH * 128 * 128;
constexpr size_t O_KS = O_GSP + (size_t)NB * NH * 128 * 256;
constexpr size_t O_VS = O_KS + (size_t)MS * 512;
constexpr size_t O_LFS = O_VS + (size_t)MS * 512;
constexpr size_t O_HSS = O_LFS + (size_t)MS * 4;
constexpr size_t O_GSS = O_HSS + (size_t)DB * NH * 128 * 128;
constexpr size_t O_END = O_GSS + (size_t)DB * NH * 128 * 256;
static_assert(O_END == 40567296, "output size");

constexpr size_t MiB = 1u << 20;
constexpr size_t WS_CTL = 0, CTL_ZERO_BYTES = 1 * MiB;
constexpr size_t WS_W1T = 2 * MiB;
constexpr size_t WS_W2T = 10 * MiB;
constexpr size_t WS_W3T = 12 * MiB;
constexpr size_t WS_W4T = 18 * MiB;
constexpr size_t WS_LB = 20 * MiB;
constexpr size_t WS_LFB = 20 * MiB + 65536;
constexpr size_t WS_CB = 21 * MiB;
constexpr size_t WS_SUFX = 22 * MiB;
constexpr size_t WS_PML = 26 * MiB;
constexpr size_t WS_PO = 26 * MiB + 65536;
constexpr size_t WS_BTOT = 28 * MiB;
constexpr size_t WS_WR = 29 * MiB;
constexpr size_t WS_XN = 32 * MiB;
constexpr size_t WS_QA = 66 * MiB;
constexpr size_t WS_IA = 84 * MiB;
constexpr size_t WS_GA = 102 * MiB;
constexpr size_t WS_GB = 120 * MiB;
constexpr size_t WS_GF = 138 * MiB;
constexpr size_t WS_QBH = 172 * MiB;
constexpr size_t WS_KBH = 188 * MiB;
constexpr size_t WS_VBH = 204 * MiB;
constexpr size_t WS_QS = 220 * MiB;
constexpr size_t WS_MIX = 224 * MiB;
constexpr size_t WS_X1 = 258 * MiB;
constexpr size_t WS_SLOC = 324 * MiB;
constexpr size_t WS_Q3 = 342 * MiB;
constexpr size_t WS_K3 = 360 * MiB;
constexpr size_t WS_V3 = 378 * MiB;
constexpr size_t WS_G3 = 412 * MiB;
constexpr size_t WS_GF3 = 446 * MiB;
constexpr size_t WS_SLOC3 = 480 * MiB;
constexpr size_t WS_MIX2 = 512 * MiB;
constexpr size_t WS_END = 546 * MiB;
constexpr int CW_TMO = 0;
constexpr int CW_BAR = 4096;
constexpr int CW_FLAG = 8192;
constexpr int CW_TAIL = 8192 + 64;
constexpr int CW_BAR2 = 12288;
constexpr int CW_SS1 = 16384;
constexpr int CW_SS2 = 40960;
static_assert((CW_SS2 + MT) * 4 <= (int)CTL_ZERO_BYTES, "CTL");

constexpr int RING_OFF = 0, RING_BYTES = 131072;
constexpr int LDSCTL_OFF = 146944, MISC_OFF = LDSCTL_OFF + 320;
constexpr int LDS_BYTES = 147456;
constexpr int NWAVES = 8;
namespace pg8 {
#define PG8_LAS __attribute__((address_space(3)))
typedef unsigned short bf16_t;
typedef short bf16x8 __attribute__((ext_vector_type(8)));
typedef float f32x4 __attribute__((ext_vector_type(4)));
typedef unsigned u32x4 __attribute__((ext_vector_type(4)));
constexpr int BM = 256, BK = 64, HALF = 128, HTB = HALF * BK * 2  , STAGE_BYTES = 8 * HTB, NXCD = 8, WGM = 8;

__host__ __device__ __forceinline__ int lds_byte(int r, int c) { const int st = (r >> 4) * 2 + (c >> 5), rr = r & 15, cc = c & 31, ob = rr * 64 + cc * 2; return st * 1024 + (ob ^ (((ob >> 9) & 1) << 5)); }
__host__ __device__ __forceinline__ void stage_rc(int b, int& R, int& C) { const int st = b / 1024, sb = b % 1024, swz = sb ^ (((sb >> 9) & 1) << 5); R = (st >> 1) * 16 + swz / 64; C = (st & 1) * 32 + (swz % 64) / 2; }
__host__ __device__ __forceinline__ int perm32(int rho) { const int n = rho >> 4, i = rho & 15; return 8 * (i >> 2) + 4 * n + (i & 3); }

struct Unit { int pm, pn; };
struct Gemm { const bf16_t* A; const bf16_t* Bt; int M, N, K; };

struct StaticOrder {
    int nM, nN, nwg, G, c;
    __host__ __device__ void init(int M, int N, int G_, int c_) { nM = M / BM; nN = N / BM; nwg = nM * nN; G = G_; c = c_; }
    __host__ __device__ bool next(int i, Unit& u) const {
        const long L = (long)i * G + c; if (L >= nwg) return false;
        int wgid = (int)L; { const int q = nwg / NXCD, r = nwg % NXCD, xcd = wgid % NXCD, off = wgid / NXCD; wgid = (xcd < r ? xcd * (q + 1) : r * (q + 1) + (xcd - r) * q) + off; }
        const int nig = WGM * nN, gid = wgid / nig, fm = gid * WGM, gsz = (nM - fm) < WGM ? (nM - fm) : WGM;
        u.pm = fm + ((wgid % nig) % gsz); u.pn = (wgid % nig) / gsz; return true;
    }
    __device__ __forceinline__ void a_ready(const Unit&) const {}
    __device__ __forceinline__ void done(const Unit&) const {}
};

__device__ __forceinline__ unsigned cvt_pk_bf16(float lo, float hi) { unsigned r; asm volatile("v_cvt_pk_bf16_f32 %0, %1, %2" : "=v"(r) : "v"(lo), "v"(hi)); return r; }
typedef float f32x2 __attribute__((ext_vector_type(2)));
template <class Epi, class Sched, bool ALIGN_EPI = false, bool SP2 = false>
__device__ __forceinline__ void gemm_phase(PG8_LAS unsigned char* lds, const Gemm g, const Sched& S, const Epi& E) {
    const int tid = threadIdx.x, wid = __builtin_amdgcn_readfirstlane(tid >> 6), lane = tid & 63, wr = wid >> 2, wc = wid & 3, fr = lane & 15, fq = lane >> 4;
    const int K = g.K, nt = K / BK;
    unsigned voffA[2], voffB[2];
#pragma unroll
    for (int i = 0; i < 2; ++i) { int R, C; stage_rc(tid * 16 + i * 8192, R, C); const int Rb = Epi::PERM ? ((R & ~31) + perm32(R & 31)) : R;
        voffA[i] = (unsigned)(R * K + C) * 2u; voffB[i] = (unsigned)(Rb * K + C) * 2u; }
    const size_t kstep = (size_t)(BK * 2);
    const size_t hstep = (size_t)HALF * K * 2;
    const size_t tstep = 2 * hstep;
    const unsigned ldsw = (unsigned)wid * 1024u;
    const int aoff = lds_byte(wr * 64 + fr, fq * 8), boff = lds_byte(wc * 32 + fr, fq * 8);
#define PG8_SA(b, h) (((b) * 2 + (h)) * HTB)
#define PG8_SB(b, h) ((4 + (b) * 2 + (h)) * HTB)
#define PG8_STAGE(bufoff, gbase, voff) do { _Pragma("unroll") for (int _i = 0; _i < 2; ++_i) \
        __builtin_amdgcn_global_load_lds((const unsigned*)((const char*)(gbase) + (voff)[_i]), (PG8_LAS unsigned*)(lds + (bufoff) + ldsw + _i * 8192), 16, 0, 0); } while (0)
#define PG8_LDA(dst, b, h) do { _Pragma("unroll") for (int m = 0; m < 4; ++m) _Pragma("unroll") for (int k = 0; k < 2; ++k) dst[m][k] = *(const PG8_LAS bf16x8*)(lds + PG8_SA(b, h) + aoff + m * 2048 + k * 1024); } while (0)
#define PG8_LDB(dst, b, h) do { _Pragma("unroll") for (int n = 0; n < 2; ++n) _Pragma("unroll") for (int k = 0; k < 2; ++k) dst[n][k] = *(const PG8_LAS bf16x8*)(lds + PG8_SB(b, h) + boff + n * 2048 + k * 1024); } while (0)
#define PG8_MMA(ai, bj, At, Bt) do { __builtin_amdgcn_s_setprio(1); _Pragma("unroll") for (int m = 0; m < 4; ++m) _Pragma("unroll") for (int n = 0; n < 2; ++n) _Pragma("unroll") for (int k = 0; k < 2; ++k) \
        acc[ai][bj][m][n] = __builtin_amdgcn_mfma_f32_16x16x32_bf16(Bt[n][k], At[m][k], acc[ai][bj][m][n], 0, 0, 0); __builtin_amdgcn_s_setprio(0); } while (0)
#define PG8_WAIT_V(n) asm volatile("s_waitcnt vmcnt(" #n ")" ::: "memory")
#define PG8_WAIT_L(n) asm volatile("s_waitcnt lgkmcnt(" #n ")" ::: "memory")
#define PG8_BAR __builtin_amdgcn_s_barrier()
#define PG8_SCHED __builtin_amdgcn_sched_barrier(0)
    Unit cur, nxt; int ui = 0;
    if (!S.next(0, cur)) return;
    f32x4 acc[2][2][4][2];
#pragma unroll
    for (int a = 0; a < 2; ++a)
#pragma unroll
        for (int b = 0; b < 2; ++b)
#pragma unroll
            for (int m = 0; m < 4; ++m)
#pragma unroll
                for (int n = 0; n < 2; ++n) acc[a][b][m][n] = (f32x4){0.f, 0.f, 0.f, 0.f};
    bf16x8 At[4][2], B0[2][2], B1[2][2];
    const char* cA = (const char*)g.A + (size_t)cur.pm * tstep; const char* cB = (const char*)g.Bt + (size_t)cur.pn * tstep;
    S.a_ready(cur);
    if constexpr (SP2) {
        PG8_STAGE(PG8_SB(0, 0), cB, voffB); PG8_STAGE(PG8_SB(0, 1), cB + hstep, voffB); PG8_STAGE(PG8_SA(0, 0), cA, voffA); PG8_STAGE(PG8_SA(0, 1), cA + hstep, voffA);
        if (wr == 1) PG8_BAR;
        PG8_WAIT_V(2); PG8_BAR;
        PG8_STAGE(PG8_SB(1, 0), cB + kstep, voffB); PG8_STAGE(PG8_SA(1, 0), cA + kstep, voffA); PG8_STAGE(PG8_SB(1, 1), cB + hstep + kstep, voffB);
        PG8_WAIT_V(6); PG8_BAR;
    } else {
        PG8_STAGE(PG8_SB(0, 0), cB, voffB); PG8_STAGE(PG8_SA(0, 0), cA, voffA); PG8_STAGE(PG8_SB(0, 1), cB + hstep, voffB); PG8_STAGE(PG8_SA(0, 1), cA + hstep, voffA);
        if (wr == 1) PG8_BAR;
        PG8_WAIT_V(4); PG8_BAR;
        PG8_STAGE(PG8_SB(1, 0), cB + kstep, voffB); PG8_STAGE(PG8_SA(1, 0), cA + kstep, voffA); PG8_STAGE(PG8_SB(1, 1), cB + hstep + kstep, voffB);
        PG8_WAIT_V(6); PG8_BAR;
    }
    for (;;) {
        const bool has_next = S.next(ui + 1, nxt);
        const char* nA = has_next ? (const char*)g.A + (size_t)nxt.pm * tstep : cA; const char* nB = has_next ? (const char*)g.Bt + (size_t)nxt.pn * tstep : cB;
        for (int t = 0; t < nt; t += 2) {
            const bool last = (t == nt - 2);
            const char* a1 = cA + (size_t)(t + 1) * kstep;
            const char* a2 = last ? nA : cA + (size_t)(t + 2) * kstep; const char* b2 = last ? nB : cB + (size_t)(t + 2) * kstep;
            const char* a3 = a2 + kstep; const char* b3 = b2 + kstep;
            if (last && has_next) S.a_ready(nxt);
            if constexpr (SP2) {
            PG8_LDB(B0, 0, 0); PG8_LDB(B1, 0, 1); PG8_SCHED; PG8_LDA(At, 0, 0); PG8_STAGE(PG8_SA(1, 1), a1 + hstep, voffA);
            PG8_WAIT_V(8); PG8_WAIT_L(0); PG8_BAR; PG8_MMA(0, 0, At, B0); PG8_MMA(0, 1, At, B1); PG8_BAR; PG8_SCHED;
            PG8_LDA(At, 0, 1); PG8_STAGE(PG8_SB(0, 0), b2, voffB); PG8_STAGE(PG8_SB(0, 1), b2 + hstep, voffB); PG8_STAGE(PG8_SA(0, 0), a2, voffA);
            PG8_WAIT_V(8); PG8_WAIT_L(0); PG8_BAR; PG8_MMA(1, 0, At, B0); PG8_MMA(1, 1, At, B1); PG8_BAR; PG8_SCHED;
            PG8_LDB(B0, 1, 0); PG8_LDB(B1, 1, 1); PG8_SCHED; PG8_LDA(At, 1, 0); PG8_STAGE(PG8_SA(0, 1), a2 + hstep, voffA);
            PG8_WAIT_V(8); PG8_WAIT_L(0); PG8_BAR; PG8_MMA(0, 0, At, B0); PG8_MMA(0, 1, At, B1); PG8_BAR; PG8_SCHED;
            PG8_LDA(At, 1, 1); PG8_STAGE(PG8_SB(1, 0), b3, voffB); PG8_STAGE(PG8_SB(1, 1), b3 + hstep, voffB); PG8_STAGE(PG8_SA(1, 0), a3, voffA);
            PG8_WAIT_V(8); PG8_WAIT_L(0); PG8_BAR; PG8_MMA(1, 0, At, B0); PG8_MMA(1, 1, At, B1); PG8_BAR; PG8_SCHED;
            } else {
            PG8_LDB(B0, 0, 0); PG8_SCHED; PG8_LDA(At, 0, 0); PG8_STAGE(PG8_SA(1, 1), a1 + hstep, voffA);
            PG8_WAIT_L(8); PG8_BAR; PG8_WAIT_L(0); PG8_MMA(0, 0, At, B0); PG8_BAR; PG8_SCHED;
            PG8_LDB(B1, 0, 1); PG8_STAGE(PG8_SB(0, 0), b2, voffB);
            PG8_BAR; PG8_WAIT_L(0); PG8_MMA(0, 1, At, B1); PG8_BAR;
            PG8_LDA(At, 0, 1); PG8_STAGE(PG8_SA(0, 0), a2, voffA);
            PG8_BAR; PG8_WAIT_L(0); PG8_MMA(1, 0, At, B0); PG8_BAR; PG8_SCHED;
            PG8_STAGE(PG8_SB(0, 1), b2 + hstep, voffB);
            PG8_WAIT_V(6); PG8_BAR; PG8_MMA(1, 1, At, B1); PG8_BAR;
            PG8_LDB(B0, 1, 0); PG8_SCHED; PG8_LDA(At, 1, 0); PG8_STAGE(PG8_SA(0, 1), a2 + hstep, voffA);
            PG8_WAIT_L(8); PG8_BAR; PG8_WAIT_L(0); PG8_MMA(0, 0, At, B0); PG8_BAR; PG8_SCHED;
            PG8_LDB(B1, 1, 1); PG8_STAGE(PG8_SB(1, 0), b3, voffB);
            PG8_BAR; PG8_WAIT_L(0); PG8_MMA(0, 1, At, B1); PG8_BAR;
            PG8_LDA(At, 1, 1); PG8_STAGE(PG8_SA(1, 0), a3, voffA);
            PG8_BAR; PG8_WAIT_L(0); PG8_MMA(1, 0, At, B0); PG8_BAR; PG8_SCHED;
            PG8_STAGE(PG8_SB(1, 1), b3 + hstep, voffB);
            PG8_WAIT_V(6); PG8_BAR; PG8_MMA(1, 1, At, B1); PG8_BAR;
            }
        }
        if constexpr (ALIGN_EPI) { if (wr == 0) PG8_BAR; }
        if constexpr (!Epi::AFTER_DRAIN) { E(acc, cur, wr, wc, fr, fq); S.done(cur); }
        if (!has_next) break;
#pragma unroll
        for (int a = 0; a < 2; ++a)
#pragma unroll
            for (int b = 0; b < 2; ++b)
#pragma unroll
                for (int m = 0; m < 4; ++m)
#pragma unroll
                    for (int n = 0; n < 2; ++n) acc[a][b][m][n] = (f32x4){0.f, 0.f, 0.f, 0.f};
        cur = nxt; cA = nA; cB = nB; ++ui;
        if constexpr (ALIGN_EPI) { if (wr == 1) PG8_BAR; }
    }
    PG8_WAIT_V(0);
    if constexpr (!ALIGN_EPI) { if (wr == 0) PG8_BAR; }
    PG8_BAR;
    if constexpr (Epi::AFTER_DRAIN) { E.fused(acc, cur, wr, wc, fr, fq, lds, wid, lane); S.done(cur); }
#undef PG8_SA
#undef PG8_SB
#undef PG8_STAGE
#undef PG8_LDA
#undef PG8_LDB
#undef PG8_MMA
#undef PG8_WAIT_V
#undef PG8_WAIT_L
#undef PG8_BAR
#undef PG8_SCHED
}
}
#define GAS __attribute__((address_space(1)))
#define LAS __attribute__((address_space(3)))
typedef unsigned short bf16;
typedef unsigned v4u __attribute__((ext_vector_type(4)));
typedef float f32x4 __attribute__((ext_vector_type(4)));
typedef short bf16x8 __attribute__((ext_vector_type(8)));
typedef GAS unsigned gu32;
typedef GAS unsigned long long gu64;
#define RLX_AGENT __ATOMIC_RELAXED, __HIP_MEMORY_SCOPE_AGENT
#define LDS_WAIT() asm volatile("s_waitcnt lgkmcnt(0)" ::: "memory")
#define VM_WAIT() asm volatile("s_waitcnt vmcnt(0)" ::: "memory")
__device__ __forceinline__ unsigned long long rt() { return __builtin_amdgcn_s_memrealtime(); }
__device__ __forceinline__ unsigned f2bf(float f) { unsigned u = __builtin_bit_cast(unsigned, f); return (u + 0x7fffu + ((u >> 16) & 1u)) >> 16; }
__device__ __forceinline__ unsigned pk2(float lo, float hi) { return f2bf(lo) | (f2bf(hi) << 16); }

#define XB_TMO      128
#define XB_XCNT(j)  (256  + 64 * (j))
#define XB_XSUB(j)  (1280 + 64 * (j))
#define XB_XGEN(j)  (2304 + 64 * (j))
#define XB_TOP      3328
#define XB_TOPGEN   3392
#define XCD_BAR_WORDS 3456
#define XB_SPIN_CAP (1u << 18)

__device__ __forceinline__ unsigned xb_ld(unsigned* p)              { return __hip_atomic_load(p, __ATOMIC_RELAXED, __HIP_MEMORY_SCOPE_AGENT); }
__device__ __forceinline__ unsigned xb_add(unsigned* p, unsigned v) { return __hip_atomic_fetch_add(p, v, __ATOMIC_RELAXED, __HIP_MEMORY_SCOPE_AGENT); }
__device__ __forceinline__ unsigned xb_xcc_id() { return (unsigned)__builtin_amdgcn_s_getreg((3 << 11) | 20) & 0xFu; }
#define XB_SPIN(cond, bar) do { unsigned _sp = 0; while (cond) { __builtin_amdgcn_s_sleep(1); \
    if ((++_sp & 255u) == 0u) { if (xb_ld(&(bar)[XB_TMO])) break; if (_sp > XB_SPIN_CAP) { atomicAdd(&(bar)[XB_TMO], 1u); break; } } } } while (0)

struct XcdBarrier {
    unsigned* bar; unsigned x;
    volatile LAS unsigned* st;
    unsigned total;
};

__device__ __forceinline__ XcdBarrier xcd_barrier_post(unsigned* bar, volatile LAS unsigned* st) {
    XcdBarrier b; b.bar = bar; b.x = xb_xcc_id(); b.st = st; b.total = 0u;
    if (threadIdx.x == 0) (void)xb_add(&bar[XB_XCNT(b.x)], 1u);
    return b;
}
__device__ __forceinline__ void xcd_barrier_complete(unsigned* bar, unsigned x, unsigned& nloc, unsigned& nx, unsigned total) {
    const unsigned G = total ? total : gridDim.x * gridDim.y * gridDim.z;
    unsigned sum, cnt, mine, sp = 0u;
    for (;;) {
        sum = 0u; cnt = 0u; mine = 0u;
#pragma unroll
        for (unsigned j = 0; j < 16; ++j) { const unsigned c = xb_ld(&bar[XB_XCNT(j)]); sum += c; cnt += (c > 0u) ? 1u : 0u; mine = (j == x) ? c : mine; }
        if (sum == G) break;
        __builtin_amdgcn_s_sleep(1);
        if ((++sp & 255u) == 0u) { if (xb_ld(&bar[XB_TMO])) break; if (sp > XB_SPIN_CAP) { atomicAdd(&bar[XB_TMO], 1u); break; } }
    }
    nloc = mine > 0u ? mine : 1u; nx = cnt > 0u ? cnt : 1u;
}

__device__ __forceinline__ void xcd_barrier(const XcdBarrier& b) {
    asm volatile("s_waitcnt vmcnt(0)" ::: "memory");
    __syncthreads();
    if (threadIdx.x == 0) {
        unsigned* bar = b.bar;
        __builtin_amdgcn_s_waitcnt(0);
        unsigned nloc = b.st[0], nx = b.st[1];
        if (nloc == 0u) { xcd_barrier_complete(bar, b.x, nloc, nx, b.total); b.st[0] = nloc; b.st[1] = nx; }
        const unsigned old = xb_add(&bar[XB_XSUB(b.x)], 1u);
        const unsigned gen = old / nloc;
        if (old + 1u == (gen + 1u) * nloc) {
            __builtin_amdgcn_fence(__ATOMIC_RELEASE, "agent");
            asm volatile("s_waitcnt vmcnt(0)" ::: "memory");
            const unsigned og = xb_add(&bar[XB_TOP], 1u);
            const unsigned tg = og / nx;
            if (og + 1u == (tg + 1u) * nx) xb_add(&bar[XB_TOPGEN], 1u);
            else XB_SPIN(xb_ld(&bar[XB_TOPGEN]) == tg, bar);
            __builtin_amdgcn_fence(__ATOMIC_ACQUIRE, "agent");
            xb_add(&bar[XB_XGEN(b.x)], 1u);
            asm volatile("s_waitcnt vmcnt(0)" ::: "memory");
        } else {
            XB_SPIN(xb_ld(&bar[XB_XGEN(b.x)]) == gen, bar);
            __builtin_amdgcn_fence(__ATOMIC_ACQUIRE, "agent");
            asm volatile("s_waitcnt vmcnt(0)" ::: "memory");
        }
    }
    __syncthreads();
}

typedef unsigned u32x2v __attribute__((ext_vector_type(2)));
struct Frame {
    LAS unsigned char* lds;
    volatile LAS unsigned* MISC;
    gu32* ctl;
    int tid, lane, wave;
    int G;
    unsigned char* ws;
    float* out;
    const float *xp, *xs, *ck, *cv, *clf, *sh, *sg; const int* pt;
    const float *norm_even, *w_in_even, *b_fox, *lb_logits, *hgrn_gain, *w_out_even, *norm_odd, *w_in_odd, *w_gla_gate, *b_gla_gate, *gla_gain, *w_out_odd, *final_norm;
};
#define WSP(T, off) ((T*)(F.ws + (off)))

template <int CTRL> __device__ __forceinline__ float dppf(float x) { return __builtin_bit_cast(float, __builtin_amdgcn_mov_dpp(__builtin_bit_cast(int, x), CTRL, 0xf, 0xf, true)); }
__device__ __forceinline__ float row16_sum(float v) { v += dppf<0xB1>(v); v += dppf<0x4E>(v); v += dppf<0x141>(v); v += dppf<0x140>(v); return v; }
__device__ __forceinline__ float wave_sum(float v) {
    v = row16_sum(v);
    auto s = __builtin_amdgcn_permlane16_swap(__float_as_uint(v), __float_as_uint(v), false, false); v = __uint_as_float(s[0]) + __uint_as_float(s[1]);
    auto t = __builtin_amdgcn_permlane32_swap(__float_as_uint(v), __float_as_uint(v), false, false); return __uint_as_float(t[0]) + __uint_as_float(t[1]);
}
__device__ __forceinline__ float fast_exp(float x) { return __builtin_amdgcn_exp2f(x * LOG2E); }
__device__ __forceinline__ float sigmoidf_(float x) { return __builtin_amdgcn_rcpf(1.0f + fast_exp(-x)); }
__device__ __forceinline__ float siluf_(float x) { return x * sigmoidf_(x); }
__device__ __forceinline__ float log_sigmoidf_(float x) {
    const float e = __builtin_amdgcn_exp2f(-fabsf(x) * LOG2E);
    return fminf(x, 0.f) - __builtin_amdgcn_logf(1.0f + e) * 0.6931471805599453f;
}
typedef float f32x2_t __attribute__((ext_vector_type(2)));
typedef __bf16 bf16x2_t __attribute__((ext_vector_type(2)));
__device__ __forceinline__ unsigned cvtpk_s(float lo, float hi) { f32x2_t v = {lo, hi}; bf16x2_t b = __builtin_convertvector(v, bf16x2_t); return __builtin_bit_cast(unsigned, b); }
__device__ __forceinline__ bf16x8 pack8f(f32x4 a, f32x4 b) { v4u w = {cvtpk_s(a[0], a[1]), cvtpk_s(a[2], a[3]), cvtpk_s(b[0], b[1]), cvtpk_s(b[2], b[3])}; return __builtin_bit_cast(bf16x8, w); }
__device__ __forceinline__ float bf2f(unsigned short b) { return __builtin_bit_cast(float, (unsigned)b << 16); }
__device__ __forceinline__ void st_bf4(bf16* p, f32x4 v) { u32x2v w; w.x = cvtpk_s(v[0], v[1]); w.y = cvtpk_s(v[2], v[3]); *(GAS u32x2v*)p = w; }
__device__ __forceinline__ void st_bf8(bf16* p, f32x4 a, f32x4 b) { v4u w = {cvtpk_s(a[0], a[1]), cvtpk_s(a[2], a[3]), cvtpk_s(b[0], b[1]), cvtpk_s(b[2], b[3])}; *(GAS v4u*)p = w; }

__device__ __forceinline__ void p0_transpose_item(const float* W, int K, int ld, int N, bf16* WT, LAS float* scr, int item, int lane, const float* gain) {
    const int nblk = N / 32, kb = item / nblk, nb = item % nblk, k0 = 64 * kb, n0 = 32 * nb;
    float wv[32];
#pragma unroll
    for (int i = 0; i < 32; ++i) { const int kk = 2 * i + (lane >> 5); wv[i] = W[(size_t)(k0 + kk) * ld + n0 + (lane & 31)]; }
#pragma unroll
    for (int i = 0; i < 32; ++i) { const int kk = 2 * i + (lane >> 5); float w = wv[i]; if (gain) w *= gain[k0 + kk]; scr[kk * 33 + (lane & 31)] = w; }
    LDS_WAIT(); asm volatile("" ::: "memory");
    const int c = lane & 7;
#pragma unroll
    for (int j = 0; j < 4; ++j) { const int n = (lane >> 3) + 8 * j; const LAS float* s = scr + (8 * c) * 33 + n;
        v4u o; o.x = pk2(s[0 * 33], s[1 * 33]); o.y = pk2(s[2 * 33], s[3 * 33]); o.z = pk2(s[4 * 33], s[5 * 33]); o.w = pk2(s[6 * 33], s[7 * 33]);
        *(GAS v4u*)(WT + (size_t)(n0 + n) * K + k0 + 8 * c) = o; }
    LDS_WAIT(); asm volatile("" ::: "memory");
}

__device__ __forceinline__ float block_excl_scan(float v, LAS float* scr, int lane, int wave, float* total) {
    float inc = v;
#pragma unroll
    for (int o = 1; o < 64; o <<= 1) { const float t = __shfl_up(inc, o); if (lane >= o) inc += t; }
    if (lane == 63) scr[wave] = inc;
    __syncthreads();
    float pre = 0.f, tot = 0.f;
#pragma unroll
    for (int w = 0; w < 8; ++w) { const float t = scr[w]; if (w < wave) pre += t; tot += t; }
    __syncthreads();
    *total = tot;
    return pre + inc - v;
}

__device__ __forceinline__ void p0_prologue(Frame& F, int sub) {
    LAS float* scr = (LAS float*)(F.lds + RING_OFF + F.wave * 16384);
    const int gw = (int)blockIdx.x * NWAVES + F.wave, NGW = F.G * NWAVES;
    constexpr int I1 = 16 * (4096 / 32);
    if (sub & 1) for (int it = gw; it < I1; it += NGW) p0_transpose_item(F.w_in_even, DM, EVEN_IN, 4096, WSP(bf16, WS_W1T), scr, it, F.lane, nullptr);
    if (blockIdx.x == 0) { float* LB = WSP(float, WS_LB); const int c = F.tid; LB[c] = 1.0f / (1.0f + __expf(F.lb_logits[512 + c] - F.lb_logits[c])); }
    { bf16* WRB = WSP(bf16, WS_WR); bf16* WGB = WSP(bf16, WS_WR + 65536); const int gt = (int)blockIdx.x * 512 + F.tid;
      for (int e = gt; e < 16 * 1024; e += F.G * 512) { const int j = e >> 10, k = e & 1023; WRB[e] = (bf16)(cvtpk_s(F.w_in_odd[(size_t)k * ODD_IN + 3072 + j] * F.norm_odd[k], 0.f) & 0xffffu); }
      for (int e = gt; e < 512 * 16; e += F.G * 512) { const int c = e >> 4, j = e & 15; WGB[e] = (bf16)(cvtpk_s(F.w_gla_gate[j * 512 + c], 0.f) & 0xffffu); } }
    __syncthreads();
    if ((sub & 2) && blockIdx.x < DB) {
        const int b = blockIdx.x; float* SUFX = WSP(float, WS_SUFX);
        LAS float* sscr = (LAS float*)(F.lds + RING_OFF);
        const int i = F.tid; f32x4 v[16];
#pragma unroll
        for (int j = 0; j < 16; ++j) { const int s = 8191 - (16 * i + j); const int pg = F.pt[b * NPAGES + (s >> 7)]; v[j] = *(const GAS f32x4*)(F.clf + ((size_t)pg * PAGE + (s & 127)) * 4); }
        f32x4 run = {0.f, 0.f, 0.f, 0.f};
#pragma unroll
        for (int j = 0; j < 16; ++j) { const f32x4 t = v[j]; v[j] = run; run += t; }
        f32x4 pre;
        {
            f32x4 inc = run;
#pragma unroll
            for (int o = 1; o < 64; o <<= 1) { f32x4 t; t.x = __shfl_up(inc.x, o); t.y = __shfl_up(inc.y, o); t.z = __shfl_up(inc.z, o); t.w = __shfl_up(inc.w, o); if (F.lane >= o) inc += t; }
            if (F.lane == 63) *(LAS f32x4*)(sscr + 4 * F.wave) = inc;
            __syncthreads();
            f32x4 p = {0.f, 0.f, 0.f, 0.f};
#pragma unroll
            for (int w = 0; w < 8; ++w) { const f32x4 t = *(const LAS f32x4*)(sscr + 4 * w); if (w < F.wave) p += t; }
            pre = p + inc - run; }
        const int sb = 8191 - (16 * i + 15);
#pragma unroll
        for (int q = 0; q < 4; ++q) {
            const f32x4 o3 = (v[15 - 4 * q] + pre) * LOG2E, o2 = (v[14 - 4 * q] + pre) * LOG2E, o1 = (v[13 - 4 * q] + pre) * LOG2E, o0 = (v[12 - 4 * q] + pre) * LOG2E;
            *(GAS f32x4*)(SUFX + (size_t)(b * 4 + 0) * PAST + sb + 4 * q) = (f32x4){o3.x, o2.x, o1.x, o0.x};
            *(GAS f32x4*)(SUFX + (size_t)(b * 4 + 1) * PAST + sb + 4 * q) = (f32x4){o3.y, o2.y, o1.y, o0.y};
            *(GAS f32x4*)(SUFX + (size_t)(b * 4 + 2) * PAST + sb + 4 * q) = (f32x4){o3.z, o2.z, o1.z, o0.z};
            *(GAS f32x4*)(SUFX + (size_t)(b * 4 + 3) * PAST + sb + 4 * q) = (f32x4){o3.w, o2.w, o1.w, o0.w}; }
    }
    LAS float* wfb = (LAS float*)(F.lds + RING_OFF);
    __syncthreads();
    for (int k = F.tid; k < 1024; k += 512) *(LAS f32x4*)(wfb + 4 * k) = *(const GAS f32x4*)(F.w_in_even + (size_t)k * EVEN_IN + 4096);
    __syncthreads();
    bf16* XN = WSP(bf16, WS_XN); float* LFB = WSP(float, WS_LFB);
    const float bfl = F.b_fox[F.lane & 3];
    f32x4 gn[4];
#pragma unroll
    for (int j = 0; j < 4; ++j) gn[j] = *(const GAS f32x4*)(F.norm_even + 4 * F.lane + 256 * j);
    constexpr int NSW = DB * NWAVES, RSPLIT = MT - 5 * NSW;
    int m0r = gw, mstep = NGW, mend = MT;
    if (NGW > NSW) { if (gw < NSW) { m0r = RSPLIT + gw; mstep = NSW; mend = MT; } else { m0r = gw - NSW; mstep = NGW - NSW; mend = RSPLIT; } }
    f32x4 vn[4];
    if (m0r < mend) { const float* xrow = m0r < MP ? F.xp + (size_t)m0r * DM : F.xs + (size_t)(m0r - MP) * DM; const GAS f32x4* xr = (const GAS f32x4*)xrow + F.lane;
#pragma unroll
        for (int j = 0; j < 4; ++j) vn[j] = xr[64 * j]; }
    if (sub & 4) for (int m = m0r; m < mend; m += mstep) {
        f32x4 v[4]; float s = 0.f;
#pragma unroll
        for (int j = 0; j < 4; ++j) v[j] = vn[j];
        { const int mn = (m + mstep < mend) ? m + mstep : m; const float* xrow = mn < MP ? F.xp + (size_t)mn * DM : F.xs + (size_t)(mn - MP) * DM; const GAS f32x4* xr = (const GAS f32x4*)xrow + F.lane;
#pragma unroll
            for (int j = 0; j < 4; ++j) vn[j] = xr[64 * j]; }
#pragma unroll
        for (int j = 0; j < 4; ++j) s += (v[j].x * v[j].x + v[j].y * v[j].y) + (v[j].z * v[j].z + v[j].w * v[j].w);
        const float rstd = 1.0f / sqrtf(wave_sum(s) * (1.f / DM) + EPS);
        f32x4 d = {0.f, 0.f, 0.f, 0.f};
        GAS unsigned long long* o8 = (GAS unsigned long long*)(XN + (size_t)m * DM) + F.lane;
#pragma unroll
        for (int j = 0; j < 4; ++j) { const int c0 = 4 * F.lane + 256 * j;
            const f32x4 h = v[j] * rstd * gn[j];
            o8[64 * j] = (unsigned long long)cvtpk_s(h.x, h.y) | ((unsigned long long)cvtpk_s(h.z, h.w) << 32);
            d += h.x * *(LAS f32x4*)(wfb + 4 * c0) + h.y * *(LAS f32x4*)(wfb + 4 * c0 + 4) + h.z * *(LAS f32x4*)(wfb + 4 * c0 + 8) + h.w * *(LAS f32x4*)(wfb + 4 * c0 + 12); }
        d.x = wave_sum(d.x); d.y = wave_sum(d.y); d.z = wave_sum(d.z); d.w = wave_sum(d.w);
        if (F.lane < 4) { const float dj = F.lane == 0 ? d.x : F.lane == 1 ? d.y : F.lane == 2 ? d.z : d.w; const float lf = log_sigmoidf_(dj + bfl);
            LFB[(size_t)m * 4 + F.lane] = lf;
            float* o = m < MP ? F.out + O_LFP + (size_t)m * 4 : F.out + O_LFS + (size_t)(m - MP) * 4; o[F.lane] = lf; }
    }
    __syncthreads();
}

__device__ __forceinline__ void late_weights(Frame& F, int gwi, int nw) {
    LAS float* scr = (LAS float*)(F.lds + RING_OFF + F.wave * 16384);
    constexpr int I2 = 16 * (1024 / 32), I3 = 16 * (3072 / 32), I4 = I2;
    for (int it = gwi; it < I2 + I3 + I4 && it < nw; it += NWAVES) {
        int r = it;
        if (r < I2) { p0_transpose_item(F.w_out_even, DM, DM, 1024, WSP(bf16, WS_W2T), scr, r, F.lane, nullptr); continue; } r -= I2;
        if (r < I3) { p0_transpose_item(F.w_in_odd, DM, ODD_IN, 3072, WSP(bf16, WS_W3T), scr, r, F.lane, F.norm_odd); continue; } r -= I3;
        p0_transpose_item(F.w_out_odd, DM, DM, 1024, WSP(bf16, WS_W4T), scr, r, F.lane, nullptr);
    }
}
__device__ __forceinline__ void fox_cumsum_unit(Frame& F, int b) {
    const float* LFB = WSP(float, WS_LFB); float* CB = WSP(float, WS_CB);
    LAS float* sscr = (LAS float*)(F.lds + RING_OFF);
    f32x4 v[16]; f32x4 run = {0.f, 0.f, 0.f, 0.f};
#pragma unroll
    for (int j = 0; j < 16; ++j) v[j] = *(const GAS f32x4*)(LFB + (size_t)(b * SEQ + 16 * F.tid + j) * 4);
#pragma unroll
    for (int j = 0; j < 16; ++j) { run += v[j]; v[j] = run; }
    f32x4 pre;
    {   f32x4 inc = run;
#pragma unroll
        for (int o = 1; o < 64; o <<= 1) { f32x4 t; t.x = __shfl_up(inc.x, o); t.y = __shfl_up(inc.y, o); t.z = __shfl_up(inc.z, o); t.w = __shfl_up(inc.w, o); if (F.lane >= o) inc += t; }
        if (F.lane == 63) *(LAS f32x4*)(sscr + 4 * F.wave) = inc;
        __syncthreads();
        f32x4 p = {0.f, 0.f, 0.f, 0.f};
#pragma unroll
        for (int w = 0; w < 8; ++w) { const f32x4 t = *(const LAS f32x4*)(sscr + 4 * w); if (w < F.wave) p += t; }
        pre = p + inc - run;
        __syncthreads(); }
    const float ns = -1.0f / ATT_SCALE;
#pragma unroll
    for (int q = 0; q < 4; ++q) { const f32x4 o0 = (v[4 * q] + pre) * ns, o1 = (v[4 * q + 1] + pre) * ns, o2 = (v[4 * q + 2] + pre) * ns, o3 = (v[4 * q + 3] + pre) * ns;
        const size_t off = (size_t)16 * F.tid + 4 * q;
        *(GAS f32x4*)(CB + (size_t)(b * 4 + 0) * SEQ + off) = (f32x4){o0.x, o1.x, o2.x, o3.x};
        *(GAS f32x4*)(CB + (size_t)(b * 4 + 1) * SEQ + off) = (f32x4){o0.y, o1.y, o2.y, o3.y};
        *(GAS f32x4*)(CB + (size_t)(b * 4 + 2) * SEQ + off) = (f32x4){o0.z, o1.z, o2.z, o3.z};
        *(GAS f32x4*)(CB + (size_t)(b * 4 + 3) * SEQ + off) = (f32x4){o0.w, o1.w, o2.w, o3.w}; }
}

struct P1 { bf16 *QA, *IA, *GA, *GB, *QBH, *KBH, *VBH, *GF; float *QS; const float* LB; float* out; };
__device__ __forceinline__ void epi1_4(const P1& p, int m, int c, f32x4 v) {
    const int sec = c >> 9, cs = c & 511;
    const size_t rc = (size_t)m * 512 + cs;
    switch (sec) {
    case 0: st_bf4(p.QA + rc, v); break;
    case 1: { const f32x4 lb = *(const GAS f32x4*)(p.LB + cs); f32x4 g;
#pragma unroll
        for (int i = 0; i < 4; ++i) { const float f = lb[i] + (1.0f - lb[i]) * sigmoidf_(v[i]); g[i] = __logf(f); }
        st_bf4(p.GF + rc, g); } break;
    case 2: st_bf4(p.IA + rc, v); break;
    case 3: { f32x4 g; for (int i = 0; i < 4; ++i) g[i] = siluf_(v[i]); st_bf4(p.GA + rc, g); } break;
    case 4: if (m < MP) { const int b = m >> 13, s = m & 8191, h = cs >> 7, d = cs & 127; st_bf4(p.QBH + ((size_t)((b * 4 + h) * SEQ + s) * HD + d), v); }
            else *(GAS f32x4*)(p.QS + (size_t)(m - MP) * 512 + cs) = v;
            break;
    case 5: if (m < MP) { const int b = m >> 13, s = m & 8191, h = cs >> 7, d = cs & 127; st_bf4(p.KBH + ((size_t)((b * 4 + h) * SEQ + s) * HD + d), v); *(GAS f32x4*)(p.out + O_KP + rc) = v; }
            else *(GAS f32x4*)(p.out + O_KS + (size_t)(m - MP) * 512 + cs) = v;
            break;
    case 6: if (m < MP) { const int b = m >> 13, s = m & 8191, h = cs >> 7, d = cs & 127; st_bf4(p.VBH + ((size_t)((b * 4 + h) * SEQ + s) * HD + d), v); *(GAS f32x4*)(p.out + O_VP + rc) = v; }
            else *(GAS f32x4*)(p.out + O_VS + (size_t)(m - MP) * 512 + cs) = v;
            break;
    default: { f32x4 g; for (int i = 0; i < 4; ++i) g[i] = siluf_(v[i]); st_bf4(p.GB + rc, g); } break;
    }
}
struct P2 { const float *xp, *xs; bf16* X1B; float* SS; };
__device__ __forceinline__ float epi2_4(const P2& p, int m, int c, f32x4 v) {
    const float* xr = m < MP ? p.xp + (size_t)m * DM : p.xs + (size_t)(m - MP) * DM;
    const f32x4 o = *(const GAS f32x4*)(xr + c) + v;
    st_bf4(p.X1B + (size_t)m * DM + c, o);
    return (o.x * o.x + o.y * o.y) + (o.z * o.z + o.w * o.w);
}
struct P3 { bf16 *Q3, *K3, *V3, *G3; const float* SS; };
__device__ __forceinline__ void epi3_4(const P3& p, int m, int c, f32x4 v, float rstd) {
    v = v * rstd;
    if (c < 512) { st_bf4(p.Q3 + (size_t)m * 512 + c, v * ATT_SCALE); }
    else if (c < 1024) { st_bf4(p.K3 + (size_t)m * 512 + (c - 512), v); }
    else if (c < 2048) { st_bf4(p.V3 + (size_t)m * 1024 + (c - 1024), v); }
    else { f32x4 g; for (int i = 0; i < 4; ++i) g[i] = siluf_(v[i]); st_bf4(p.G3 + (size_t)m * 1024 + (c - 2048), g); }
}
struct P4 { const bf16* X1B; float* Y; float* SS; };
__device__ __forceinline__ float epi4_4(const P4& p, int m, int c, f32x4 v) {
    const u32x2v xb = *(const GAS u32x2v*)(p.X1B + (size_t)m * DM + c);
    const f32x4 o = (f32x4){__uint_as_float(xb.x << 16), __uint_as_float(xb.x & 0xffff0000u), __uint_as_float(xb.y << 16), __uint_as_float(xb.y & 0xffff0000u)} + v;
    *(GAS f32x4*)(p.Y + (size_t)m * DM + c) = o;
    return (o.x * o.x + o.y * o.y) + (o.z * o.z + o.w * o.w);
}

__device__ __forceinline__ f32x4 silu4(f32x4 v) { f32x4 g; g.x = siluf_(v.x); g.y = siluf_(v.y); g.z = siluf_(v.z); g.w = siluf_(v.w); return g; }
struct Epi1 { static constexpr bool PERM = true, AFTER_DRAIN = false; P1 p; int skip;
    __device__ __forceinline__ void operator()(const pg8::f32x4 (&acc)[2][2][4][2], const pg8::Unit& u, int wr, int wc, int fr, int fq) const {
        if (skip == 1) { asm volatile("" :: "v"(acc[0][0][0][0][0]), "v"(acc[1][1][3][1][3])); return; }
        if (skip == 2) {
            const int lane_ = threadIdx.x & 63, wv_ = threadIdx.x >> 6; const int sec_ = u.pn >> 1;
            bf16* sb = p.QA + ((size_t)((u.pm * 16 + u.pn) & 255) * 8 + wv_) * 65536;
            int n_ = 0;
#pragma unroll
            for (int ai = 0; ai < 2; ++ai)
#pragma unroll
                for (int m = 0; m < 4; ++m)
#pragma unroll
                    for (int bj = 0; bj < 2; ++bj) { st_bf8(sb + (size_t)n_ * 512 + lane_ * 8, acc[ai][bj][m][0], acc[ai][bj][m][1]); ++n_;
                        if (sec_ == 5 || sec_ == 6 || sec_ == 1) { float* fp = (float*)(sb + 16384) + (size_t)(2 * n_) * 256 + lane_ * 4; *(GAS f32x4*)fp = acc[ai][bj][m][0]; *(GAS f32x4*)(fp + 256) = acc[ai][bj][m][1]; } }
            return; }
        const int sec = u.pn >> 1, row0 = u.pm * 256 + wr * 64 + fr, cs0 = (u.pn & 1) * 256 + wc * 32 + 8 * fq;
#define EPI1_LOOP(...) _Pragma("unroll") for (int ai = 0; ai < 2; ++ai) _Pragma("unroll") for (int m = 0; m < 4; ++m) { const int row = row0 + ai * 128 + m * 16; \
            _Pragma("unroll") for (int bj = 0; bj < 2; ++bj) { const int cs = cs0 + bj * 128; const f32x4 v0 = acc[ai][bj][m][0], v1 = acc[ai][bj][m][1]; __VA_ARGS__ } }
        if (sec == 0) { EPI1_LOOP( st_bf8(p.QA + (size_t)row * 512 + cs, v0, v1); ) }
        else if (sec == 2) { EPI1_LOOP( st_bf8(p.IA + (size_t)row * 512 + cs, v0, v1); ) }
        else if (sec == 3) { EPI1_LOOP( st_bf8(p.GA + (size_t)row * 512 + cs, silu4(v0), silu4(v1)); ) }
        else if (sec == 7) { EPI1_LOOP( st_bf8(p.GB + (size_t)row * 512 + cs, silu4(v0), silu4(v1)); ) }
        else if (sec == 1) {
            f32x4 lb[2][2];
#pragma unroll
            for (int bj = 0; bj < 2; ++bj) { lb[bj][0] = *(const GAS f32x4*)(p.LB + cs0 + bj * 128); lb[bj][1] = *(const GAS f32x4*)(p.LB + cs0 + bj * 128 + 4); }
            EPI1_LOOP( f32x4 g0, g1;
                _Pragma("unroll") for (int i = 0; i < 4; ++i) { g0[i] = __logf(lb[bj][0][i] + (1.0f - lb[bj][0][i]) * sigmoidf_(v0[i])); g1[i] = __logf(lb[bj][1][i] + (1.0f - lb[bj][1][i]) * sigmoidf_(v1[i])); }
                st_bf8(p.GF + (size_t)row * 512 + cs, g0, g1); )
        } else {
            bf16* hb = sec == 4 ? p.QBH : sec == 5 ? p.KBH : p.VBH;
            float* fo = sec == 5 ? p.out + O_KP : p.out + O_VP;
            const int hbase = (u.pn & 1) * 2, d = wc * 32 + 8 * fq;
            EPI1_LOOP( const int b = row >> 13, s = row & 8191;
                st_bf8(hb + ((size_t)((b * 4 + hbase + bj) * SEQ + s) * HD + d), v0, v1);
                if (sec != 4) { float* op = fo + (size_t)row * 512 + cs; __builtin_nontemporal_store(v0, (GAS f32x4*)op); __builtin_nontemporal_store(v1, (GAS f32x4*)(op + 4)); } )
        }
#undef EPI1_LOOP
    } };
struct Epi2 { static constexpr bool PERM = true, AFTER_DRAIN = false; P2 p;
    __device__ __forceinline__ void operator()(const pg8::f32x4 (&acc)[2][2][4][2], const pg8::Unit& u, int wr, int wc, int fr, int fq) const {
        const int row0 = u.pm * 256 + wr * 64 + fr, c0 = u.pn * 256 + wc * 32 + 8 * fq;
#pragma unroll
        for (int ai = 0; ai < 2; ++ai)
#pragma unroll
            for (int m = 0; m < 4; ++m) { const int row = row0 + ai * 128 + m * 16; float ss = 0.f;
#pragma unroll
                for (int bj = 0; bj < 2; ++bj) { const size_t off = (size_t)row * DM + c0 + bj * 128;
                    const f32x4 o0 = *(const GAS f32x4*)(p.xp + off) + acc[ai][bj][m][0], o1 = *(const GAS f32x4*)(p.xp + off + 4) + acc[ai][bj][m][1];
                    st_bf8(p.X1B + off, o0, o1);
                    ss += ((o0.x * o0.x + o0.y * o0.y) + (o0.z * o0.z + o0.w * o0.w)) + ((o1.x * o1.x + o1.y * o1.y) + (o1.z * o1.z + o1.w * o1.w)); }
                ss += __shfl_xor(ss, 16); ss += __shfl_xor(ss, 32);
                if (fq == 0) atomicAdd(p.SS + row, ss); }
    } };
struct Epi3 { static constexpr bool PERM = true, AFTER_DRAIN = false; P3 p; int skip;
    __device__ __forceinline__ void operator()(const pg8::f32x4 (&acc)[2][2][4][2], const pg8::Unit& u, int wr, int wc, int fr, int fq) const {
        if (skip) { asm volatile("" :: "v"(acc[0][0][0][0][0]), "v"(acc[1][1][3][1][3])); return; }
        const int row0 = u.pm * 256 + wr * 64 + fr, cl = (u.pn * 256 + wc * 32 + 8 * fq);
        const int kind = u.pn < 2 ? 0 : u.pn < 4 ? 1 : u.pn < 8 ? 2 : 3;
        bf16* dst = kind == 0 ? p.Q3 : kind == 1 ? p.K3 : kind == 2 ? p.V3 : p.G3;
        const int ld = kind < 2 ? 512 : 1024, cb = kind == 0 ? cl : kind == 1 ? cl - 512 : kind == 2 ? cl - 1024 : cl - 2048;
#pragma unroll
        for (int ai = 0; ai < 2; ++ai)
#pragma unroll
            for (int m = 0; m < 4; ++m) { const int row = row0 + ai * 128 + m * 16;
                float rstd = 1.0f / sqrtf(__hip_atomic_load(p.SS + row, __ATOMIC_RELAXED, __HIP_MEMORY_SCOPE_AGENT) * (1.f / DM) + EPS);
                if (kind == 0) rstd *= ATT_SCALE;
#pragma unroll
                for (int bj = 0; bj < 2; ++bj) { f32x4 v0 = acc[ai][bj][m][0] * rstd, v1 = acc[ai][bj][m][1] * rstd;
                    if (kind == 3) { v0 = silu4(v0); v1 = silu4(v1); }
                    st_bf8(dst + (size_t)row * ld + cb + bj * 128, v0, v1); } }
    } };
struct Epi4 { static constexpr bool PERM = true, AFTER_DRAIN = false; P4 p;
    __device__ __forceinline__ void operator()(const pg8::f32x4 (&acc)[2][2][4][2], const pg8::Unit& u, int wr, int wc, int fr, int fq) const {
        const int row0 = u.pm * 256 + wr * 64 + fr, c0 = u.pn * 256 + wc * 32 + 8 * fq;
#pragma unroll
        for (int ai = 0; ai < 2; ++ai)
#pragma unroll
            for (int m = 0; m < 4; ++m) { const int row = row0 + ai * 128 + m * 16; float ss = 0.f;
#pragma unroll
                for (int bj = 0; bj < 2; ++bj) { const size_t off = (size_t)row * DM + c0 + bj * 128;
                    const v4u xb = *(const GAS v4u*)(p.X1B + off);
                    const f32x4 o0 = (f32x4){__uint_as_float(xb.x << 16), __uint_as_float(xb.x & 0xffff0000u), __uint_as_float(xb.y << 16), __uint_as_float(xb.y & 0xffff0000u)} + acc[ai][bj][m][0];
                    const f32x4 o1 = (f32x4){__uint_as_float(xb.z << 16), __uint_as_float(xb.z & 0xffff0000u), __uint_as_float(xb.w << 16), __uint_as_float(xb.w & 0xffff0000u)} + acc[ai][bj][m][1];
                    *(GAS f32x4*)(p.Y + off) = o0; *(GAS f32x4*)(p.Y + off + 4) = o1;
                    ss += ((o0.x * o0.x + o0.y * o0.y) + (o0.z * o0.z + o0.w * o0.w)) + ((o1.x * o1.x + o1.y * o1.y) + (o1.z * o1.z + o1.w * o1.w)); }
                ss += __shfl_xor(ss, 16); ss += __shfl_xor(ss, 32);
                if (fq == 0) atomicAdd(p.SS + row, ss); }
    } };

struct Epi4F { static constexpr bool PERM = true, AFTER_DRAIN = true; P4 p; const float* gain; const XcdBarrier* bar;
    __device__ __forceinline__ void fused(pg8::f32x4 (&acc)[2][2][4][2], const pg8::Unit& u, int wr, int wc, int fr, int fq, PG8_LAS unsigned char* lds, int wid, int lane) const {
        const int row0 = u.pm * 256 + wr * 64 + fr, c0 = u.pn * 256 + wc * 32 + 8 * fq;
#pragma unroll
        for (int ai = 0; ai < 2; ++ai)
#pragma unroll
            for (int m = 0; m < 4; ++m) { const int row = row0 + ai * 128 + m * 16; float ss = 0.f;
#pragma unroll
                for (int bj = 0; bj < 2; ++bj) { const size_t off = (size_t)row * DM + c0 + bj * 128;
                    const v4u xb = *(const GAS v4u*)(p.X1B + off);
                    const f32x4 o0 = (f32x4){__uint_as_float(xb.x << 16), __uint_as_float(xb.x & 0xffff0000u), __uint_as_float(xb.y << 16), __uint_as_float(xb.y & 0xffff0000u)} + acc[ai][bj][m][0];
                    const f32x4 o1 = (f32x4){__uint_as_float(xb.z << 16), __uint_as_float(xb.z & 0xffff0000u), __uint_as_float(xb.w << 16), __uint_as_float(xb.w & 0xffff0000u)} + acc[ai][bj][m][1];
                    acc[ai][bj][m][0] = o0; acc[ai][bj][m][1] = o1;
                    ss += ((o0.x * o0.x + o0.y * o0.y) + (o0.z * o0.z + o0.w * o0.w)) + ((o1.x * o1.x + o1.y * o1.y) + (o1.z * o1.z + o1.w * o1.w)); }
                ss += __shfl_xor(ss, 16); ss += __shfl_xor(ss, 32);
                if (fq == 0) atomicAdd(p.SS + row, ss); }
        xcd_barrier(*bar);
        f32x4 g[2][2];
#pragma unroll
        for (int bj = 0; bj < 2; ++bj) { g[bj][0] = *(const GAS f32x4*)(gain + c0 + bj * 128); g[bj][1] = *(const GAS f32x4*)(gain + c0 + bj * 128 + 4); }
#pragma unroll
        for (int ai = 0; ai < 2; ++ai)
#pragma unroll
            for (int m = 0; m < 4; ++m) { const int row = row0 + ai * 128 + m * 16;
                const float rstd = 1.0f / sqrtf(__hip_atomic_load(p.SS + row, __ATOMIC_RELAXED, __HIP_MEMORY_SCOPE_AGENT) * (1.f / DM) + EPS);
#pragma unroll
                for (int bj = 0; bj < 2; ++bj) { const size_t off = (size_t)row * DM + c0 + bj * 128;
                    *(GAS f32x4*)(p.Y + off) = acc[ai][bj][m][0] * rstd * g[bj][0]; *(GAS f32x4*)(p.Y + off + 4) = acc[ai][bj][m][1] * rstd * g[bj][1]; } }
    } };

template <class EpiF>
__device__ __forceinline__ void sgemm_unit(const bf16* A, const bf16* WT, int u, int wave, int lane, const EpiF& epi) {
    const int fr = lane & 15, fq = lane >> 4;
    const GAS bf16x8* wp = (const GAS bf16x8*)(WT + (size_t)(16 * u + fr) * DM + 8 * fq);
    const GAS bf16x8* ap = (const GAS bf16x8*)(A + (size_t)(MP + 16 * wave + fr) * DM + 8 * fq);
    pg8::f32x4 acc = {0.f, 0.f, 0.f, 0.f};
#pragma unroll 1
    for (int k0 = 0; k0 < 32; k0 += 16) {
        bf16x8 wv[16], av[16];
#pragma unroll
        for (int i = 0; i < 16; ++i) { wv[i] = wp[(k0 + i) * 4]; av[i] = ap[(k0 + i) * 4]; }
#pragma unroll
        for (int i = 0; i < 16; ++i) acc = __builtin_amdgcn_mfma_f32_16x16x32_bf16(wv[i], av[i], acc, 0, 0, 0);
    }
    epi(MP + 16 * wave + fr, 16 * u + 4 * fq, acc);
}

typedef short s16x4 __attribute__((ext_vector_type(4)));

struct LaArgs {
    const bf16* Q; const bf16* Kp; const bf16* G;
    const bf16* V; const bf16* GATE; int ldv;
    const float* gain;
    bf16* MIXo; int mixoff;
    bf16* SBUF; float* BTOT;
    const float* S0; float* S1;
};
template <int DV, bool HAS_K, int MODE>
__device__ __forceinline__ void la_unit(LAS unsigned char* lds, const LaArgs& a, int m0, int h, int tid, int wave, int lane) {
    constexpr int NVT = DV / 128, NCH = 4, TV = 64; static_assert(MODE == 0 || MODE == 1, "la_unit modes");
    constexpr bool FULL = MODE != 0;
    constexpr int VS = DV + 8;
    constexpr int R0 = 0;
    constexpr int R1 = 17408;
    constexpr int R2 = 34816, R2_SZ = (DV * 144 > 33792) ? DV * 144 : 33792;
    constexpr int R3 = R2 + R2_SZ, R3_SZ = 64 * VS * 2;
    constexpr int K2T_OFF = R3 + R3_SZ;
    constexpr int P_OFF = K2T_OFF + 18432;
    constexpr int TOT_OFF = P_OFF + 9216, EBR_OFF = TOT_OFF + 4096, EBL_OFF = EBR_OFF + 512, SSQ_OFF = EBL_OFF + 512;
    static_assert(SSQ_OFF + 2048 <= LDSCTL_OFF, "LA LDS");
    constexpr int A1_OFF = R0, K1_OFF = R1, VT_OFF = R2;
    LAS float* TOT = (LAS float*)(lds + TOT_OFF); LAS float* EBR = (LAS float*)(lds + EBR_OFF); LAS float* EBL = (LAS float*)(lds + EBL_OFF); LAS float* SSQ = (LAS float*)(lds + SSQ_OFF);
    f32x4 S[8][NVT];
#pragma unroll
    for (int kp = 0; kp < 4; ++kp)
#pragma unroll
        for (int vt = 0; vt < NVT; ++vt) {
            if (MODE == 0) { S[2 * kp][vt] = (f32x4){0.f, 0.f, 0.f, 0.f}; S[2 * kp + 1][vt] = (f32x4){0.f, 0.f, 0.f, 0.f}; }
            else { const v4u sv = *(const GAS v4u*)(a.SBUF + ((size_t)((wave * 4 + kp) * NVT + vt) * 64 + lane) * 8);
                S[2 * kp][vt] = (f32x4){__uint_as_float(sv.x << 16), __uint_as_float(sv.x & 0xffff0000u), __uint_as_float(sv.y << 16), __uint_as_float(sv.y & 0xffff0000u)};
                S[2 * kp + 1][vt] = (f32x4){__uint_as_float(sv.z << 16), __uint_as_float(sv.z & 0xffff0000u), __uint_as_float(sv.w << 16), __uint_as_float(sv.w & 0xffff0000u)}; }
        }
    constexpr int NV = NVT * 2, VCH = DV / 8;
    v4u rg[2], rq[2], rk[2], rv[NV];
#define TZ(name) int name = tid; asm volatile("" : "+v"(name))
#define LB(name, off) LAS unsigned char* name = lds + (off); asm volatile("" : "+v"(name))
#define LA_LOAD(chn) do { const int mr_ = m0 + 64 * (chn); TZ(tz_);                                                                                            \
        const bf16* gb_ = a.G + (size_t)mr_ * 512 + h * 128;  const bf16* qb_ = a.Q + (size_t)mr_ * 512 + h * 128; const bf16* kb_ = HAS_K ? a.Kp + (size_t)mr_ * 512 + h * 128 : nullptr; \
        const bf16* vb_ = a.V + (size_t)mr_ * a.ldv + h * DV;                                                                                                 \
        _Pragma("unroll") for (int i_ = 0; i_ < 2; ++i_) { const int e_ = tz_ + 512 * i_; const unsigned o_ = (unsigned)((e_ >> 4) * 512 + 8 * (e_ & 15));   \
            rg[i_] = *(const GAS v4u*)(gb_ + o_); if (FULL) rq[i_] = *(const GAS v4u*)(qb_ + o_); if (HAS_K) rk[i_] = *(const GAS v4u*)(kb_ + o_); }                                              \
        _Pragma("unroll") for (int i_ = 0; i_ < NV; ++i_) { const int e_ = tz_ + 512 * i_; rv[i_] = *(const GAS v4u*)(vb_ + (unsigned)((e_ / VCH) * a.ldv + 8 * (e_ % VCH))); } } while (0)
    LA_LOAD(0);
    float btot_run_A = 0.f, btot_run_B = 0.f;
#pragma unroll 1
    for (int ch = 0; ch < NCH; ++ch) {
        const int mr0 = m0 + 64 * ch;
        v4u gt[NV];
        { TZ(tz);
#pragma unroll
        for (int i = 0; i < 2; ++i) { const int e = tz + 512 * i, row = e >> 4;
            { LAS f32x4* gp = (LAS f32x4*)(lds + R2 + (row * 132 + 8 * (e & 15)) * 4);
              gp[0] = (f32x4){__uint_as_float(rg[i].x << 16), __uint_as_float(rg[i].x & 0xffff0000u), __uint_as_float(rg[i].y << 16), __uint_as_float(rg[i].y & 0xffff0000u)};
              gp[1] = (f32x4){__uint_as_float(rg[i].z << 16), __uint_as_float(rg[i].z & 0xffff0000u), __uint_as_float(rg[i].w << 16), __uint_as_float(rg[i].w & 0xffff0000u)}; }
            if (FULL) *(LAS v4u*)(lds + R0 + (row * 136 + 8 * (e & 15)) * 2) = rq[i];
            if (HAS_K) *(LAS v4u*)(lds + R1 + (row * 136 + 8 * (e & 15)) * 2) = rk[i]; }
#pragma unroll
        for (int i = 0; i < NV; ++i) { const int e = tz + 512 * i, row = e / VCH; *(LAS v4u*)(lds + R3 + (row * VS + 8 * (e % VCH)) * 2) = rv[i]; } }
        __syncthreads();
        if (NCH > 1) { const int chn = ch + 1 < NCH ? ch + 1 : ch; LA_LOAD(chn); }
        if (FULL) { const bf16* gtb = a.GATE + (size_t)mr0 * a.ldv + h * DV; TZ(tz);
#pragma unroll
            for (int i = 0; i < NV; ++i) { const int e = tz + 512 * i; gt[i] = *(const GAS v4u*)(gtb + (unsigned)((e / VCH) * a.ldv + 8 * (e % VCH))); } }
        {
        TZ(tzb); const int c2 = tzb & 63, seg = tzb >> 6, cA = 2 * c2;
        float gA[8], gB[8], kA[8], kB[8], qA[8], qB[8];
        LB(bG, R2 + (8 * seg * 132 + cA) * 4); LB(bQ, R0 + (8 * seg * 136 + cA) * 2); LB(bK, R1 + (8 * seg * 136 + cA) * 2);
#pragma unroll
        for (int i = 0; i < 8; ++i) {
            const f32x2_t gg = *(const LAS f32x2_t*)(bG + i * 528); gA[i] = gg.x; gB[i] = gg.y;
            if (FULL) { const unsigned qq = *(const LAS unsigned*)(bQ + i * 272); qA[i] = __uint_as_float(qq << 16); qB[i] = __uint_as_float(qq & 0xffff0000u); }
            if (HAS_K) { const unsigned kk = *(const LAS unsigned*)(bK + i * 272); kA[i] = __uint_as_float(kk << 16); kB[i] = __uint_as_float(kk & 0xffff0000u); } }
#pragma unroll
        for (int i = 0; i < 8; ++i) { if (!HAS_K) { kA[i] = 1.0f - __expf(gA[i]); kB[i] = 1.0f - __expf(gB[i]); } if (i) { gA[i] += gA[i - 1]; gB[i] += gB[i - 1]; } }
        LB(bT, TOT_OFF + cA * 4);
        *(LAS f32x2_t*)(bT + seg * 512) = (f32x2_t){gA[7], gB[7]};
        __syncthreads();
        float preA = 0.f, preB = 0.f, brA = 0.f, brB = 0.f, blA = 0.f, blB = 0.f;
#pragma unroll
        for (int q = 0; q < 8; ++q) { const f32x2_t tt_ = *(const LAS f32x2_t*)(bT + q * 512);
            if (q < seg) { preA += tt_.x; preB += tt_.y; } if (q < 4) { brA += tt_.x; brB += tt_.y; } blA += tt_.x; blB += tt_.y; }
        if (seg == 0) { *(LAS f32x2_t*)(bT + (EBR_OFF - TOT_OFF)) = (f32x2_t){__expf(brA), __expf(brB)}; *(LAS f32x2_t*)(bT + (EBL_OFF - TOT_OFF)) = (f32x2_t){__expf(blA), __expf(blB)}; btot_run_A += blA; btot_run_B += blB; }
        {   unsigned k2a[4], k2b[4];
#pragma unroll
            for (int i = 0; i < 8; i += 2) { const float a0 = gA[i] + preA, a1 = gA[i + 1] + preA, b0 = gB[i] + preB, b1 = gB[i + 1] + preB;
                k2a[i >> 1] = cvtpk_s(kA[i] * __expf(blA - a0), kA[i + 1] * __expf(blA - a1));
                k2b[i >> 1] = cvtpk_s(kB[i] * __expf(blB - b0), kB[i + 1] * __expf(blB - b1));
                if (FULL) {
                    *(LAS unsigned*)(bQ + i * 272) = cvtpk_s(qA[i] * __expf(a0 - brA), qB[i] * __expf(b0 - brB));
                    *(LAS unsigned*)(bQ + (i + 1) * 272) = cvtpk_s(qA[i + 1] * __expf(a1 - brA), qB[i + 1] * __expf(b1 - brB));
                    *(LAS unsigned*)(bK + i * 272) = cvtpk_s(kA[i] * __expf(brA - a0), kB[i] * __expf(brB - b0));
                    *(LAS unsigned*)(bK + (i + 1) * 272) = cvtpk_s(kA[i + 1] * __expf(brA - a1), kB[i + 1] * __expf(brB - b1)); } }
            LB(bK2, K2T_OFF + (cA * 72 + 8 * seg) * 2);
            *(LAS v4u*)(bK2) = (v4u){k2a[0], k2a[1], k2a[2], k2a[3]};
            *(LAS v4u*)(bK2 + 144) = (v4u){k2b[0], k2b[1], k2b[2], k2b[3]}; }
        LB(bVr, R3 + (8 * seg * VS + cA) * 2); LB(bVw, VT_OFF + (cA * 72 + 8 * seg) * 2);
#pragma unroll
        for (int ps = 0; ps < NVT; ++ps) { unsigned vv[8];
#pragma unroll
            for (int i = 0; i < 8; ++i) vv[i] = *(const LAS unsigned*)(bVr + (i * VS + 128 * ps) * 2);
            v4u wa, wb;
            wa.x = (vv[0] & 0xffffu) | (vv[1] << 16); wa.y = (vv[2] & 0xffffu) | (vv[3] << 16); wa.z = (vv[4] & 0xffffu) | (vv[5] << 16); wa.w = (vv[6] & 0xffffu) | (vv[7] << 16);
            wb.x = (vv[0] >> 16) | (vv[1] & 0xffff0000u); wb.y = (vv[2] >> 16) | (vv[3] & 0xffff0000u); wb.z = (vv[4] >> 16) | (vv[5] & 0xffff0000u); wb.w = (vv[6] >> 16) | (vv[7] & 0xffff0000u);
            *(LAS v4u*)(bVw + 128 * ps * 144) = wa; *(LAS v4u*)(bVw + 128 * ps * 144 + 144) = wb; }
        }
        __syncthreads();
        if (FULL) {
            TZ(tzc); const int lc = tzc & 63, fr = lc & 15, fq = lc >> 4, wv = __builtin_amdgcn_readfirstlane(tzc >> 6);
            const int tt = wv >> 1, st0 = 2 * (wv & 1);
            f32x4 p0 = {0.f, 0.f, 0.f, 0.f}, p1 = {0.f, 0.f, 0.f, 0.f};
            LB(bA, A1_OFF + ((16 * tt + fr) * 136 + 8 * fq) * 2); LB(bB, K1_OFF + ((16 * st0 + fr) * 136 + 8 * fq) * 2);
#pragma unroll
            for (int ks = 0; ks < 4; ++ks) {
                const bf16x8 av = *(const LAS bf16x8*)(bA + ks * 64);
                const bf16x8 b0 = *(const LAS bf16x8*)(bB + ks * 64);
                const bf16x8 b1 = *(const LAS bf16x8*)(bB + 16 * 272 + ks * 64);
                p0 = __builtin_amdgcn_mfma_f32_16x16x32_bf16(av, b0, p0, 0, 0, 0);
                p1 = __builtin_amdgcn_mfma_f32_16x16x32_bf16(av, b1, p1, 0, 0, 0);
            }
            LB(bP, P_OFF + ((16 * tt + 4 * fq) * 72 + 16 * st0 + fr) * 2);
#pragma unroll
            for (int j = 0; j < 4; ++j) { const int t = 16 * tt + 4 * fq + j, s0 = 16 * st0 + fr, s1 = s0 + 16;
                const float x0 = (s0 <= t) ? p0[j] : 0.f, x1 = (s1 <= t) ? p1[j] : 0.f;
                *(LAS bf16*)(bP + j * 144) = (bf16)(cvtpk_s(x0, 0.f) & 0xffffu);
                *(LAS bf16*)(bP + j * 144 + 32) = (bf16)(cvtpk_s(x1, 0.f) & 0xffffu); }
            __syncthreads();
        }
        TZ(tzd); const int ld_ = tzd & 63, fr = ld_ & 15, fq = ld_ >> 4, wave_d = __builtin_amdgcn_readfirstlane(tzd >> 6), vbase = wave_d * (DV / 8);
        bf16x8 vb[NVT][2];
        LB(bVT, VT_OFF + ((vbase + fr) * 72 + 8 * fq) * 2);
#pragma unroll
        for (int vt = 0; vt < NVT; ++vt)
#pragma unroll
            for (int ks = 0; ks < 2; ++ks) vb[vt][ks] = *(const LAS bf16x8*)(bVT + vt * 16 * 144 + ks * 64);
        f32x4 o[4][NVT];
        if (FULL) {
            LB(bPr, P_OFF + (fr * 72 + 8 * fq) * 2); LB(bE, EBR_OFF + 16 * fq); LB(bA4, A1_OFF + (fr * 136 + 4 * fq) * 2);
#pragma unroll
            for (int tt = 0; tt < 4; ++tt)
#pragma unroll
                for (int vt = 0; vt < NVT; ++vt) o[tt][vt] = (f32x4){0.f, 0.f, 0.f, 0.f};
#pragma unroll
            for (int tt = 0; tt < 4; ++tt)
#pragma unroll
                for (int ks = 0; ks < 2; ++ks) { const bf16x8 pa = *(const LAS bf16x8*)(bPr + tt * 16 * 144 + ks * 64);
#pragma unroll
                    for (int vt = 0; vt < NVT; ++vt) o[tt][vt] = __builtin_amdgcn_mfma_f32_16x16x32_bf16(pa, vb[vt][ks], o[tt][vt], 0, 0, 0); }
#pragma unroll
            for (int ks = 0; ks < 4; ++ks) {
                const f32x4 e0 = *(const LAS f32x4*)(bE + ks * 128), e1 = *(const LAS f32x4*)(bE + ks * 128 + 64);
                bf16x8 sb[NVT];
#pragma unroll
                for (int vt = 0; vt < NVT; ++vt) sb[vt] = pack8f(S[2 * ks][vt] * e0, S[2 * ks + 1][vt] * e1);
#pragma unroll
                for (int tt = 0; tt < 4; ++tt) {
                    const s16x4 alo = *(const LAS s16x4*)(bA4 + tt * 16 * 272 + ks * 64);
                    const s16x4 ahi = *(const LAS s16x4*)(bA4 + tt * 16 * 272 + ks * 64 + 32);
                    const bf16x8 aa = __builtin_shufflevector(alo, ahi, 0, 1, 2, 3, 4, 5, 6, 7);
#pragma unroll
                    for (int vt = 0; vt < NVT; ++vt) o[tt][vt] = __builtin_amdgcn_mfma_f32_16x16x32_bf16(aa, sb[vt], o[tt][vt], 0, 0, 0);
                }
            }
        }
        LB(bL, EBL_OFF + 16 * fq); LB(bK2r, K2T_OFF + (fr * 72 + 8 * fq) * 2);
#pragma unroll
        for (int kt = 0; kt < 8; ++kt) {
            const f32x4 el = *(const LAS f32x4*)(bL + kt * 64);
#pragma unroll
            for (int vt = 0; vt < NVT; ++vt) S[kt][vt] = S[kt][vt] * el;
#pragma unroll
            for (int ks = 0; ks < 2; ++ks) { const bf16x8 ka = *(const LAS bf16x8*)(bK2r + kt * 16 * 144 + ks * 64);
#pragma unroll
                for (int vt = 0; vt < NVT; ++vt) S[kt][vt] = __builtin_amdgcn_mfma_f32_16x16x32_bf16(ka, vb[vt][ks], S[kt][vt], 0, 0, 0); }
        }
        if (FULL) {
            LB(bS, SSQ_OFF + (wave_d * 64 + 4 * fq) * 4); LB(bR, TOT_OFF + 16 * fq); LB(bO, R3 + ((4 * fq) * VS + vbase + fr) * 2);
#pragma unroll
            for (int tt = 0; tt < 4; ++tt) { f32x4 ss = {0.f, 0.f, 0.f, 0.f};
#pragma unroll
                for (int vt = 0; vt < NVT; ++vt) ss += o[tt][vt] * o[tt][vt];
#pragma unroll
                for (int j = 0; j < 4; ++j) ss[j] = row16_sum(ss[j]);
                if (fr == 0) *(LAS f32x4*)(bS + tt * 64) = ss; }
            __syncthreads();
            if (ld_ < 8) { const int t = 8 * wave_d + ld_; float tot = 0.f;
#pragma unroll
                for (int w = 0; w < 8; ++w) tot += SSQ[w * 64 + t];
                TOT[t] = 1.0f / sqrtf(tot * (1.0f / DV) + EPS); }
            float gn[NVT];
#pragma unroll
            for (int vt = 0; vt < NVT; ++vt) gn[vt] = a.gain[h * DV + vbase + 16 * vt + fr];
            __syncthreads();
#pragma unroll
            for (int tt = 0; tt < 4; ++tt) {
                const f32x4 rs = *(const LAS f32x4*)(bR + tt * 64);
#pragma unroll
                for (int j = 0; j < 4; ++j) { const int t = 16 * tt + 4 * fq + j;
#pragma unroll
                    for (int vt = 0; vt < NVT; ++vt) { const float val = o[tt][vt][j] * rs[j] * gn[vt]; const float vn = dppf<0xB1>(val);
                        if ((fr & 1) == 0) *(LAS unsigned*)(bO + ((16 * tt + j) * VS + 16 * vt) * 2) = cvtpk_s(val, vn); } }
            }
            __syncthreads();
            TZ(tze);
#pragma unroll
            for (int i = 0; i < NV; ++i) { const int e = tze + 512 * i, row = e / VCH;
                { const v4u ov = *(const LAS v4u*)(lds + R3 + (row * VS + 8 * (e % VCH)) * 2); v4u w;
#pragma unroll
                    for (int k = 0; k < 4; ++k) w[k] = cvtpk_s(__uint_as_float(ov[k] << 16) * __uint_as_float(gt[i][k] << 16), __uint_as_float(ov[k] & 0xffff0000u) * __uint_as_float(gt[i][k] & 0xffff0000u));
                    *(GAS v4u*)(a.MIXo + (size_t)(mr0 + row) * 1024 + a.mixoff + h * DV + 8 * (e % VCH)) = w; } }
        }
        __syncthreads();
    }
#undef LA_LOAD
#undef TZ
#undef LB
    if (MODE == 0) {
#pragma unroll
        for (int kp = 0; kp < 4; ++kp)
#pragma unroll
            for (int vt = 0; vt < NVT; ++vt) st_bf8(a.SBUF + ((size_t)((wave * 4 + kp) * NVT + vt) * 64 + lane) * 8, S[2 * kp][vt], S[2 * kp + 1][vt]);
        if ((tid >> 6) == 0) { a.BTOT[2 * (tid & 63)] = btot_run_A; a.BTOT[2 * (tid & 63) + 1] = btot_run_B; }
    }
}

template <int DV, bool HAS_K>
__device__ __forceinline__ void la_sample_unit(LAS unsigned char* lds, const LaArgs& a, int u, int tid, int wave, int lane) {
    constexpr int KS = 512 / DV, KPT = 128 / KS, NOUT = 4 * DV / 512;
    const int b = u >> 2, h = u & 3, m0 = MP + b * 4;
    LAS float* EG = (LAS float*)lds; LAS float* KK = EG + 512; LAS float* QQ = KK + 512; LAS float* RED = QQ + 512; LAS float* WS = RED + 4 * KS * DV;
    { const int t = tid >> 7, k = tid & 127; const size_t off = (size_t)(m0 + t) * 512 + h * 128 + k;
      const float g = bf2f(a.G[off]), eg = __expf(g); EG[tid] = eg; KK[tid] = HAS_K ? bf2f(a.Kp[off]) : 1.0f - eg; QQ[tid] = bf2f(a.Q[off]); }
    __syncthreads();
    const int v = tid % DV, ks = tid / DV, k0 = ks * KPT;
    float S[KPT];
    { const float* sp = a.S0 + (size_t)k0 * DV + v;
#pragma unroll
      for (int i0 = 0; i0 < KPT; i0 += 4) { asm volatile("" : "+v"(sp));
#pragma unroll
          for (int i = 0; i < 4; ++i) S[i0 + i] = sp[i * DV];
          sp += 4 * DV; } }
#pragma unroll
    for (int t = 0; t < 4; ++t) {
        const float vt = bf2f(a.V[(size_t)(m0 + t) * a.ldv + h * DV + v]); float o = 0.f;
#pragma unroll
        for (int i = 0; i < KPT; ++i) { S[i] = S[i] * EG[t * 128 + k0 + i] + KK[t * 128 + k0 + i] * vt; o += S[i] * QQ[t * 128 + k0 + i]; }
        RED[(t * KS + ks) * DV + v] = o;
    }
    { float* sp = a.S1 + (size_t)k0 * DV + v;
#pragma unroll
      for (int i0 = 0; i0 < KPT; i0 += 4) { asm volatile("" : "+v"(sp));
#pragma unroll
          for (int i = 0; i < 4; ++i) sp[i * DV] = S[i0 + i];
          sp += 4 * DV; } }
    __syncthreads();
    float ov[NOUT];
#pragma unroll
    for (int j = 0; j < NOUT; ++j) { const int idx = tid + 512 * j, t = idx / DV, vv = idx % DV; float o = 0.f;
#pragma unroll
        for (int q = 0; q < KS; ++q) o += RED[(t * KS + q) * DV + vv];
        ov[j] = o; const float ss = wave_sum(o * o); if (lane == 0) WS[j * 8 + wave] = ss; }
    __syncthreads();
#pragma unroll
    for (int j = 0; j < NOUT; ++j) { const int idx = tid + 512 * j, t = idx / DV, vv = idx % DV;
        constexpr int WPT = DV / 64;
        const int w0 = (wave / WPT) * WPT; float tot = 0.f;
#pragma unroll
        for (int q = 0; q < WPT; ++q) tot += WS[j * 8 + w0 + q];
        const float rstd = 1.0f / sqrtf(tot * (1.0f / DV) + EPS); const size_t row = (size_t)(m0 + t);
        const float val = ov[j] * rstd * a.gain[h * DV + vv] * bf2f(a.GATE[row * a.ldv + h * DV + vv]);
        a.MIXo[row * 1024 + a.mixoff + h * DV + vv] = (bf16)(cvtpk_s(val, 0.f) & 0xffffu); }
    __syncthreads();
}

template <int DV>
__device__ __forceinline__ void la_scan(bf16* SLOC, const float* BTOT, float* outstate, int gtid, int gthreads) {
    constexpr int NVT = DV / 128, LP = 8192 * NVT;
    GAS unsigned* SW = (GAS unsigned*)SLOC;
    for (int eg = gtid; eg < 8 * LP; eg += gthreads) {
        const int bh = eg / LP, e = eg % LP;
        const int jj = e & 1, kk = (e >> 1) & 1, ln = (e >> 2) & 63, rest = e >> 8, vt = rest % NVT, kp = (rest / NVT) & 3, w = rest / (NVT * 4);
        const int k = 16 * (2 * kp + kk) + 4 * (ln >> 4) + 2 * jj, v = w * (DV / 8) + 16 * vt + (ln & 15);
        float c0 = 0.f, c1 = 0.f;
        {   constexpr int s0 = 0;
            unsigned loc[32]; f32x2_t dec[32];
#pragma unroll
            for (int sc = 0; sc < 32; ++sc) { loc[sc] = SW[(size_t)(bh * 32 + s0 + sc) * LP + e]; dec[sc] = *(const GAS f32x2_t*)(BTOT + (size_t)(bh * 32 + s0 + sc) * 128 + k); }
#pragma unroll
            for (int sc = 0; sc < 32; ++sc) { SW[(size_t)(bh * 32 + s0 + sc) * LP + e] = cvtpk_s(c0, c1);
                c0 = c0 * __expf(dec[sc].x) + __uint_as_float(loc[sc] << 16); c1 = c1 * __expf(dec[sc].y) + __uint_as_float(loc[sc] & 0xffff0000u); }
        }
        outstate[(size_t)(bh * 128 + k) * DV + v] = c0; outstate[(size_t)(bh * 128 + k + 1) * DV + v] = c1;
    }
}

namespace fox {
using TIN = __hip_bfloat16; using TOUT = __hip_bfloat16;
constexpr int D = 128, SKV = 8192, WINDOW = SKV; constexpr float THR = 8.f; constexpr bool WSKIP = false;
constexpr int OSTR = 1024, GSTR = 512;
constexpr float SCALE = 0.08838834764831845f;
constexpr int NW = 8, QBLK = 32, KVBLK = 64, QB = NW * QBLK;
constexpr int SHM_V = KVBLK * D * 2, SHM_K = KVBLK * D * 2;
constexpr int LDS_BIAS = 2 * SHM_V + 2 * SHM_K + NW * 64 * 4;
constexpr int LDS_BYTES = LDS_BIAS + 512;
constexpr int ORS = 136, OST_WAVE = 32 * ORS * 2, OST_OFF = 69632;

using bf16 = __hip_bfloat16;
typedef short bf16x8 __attribute__((ext_vector_type(8)));
typedef short s16x4 __attribute__((ext_vector_type(4)));
typedef float f32x16 __attribute__((ext_vector_type(16)));
typedef float f32x4 __attribute__((ext_vector_type(4)));
typedef unsigned u32x4 __attribute__((ext_vector_type(4)));
template <class A, class Bt> struct same_t { static constexpr bool v = false; };
template <class A> struct same_t<A, A> { static constexpr bool v = true; };

#define KSWZ(row, colB) ((row) * 256 + ((colB) ^ (((row) & 7) << 4)))
#define SBAR() __builtin_amdgcn_sched_barrier(0)
__device__ __forceinline__ int v_st(int k, int c) { const int kk = (k & ~0xC) | ((k & 4) << 1) | ((k & 8) >> 1); return ((kk >> 3) * 4 + (c >> 5)) * 512 + ((kk & 7) * 32 + (c & 31)) * 2; }
__device__ __forceinline__ int v_rd_base(int lane) { return ((lane & 3) << 3) | (((lane >> 2) & 3) << 6) | (((lane >> 4) & 1) << 5) | (((lane >> 5) & 1) << 8); }
constexpr int v_rd_off(int d0, int ks, int half) { return d0 * 512 + ks * 4096 + half * 2048; }
__device__ __forceinline__ int crow(int r, int hi) { return (r & 3) + 8 * (r >> 2) + 4 * hi; }
__device__ __forceinline__ unsigned cvtpk(float lo, float hi) {
    unsigned r; asm volatile("v_cvt_pk_bf16_f32 %0, %1, %2" : "=v"(r) : "v"(lo), "v"(hi)); return r;
}
__device__ __forceinline__ bf16x8 pack8(f32x4 a, f32x4 b) {
    u32x4 w = {cvtpk(a[0], a[1]), cvtpk(a[2], a[3]), cvtpk(b[0], b[1]), cvtpk(b[2], b[3])};
    return *reinterpret_cast<bf16x8*>(&w);
}
template <class T> __device__ __forceinline__ bf16x8 load8(const T* p) {
    if constexpr (same_t<T, float>::v) { return pack8(*(const f32x4*)p, *(const f32x4*)(p + 4)); }
    else { return *reinterpret_cast<const bf16x8*>(p); }
}
__device__ __forceinline__ void mask_tile(f32x16& p0, f32x16& p1, int dq, unsigned W) {
    const float NEG = -__builtin_inff();
#pragma unroll
    for (int r = 0; r < 16; ++r) {
        const int c = (r & 3) + 8 * (r >> 2);
        if ((unsigned)(dq - c) >= W) p0[r] = NEG;
        if ((unsigned)(dq - c - 32) >= W) p1[r] = NEG;
    }
}
__device__ __forceinline__ void partialSM(f32x16& p0, f32x16& p1, float& m_reg, float& mn, float& alpha) {
    float pmax = p0[0]; for (int r = 1; r < 16; ++r) pmax = fmaxf(pmax, p0[r]); for (int r = 0; r < 16; ++r) pmax = fmaxf(pmax, p1[r]);
    { auto rr = __builtin_amdgcn_permlane32_swap(__float_as_uint(pmax), __float_as_uint(pmax), false, false);
      pmax = fmaxf(__uint_as_float(rr[0]), __uint_as_float(rr[1])); }
    constexpr float C2 = 1.4426950408889634f * SCALE;
    if (__builtin_expect(__all((pmax - m_reg) * SCALE <= THR), 1)) { mn = m_reg; alpha = 1.f; }
    else { mn = fmaxf(m_reg, pmax); alpha = __builtin_amdgcn_exp2f((m_reg - mn) * C2); m_reg = mn; }
    const float mnL = -mn * C2;
    for (int r = 0; r < 16; ++r) p0[r] = fmaf(p0[r], C2, mnL); for (int r = 0; r < 16; ++r) p1[r] = fmaf(p1[r], C2, mnL);
    for (int r = 0; r < 16; ++r) p0[r] = __builtin_amdgcn_exp2f(p0[r]);
}
__device__ __forceinline__ void finishSM(f32x16& p0, f32x16& p1, float alpha, float& l_reg, bf16x8& pa0, bf16x8& pa1, bf16x8& pa2, bf16x8& pa3) {
    for (int r = 0; r < 16; ++r) p1[r] = __builtin_amdgcn_exp2f(p1[r]);
    float ps = 0; for (int r = 0; r < 16; ++r) ps += p0[r]; for (int r = 0; r < 16; ++r) ps += p1[r];
    { auto rr = __builtin_amdgcn_permlane32_swap(__float_as_uint(ps), __float_as_uint(ps), false, false);
      ps = __uint_as_float(rr[0]) + __uint_as_float(rr[1]); }
    l_reg = l_reg * alpha + ps;
#define PK4(P, B_, OUT) do { unsigned a0 = cvtpk(P[B_+0], P[B_+1]), a1 = cvtpk(P[B_+2], P[B_+3]);                          \
        unsigned b0 = cvtpk(P[B_+4], P[B_+5]), b1 = cvtpk(P[B_+6], P[B_+7]);                                             \
        auto r0 = __builtin_amdgcn_permlane32_swap(a0, b0, false, false); auto r1 = __builtin_amdgcn_permlane32_swap(a1, b1, false, false); \
        u32x4 w = {r0[0], r1[0], r0[1], r1[1]}; OUT = *reinterpret_cast<bf16x8*>(&w); } while (0)
    PK4(p0, 0, pa0); PK4(p0, 8, pa1); PK4(p1, 0, pa2); PK4(p1, 8, pa3);
#undef PK4
}
constexpr int NQR = 8;
template <int KB, bool SK>
__device__ __forceinline__ void qkt(f32x16& p0, f32x16& p1, const char* K_lds, int r32, int hi, const char* qs, const bf16x8* qrh, bool act) {
    if (SK && !act) { const float NEG = -__builtin_inff();
#pragma unroll
        for (int r = 0; r < 16; ++r) { p0[r] = NEG; p1[r] = NEG; } return; }
    { const float* bl = (const float*)(K_lds + 2 * SHM_K + NW * 64 * 4 + KB * 256) + 4 * hi;
#pragma unroll
      for (int g = 0; g < 4; ++g) { const f32x4 b0 = *(const f32x4*)(bl + 8 * g), b1 = *(const f32x4*)(bl + 32 + 8 * g);
          p0[4 * g] = b0[0]; p0[4 * g + 1] = b0[1]; p0[4 * g + 2] = b0[2]; p0[4 * g + 3] = b0[3]; p1[4 * g] = b1[0]; p1[4 * g + 1] = b1[1]; p1[4 * g + 2] = b1[2]; p1[4 * g + 3] = b1[3]; } }
    const char* kb[4];
#pragma unroll
    for (int dd = 0; dd < 4; ++dd) kb[dd] = K_lds + KB * SHM_K + KSWZ(r32, (dd * 16 + hi * 8) * 2);
#pragma unroll
    for (int d0 = 0; d0 < 8; ++d0) { const char* a = kb[d0 & 3] + (d0 >> 2) * 128;
        bf16x8 b0 = *reinterpret_cast<const bf16x8*>(a);
        bf16x8 b1 = *reinterpret_cast<const bf16x8*>(a + 32 * 256);
        const bf16x8 qv = d0 < NQR ? qrh[d0] : *reinterpret_cast<const bf16x8*>(qs + d0 * 32);
        p0 = __builtin_amdgcn_mfma_f32_32x32x16_bf16(b0, qv, p0, 0, 0, 0);
        p1 = __builtin_amdgcn_mfma_f32_32x32x16_bf16(b1, qv, p1, 0, 0, 0); }
}
template <int VB, bool SK>
__device__ __forceinline__ void pv_tile(f32x16* o, int vb0, bf16x8 pa0, bf16x8 pa1, bf16x8 pa2, bf16x8 pa3, bool act) {
    if (SK && !act) return;
#define TRRD(dst, off) asm volatile("ds_read_b64_tr_b16 %0, %1 offset:%2" : "=&v"(dst) : "v"(vb0), "i"(off) : "memory")
#define PV_D0(d0) do { s16x4 l0, l1, l2, l3, h0, h1, h2, h3; constexpr int b_ = VB * SHM_V + v_rd_off(d0, 0, 0);     \
        TRRD(l0, b_); TRRD(h0, b_ + 2048); TRRD(l1, b_ + 4096); TRRD(h1, b_ + 6144); TRRD(l2, b_ + 8192); TRRD(h2, b_ + 10240); TRRD(l3, b_ + 12288); TRRD(h3, b_ + 14336); \
        asm volatile("s_waitcnt lgkmcnt(0)" ::: "memory"); SBAR();                 \
        o[d0] = __builtin_amdgcn_mfma_f32_32x32x16_bf16(pa0, (bf16x8){l0[0], l0[1], l0[2], l0[3], h0[0], h0[1], h0[2], h0[3]}, o[d0], 0, 0, 0);   \
        o[d0] = __builtin_amdgcn_mfma_f32_32x32x16_bf16(pa1, (bf16x8){l1[0], l1[1], l1[2], l1[3], h1[0], h1[1], h1[2], h1[3]}, o[d0], 0, 0, 0);   \
        o[d0] = __builtin_amdgcn_mfma_f32_32x32x16_bf16(pa2, (bf16x8){l2[0], l2[1], l2[2], l2[3], h2[0], h2[1], h2[2], h2[3]}, o[d0], 0, 0, 0);   \
        o[d0] = __builtin_amdgcn_mfma_f32_32x32x16_bf16(pa3, (bf16x8){l3[0], l3[1], l3[2], l3[3], h3[0], h3[1], h3[2], h3[3]}, o[d0], 0, 0, 0); } while (0)
    PV_D0(0); PV_D0(1); PV_D0(2); PV_D0(3);
#undef PV_D0
#undef TRRD
}

template <class TIn, class TOut> struct BlockRef { const TIn* Q; const TIn* K; const TIn* V; TOut* O; int P0; const float* CB; const TIn* G; };
template <class TIn> struct Seam {
    bf16x8 qr[8];
    bf16x8 st_v0, st_v1, st_k0, st_k1; f32x4 sf0, sf1, sf2, sf3; float st_b;
    f32x4 tq[16];
};
__device__ __forceinline__ int swa_jlo(int P0, int W) { const int lowk = P0 - W + 1; return lowk > 0 ? lowk / KVBLK : 0; }
#define ROW(p, k0, rr) ((p) + (size_t)(k0) * D + (unsigned)((rr) * D + sc))
#define VMW() asm volatile("s_waitcnt vmcnt(0)" ::: "memory")
#define VMWN(n) asm volatile("s_waitcnt vmcnt(%0)" :: "i"(n) : "memory")
#define SLOAD_H(Kp, Vp, Cp, k0) do { S.st_v0 = load8<TIn>(ROW(Vp, k0, sr)); S.st_v1 = load8<TIn>(ROW(Vp, k0, 32 + sr));              \
                         S.st_k0 = load8<TIn>(ROW(Kp, k0, sr)); S.st_k1 = load8<TIn>(ROW(Kp, k0, 32 + sr)); { int tb_ = tid; asm volatile("" : "+v"(tb_)); S.st_b = ((Cp) + (k0))[(unsigned)(tb_ & 63)]; } } while (0)
#define SWRITE_HK(bf) do { *(bf16x8*)(K_lds + (bf) * SHM_K + kws) = S.st_k0; *(bf16x8*)(K_lds + (bf) * SHM_K + kws + 32 * 256) = S.st_k1; if (tid < 64) *(float*)(K_lds + 2 * SHM_K + NW * 64 * 4 + (bf) * 256 + tid * 4) = S.st_b; } while (0)
#define SWRITE_HV(bf) do { *(bf16x8*)(V_lds + (bf) * SHM_V + vst0) = S.st_v0; *(bf16x8*)(V_lds + (bf) * SHM_V + vst1) = S.st_v1; } while (0)
#define SWRITE_H(bf) do { SWRITE_HV(bf); SWRITE_HK(bf); } while (0)
#define SLOAD_F(p, k0) do { S.sf0 = *(const f32x4*)ROW(p, k0, sr); S.sf1 = *(const f32x4*)(ROW(p, k0, sr) + 4);                \
                            S.sf2 = *(const f32x4*)ROW(p, k0, 32 + sr); S.sf3 = *(const f32x4*)(ROW(p, k0, 32 + sr) + 4); } while (0)
#define SWRITE_KF(bf) do { *(bf16x8*)(K_lds + (bf) * SHM_K + kws) = pack8(S.sf0, S.sf1); *(bf16x8*)(K_lds + (bf) * SHM_K + kws + 32 * 256) = pack8(S.sf2, S.sf3); } while (0)
#define SWRITE_VF(bf) do { *(bf16x8*)(V_lds + (bf) * SHM_V + vst0) = pack8(S.sf0, S.sf1); *(bf16x8*)(V_lds + (bf) * SHM_V + vst1) = pack8(S.sf2, S.sf3); } while (0)
template <class TIn, class TOut>
__device__ __forceinline__ void causal_swa_prime(const BlockRef<TIn, TOut>& cur, int W, char* lds, Seam<TIn>& S) {
    constexpr bool F32 = same_t<TIn, float>::v;
    const int tid = threadIdx.x, wid = __builtin_amdgcn_readfirstlane(tid >> 6), lane = tid & 63, r32 = lane & 31, hi = lane >> 5;
    const int sr = tid >> 4, sc = (tid & 15) * 8, kws = KSWZ(sr, sc * 2); char* K_lds = lds + 2 * SHM_V;
    const int kb0 = swa_jlo(cur.P0, W) * KVBLK;
    for (int d0 = 0; d0 < 8; ++d0) S.qr[d0] = load8<TIn>(cur.Q + (size_t)(wid * QBLK + r32) * D + d0 * 16 + hi * 8);
    if constexpr (F32) { SLOAD_F((const float*)cur.K, kb0); VMW(); SWRITE_KF(0); SBAR(); SLOAD_F((const float*)cur.V, kb0); }
    else { SLOAD_H(cur.K, cur.V, cur.CB, kb0); VMW(); SWRITE_HK(0); }
    { char* const qsw = lds + OST_OFF + wid * OST_WAVE + r32 * ORS * 2 + hi * 16;
#pragma unroll
      for (int d0 = 0; d0 < 8; ++d0) *reinterpret_cast<bf16x8*>(qsw + d0 * 32) = S.qr[d0]; }
    __syncthreads();
}
template <class TIn, class TOut>
__device__ __forceinline__ void causal_swa_block(const BlockRef<TIn, TOut>& cur, const BlockRef<TIn, TOut>& nxt, int skv, int W, char* lds, Seam<TIn>& S) {
    constexpr bool F32 = same_t<TIn, float>::v;
    const int tid = threadIdx.x, wid = __builtin_amdgcn_readfirstlane(tid >> 6), lane = tid & 63, r32 = lane & 31, hi = lane >> 5;
    const int j_lo = swa_jlo(cur.P0, W);
    int j_hi = (cur.P0 + QB - 1) / KVBLK + 1; if (j_hi > skv / KVBLK) j_hi = skv / KVBLK;
    const int NT = j_hi - j_lo;
    const int kbn = swa_jlo(nxt.P0, W) * KVBLK;
    const int qlo = cur.P0 + wid * QBLK, qm = qlo + r32 - 4 * hi;
    char* V_lds = lds; char* K_lds = lds + 2 * SHM_V;
    float* ws = (float*)(lds + 2 * SHM_V + 2 * SHM_K) + wid * 64; float* li_l = ws, * al_l = ws + 32;
    float m_reg = -1e30f, l_reg = 0; f32x16 o[4] = {};
    const int sr = tid >> 4, sc = (tid & 15) * 8, vst0 = v_st(sr, sc), vst1 = v_st(32 + sr, sc), kws = KSWZ(sr, sc * 2);
    const int vb0 = (int)(uintptr_t)V_lds + v_rd_base(lane);
    char* const qs = lds + OST_OFF + wid * OST_WAVE + r32 * ORS * 2 + hi * 16;
    bf16x8 qrh[NQR];
#pragma unroll
    for (int d0 = 0; d0 < NQR; ++d0) qrh[d0] = *reinterpret_cast<const bf16x8*>(qs + d0 * 32);
    const TIn* Kh = cur.K; const TIn* Vh = cur.V; const float* Ch = cur.CB;
#define RESC(a) do { if (__any((a) < 1.f)) { if (hi == 0) al_l[r32] = (a); asm volatile("s_waitcnt lgkmcnt(0)" ::: "memory");              \
                     for (int d_ = 0; d_ < 4; ++d_) for (int r = 0; r < 16; ++r) o[d_][r] *= al_l[crow(r, hi)]; } } while (0)
#define KBASE(t) ((j_lo + (t)) * KVBLK)
#define ACT(t) (KBASE(t) <= qlo + QBLK - 1 && KBASE(t) + KVBLK - 1 >= qlo - W + 1)
#define MASKT(P0_, P1_, t) do { const int kb_ = KBASE(t); if ((!SK || ACT(t)) && (kb_ + KVBLK - 1 > qlo || kb_ <= qlo + QBLK - 1 - W)) mask_tile(P0_, P1_, qm - kb_, (unsigned)W); } while (0)
#define BIASADD(P0_, P1_, KB_) do { const float* bl_ = (const float*)(K_lds + 2 * SHM_K + NW * 64 * 4 + (KB_) * 256) + 4 * hi;                    \
        _Pragma("unroll") for (int g_ = 0; g_ < 4; ++g_) { const f32x4 b0_ = *(const f32x4*)(bl_ + 8 * g_), b1_ = *(const f32x4*)(bl_ + 32 + 8 * g_); \
            _Pragma("unroll") for (int i_ = 0; i_ < 4; ++i_) { P0_[4 * g_ + i_] += b0_[i_]; P1_[4 * g_ + i_] += b1_[i_]; } } } while (0)
    constexpr int NQL = F32 ? 16 : 0;
    constexpr bool SK = WSKIP && !F32;
#define SEAM_K0() do { VMWN(NQL); if constexpr (F32) { SWRITE_KF(0); SBAR(); SLOAD_F((const float*)nxt.V, kbn); } else { SWRITE_HK(0); } SBAR(); } while (0)
    f32x16 pA0, pA1, pB0, pB1; float mnA, mnB, alA, alB; bf16x8 pa0, pa1, pa2, pa3;
    if constexpr (F32) { VMW(); SWRITE_VF(0); SBAR(); } else { SWRITE_HV(0); SBAR(); }
    if (NT > 1) { if constexpr (F32) SLOAD_F((const float*)Kh, KBASE(1)); else SLOAD_H(Kh, Vh, Ch, KBASE(1)); }
    SBAR(); qkt<0, SK>(pA0, pA1, K_lds, r32, hi, qs, qrh, ACT(0));
    if constexpr (F32) { if (NT > 1) { VMW(); SWRITE_KF(1); SBAR(); SLOAD_F((const float*)Vh, KBASE(1)); } }
    MASKT(pA0, pA1, 0); partialSM(pA0, pA1, m_reg, mnA, alA);
    if (NT > 1) { VMW(); if constexpr (F32) { SWRITE_VF(1); SBAR(); if (NT > 2) SLOAD_F((const float*)Kh, KBASE(2)); } else SWRITE_H(1); }
    __syncthreads();
#define HALF_STEP(PX0, PX1, mnX, alX, PY0, PY1, alY, t, KB, VB, SB) do {                                                      \
        SBAR(); qkt<KB, SK>(PX0, PX1, K_lds, r32, hi, qs, qrh, ACT(t));                                             \
        finishSM(PY0, PY1, alY, l_reg, pa0, pa1, pa2, pa3); SBAR();                                                           \
        if ((t) + 1 < NT) { if constexpr (F32) { VMW(); SWRITE_KF(SB); SBAR(); SLOAD_F((const float*)Vh, KBASE((t) + 1)); }  \
                            else { SLOAD_H(Kh, Vh, Ch, KBASE((t) + 1)); } SBAR(); }                                               \
        pv_tile<VB, SK>(o, vb0, pa0, pa1, pa2, pa3, ACT((t) - 1)); MASKT(PX0, PX1, (t)); partialSM(PX0, PX1, m_reg, mnX, alX);                                        \
        __syncthreads();                                                                                                      \
        if ((t) + 1 < NT) { VMW(); if constexpr (F32) { SWRITE_VF(SB); SBAR(); if ((t) + 2 < NT) SLOAD_F((const float*)Kh, KBASE((t) + 2)); } \
                            else { SWRITE_H(SB); } }                                                                          \
        RESC(alX); __syncthreads(); } while (0)
    for (int t = 1; t + 1 < NT; t += 2) {
        HALF_STEP(pB0, pB1, mnB, alB, pA0, pA1, alA, t, 1, 0, 0);
        HALF_STEP(pA0, pA1, mnA, alA, pB0, pB1, alB, t + 1, 0, 1, 1);
    }
    const bool even = (NT & 1) == 0;
    if (even) { SBAR(); qkt<1, SK>(pB0, pB1, K_lds, r32, hi, qs, qrh, ACT(NT - 1)); SBAR(); }
#define QROW(e) (nxt.Q + (size_t)(wid * QBLK + r32) * D + ((e) >> 1) * 16 + hi * 8 + ((e) & 1) * 4)
    if constexpr (F32) { SLOAD_F((const float*)nxt.K, kbn); SBAR();
#pragma unroll
        for (int e = 0; e < 8; ++e) S.tq[e] = *(const f32x4*)QROW(e); }
    else { SLOAD_H(nxt.K, nxt.V, nxt.CB, kbn); SBAR(); }
    SBAR();
    finishSM(pA0, pA1, alA, l_reg, pa0, pa1, pa2, pa3); SBAR();
    if constexpr (F32) {
#pragma unroll
        for (int e = 8; e < 16; ++e) S.tq[e] = *(const f32x4*)QROW(e); SBAR(); }
#undef QROW
    pv_tile<0, SK>(o, vb0, pa0, pa1, pa2, pa3, ACT(even ? NT - 2 : NT - 1));
    if (even) { MASKT(pB0, pB1, NT - 1); partialSM(pB0, pB1, m_reg, mnB, alB); __syncthreads(); RESC(alB);
        finishSM(pB0, pB1, alB, l_reg, pa0, pa1, pa2, pa3); SBAR(); pv_tile<1, SK>(o, vb0, pa0, pa1, pa2, pa3, ACT(NT - 1)); }
    SBAR(); SEAM_K0();
    {
    int tz = threadIdx.x; asm volatile("" : "+v"(tz));
    const int lane_e = tz & 63, wid_e = __builtin_amdgcn_readfirstlane(tz >> 6), r32_e = lane_e & 31, hi_e = lane_e >> 5;
    float* li_e = (float*)(lds + 2 * SHM_V + 2 * SHM_K) + wid_e * 64;
    if (hi_e == 0) li_e[r32_e] = l_reg; asm volatile("s_waitcnt lgkmcnt(0)" ::: "memory");
    float rli[16];
#pragma unroll
    for (int r = 0; r < 16; ++r) rli[r] = __builtin_amdgcn_rcpf(li_e[crow(r, hi_e)]);
    char* ost = lds + OST_OFF + wid_e * OST_WAVE;
    {   char* ob = ost + (4 * hi_e * ORS + r32_e) * 2;
#pragma unroll
        for (int r = 0; r < 16; ++r) {
#pragma unroll
            for (int d0 = 0; d0 < 4; ++d0) { const float v = o[d0][r] * rli[r]; const float vn = __shfl_xor(v, 1);
                if ((r32_e & 1) == 0) *(unsigned*)(ob + (((r & 3) + 8 * (r >> 2)) * ORS + d0 * 32) * 2) = cvtpk(v, vn); } } }
    asm volatile("s_waitcnt lgkmcnt(0)" ::: "memory");
    if constexpr (!F32) {
        const TIn* qn = nxt.Q + (size_t)(wid_e * QBLK + r32_e) * D + hi_e * 8;
#pragma unroll
        for (int d0 = 0; d0 < 8; ++d0) S.qr[d0] = load8<TIn>(qn + d0 * 16); }
    {   const int orow = lane_e >> 4, och = lane_e & 15;
        const TOut* Ow_c = cur.O + (size_t)(wid_e * QBLK + orow) * OSTR + och * 8; TOut* Ow = const_cast<TOut*>(Ow_c);
        const TIn* Gw = cur.G + (size_t)(wid_e * QBLK + orow) * GSTR + och * 8;
#pragma unroll
        for (int i = 0; i < 8; ++i) {
            const u32x4 ov = *(const u32x4*)(ost + (4 * i + orow) * ORS * 2 + och * 16);
            const u32x4 gv = *(const u32x4*)(Gw + (size_t)(4 * i) * GSTR);
            u32x4 w;
#pragma unroll
            for (int k = 0; k < 4; ++k) w[k] = cvtpk(__uint_as_float(ov[k] << 16) * __uint_as_float(gv[k] << 16), __uint_as_float(ov[k] & 0xffff0000u) * __uint_as_float(gv[k] & 0xffff0000u));
            *(u32x4*)(Ow + (size_t)(4 * i) * OSTR) = w; } }
    if constexpr (!F32) {
        char* qsw = ost + r32_e * ORS * 2 + hi_e * 16;
#pragma unroll
        for (int d0 = 0; d0 < 8; ++d0) *reinterpret_cast<bf16x8*>(qsw + d0 * 32) = S.qr[d0]; }
    }
    if constexpr (F32) {
#pragma unroll
        for (int d0 = 0; d0 < 8; ++d0) S.qr[d0] = pack8(S.tq[2 * d0], S.tq[2 * d0 + 1]); }
    __syncthreads();
#undef RESC
#undef KBASE
#undef ACT
#undef MASKT
#undef SEAM_K0
#undef BIASADD
#undef HALF_STEP
}
#undef ROW
#undef VMW
#undef VMWN
#undef SLOAD_H
#undef SWRITE_HK
#undef SWRITE_HV
#undef SWRITE_H
#undef SLOAD_F
#undef SWRITE_KF
#undef SWRITE_VF


}

namespace dec {
constexpr int D = 128, PG16 = 16, WAVES = 4, GE = 4, GEP = 4, HPL = 1, NSPLIT = 4, TOK_STRIDE = 512;
constexpr int PPW = (PAST / PG16) / NSPLIT / WAVES;
constexpr int LDS_P = 0, LDS_MRG = WAVES * 64 * HPL, MRG_REC = 4 + D, LDS_FLOATS = LDS_MRG + WAVES * GEP * MRG_REC + 4;
using bf16x2 = __attribute__((ext_vector_type(2))) __bf16;
using u32x4  = __attribute__((ext_vector_type(4))) unsigned;
using f32x4  = __attribute__((ext_vector_type(4))) float;
using f32x8  = __attribute__((ext_vector_type(8))) float;
__device__ __forceinline__ float dot2(unsigned k, unsigned q, float acc) { return __builtin_amdgcn_fdot2_f32_bf16(__builtin_bit_cast(bf16x2, k), __builtin_bit_cast(bf16x2, q), acc, false); }
__device__ __forceinline__ unsigned cvtpk(float lo, float hi) { unsigned r; asm volatile("v_cvt_pk_bf16_f32 %0, %1, %2" : "=v"(r) : "v"(lo), "v"(hi)); return r; }
template <int CTRL> __device__ __forceinline__ float dpp(float x) { return __builtin_bit_cast(float, __builtin_amdgcn_mov_dpp(__builtin_bit_cast(int, x), CTRL, 0xf, 0xf, true)); }
constexpr int XOR1 = 0xB1, XOR2 = 0x4E, XOR7 = 0x141, XOR8 = 0x128, ROR4 = 0x124;
__device__ __forceinline__ float xrow16_max(float x) {
  auto s = __builtin_amdgcn_permlane16_swap(__float_as_uint(x), __float_as_uint(x), false, false);
  x = fmaxf(__uint_as_float(s[0]), __uint_as_float(s[1]));
  auto t = __builtin_amdgcn_permlane32_swap(__float_as_uint(x), __float_as_uint(x), false, false);
  return fmaxf(__uint_as_float(t[0]), __uint_as_float(t[1]));
}
__device__ __forceinline__ float xrow16_sum(float x) {
  auto s = __builtin_amdgcn_permlane16_swap(__float_as_uint(x), __float_as_uint(x), false, false);
  x = __uint_as_float(s[0]) + __uint_as_float(s[1]);
  auto t = __builtin_amdgcn_permlane32_swap(__float_as_uint(x), __float_as_uint(x), false, false);
  return __uint_as_float(t[0]) + __uint_as_float(t[1]);
}
__device__ __forceinline__ f32x8 ld8(const float* p) { const f32x4 lo = __builtin_nontemporal_load(reinterpret_cast<const f32x4*>(p)), hi = __builtin_nontemporal_load(reinterpret_cast<const f32x4*>(p + 64));
  return f32x8{lo[0], lo[1], lo[2], lo[3], hi[0], hi[1], hi[2], hi[3]}; }
__device__ __forceinline__ u32x4 tobf(f32x8 x) { u32x4 w = {cvtpk(x[0], x[1]), cvtpk(x[2], x[3]), cvtpk(x[4], x[5]), cvtpk(x[6], x[7])}; return w; }

struct DecArgs { const float* q; const float* k; const float* v; const int* pt; const float* sufx; float* pml; float* po; };

__device__ __forceinline__ void decode_unit(const DecArgs& a, int b, int kvh, int s, float* lds, int wave, int lane) {
  const int r = lane >> 4, c = lane & 15;
  constexpr float C2 = ATT_SCALE * 1.4426950408889634f;
  const int sp0 = s * (PAST / PG16 / NSPLIT);
  int btv = 0;
  if (lane < PPW) { const int sp = sp0 + wave + 4 * lane; btv = a.pt[b * NPAGES + (sp >> 3)] * 8 + (sp & 7); }
  u32x4 qpk[GEP];
#pragma unroll
  for (int g = 0; g < GEP; ++g) { const float* qp = a.q + ((size_t)(b * 4 + g) * 512 + kvh * D + 4 * c); const f32x4 lo = *reinterpret_cast<const f32x4*>(qp), hi = *reinterpret_cast<const f32x4*>(qp + 64);
    qpk[g] = tobf(f32x8{lo[0], lo[1], lo[2], lo[3], hi[0], hi[1], hi[2], hi[3]}); }
  const unsigned loff = (unsigned)(r * TOK_STRIDE + 4 * c);
  const float* sufx = a.sufx + (size_t)(b * 4 + kvh) * PAST; const unsigned soff = (unsigned)(r + 4 * (c >> 2));
#define PAGE_BASE(spid) ((size_t)(spid) * (PG16 * TOK_STRIDE) + (size_t)kvh * D)
#define ISSUE_K(KBUF, BV, i_) do { const int ii_ = (i_) < PPW ? (i_) : PPW - 1; const int phys_ = __builtin_amdgcn_readlane(btv, ii_); const float* kb_ = a.k + PAGE_BASE(phys_); \
    _Pragma("unroll") for (int t_ = 0; t_ < 4; ++t_) KBUF[t_] = ld8(kb_ + (loff + (unsigned)(t_ * 4 * TOK_STRIDE))); BV = sufx[(unsigned)((sp0 + wave + 4 * ii_) * PG16) + soff]; } while (0)
#define ISSUE_V(i_) do { const int ii_ = (i_) < PPW ? (i_) : PPW - 1; const int phys_ = __builtin_amdgcn_readlane(btv, ii_); const float* vb_ = a.v + PAGE_BASE(phys_); \
    _Pragma("unroll") for (int t_ = 0; t_ < 4; ++t_) Vn[t_] = ld8(vb_ + (loff + (unsigned)(t_ * 4 * TOK_STRIDE))); } while (0)
  f32x8 KA[4], KB[4], Vn[4]; float bA, bB;
  float m[HPL], l[HPL], acc[GEP * 8];
#pragma unroll
  for (int j = 0; j < HPL; ++j) { m[j] = -INFINITY; l[j] = 0.f; }
#pragma unroll
  for (int k = 0; k < GEP * 8; ++k) acc[k] = 0.f;
  ISSUE_K(KA, bA, 0); ISSUE_V(0); ISSUE_K(KB, bB, 1);
#define TR_STEP(HALF, CTRL, BIT) _Pragma("unroll") for (int h = 0; h < (HALF); ++h) _Pragma("unroll") for (int j = 0; j < HPL; ++j) { \
      const float lo_ = x[h * HPL + j], hi_ = x[(h + (HALF)) * HPL + j]; const float t1_ = lo_ + dpp<CTRL>(lo_), t2_ = hi_ + dpp<CTRL>(hi_); \
      x[h * HPL + j] = (c & (BIT)) ? t2_ : t1_; }
#define DEC_STEP(KBUF, BV, i_) do {                                                                                              \
    u32x4 Kc[4], Vc[4];                                                                                                          \
    _Pragma("unroll") for (int t = 0; t < 4; ++t) { Kc[t] = tobf(KBUF[t]); Vc[t] = tobf(Vn[t]); }                                \
    const float bias = BV;                                                                                                       \
    ISSUE_V((i_) + 1); ISSUE_K(KBUF, BV, (i_) + 2);                                                                              \
    float x[4 * GEP];                                                                                                            \
    _Pragma("unroll") for (int t = 0; t < 4; ++t) _Pragma("unroll") for (int g = 0; g < GEP; ++g) { float d = 0.f;              \
        _Pragma("unroll") for (int k = 0; k < 4; ++k) d = dot2(Kc[t][k], qpk[g][k], d);                                          \
        x[t * GEP + g] = d; }                                                                                                    \
    TR_STEP(8, XOR8, 8) TR_STEP(4, XOR7, 4) TR_STEP(2, XOR2, 2) TR_STEP(1, XOR1, 1)                                              \
    float p[HPL], alpha[HPL];                                                                                                    \
    _Pragma("unroll") for (int j = 0; j < HPL; ++j) {                                                                            \
      const float sc = x[j] * C2 + bias;                                                                                         \
      float pm = sc; pm = fmaxf(pm, dpp<ROR4>(pm)); pm = fmaxf(pm, dpp<XOR8>(pm)); pm = xrow16_max(pm);                          \
      const float mn = fmaxf(m[j], pm), msub = (mn == -INFINITY) ? 0.f : mn;                                                     \
      alpha[j] = __builtin_amdgcn_exp2f(m[j] - msub); p[j] = __builtin_amdgcn_exp2f(sc - msub);                                  \
      l[j] = fmaf(l[j], alpha[j], p[j]); m[j] = mn; }                                                                            \
    _Pragma("unroll") for (int q4 = 0; q4 < 4; ++q4) _Pragma("unroll") for (int j = 0; j < HPL; ++j) {                           \
        const float al = q4 == 0 ? dpp<0x00>(alpha[j]) : q4 == 1 ? dpp<0x55>(alpha[j]) : q4 == 2 ? dpp<0xAA>(alpha[j]) : dpp<0xFF>(alpha[j]); \
        _Pragma("unroll") for (int k = 0; k < 8; ++k) acc[(q4 * HPL + j) * 8 + k] *= al; }                                       \
    float* prow = lds + LDS_P + (wave * 4 + r) * 16 * HPL;                                                                       \
    _Pragma("unroll") for (int j = 0; j < HPL; ++j) prow[c * HPL + j] = p[j];                                                    \
    asm volatile("s_waitcnt lgkmcnt(0)" ::: "memory");                                                                           \
    f32x4 pr[GEP];                                                                                                               \
    _Pragma("unroll") for (int u = 0; u < GEP; ++u) pr[u] = *reinterpret_cast<const f32x4*>(prow + 4 * u);                       \
    _Pragma("unroll") for (int t = 0; t < 4; ++t) { float vf[8];                                                                 \
      _Pragma("unroll") for (int k = 0; k < 4; ++k) { vf[2 * k] = __builtin_bit_cast(float, Vc[t][k] << 16); vf[2 * k + 1] = __builtin_bit_cast(float, Vc[t][k] & 0xffff0000u); } \
      _Pragma("unroll") for (int g = 0; g < GE; ++g) { const float pg_ = pr[(t * GEP + g) >> 2][(t * GEP + g) & 3];              \
        _Pragma("unroll") for (int k = 0; k < 8; ++k) acc[g * 8 + k] = fmaf(pg_, vf[k], acc[g * 8 + k]); } } } while (0)
#pragma unroll 1
  for (int i = 0; i < PPW; i += 2) { DEC_STEP(KA, bA, i); DEC_STEP(KB, bB, i + 1); }
#undef DEC_STEP
#undef TR_STEP
#undef ISSUE_K
#undef ISSUE_V
#undef PAGE_BASE
#pragma unroll
  for (int k = 0; k < GE * 8; ++k) acc[k] = xrow16_sum(acc[k]);
#pragma unroll
  for (int j = 0; j < HPL; ++j) { float t = l[j]; t += dpp<ROR4>(t); t += dpp<XOR8>(t); l[j] = xrow16_sum(t); }
  float* mrg = lds + LDS_MRG;
  if (r == 0) {
#pragma unroll
    for (int g = 0; g < GE; ++g) {
      float* rec = mrg + (wave * GEP + g) * MRG_REC;
#pragma unroll
      for (int k = 0; k < 8; k += 4) *reinterpret_cast<f32x4*>(rec + 4 + 4 * c + 16 * k) = f32x4{acc[g * 8 + k], acc[g * 8 + k + 1], acc[g * 8 + k + 2], acc[g * 8 + k + 3]};
      if (c == g / HPL) { rec[0] = m[g % HPL]; rec[1] = l[g % HPL]; } } }
  __syncthreads();
  {
    const int g = wave, d0 = 2 * lane;
    const size_t row = (size_t)(b * 4 + kvh) * 4 + g;
    float M = -INFINITY;
#pragma unroll
    for (int w = 0; w < WAVES; ++w) M = fmaxf(M, mrg[(w * GEP + g) * MRG_REC]);
    float L = 0.f, o0 = 0.f, o1 = 0.f;
#pragma unroll
    for (int w = 0; w < WAVES; ++w) { const float* rec = mrg + (w * GEP + g) * MRG_REC; const float lw = rec[1];
      const float wt = (lw > 0.f) ? __builtin_amdgcn_exp2f(rec[0] - M) : 0.f;
      L = fmaf(wt, lw, L); o0 = fmaf(wt, rec[4 + d0], o0); o1 = fmaf(wt, rec[4 + d0 + 1], o1); }
    const size_t slot = row * NSPLIT + s;
    *reinterpret_cast<float2*>(a.po + slot * D + d0) = make_float2(o0, o1);
    if (lane == 0) *reinterpret_cast<float2*>(a.pml + 2 * slot) = make_float2(M, L);
  }
  __syncthreads();
}

struct CombArgs { const float* pml; const float* po; const float* q; const float* knew; const float* vnew; const float* lfb; const unsigned short* gate; unsigned short* mix; };
__device__ __forceinline__ void combine_row(const CombArgs& a, int b, int h, int t, int lane) {
  constexpr float C2 = ATT_SCALE * 1.4426950408889634f;
  const size_t row = (size_t)(b * 4 + h) * 4 + t; const int d0 = 2 * lane;
  const float* pml = a.pml + row * NSPLIT * 2; const float* po = a.po + row * NSPLIT * D;
  const float2 qv = *reinterpret_cast<const float2*>(a.q + (size_t)(b * 4 + t) * 512 + h * D + d0);
  float scn[4]; float cum = 0.f;
#pragma unroll
  for (int s = 0; s < 4; ++s) {
    const float2 kv = *reinterpret_cast<const float2*>(a.knew + (size_t)(b * 4 + s) * 512 + h * D + d0);
    float d = qv.x * kv.x + qv.y * kv.y;
#pragma unroll
    for (int o = 1; o < 64; o <<= 1) d += __shfl_xor(d, o);
    cum += a.lfb[(size_t)(MP + b * 4 + s) * 4 + h];
    scn[s] = (s <= t) ? d * C2 - cum * LOG2E : -INFINITY;
  }
  float M = -INFINITY;
#pragma unroll
  for (int s = 0; s < NSPLIT; ++s) M = fmaxf(M, pml[2 * s]);
#pragma unroll
  for (int s = 0; s < 4; ++s) M = fmaxf(M, scn[s]);
  float L = 0.f, o0 = 0.f, o1 = 0.f;
#pragma unroll
  for (int s = 0; s < NSPLIT; ++s) { const float ls = pml[2 * s + 1], w = (ls > 0.f) ? __builtin_amdgcn_exp2f(pml[2 * s] - M) : 0.f;
    const float2 av = *reinterpret_cast<const float2*>(po + (size_t)s * D + d0);
    L = fmaf(w, ls, L); o0 = fmaf(w, av.x, o0); o1 = fmaf(w, av.y, o1); }
#pragma unroll
  for (int s = 0; s < 4; ++s) { const float w = __builtin_amdgcn_exp2f(scn[s] - M);
    const float2 vv = *reinterpret_cast<const float2*>(a.vnew + (size_t)(b * 4 + s) * 512 + h * D + d0);
    L += w; o0 = fmaf(w, vv.x, o0); o1 = fmaf(w, vv.y, o1); }
  const float inv = 1.f / L;
  const size_t ms = (size_t)(MP + b * 4 + t);
  const unsigned gp = *reinterpret_cast<const unsigned*>(a.gate + ms * 512 + h * D + d0);
  const float g0 = __uint_as_float(gp << 16), g1 = __uint_as_float(gp & 0xffff0000u);
  *reinterpret_cast<unsigned*>(a.mix + ms * 1024 + 512 + h * D + d0) = cvtpk(o0 * inv * g0, o1 * inv * g1);
}
}

__device__ __forceinline__ void p6_rpass(Frame& F, int part) {
    const int gw = (int)blockIdx.x * NWAVES + F.wave, NGW = F.G * NWAVES, fr = F.lane & 15, fq = F.lane >> 4;
    const bf16* X1B = WSP(bf16, WS_XN); const bf16* WRB = WSP(bf16, WS_WR); const bf16* WGB = WSP(bf16, WS_WR + 65536);
    bf16* GF3 = WSP(bf16, WS_GF3); const float* SS1 = (const float*)(F.ctl + CW_SS1);
    LAS unsigned char* rt = F.lds + RING_OFF + F.wave * 512;
    constexpr int NU = MT / 8;
    for (int it = (NGW == 2048 && part == 1) ? 1 : 0; ; ++it) {
        int u;
        if (NGW == 2048) { if (it == 0) u = gw; else if (it == 1 && part != 0 && F.wave == 0 && blockIdx.x >= 192 && (int)blockIdx.x < 192 + (NU - 2048)) u = 2048 + (int)blockIdx.x - 192; else break; }
        else { if (part == 1) break; u = gw + it * NGW; if (u >= NU) break; }
        const int g = u >> 1, hh = u & 1, row0 = 16 * g;
        const GAS bf16x8* wp = (const GAS bf16x8*)(WRB + (size_t)fr * DM + 8 * fq);
        const GAS bf16x8* ap = (const GAS bf16x8*)(X1B + (size_t)(row0 + fr) * DM + 8 * fq);
        pg8::f32x4 acc = {0.f, 0.f, 0.f, 0.f};
#pragma unroll 1
        for (int k0 = 0; k0 < 32; k0 += 16) {
            bf16x8 wv[16], av[16];
#pragma unroll
            for (int i = 0; i < 16; ++i) { wv[i] = wp[(k0 + i) * 4]; av[i] = ap[(k0 + i) * 4]; }
#pragma unroll
            for (int i = 0; i < 16; ++i) acc = __builtin_amdgcn_mfma_f32_16x16x32_bf16(wv[i], av[i], acc, 0, 0, 0);
        }
        const float rstd = 1.0f / sqrtf(SS1[row0 + fr] * (1.f / DM) + EPS);
        acc = acc * rstd;
        { u32x2v w; w.x = cvtpk_s(acc[0], acc[1]); w.y = cvtpk_s(acc[2], acc[3]); *(LAS u32x2v*)(rt + (fr * 16 + 4 * fq) * 2) = w; }
        LDS_WAIT(); asm volatile("" ::: "memory");
        bf16x8 rb = {0, 0, 0, 0, 0, 0, 0, 0};
        if (fq < 2) rb = *(const LAS bf16x8*)(rt + (fr * 16 + 8 * fq) * 2);
        LDS_WAIT(); asm volatile("" ::: "memory");
#pragma unroll 4
        for (int ct = 16 * hh; ct < 16 * hh + 16; ++ct) {
            bf16x8 wa = {0, 0, 0, 0, 0, 0, 0, 0};
            if (fq < 2) wa = *(const GAS bf16x8*)(WGB + (size_t)(16 * ct + fr) * 16 + 8 * fq);
            const pg8::f32x4 z = {0.f, 0.f, 0.f, 0.f};
            const pg8::f32x4 d = __builtin_amdgcn_mfma_f32_16x16x32_bf16(wa, rb, z, 0, 0, 0);
            const f32x4 bg = *(const GAS f32x4*)(F.b_gla_gate + 16 * ct + 4 * fq);
            f32x4 lf; lf.x = log_sigmoidf_(d[0] + bg.x) * 0.0625f; lf.y = log_sigmoidf_(d[1] + bg.y) * 0.0625f; lf.z = log_sigmoidf_(d[2] + bg.z) * 0.0625f; lf.w = log_sigmoidf_(d[3] + bg.w) * 0.0625f;
            st_bf4(GF3 + (size_t)(row0 + fr) * 512 + 16 * ct + 4 * fq, lf);
        }
    }
    __syncthreads();
}
__device__ __forceinline__ void p11_final(Frame& F) {
    const int gw = (int)blockIdx.x * NWAVES + F.wave, NGW = F.G * NWAVES;
    const float* SS2 = (const float*)(F.ctl + CW_SS2);
    for (int m = gw; m < MT; m += NGW) {
        GAS f32x4* yr = (GAS f32x4*)(F.out + O_Y + (size_t)m * DM) + F.lane;
        const float rstd = 1.0f / sqrtf(SS2[m] * (1.f / DM) + EPS);
#pragma unroll
        for (int j = 0; j < 4; ++j) { const f32x4 g = *(const GAS f32x4*)(F.final_norm + 4 * F.lane + 256 * j); yr[64 * j] = yr[64 * j] * rstd * g; }
    }
}

struct SE1 { P1 p; __device__ __forceinline__ void operator()(int m, int c, f32x4 v) const { epi1_4(p, m, c, v); } };
struct SE2 { P2 p; __device__ __forceinline__ void operator()(int m, int c, f32x4 v) const { float ss = epi2_4(p, m, c, v); ss += __shfl_xor(ss, 16); ss += __shfl_xor(ss, 32); if (((c >> 2) & 3) == 0) atomicAdd(p.SS + m, ss); } };
struct SE3 { P3 p; __device__ __forceinline__ void operator()(int m, int c, f32x4 v) const { const float rstd = 1.0f / sqrtf(p.SS[m] * (1.f / DM) + EPS); epi3_4(p, m, c, v, rstd); } };
struct SE4 { P4 p; __device__ __forceinline__ void operator()(int m, int c, f32x4 v) const { float ss = epi4_4(p, m, c, v); ss += __shfl_xor(ss, 16); ss += __shfl_xor(ss, 32); if (((c >> 2) & 3) == 0) atomicAdd(p.SS + m, ss); } };
typedef fox::BlockRef<fox::TIN, fox::TOUT> FoxRef;
__device__ __forceinline__ FoxRef fox_ref(unsigned char* ws, int bh, int qb) {
    const fox::TIN* Q = (const fox::TIN*)(ws + WS_QBH); const fox::TIN* K = (const fox::TIN*)(ws + WS_KBH); const fox::TIN* V = (const fox::TIN*)(ws + WS_VBH);
    const int b = bh >> 2, h = bh & 3; FoxRef r;
    r.Q = Q + ((size_t)bh * SEQ + (size_t)qb * 256) * 128; r.K = K + (size_t)bh * SEQ * 128; r.V = V + (size_t)bh * SEQ * 128;
    r.O = (fox::TOUT*)(ws + WS_MIX) + ((size_t)(b * SEQ + qb * 256)) * 1024 + 512 + h * 128; r.G = (const fox::TIN*)(ws + WS_GB) + ((size_t)(b * SEQ + qb * 256)) * 512 + h * 128;
    r.CB = (const float*)(ws + WS_CB) + (size_t)bh * SEQ; r.P0 = qb * 256; return r;
}


__device__ __forceinline__ void sub_barrier(unsigned* cnt, unsigned n, unsigned& gen) {
    asm volatile("s_waitcnt vmcnt(0)" ::: "memory");
    __syncthreads();
    if (threadIdx.x == 0) {
        __builtin_amdgcn_fence(__ATOMIC_RELEASE, "agent");
        asm volatile("s_waitcnt vmcnt(0)" ::: "memory");
        (void)__hip_atomic_fetch_add(cnt, 1u, __ATOMIC_RELAXED, __HIP_MEMORY_SCOPE_AGENT);
        const unsigned target = (gen + 1u) * n; unsigned sp = 0;
        while (__hip_atomic_load(cnt, __ATOMIC_RELAXED, __HIP_MEMORY_SCOPE_AGENT) < target) { __builtin_amdgcn_s_sleep(1); if (++sp > (1u << 22)) break; }
        __builtin_amdgcn_fence(__ATOMIC_ACQUIRE, "agent");
        asm volatile("s_waitcnt vmcnt(0)" ::: "memory");
    }
    __syncthreads();
    ++gen;
}

#ifndef MK_N_LAUNCHES
#define MK_N_LAUNCHES 1
#endif
constexpr int N_LAUNCHES = MK_N_LAUNCHES;
constexpr int N_PHASES = 12;
struct Args { const void* in[21]; float* out; unsigned char* ws; int ph_lo, ph_hi, sub, pad; };
__global__ void __launch_bounds__(NWAVES * 64, 2) hybrid_fwd(Args args) {
    extern __shared__ __attribute__((aligned(16))) unsigned char lds[];
    Frame F;
    F.lds = (LAS unsigned char*)lds;
    F.MISC = (volatile LAS unsigned*)(F.lds + MISC_OFF);
    F.tid = threadIdx.x; F.lane = F.tid & 63; F.wave = __builtin_amdgcn_readfirstlane(F.tid >> 6);
    F.G = gridDim.x;
    F.ws = args.ws; F.out = args.out; F.ctl = (gu32*)(args.ws + WS_CTL);
    F.xp = (const float*)args.in[0]; F.xs = (const float*)args.in[1]; F.ck = (const float*)args.in[2]; F.cv = (const float*)args.in[3]; F.clf = (const float*)args.in[4];
    F.sh = (const float*)args.in[5]; F.sg = (const float*)args.in[6]; F.pt = (const int*)args.in[7];
    F.norm_even = (const float*)args.in[8]; F.w_in_even = (const float*)args.in[9]; F.b_fox = (const float*)args.in[10]; F.lb_logits = (const float*)args.in[11];
    F.hgrn_gain = (const float*)args.in[12]; F.w_out_even = (const float*)args.in[13]; F.norm_odd = (const float*)args.in[14]; F.w_in_odd = (const float*)args.in[15];
    F.w_gla_gate = (const float*)args.in[16]; F.b_gla_gate = (const float*)args.in[17]; F.gla_gain = (const float*)args.in[18]; F.w_out_odd = (const float*)args.in[19]; F.final_norm = (const float*)args.in[20];
    for (int u = F.tid; u < (LDS_BYTES - LDSCTL_OFF) / 4; u += NWAVES * 64) ((LAS unsigned*)(F.lds + LDSCTL_OFF))[u] = 0u;
    __syncthreads();
    XcdBarrier bar; bar.bar = (unsigned*)(F.ctl + CW_BAR); bar.x = 0; bar.st = nullptr; bar.total = 0u;
    if (N_LAUNCHES == 1) bar = xcd_barrier_post((unsigned*)(F.ctl + CW_BAR), F.MISC + 8);
    XcdBarrier bar2; bar2.bar = (unsigned*)(F.ctl + CW_BAR2); bar2.x = 0; bar2.st = nullptr; bar2.total = 0u;
    if ((int)blockIdx.x >= (int)gridDim.x / 2) { bar2 = xcd_barrier_post((unsigned*)(F.ctl + CW_BAR2), F.MISC + 12); bar2.total = gridDim.x - gridDim.x / 2; }
#define GRID_BAR() do { if (N_LAUNCHES == 1) xcd_barrier(bar); } while (0)
    const int lo = args.ph_lo, hi = args.ph_hi;
#ifndef REP_MASK
#define REP_MASK 0
#endif
#if REP_MASK
#define REPS(k) for (int rep_ = 0; rep_ <= (((REP_MASK) >> (k)) & 1); ++rep_)
#else
#define REPS(k)
#endif
#ifndef SUB_MASK
#define SUB_MASK 7
#endif
#ifndef PH_MASK
#define PH_MASK 0xFFF
#endif
#define IN(k) ((((PH_MASK) >> (k)) & 1) && lo <= (k) && (k) < hi)
#define BOTH(k) (IN(k) && IN((k) + 1))
    const int bid = blockIdx.x;

    REPS(0) if (IN(0)) { p0_prologue(F, args.sub); if (BOTH(0)) GRID_BAR(); }

    REPS(1) if (IN(1)) {
        const bool late1 = ((blockIdx.x >> 3) & 1u) != 0u;
        if (bid < NB && !(args.sub & 32)) fox_cumsum_unit(F, bid);
        P1 p{WSP(bf16, WS_QA), WSP(bf16, WS_IA), WSP(bf16, WS_GA), WSP(bf16, WS_GB), WSP(bf16, WS_QBH), WSP(bf16, WS_KBH), WSP(bf16, WS_VBH), WSP(bf16, WS_GF), WSP(float, WS_QS), WSP(float, WS_LB), F.out};
        { pg8::Gemm g{WSP(bf16, WS_XN), WSP(bf16, WS_W1T), MP, 4096, DM}; pg8::StaticOrder S; S.init(MP, 4096, F.G, bid);
          Epi1 E{p, (args.sub >> 4) & 1 ? 1 : ((args.sub >> 7) & 1 ? 2 : 0)};
          if (!late1 && !(args.sub & 32)) for (int u = bid; u < 256; u += F.G)
              sgemm_unit(WSP(bf16, WS_XN), WSP(bf16, WS_W1T), u, F.wave, F.lane, SE1{p});
          pg8::gemm_phase<Epi1, pg8::StaticOrder, true, true>(F.lds + RING_OFF, g, S, E); }
        if (late1 && !(args.sub & 32)) for (int u = bid; u < 256; u += F.G)
            sgemm_unit(WSP(bf16, WS_XN), WSP(bf16, WS_W1T), u, F.wave, F.lane, SE1{p});
        if (BOTH(1)) GRID_BAR();
    }

    REPS(2) if (IN(2)) {
        const int half = F.G / 2;
        if (args.sub & 8) {
            dec::DecArgs da{WSP(float, WS_QS), F.ck, F.cv, F.pt, WSP(float, WS_SUFX), WSP(float, WS_PML), WSP(float, WS_PO)};
            float* dl = (float*)(lds + RING_OFF) + (F.wave >> 2) * dec::LDS_FLOATS;
            for (int wu = bid; wu < 256; wu += F.G) { const int du = 2 * wu + (F.wave >> 2); dec::decode_unit(da, du >> 4, (du >> 2) & 3, du & 3, dl, F.wave & 3, F.lane); }
        } else if (bid < half) {
            if ((SUB_MASK & 1) && (args.sub & 1)) for (int L = bid; L < 128; L += half) {
                const int bh = L & 7, x = L >> 3;
                const FoxRef b0 = fox_ref(F.ws, bh, 31 - x), b1 = fox_ref(F.ws, bh, x);
                fox::Seam<fox::TIN> S;
                fox::causal_swa_prime<fox::TIN, fox::TOUT>(b0, fox::WINDOW, (char*)lds + RING_OFF, S);
                FoxRef cur = b0; int pass = 0;
                for (;;) { const bool last = pass == 1; const FoxRef nxt = last ? cur : b1;
                    fox::causal_swa_block<fox::TIN, fox::TOUT>(cur, nxt, fox::SKV, fox::WINDOW, (char*)lds + RING_OFF, S);
                    if (last) break; cur = nxt; pass = 1; }
            }
        } else {
            const int cb = bid - half, nb = F.G - half;
            if ((SUB_MASK & 2) && (args.sub & 2)) { dec::DecArgs da{WSP(float, WS_QS), F.ck, F.cv, F.pt, WSP(float, WS_SUFX), WSP(float, WS_PML), WSP(float, WS_PO)};
              float* dl = (float*)(lds + RING_OFF) + (F.wave >> 2) * dec::LDS_FLOATS;
              for (int wu = cb; wu < 256; wu += nb) { const int du = 2 * wu + (F.wave >> 2); dec::decode_unit(da, du >> 4, du & 3, (du >> 2) & 3, dl, F.wave & 3, F.lane); } }
            __syncthreads();
            LaArgs a{}; a.Q = WSP(bf16, WS_QA); a.Kp = nullptr; a.G = WSP(bf16, WS_GF); a.V = WSP(bf16, WS_IA); a.GATE = WSP(bf16, WS_GA); a.ldv = 512; a.gain = F.hgrn_gain; a.MIXo = WSP(bf16, WS_MIX); a.mixoff = 0;
            if ((SUB_MASK & 4) && (args.sub & 4)) {
              for (int u = cb; u < 256; u += nb) { const int bh = u >> 5, sc = u & 31; a.SBUF = WSP(bf16, WS_SLOC) + (size_t)u * 16384; a.BTOT = WSP(float, WS_BTOT) + (size_t)u * 128;
                  la_unit<128, false, 0>(F.lds + RING_OFF, a, (bh >> 2) * SEQ + sc * 256, bh & 3, F.tid, F.wave, F.lane); }
            }
            if (args.sub == 7) {
              xcd_barrier(bar2);
              if (cb == 0 && F.tid == 0) __hip_atomic_store((unsigned*)(F.ctl + CW_FLAG), 1u, __ATOMIC_RELAXED, __HIP_MEMORY_SCOPE_AGENT);
              la_scan<128>(WSP(bf16, WS_SLOC), WSP(float, WS_BTOT), F.out + O_HSP, cb * 512 + F.tid, nb * 512);
              xcd_barrier(bar2);
              for (int u = cb; u < 256; u += nb) { const int bh = u >> 5, sc = u & 31; a.SBUF = WSP(bf16, WS_SLOC) + (size_t)u * 16384; a.BTOT = nullptr;
                  la_unit<128, false, 1>(F.lds + RING_OFF, a, (bh >> 2) * SEQ + sc * 256, bh & 3, F.tid, F.wave, F.lane); }
            }
        }
        if (args.sub == 7) {
            constexpr int T_S = 128, T_C = 64, T_W = 160, T_ALL = T_S + T_C + T_W;
            LaArgs a{}; a.Q = WSP(bf16, WS_QA); a.Kp = nullptr; a.G = WSP(bf16, WS_GF); a.V = WSP(bf16, WS_IA); a.GATE = WSP(bf16, WS_GA); a.ldv = 512; a.gain = F.hgrn_gain; a.MIXo = WSP(bf16, WS_MIX); a.mixoff = 0;
            dec::CombArgs ca{WSP(float, WS_PML), WSP(float, WS_PO), WSP(float, WS_QS), F.out + O_KS, F.out + O_VS, WSP(float, WS_LFB), WSP(bf16, WS_GB), WSP(bf16, WS_MIX)};
            bool flagged = bid >= half; unsigned nxt = 0u; int par = 0;
            __syncthreads();
            if (F.tid == 0) nxt = __hip_atomic_fetch_add((unsigned*)(F.ctl + CW_TAIL), 1u, __ATOMIC_RELAXED, __HIP_MEMORY_SCOPE_AGENT);
            for (;;) {
                if (F.tid == 0) F.MISC[16 + par] = nxt;
                __syncthreads();
                const int it = __builtin_amdgcn_readfirstlane((int)F.MISC[16 + par]); par ^= 1;
                if (it >= T_ALL) break;
                if (F.tid == 0) nxt = __hip_atomic_fetch_add((unsigned*)(F.ctl + CW_TAIL), 1u, __ATOMIC_RELAXED, __HIP_MEMORY_SCOPE_AGENT);
                if (it < T_S) { a.S0 = F.sh + (size_t)it * 16384; a.S1 = F.out + O_HSS + (size_t)it * 16384;
                    la_sample_unit<128, false>(F.lds + RING_OFF, a, it, F.tid, F.wave, F.lane); }
                else if (it < T_S + T_C) {
                    if (!flagged) { flagged = true;
                        if (F.tid == 0) { unsigned sp = 0; while (__hip_atomic_load((unsigned*)(F.ctl + CW_FLAG), __ATOMIC_RELAXED, __HIP_MEMORY_SCOPE_AGENT) == 0u) { __builtin_amdgcn_s_sleep(2); if (++sp > (1u << 22)) break; }
                            __builtin_amdgcn_fence(__ATOMIC_ACQUIRE, "agent"); asm volatile("s_waitcnt vmcnt(0)" ::: "memory"); }
                        __syncthreads(); }
                    const int r = (it - T_S) * NWAVES + F.wave; dec::combine_row(ca, r >> 4, (r >> 2) & 3, r & 3, F.lane); }
                else { __syncthreads(); late_weights(F, (it - T_S - T_C) * 16 + F.wave, (it - T_S - T_C) * 16 + 16); }
            }
        }
        if (BOTH(2)) GRID_BAR();
    }


    REPS(5) if (IN(5)) {
        P2 p{F.xp, F.xs, WSP(bf16, WS_XN), (float*)(F.ctl + CW_SS1)};
        { pg8::Gemm g{WSP(bf16, WS_MIX), WSP(bf16, WS_W2T), MP, 1024, DM}; pg8::StaticOrder S; S.init(MP, 1024, F.G, bid);
          Epi2 E{p};
          pg8::gemm_phase<Epi2, pg8::StaticOrder, true, true>(F.lds + RING_OFF, g, S, E); }
        for (int u = bid; u < 64; u += F.G)
            sgemm_unit(WSP(bf16, WS_MIX), WSP(bf16, WS_W2T), u, F.wave, F.lane, SE2{p});
        if (BOTH(5)) GRID_BAR();
    }

    REPS(6) if (IN(6)) {
        const bool late6 = ((blockIdx.x >> 3) & 1u) != 0u;
        if ((SUB_MASK & 1) && !(args.sub & 64) && !late6) p6_rpass(F, 0);
        P3 p{WSP(bf16, WS_Q3), WSP(bf16, WS_K3), WSP(bf16, WS_V3), WSP(bf16, WS_G3), (const float*)(F.ctl + CW_SS1)};
        if (SUB_MASK & 2) { pg8::Gemm g{WSP(bf16, WS_XN), WSP(bf16, WS_W3T), MP, 3072, DM}; pg8::StaticOrder S; S.init(MP, 3072, F.G, bid);
          Epi3 E{p, (args.sub >> 4) & 1};
          pg8::gemm_phase<Epi3, pg8::StaticOrder, true, true>(F.lds + RING_OFF, g, S, E); }
        if ((SUB_MASK & 4) && !(args.sub & 32)) for (int u = bid; u < 192; u += F.G)
            sgemm_unit(WSP(bf16, WS_XN), WSP(bf16, WS_W3T), u, F.wave, F.lane, SE3{p});
        if ((SUB_MASK & 1) && !(args.sub & 64)) { __syncthreads(); p6_rpass(F, late6 ? 2 : 1); }
        if (BOTH(6)) GRID_BAR();
    }

    REPS(7) if (IN(7)) {
        LaArgs a{}; a.Q = WSP(bf16, WS_Q3); a.Kp = WSP(bf16, WS_K3); a.G = WSP(bf16, WS_GF3); a.V = WSP(bf16, WS_V3); a.GATE = WSP(bf16, WS_G3); a.ldv = 1024; a.gain = F.gla_gain; a.MIXo = WSP(bf16, WS_MIX2); a.mixoff = 0;
        for (int u = bid; u < 256; u += F.G) { const int bh = u >> 5, sc = u & 31; a.SBUF = WSP(bf16, WS_SLOC3) + (size_t)u * 32768; a.BTOT = WSP(float, WS_BTOT) + 32768 + (size_t)u * 128;
            la_unit<256, true, 0>(F.lds + RING_OFF, a, (bh >> 2) * SEQ + sc * 256, bh & 3, F.tid, F.wave, F.lane); }
        for (int u = bid; u < 128; u += F.G) { a.S0 = F.sg + (size_t)u * 32768; a.S1 = F.out + O_GSS + (size_t)u * 32768;
            la_sample_unit<256, true>(F.lds + RING_OFF, a, u, F.tid, F.wave, F.lane); }
        if (BOTH(7)) GRID_BAR();
    }
    REPS(8) if (IN(8)) {
        la_scan<256>(WSP(bf16, WS_SLOC3), WSP(float, WS_BTOT) + 32768, F.out + O_GSP, bid * 512 + F.tid, F.G * 512);
        if (F.G == 256) { P4 p{WSP(bf16, WS_XN), F.out + O_Y, (float*)(F.ctl + CW_SS2)};
            for (int u = 255 - bid; u < 64; u += F.G) sgemm_unit(WSP(bf16, WS_MIX2), WSP(bf16, WS_W4T), u, F.wave, F.lane, SE4{p}); }
        if (BOTH(8)) GRID_BAR();
    }
    REPS(9) if (IN(9)) {
        LaArgs a{}; a.Q = WSP(bf16, WS_Q3); a.Kp = WSP(bf16, WS_K3); a.G = WSP(bf16, WS_GF3); a.V = WSP(bf16, WS_V3); a.GATE = WSP(bf16, WS_G3); a.ldv = 1024; a.gain = F.gla_gain; a.MIXo = WSP(bf16, WS_MIX2); a.mixoff = 0;
        for (int u = bid; u < 256; u += F.G) { const int bh = u >> 5, sc = u & 31; a.SBUF = WSP(bf16, WS_SLOC3) + (size_t)u * 32768; a.BTOT = nullptr;
            la_unit<256, true, 1>(F.lds + RING_OFF, a, (bh >> 2) * SEQ + sc * 256, bh & 3, F.tid, F.wave, F.lane); }
        if (BOTH(9)) GRID_BAR();
    }
    REPS(10) if (IN(10)) {
        P4 p{WSP(bf16, WS_XN), F.out + O_Y, (float*)(F.ctl + CW_SS2)};
        pg8::Gemm g{WSP(bf16, WS_MIX2), WSP(bf16, WS_W4T), MP, 1024, DM}; pg8::StaticOrder S; S.init(MP, 1024, F.G, bid);
        if (F.G == 256) {
            Epi4F E{p, F.final_norm, &bar};
            pg8::gemm_phase<Epi4F, pg8::StaticOrder, false, true>(F.lds + RING_OFF, g, S, E);
            const int gw = bid * NWAVES + F.wave;
            if (gw < MS) { const int m = MP + gw; GAS f32x4* yr = (GAS f32x4*)(F.out + O_Y + (size_t)m * DM) + F.lane;
                const float rstd = 1.0f / sqrtf(__hip_atomic_load(p.SS + m, __ATOMIC_RELAXED, __HIP_MEMORY_SCOPE_AGENT) * (1.f / DM) + EPS);
#pragma unroll
                for (int j = 0; j < 4; ++j) { const f32x4 gg = *(const GAS f32x4*)(F.final_norm + 4 * F.lane + 256 * j); yr[64 * j] = yr[64 * j] * rstd * gg; } }
        } else {
            Epi4 E{p};
            pg8::gemm_phase<Epi4, pg8::StaticOrder, true, true>(F.lds + RING_OFF, g, S, E);
            for (int u = bid; u < 64; u += F.G) sgemm_unit(WSP(bf16, WS_MIX2), WSP(bf16, WS_W4T), u, F.wave, F.lane, SE4{p});
            if (BOTH(10)) GRID_BAR();
        }
    }
    if (IN(11) && F.G != 256) p11_final(F);
#undef IN
#undef BOTH
}

extern "C" void kernel_launch(void* const* d_in, const int* in_sizes, int n_in, void* d_out, int out_size, void* d_ws, size_t ws_size, hipStream_t stream) {
    static int grid = 0;
    if (grid == 0) {
        if (n_in != 21 || out_size != (int)O_END || ws_size < WS_END) { fprintf(stderr, "kernel_launch: unexpected problem (n_in %d out %d ws %zu)\n", n_in, out_size, ws_size); grid = -1; return; }
        int dev = 0, cus = 0, per_cu = 0;
        if (hipGetDevice(&dev) != hipSuccess || hipDeviceGetAttribute(&cus, hipDeviceAttributeMultiprocessorCount, dev) != hipSuccess) { grid = -1; return; }
        if (hipFuncSetAttribute((const void*)hybrid_fwd, hipFuncAttributeMaxDynamicSharedMemorySize, LDS_BYTES) != hipSuccess) { fprintf(stderr, "kernel_launch: hipFuncSetAttribute failed\n"); grid = -1; return; }
        if (hipOccupancyMaxActiveBlocksPerMultiprocessor(&per_cu, (const void*)hybrid_fwd, NWAVES * 64, LDS_BYTES) != hipSuccess || per_cu < 1)
            fprintf(stderr, "kernel_launch: occupancy query reports %d workgroups per CU\n", per_cu);
        (void)hipGetLastError();
        grid = cus;
    }
    if (grid < 0) return;
    if (hipMemsetAsync((char*)d_ws + WS_CTL, 0, CTL_ZERO_BYTES, stream) != hipSuccess) { fprintf(stderr, "kernel_launch: memset failed\n"); return; }
    Args a{};
    for (int i = 0; i < 21; ++i) a.in[i] = d_in[i];
    a.out = (float*)d_out; a.ws = (unsigned char*)d_ws; a.sub = 7;
    for (int li = 0; li < N_LAUNCHES; ++li) {
        a.ph_lo = (N_LAUNCHES == 1) ? 0 : li; a.ph_hi = (N_LAUNCHES == 1) ? N_PHASES : li + 1;
        hipLaunchKernelGGL(hybrid_fwd, dim3(grid), dim3(NWAVES * 64), LDS_BYTES, stream, a);
        const hipError_t le = hipPeekAtLastError();
        if (le != hipSuccess) { fprintf(stderr, "kernel_launch: launch %d failed: %s\n", li, hipGetErrorName(le)); break; }
    }
#if defined(PROBE_LO)
    for (int r = 0; r < PROBE_REPS; ++r)
        for (int ph = PROBE_LO; ph < PROBE_HI; ++ph) { (void)hipMemsetAsync((char*)d_ws + WS_CTL + (size_t)CW_BAR * 4, 0, (size_t)(CW_SS1 - CW_BAR) * 4, stream); a.sub = PROBE_SUB; a.ph_lo = ph; a.ph_hi = ph + 1; hipLaunchKernelGGL(hybrid_fwd, dim3(grid), dim3(NWAVES * 64), LDS_BYTES, stream, a); }
#endif
}
```

```cpp
#include <hip/hip_runtime.h>
#include <hip/hip_bf16.h>
#include <cstdio>
#include <cstdint>

constexpr int DM = 1024;
constexpr int SEQ = 8192, NB = 2;
constexpr int MP = NB * SEQ;
constexpr int DB = 32, DT = 4;
constexpr int MS = DB * DT;
constexpr int MT = MP + MS;
constexpr int MTP = 16640;
constexpr int EVEN_IN = 4100, ODD_IN = 3088;
constexpr int NH = 4, HD = 128;
constexpr int PAST = 8192, PAGE = 128, NPAGES = PAST / PAGE;
constexpr float EPS = 1e-6f;
constexpr float ATT_SCALE = 0.08838834764831845f;
constexpr float LOG2E = 1.4426950408889634f;

constexpr size_t O_Y = 0;
constexpr size_t O_KP = (size_t)MT * DM;
constexpr size_t O_VP = O_KP + (size_t)MP * 512;
constexpr size_t O_LFP = O_VP + (size_t)MP * 512;
constexpr size_t O_HSP = O_LFP + (size_t)MP * 4;
constexpr size_t O_GSP = O_HSP + (size_t)NB * NH * 128 * 128;
constexpr size_t O_KS = O_GSP + (size_t)NB * NH * 128 * 256;
constexpr size_t O_VS = O_KS + (size_t)MS * 512;
constexpr size_t O_LFS = O_VS + (size_t)MS * 512;
constexpr size_t O_HSS = O_LFS + (size_t)MS * 4;
constexpr size_t O_GSS = O_HSS + (size_t)DB * NH * 128 * 128;
constexpr size_t O_END = O_GSS + (size_t)DB * NH * 128 * 256;
static_assert(O_END == 40567296, "output size");

constexpr size_t MiB = 1u << 20;
constexpr size_t WS_CTL = 0, CTL_ZERO_BYTES = 1 * MiB;
constexpr size_t WS_W1T = 2 * MiB;
constexpr size_t WS_W2T = 10 * MiB;
constexpr size_t WS_W3T = 12 * MiB;
constexpr size_t WS_W4T = 18 * MiB;
constexpr size_t WS_LB = 20 * MiB;
constexpr size_t WS_LFB = 20 * MiB + 65536;
constexpr size_t WS_CB = 21 * MiB;
constexpr size_t WS_SUFX = 22 * MiB;
constexpr size_t WS_PML = 26 * MiB;
constexpr size_t WS_PO = 26 * MiB + 65536;
constexpr size_t WS_BTOT = 28 * MiB;
constexpr size_t WS_WR = 29 * MiB;
constexpr size_t WS_XN = 32 * MiB;
constexpr size_t WS_QA = 66 * MiB;
constexpr size_t WS_IA = 84 * MiB;
constexpr size_t WS_GA = 102 * MiB;
constexpr size_t WS_GB = 120 * MiB;
constexpr size_t WS_GF = 138 * MiB;
constexpr size_t WS_QBH = 172 * MiB;
constexpr size_t WS_KBH = 188 * MiB;
constexpr size_t WS_VBH = 204 * MiB;
constexpr size_t WS_QS = 220 * MiB;
constexpr size_t WS_MIX = 224 * MiB;
constexpr size_t WS_X1 = 258 * MiB;
constexpr size_t WS_SLOC = 324 * MiB;
constexpr size_t WS_Q3 = 342 * MiB;
constexpr size_t WS_K3 = 360 * MiB;
constexpr size_t WS_V3 = 378 * MiB;
constexpr size_t WS_G3 = 412 * MiB;
constexpr size_t WS_GF3 = 446 * MiB;
constexpr size_t WS_SLOC3 = 480 * MiB;
constexpr size_t WS_MIX2 = 512 * MiB;
constexpr size_t WS_END = 546 * MiB;
constexpr int CW_TMO = 0;
constexpr int CW_BAR = 4096;
constexpr int CW_FLAG = 8192;
constexpr int CW_TAIL = 8192 + 64;
constexpr int CW_BAR2 = 12288;
constexpr int CW_SS1 = 16384;
constexpr int CW_SS2 = 40960;
static_assert((CW_SS2 + MT) * 4 <= (int)CTL_ZERO_BYTES, "CTL");

constexpr int RING_OFF = 0, RING_BYTES = 131072;
constexpr int LDSCTL_OFF = 146944, MISC_OFF = LDSCTL_OFF + 320;
constexpr int LDS_BYTES = 147456;
constexpr int NWAVES = 8;
namespace pg8 {
#define PG8_LAS __attribute__((address_space(3)))
typedef unsigned short bf16_t;
typedef short bf16x8 __attribute__((ext_vector_type(8)));
typedef float f32x4 __attribute__((ext_vector_type(4)));
typedef unsigned u32x4 __attribute__((ext_vector_type(4)));
constexpr int BM = 256, BK = 64, HALF = 128, HTB = HALF * BK * 2  , STAGE_BYTES = 8 * HTB, NXCD = 8, WGM = 8;

__host__ __device__ __forceinline__ int lds_byte(int r, int c) { const int st = (r >> 4) * 2 + (c >> 5), rr = r & 15, cc = c & 31, ob = rr * 64 + cc * 2; return st * 1024 + (ob ^ (((ob >> 9) & 1) << 5)); }
__host__ __device__ __forceinline__ void stage_rc(int b, int& R, int& C) { const int st = b / 1024, sb = b % 1024, swz = sb ^ (((sb >> 9) & 1) << 5); R = (st >> 1) * 16 + swz / 64; C = (st & 1) * 32 + (swz % 64) / 2; }
__host__ __device__ __forceinline__ int perm32(int rho) { const int n = rho >> 4, i = rho & 15; return 8 * (i >> 2) + 4 * n + (i & 3); }

struct Unit { int pm, pn; };
struct Gemm { const bf16_t* A; const bf16_t* Bt; int M, N, K; };

struct StaticOrder {
    int nM, nN, nwg, G, c;
    __host__ __device__ void init(int M, int N, int G_, int c_) { nM = M / BM; nN = N / BM; nwg = nM * nN; G = G_; c = c_; }
    __host__ __device__ bool next(int i, Unit& u) const {
        const long L = (long)i * G + c; if (L >= nwg) return false;
        int wgid = (int)L; { const int q = nwg / NXCD, r = nwg % NXCD, xcd = wgid % NXCD, off = wgid / NXCD; wgid = (xcd < r ? xcd * (q + 1) : r * (q + 1) + (xcd - r) * q) + off; }
        const int nig = WGM * nN, gid = wgid / nig, fm = gid * WGM, gsz = (nM - fm) < WGM ? (nM - fm) : WGM;
        u.pm = fm + ((wgid % nig) % gsz); u.pn = (wgid % nig) / gsz; return true;
    }
    __device__ __forceinline__ void a_ready(const Unit&) const {}
    __device__ __forceinline__ void done(const Unit&) const {}
};

__device__ __forceinline__ unsigned cvt_pk_bf16(float lo, float hi) { unsigned r; asm volatile("v_cvt_pk_bf16_f32 %0, %1, %2" : "=v"(r) : "v"(lo), "v"(hi)); return r; }
typedef float f32x2 __attribute__((ext_vector_type(2)));
template <class Epi, class Sched, bool ALIGN_EPI = false, bool SP2 = false>
__device__ __forceinline__ void gemm_phase(PG8_LAS unsigned char* lds, const Gemm g, const Sched& S, const Epi& E) {
    const int tid = threadIdx.x, wid = __builtin_amdgcn_readfirstlane(tid >> 6), lane = tid & 63, wr = wid >> 2, wc = wid & 3, fr = lane & 15, fq = lane >> 4;
    const int K = g.K, nt = K / BK;
    unsigned voffA[2], voffB[2];
#pragma unroll
    for (int i = 0; i < 2; ++i) { int R, C; stage_rc(tid * 16 + i * 8192, R, C); const int Rb = Epi::PERM ? ((R & ~31) + perm32(R & 31)) : R;
        voffA[i] = (unsigned)(R * K + C) * 2u; voffB[i] = (unsigned)(Rb * K + C) * 2u; }
    const size_t kstep = (size_t)(BK * 2);
    const size_t hstep = (size_t)HALF * K * 2;
    const size_t tstep = 2 * hstep;
    const unsigned ldsw = (unsigned)wid * 1024u;
    const int aoff = lds_byte(wr * 64 + fr, fq * 8), boff = lds_byte(wc * 32 + fr, fq * 8);
#define PG8_SA(b, h) (((b) * 2 + (h)) * HTB)
#define PG8_SB(b, h) ((4 + (b) * 2 + (h)) * HTB)
#define PG8_STAGE(bufoff, gbase, voff) do { _Pragma("unroll") for (int _i = 0; _i < 2; ++_i) \
        __builtin_amdgcn_global_load_lds((const unsigned*)((const char*)(gbase) + (voff)[_i]), (PG8_LAS unsigned*)(lds + (bufoff) + ldsw + _i * 8192), 16, 0, 0); } while (0)
#define PG8_LDA(dst, b, h) do { _Pragma("unroll") for (int m = 0; m < 4; ++m) _Pragma("unroll") for (int k = 0; k < 2; ++k) dst[m][k] = *(const PG8_LAS bf16x8*)(lds + PG8_SA(b, h) + aoff + m * 2048 + k * 1024); } while (0)
#define PG8_LDB(dst, b, h) do { _Pragma("unroll") for (int n = 0; n < 2; ++n) _Pragma("unroll") for (int k = 0; k < 2; ++k) dst[n][k] = *(const PG8_LAS bf16x8*)(lds + PG8_SB(b, h) + boff + n * 2048 + k * 1024); } while (0)
#define PG8_MMA(ai, bj, At, Bt) do { __builtin_amdgcn_s_setprio(1); _Pragma("unroll") for (int m = 0; m < 4; ++m) _Pragma("unroll") for (int n = 0; n < 2; ++n) _Pragma("unroll") for (int k = 0; k < 2; ++k) \
        acc[ai][bj][m][n] = __builtin_amdgcn_mfma_f32_16x16x32_bf16(Bt[n][k], At[m][k], acc[ai][bj][m][n], 0, 0, 0); __builtin_amdgcn_s_setprio(0); } while (0)
#define PG8_WAIT_V(n) asm volatile("s_waitcnt vmcnt(" #n ")" ::: "memory")
#define PG8_WAIT_L(n) asm volatile("s_waitcnt lgkmcnt(" #n ")" ::: "memory")
#define PG8_BAR __builtin_amdgcn_s_barrier()
#define PG8_SCHED __builtin_amdgcn_sched_barrier(0)
    Unit cur, nxt; int ui = 0;
    if (!S.next(0, cur)) return;
    f32x4 acc[2][2][4][2];
#pragma unroll
    for (int a = 0; a < 2; ++a)
#pragma unroll
        for (int b = 0; b < 2; ++b)
#pragma unroll
            for (int m = 0; m < 4; ++m)
#pragma unroll
                for (int n = 0; n < 2; ++n) acc[a][b][m][n] = (f32x4){0.f, 0.f, 0.f, 0.f};
    bf16x8 At[4][2], B0[2][2], B1[2][2];
    const char* cA = (const char*)g.A + (size_t)cur.pm * tstep; const char* cB = (const char*)g.Bt + (size_t)cur.pn * tstep;
    S.a_ready(cur);
    if constexpr (SP2) {
        PG8_STAGE(PG8_SB(0, 0), cB, voffB); PG8_STAGE(PG8_SB(0, 1), cB + hstep, voffB); PG8_STAGE(PG8_SA(0, 0), cA, voffA); PG8_STAGE(PG8_SA(0, 1), cA + hstep, voffA);
        if (wr == 1) PG8_BAR;
        PG8_WAIT_V(2); PG8_BAR;
        PG8_STAGE(PG8_SB(1, 0), cB + kstep, voffB); PG8_STAGE(PG8_SA(1, 0), cA + kstep, voffA); PG8_STAGE(PG8_SB(1, 1), cB + hstep + kstep, voffB);
        PG8_WAIT_V(6); PG8_BAR;
    } else {
        PG8_STAGE(PG8_SB(0, 0), cB, voffB); PG8_STAGE(PG8_SA(0, 0), cA, voffA); PG8_STAGE(PG8_SB(0, 1), cB + hstep, voffB); PG8_STAGE(PG8_SA(0, 1), cA + hstep, voffA);
        if (wr == 1) PG8_BAR;
        PG8_WAIT_V(4); PG8_BAR;
        PG8_STAGE(PG8_SB(1, 0), cB + kstep, voffB); PG8_STAGE(PG8_SA(1, 0), cA + kstep, voffA); PG8_STAGE(PG8_SB(1, 1), cB + hstep + kstep, voffB);
        PG8_WAIT_V(6); PG8_BAR;
    }
    for (;;) {
        const bool has_next = S.next(ui + 1, nxt);
        const char* nA = has_next ? (const char*)g.A + (size_t)nxt.pm * tstep : cA; const char* nB = has_next ? (const char*)g.Bt + (size_t)nxt.pn * tstep : cB;
        for (int t = 0; t < nt; t += 2) {
            const bool last = (t == nt - 2);
            const char* a1 = cA + (size_t)(t + 1) * kstep;
            const char* a2 = last ? nA : cA + (size_t)(t + 2) * kstep; const char* b2 = last ? nB : cB + (size_t)(t + 2) * kstep;
            const char* a3 = a2 + kstep; const char* b3 = b2 + kstep;
            if (last && has_next) S.a_ready(nxt);
            if constexpr (SP2) {
            PG8_LDB(B0, 0, 0); PG8_LDB(B1, 0, 1); PG8_SCHED; PG8_LDA(At, 0, 0); PG8_STAGE(PG8_SA(1, 1), a1 + hstep, voffA);
            PG8_WAIT_V(8); PG8_WAIT_L(0); PG8_BAR; PG8_MMA(0, 0, At, B0); PG8_MMA(0, 1, At, B1); PG8_BAR; PG8_SCHED;
            PG8_LDA(At, 0, 1); PG8_STAGE(PG8_SB(0, 0), b2, voffB); PG8_STAGE(PG8_SB(0, 1), b2 + hstep, voffB); PG8_STAGE(PG8_SA(0, 0), a2, voffA);
            PG8_WAIT_V(8); PG8_WAIT_L(0); PG8_BAR; PG8_MMA(1, 0, At, B0); PG8_MMA(1, 1, At, B1); PG8_BAR; PG8_SCHED;
            PG8_LDB(B0, 1, 0); PG8_LDB(B1, 1, 1); PG8_SCHED; PG8_LDA(At, 1, 0); PG8_STAGE(PG8_SA(0, 1), a2 + hstep, voffA);
            PG8_WAIT_V(8); PG8_WAIT_L(0); PG8_BAR; PG8_MMA(0, 0, At, B0); PG8_MMA(0, 1, At, B1); PG8_BAR; PG8_SCHED;
            PG8_LDA(At, 1, 1); PG8_STAGE(PG8_SB(1, 0), b3, voffB); PG8_STAGE(PG8_SB(1, 1), b3 + hstep, voffB); PG8_STAGE(PG8_SA(1, 0), a3, voffA);
            PG8_WAIT_V(8); PG8_WAIT_L(0); PG8_BAR; PG8_MMA(1, 0, At, B0); PG8_MMA(1, 1, At, B1); PG8_BAR; PG8_SCHED;
            } else {
            PG8_LDB(B0, 0, 0); PG8_SCHED; PG8_LDA(At, 0, 0); PG8_STAGE(PG8_SA(1, 1), a1 + hstep, voffA);
            PG8_WAIT_L(8); PG8_BAR; PG8_WAIT_L(0); PG8_MMA(0, 0, At, B0); PG8_BAR; PG8_SCHED;
            PG8_LDB(B1, 0, 1); PG8_STAGE(PG8_SB(0, 0), b2, voffB);
            PG8_BAR; PG8_WAIT_L(0); PG8_MMA(0, 1, At, B1); PG8_BAR;
            PG8_LDA(At, 0, 1); PG8_STAGE(PG8_SA(0, 0), a2, voffA);
            PG8_BAR; PG8_WAIT_L(0); PG8_MMA(1, 0, At, B0); PG8_BAR; PG8_SCHED;
            PG8_STAGE(PG8_SB(0, 1), b2 + hstep, voffB);
            PG8_WAIT_V(6); PG8_BAR; PG8_MMA(1, 1, At, B1); PG8_BAR;
            PG8_LDB(B0, 1, 0); PG8_SCHED; PG8_LDA(At, 1, 0); PG8_STAGE(PG8_SA(0, 1), a2 + hstep, voffA);
            PG8_WAIT_L(8); PG8_BAR; PG8_WAIT_L(0); PG8_MMA(0, 0, At, B0); PG8_BAR; PG8_SCHED;
            PG8_LDB(B1, 1, 1); PG8_STAGE(PG8_SB(1, 0), b3, voffB);
            PG8_BAR; PG8_WAIT_L(0); PG8_MMA(0, 1, At, B1); PG8_BAR;
            PG8_LDA(At, 1, 1); PG8_STAGE(PG8_SA(1, 0), a3, voffA);
            PG8_BAR; PG8_WAIT_L(0); PG8_MMA(1, 0, At, B0); PG8_BAR; PG8_SCHED;
            PG8_STAGE(PG8_SB(1, 1), b3 + hstep, voffB);
            PG8_WAIT_V(6); PG8_BAR; PG8_MMA(1, 1, At, B1); PG8_BAR;
            }
        }
        if constexpr (ALIGN_EPI) { if (wr == 0) PG8_BAR; }
        if constexpr (!Epi::AFTER_DRAIN) { E(acc, cur, wr, wc, fr, fq); S.done(cur); }
        if (!has_next) break;
#pragma unroll
        for (int a = 0; a < 2; ++a)
#pragma unroll
            for (int b = 0; b < 2; ++b)
#pragma unroll
                for (int m = 0; m < 4; ++m)
#pragma unroll
                    for (int n = 0; n < 2; ++n) acc[a][b][m][n] = (f32x4){0.f, 0.f, 0.f, 0.f};
        cur = nxt; cA = nA; cB = nB; ++ui;
        if constexpr (ALIGN_EPI) { if (wr == 1) PG8_BAR; }
    }
    PG8_WAIT_V(0);
    if constexpr (!ALIGN_EPI) { if (wr == 0) PG8_BAR; }
    PG8_BAR;
    if constexpr (Epi::AFTER_DRAIN) { E.fused(acc, cur, wr, wc, fr, fq, lds, wid, lane); S.done(cur); }
#undef PG8_SA
#undef PG8_SB
#undef PG8_STAGE
#undef PG8_LDA
#undef PG8_LDB
#undef PG8_MMA
#undef PG8_WAIT_V
#undef PG8_WAIT_L
#undef PG8_BAR
#undef PG8_SCHED
}
}
#define GAS __attribute__((address_space(1)))
#define LAS __attribute__((address_space(3)))
typedef unsigned short bf16;
typedef unsigned v4u __attribute__((ext_vector_type(4)));
typedef float f32x4 __attribute__((ext_vector_type(4)));
typedef short bf16x8 __attribute__((ext_vector_type(8)));
typedef GAS unsigned gu32;
typedef GAS unsigned long long gu64;
#define RLX_AGENT __ATOMIC_RELAXED, __HIP_MEMORY_SCOPE_AGENT
#define LDS_WAIT() asm volatile("s_waitcnt lgkmcnt(0)" ::: "memory")
#define VM_WAIT() asm volatile("s_waitcnt vmcnt(0)" ::: "memory")
__device__ __forceinline__ unsigned long long rt() { return __builtin_amdgcn_s_memrealtime(); }
__device__ __forceinline__ unsigned f2bf(float f) { unsigned u = __builtin_bit_cast(unsigned, f); return (u + 0x7fffu + ((u >> 16) & 1u)) >> 16; }
__device__ __forceinline__ unsigned pk2(float lo, float hi) { return f2bf(lo) | (f2bf(hi) << 16); }

#define XB_TMO      128
#define XB_XCNT(j)  (256  + 64 * (j))
#define XB_XSUB(j)  (1280 + 64 * (j))
#define XB_XGEN(j)  (2304 + 64 * (j))
#define XB_TOP      3328
#define XB_TOPGEN   3392
#define XCD_BAR_WORDS 3456
#define XB_SPIN_CAP (1u << 18)

__device__ __forceinline__ unsigned xb_ld(unsigned* p)              { return __hip_atomic_load(p, __ATOMIC_RELAXED, __HIP_MEMORY_SCOPE_AGENT); }
__device__ __forceinline__ unsigned xb_add(unsigned* p, unsigned v) { return __hip_atomic_fetch_add(p, v, __ATOMIC_RELAXED, __HIP_MEMORY_SCOPE_AGENT); }
__device__ __forceinline__ unsigned xb_xcc_id() { return (unsigned)__builtin_amdgcn_s_getreg((3 << 11) | 20) & 0xFu; }
#define XB_SPIN(cond, bar) do { unsigned _sp = 0; while (cond) { __builtin_amdgcn_s_sleep(1); \
    if ((++_sp & 255u) == 0u) { if (xb_ld(&(bar)[XB_TMO])) break; if (_sp > XB_SPIN_CAP) { atomicAdd(&(bar)[XB_TMO], 1u); break; } } } } while (0)

struct XcdBarrier {
    unsigned* bar; unsigned x;
    volatile LAS unsigned* st;
    unsigned total;
};

__device__ __forceinline__ XcdBarrier xcd_barrier_post(unsigned* bar, volatile LAS unsigned* st) {
    XcdBarrier b; b.bar = bar; b.x = xb_xcc_id(); b.st = st; b.total = 0u;
    if (threadIdx.x == 0) (void)xb_add(&bar[XB_XCNT(b.x)], 1u);
    return b;
}
__device__ __forceinline__ void xcd_barrier_complete(unsigned* bar, unsigned x, unsigned& nloc, unsigned& nx, unsigned total) {
    const unsigned G = total ? total : gridDim.x * gridDim.y * gridDim.z;
    unsigned sum, cnt, mine, sp = 0u;
    for (;;) {
        sum = 0u; cnt = 0u; mine = 0u;
#pragma unroll
        for (unsigned j = 0; j < 16; ++j) { const unsigned c = xb_ld(&bar[XB_XCNT(j)]); sum += c; cnt += (c > 0u) ? 1u : 0u; mine = (j == x) ? c : mine; }
        if (sum == G) break;
        __builtin_amdgcn_s_sleep(1);
        if ((++sp & 255u) == 0u) { if (xb_ld(&bar[XB_TMO])) break; if (sp > XB_SPIN_CAP) { atomicAdd(&bar[XB_TMO], 1u); break; } }
    }
    nloc = mine > 0u ? mine : 1u; nx = cnt > 0u ? cnt : 1u;
}

__device__ __forceinline__ void xcd_barrier(const XcdBarrier& b) {
    asm volatile("s_waitcnt vmcnt(0)" ::: "memory");
    __syncthreads();
    if (threadIdx.x == 0) {
        unsigned* bar = b.bar;
        __builtin_amdgcn_s_waitcnt(0);
        unsigned nloc = b.st[0], nx = b.st[1];
        if (nloc == 0u) { xcd_barrier_complete(bar, b.x, nloc, nx, b.total); b.st[0] = nloc; b.st[1] = nx; }
        const unsigned old = xb_add(&bar[XB_XSUB(b.x)], 1u);
        const unsigned gen = old / nloc;
        if (old + 1u == (gen + 1u) * nloc) {
            __builtin_amdgcn_fence(__ATOMIC_RELEASE, "agent");
            asm volatile("s_waitcnt vmcnt(0)" ::: "memory");
            const unsigned og = xb_add(&bar[XB_TOP], 1u);
            const unsigned tg = og / nx;
            if (og + 1u == (tg + 1u) * nx) xb_add(&bar[XB_TOPGEN], 1u);
            else XB_SPIN(xb_ld(&bar[XB_TOPGEN]) == tg, bar);
            __builtin_amdgcn_fence(__ATOMIC_ACQUIRE, "agent");
            xb_add(&bar[XB_XGEN(b.x)], 1u);
            asm volatile("s_waitcnt vmcnt(0)" ::: "memory");
        } else {
            XB_SPIN(xb_ld(&bar[XB_XGEN(b.x)]) == gen, bar);
            __builtin_amdgcn_fence(__ATOMIC_ACQUIRE, "agent");
            asm volatile("s_waitcnt vmcnt(0)" ::: "memory");
        }
    }
    __syncthreads();
}

typedef unsigned u32x2v __attribute__((ext_vector_type(2)));
struct Frame {
    LAS unsigned char* lds;
    volatile LAS unsigned* MISC;
    gu32* ctl;
    int tid, lane, wave;
    int G;
    unsigned char* ws;
    float* out;
    const float *xp, *xs, *ck, *cv, *clf, *sh, *sg; const int* pt;
    const float *norm_even, *w_in_even, *b_fox, *lb_logits, *hgrn_gain, *w_out_even, *norm_odd, *w_in_odd, *w_gla_gate, *b_gla_gate, *gla_gain, *w_out_odd, *final_norm;
};
#define WSP(T, off) ((T*)(F.ws + (off)))

template <int CTRL> __device__ __forceinline__ float dppf(float x) { return __builtin_bit_cast(float, __builtin_amdgcn_mov_dpp(__builtin_bit_cast(int, x), CTRL, 0xf, 0xf, true)); }
__device__ __forceinline__ float row16_sum(float v) { v += dppf<0xB1>(v); v += dppf<0x4E>(v); v += dppf<0x141>(v); v += dppf<0x140>(v); return v; }
__device__ __forceinline__ float wave_sum(float v) {
    v = row16_sum(v);
    auto s = __builtin_amdgcn_permlane16_swap(__float_as_uint(v), __float_as_uint(v), false, false); v = __uint_as_float(s[0]) + __uint_as_float(s[1]);
    auto t = __builtin_amdgcn_permlane32_swap(__float_as_uint(v), __float_as_uint(v), false, false); return __uint_as_float(t[0]) + __uint_as_float(t[1]);
}
__device__ __forceinline__ float fast_exp(float x) { return __builtin_amdgcn_exp2f(x * LOG2E); }
__device__ __forceinline__ float sigmoidf_(float x) { return __builtin_amdgcn_rcpf(1.0f + fast_exp(-x)); }
__device__ __forceinline__ float siluf_(float x) { return x * sigmoidf_(x); }
__device__ __forceinline__ float log_sigmoidf_(float x) {
    const float e = __builtin_amdgcn_exp2f(-fabsf(x) * LOG2E);
    return fminf(x, 0.f) - __builtin_amdgcn_logf(1.0f + e) * 0.6931471805599453f;
}
typedef float f32x2_t __attribute__((ext_vector_type(2)));
typedef __bf16 bf16x2_t __attribute__((ext_vector_type(2)));
__device__ __forceinline__ unsigned cvtpk_s(float lo, float hi) { f32x2_t v = {lo, hi}; bf16x2_t b = __builtin_convertvector(v, bf16x2_t); return __builtin_bit_cast(unsigned, b); }
__device__ __forceinline__ bf16x8 pack8f(f32x4 a, f32x4 b) { v4u w = {cvtpk_s(a[0], a[1]), cvtpk_s(a[2], a[3]), cvtpk_s(b[0], b[1]), cvtpk_s(b[2], b[3])}; return __builtin_bit_cast(bf16x8, w); }
__device__ __forceinline__ float bf2f(unsigned short b) { return __builtin_bit_cast(float, (unsigned)b << 16); }
__device__ __forceinline__ void st_bf4(bf16* p, f32x4 v) { u32x2v w; w.x = cvtpk_s(v[0], v[1]); w.y = cvtpk_s(v[2], v[3]); *(GAS u32x2v*)p = w; }
__device__ __forceinline__ void st_bf8(bf16* p, f32x4 a, f32x4 b) { v4u w = {cvtpk_s(a[0], a[1]), cvtpk_s(a[2], a[3]), cvtpk_s(b[0], b[1]), cvtpk_s(b[2], b[3])}; *(GAS v4u*)p = w; }

__device__ __forceinline__ void p0_transpose_item(const float* W, int K, int ld, int N, bf16* WT, LAS float* scr, int item, int lane, const float* gain) {
    const int nblk = N / 32, kb = item / nblk, nb = item % nblk, k0 = 64 * kb, n0 = 32 * nb;
    float wv[32];
#pragma unroll
    for (int i = 0; i < 32; ++i) { const int kk = 2 * i + (lane >> 5); wv[i] = W[(size_t)(k0 + kk) * ld + n0 + (lane & 31)]; }
#pragma unroll
    for (int i = 0; i < 32; ++i) { const int kk = 2 * i + (lane >> 5); float w = wv[i]; if (gain) w *= gain[k0 + kk]; scr[kk * 33 + (lane & 31)] = w; }
    LDS_WAIT(); asm volatile("" ::: "memory");
    const int c = lane & 7;
#pragma unroll
    for (int j = 0; j < 4; ++j) { const int n = (lane >> 3) + 8 * j; const LAS float* s = scr + (8 * c) * 33 + n;
        v4u o; o.x = pk2(s[0 * 33], s[1 * 33]); o.y = pk2(s[2 * 33], s[3 * 33]); o.z = pk2(s[4 * 33], s[5 * 33]); o.w = pk2(s[6 * 33], s[7 * 33]);
        *(GAS v4u*)(WT + (size_t)(n0 + n) * K + k0 + 8 * c) = o; }
    LDS_WAIT(); asm volatile("" ::: "memory");
}

__device__ __forceinline__ float block_excl_scan(float v, LAS float* scr, int lane, int wave, float* total) {
    float inc = v;
#pragma unroll
    for (int o = 1; o < 64; o <<= 1) { const float t = __shfl_up(inc, o); if (lane >= o) inc += t; }
    if (lane == 63) scr[wave] = inc;
    __syncthreads();
    float pre = 0.f, tot = 0.f;
#pragma unroll
    for (int w = 0; w < 8; ++w) { const float t = scr[w]; if (w < wave) pre += t; tot += t; }
    __syncthreads();
    *total = tot;
    return pre + inc - v;
}

__device__ __forceinline__ void p0_prologue(Frame& F, int sub) {
    LAS float* scr = (LAS float*)(F.lds + RING_OFF + F.wave * 16384);
    const int gw = (int)blockIdx.x * NWAVES + F.wave, NGW = F.G * NWAVES;
    constexpr int I1 = 16 * (4096 / 32);
    if (sub & 1) for (int it = gw; it < I1; it += NGW) p0_transpose_item(F.w_in_even, DM, EVEN_IN, 4096, WSP(bf16, WS_W1T), scr, it, F.lane, nullptr);
    if (blockIdx.x == 0) { float* LB = WSP(float, WS_LB); const int c = F.tid; LB[c] = 1.0f / (1.0f + __expf(F.lb_logits[512 + c] - F.lb_logits[c])); }
    { bf16* WRB = WSP(bf16, WS_WR); bf16* WGB = WSP(bf16, WS_WR + 65536); const int gt = (int)blockIdx.x * 512 + F.tid;
      for (int e = gt; e < 16 * 1024; e += F.G * 512) { const int j = e >> 10, k = e & 1023; WRB[e] = (bf16)(cvtpk_s(F.w_in_odd[(size_t)k * ODD_IN + 3072 + j] * F.norm_odd[k], 0.f) & 0xffffu); }
      for (int e = gt; e < 512 * 16; e += F.G * 512) { const int c = e >> 4, j = e & 15; WGB[e] = (bf16)(cvtpk_s(F.w_gla_gate[j * 512 + c], 0.f) & 0xffffu); } }
    __syncthreads();
    if ((sub & 2) && blockIdx.x < DB) {
        const int b = blockIdx.x; float* SUFX = WSP(float, WS_SUFX);
        LAS float* sscr = (LAS float*)(F.lds + RING_OFF);
        const int i = F.tid; f32x4 v[16];
#pragma unroll
        for (int j = 0; j < 16; ++j) { const int s = 8191 - (16 * i + j); const int pg = F.pt[b * NPAGES + (s >> 7)]; v[j] = *(const GAS f32x4*)(F.clf + ((size_t)pg * PAGE + (s & 127)) * 4); }
        f32x4 run = {0.f, 0.f, 0.f, 0.f};
#pragma unroll
        for (int j = 0; j < 16; ++j) { const f32x4 t = v[j]; v[j] = run; run += t; }
        f32x4 pre;
        {
            f32x4 inc = run;
#pragma unroll
            for (int o = 1; o < 64; o <<= 1) { f32x4 t; t.x = __shfl_up(inc.x, o); t.y = __shfl_up(inc.y, o); t.z = __shfl_up(inc.z, o); t.w = __shfl_up(inc.w, o); if (F.lane >= o) inc += t; }
            if (F.lane == 63) *(LAS f32x4*)(sscr + 4 * F.wave) = inc;
            __syncthreads();
            f32x4 p = {0.f, 0.f, 0.f, 0.f};
#pragma unroll
            for (int w = 0; w < 8; ++w) { const f32x4 t = *(const LAS f32x4*)(sscr + 4 * w); if (w < F.wave) p += t; }
            pre = p + inc - run; }
        const int sb = 8191 - (16 * i + 15);
#pragma unroll
        for (int q = 0; q < 4; ++q) {
            const f32x4 o3 = (v[15 - 4 * q] + pre) * LOG2E, o2 = (v[14 - 4 * q] + pre) * LOG2E, o1 = (v[13 - 4 * q] + pre) * LOG2E, o0 = (v[12 - 4 * q] + pre) * LOG2E;
            *(GAS f32x4*)(SUFX + (size_t)(b * 4 + 0) * PAST + sb + 4 * q) = (f32x4){o3.x, o2.x, o1.x, o0.x};
            *(GAS f32x4*)(SUFX + (size_t)(b * 4 + 1) * PAST + sb + 4 * q) = (f32x4){o3.y, o2.y, o1.y, o0.y};
            *(GAS f32x4*)(SUFX + (size_t)(b * 4 + 2) * PAST + sb + 4 * q) = (f32x4){o3.z, o2.z, o1.z, o0.z};
            *(GAS f32x4*)(SUFX + (size_t)(b * 4 + 3) * PAST + sb + 4 * q) = (f32x4){o3.w, o2.w, o1.w, o0.w}; }
    }
    LAS float* wfb = (LAS float*)(F.lds + RING_OFF);
    __syncthreads();
    for (int k = F.tid; k < 1024; k += 512) *(LAS f32x4*)(wfb + 4 * k) = *(const GAS f32x4*)(F.w_in_even + (size_t)k * EVEN_IN + 4096);
    __syncthreads();
    bf16* XN = WSP(bf16, WS_XN); float* LFB = WSP(float, WS_LFB);
    const float bfl = F.b_fox[F.lane & 3];
    f32x4 gn[4];
#pragma unroll
    for (int j = 0; j < 4; ++j) gn[j] = *(const GAS f32x4*)(F.norm_even + 4 * F.lane + 256 * j);
    constexpr int NSW = DB * NWAVES, RSPLIT = MT - 5 * NSW;
    int m0r = gw, mstep = NGW, mend = MT;
    if (NGW > NSW) { if (gw < NSW) { m0r = RSPLIT + gw; mstep = NSW; mend = MT; } else { m0r = gw - NSW; mstep = NGW - NSW; mend = RSPLIT; } }
    f32x4 vn[4];
    if (m0r < mend) { const float* xrow = m0r < MP ? F.xp + (size_t)m0r * DM : F.xs + (size_t)(m0r - MP) * DM; const GAS f32x4* xr = (const GAS f32x4*)xrow + F.lane;
#pragma unroll
        for (int j = 0; j < 4; ++j) vn[j] = __builtin_nontemporal_load(xr + 64 * j); }
    if (sub & 4) for (int m = m0r; m < mend; m += mstep) {
        f32x4 v[4]; float s = 0.f;
#pragma unroll
        for (int j = 0; j < 4; ++j) v[j] = vn[j];
        { const int mn = (m + mstep < mend) ? m + mstep : m; const float* xrow = mn < MP ? F.xp + (size_t)mn * DM : F.xs + (size_t)(mn - MP) * DM; const GAS f32x4* xr = (const GAS f32x4*)xrow + F.lane;
#pragma unroll
            for (int j = 0; j < 4; ++j) vn[j] = __builtin_nontemporal_load(xr + 64 * j); }
#pragma unroll
        for (int j = 0; j < 4; ++j) s += (v[j].x * v[j].x + v[j].y * v[j].y) + (v[j].z * v[j].z + v[j].w * v[j].w);
        const float rstd = 1.0f / sqrtf(wave_sum(s) * (1.f / DM) + EPS);
        f32x4 d = {0.f, 0.f, 0.f, 0.f};
        GAS unsigned long long* o8 = (GAS unsigned long long*)(XN + (size_t)m * DM) + F.lane;
#pragma unroll
        for (int j = 0; j < 4; ++j) { const int c0 = 4 * F.lane + 256 * j;
            const f32x4 h = v[j] * rstd * gn[j];
            o8[64 * j] = (unsigned long long)cvtpk_s(h.x, h.y) | ((unsigned long long)cvtpk_s(h.z, h.w) << 32);
            d += h.x * *(LAS f32x4*)(wfb + 4 * c0) + h.y * *(LAS f32x4*)(wfb + 4 * c0 + 4) + h.z * *(LAS f32x4*)(wfb + 4 * c0 + 8) + h.w * *(LAS f32x4*)(wfb + 4 * c0 + 12); }
        d.x = wave_sum(d.x); d.y = wave_sum(d.y); d.z = wave_sum(d.z); d.w = wave_sum(d.w);
        if (F.lane < 4) { const float dj = F.lane == 0 ? d.x : F.lane == 1 ? d.y : F.lane == 2 ? d.z : d.w; const float lf = log_sigmoidf_(dj + bfl);
            LFB[(size_t)m * 4 + F.lane] = lf;
            float* o = m < MP ? F.out + O_LFP + (size_t)m * 4 : F.out + O_LFS + (size_t)(m - MP) * 4; o[F.lane] = lf; }
    }
    __syncthreads();
}

__device__ __forceinline__ void late_weights(Frame& F, int gwi, int nw) {
    LAS float* scr = (LAS float*)(F.lds + RING_OFF + F.wave * 16384);
    constexpr int I2 = 16 * (1024 / 32), I3 = 16 * (3072 / 32), I4 = I2;
    for (int it = gwi; it < I2 + I3 + I4 && it < nw; it += NWAVES) {
        int r = it;
        if (r < I2) { p0_transpose_item(F.w_out_even, DM, DM, 1024, WSP(bf16, WS_W2T), scr, r, F.lane, nullptr); continue; } r -= I2;
        if (r < I3) { p0_transpose_item(F.w_in_odd, DM, ODD_IN, 3072, WSP(bf16, WS_W3T), scr, r, F.lane, F.norm_odd); continue; } r -= I3;
        p0_transpose_item(F.w_out_odd, DM, DM, 1024, WSP(bf16, WS_W4T), scr, r, F.lane, nullptr);
    }
}
__device__ __forceinline__ void fox_cumsum_unit(Frame& F, int b) {
    const float* LFB = WSP(float, WS_LFB); float* CB = WSP(float, WS_CB);
    LAS float* sscr = (LAS float*)(F.lds + RING_OFF);
    f32x4 v[16]; f32x4 run = {0.f, 0.f, 0.f, 0.f};
#pragma unroll
    for (int j = 0; j < 16; ++j) v[j] = *(const GAS f32x4*)(LFB + (size_t)(b * SEQ + 16 * F.tid + j) * 4);
#pragma unroll
    for (int j = 0; j < 16; ++j) { run += v[j]; v[j] = run; }
    f32x4 pre;
    {   f32x4 inc = run;
#pragma unroll
        for (int o = 1; o < 64; o <<= 1) { f32x4 t; t.x = __shfl_up(inc.x, o); t.y = __shfl_up(inc.y, o); t.z = __shfl_up(inc.z, o); t.w = __shfl_up(inc.w, o); if (F.lane >= o) inc += t; }
        if (F.lane == 63) *(LAS f32x4*)(sscr + 4 * F.wave) = inc;
        __syncthreads();
        f32x4 p = {0.f, 0.f, 0.f, 0.f};
#pragma unroll
        for (int w = 0; w < 8; ++w) { const f32x4 t = *(const LAS f32x4*)(sscr + 4 * w); if (w < F.wave) p += t; }
        pre = p + inc - run;
        __syncthreads(); }
    const float ns = -1.0f / ATT_SCALE;
#pragma unroll
    for (int q = 0; q < 4; ++q) { const f32x4 o0 = (v[4 * q] + pre) * ns, o1 = (v[4 * q + 1] + pre) * ns, o2 = (v[4 * q + 2] + pre) * ns, o3 = (v[4 * q + 3] + pre) * ns;
        const size_t off = (size_t)16 * F.tid + 4 * q;
        *(GAS f32x4*)(CB + (size_t)(b * 4 + 0) * SEQ + off) = (f32x4){o0.x, o1.x, o2.x, o3.x};
        *(GAS f32x4*)(CB + (size_t)(b * 4 + 1) * SEQ + off) = (f32x4){o0.y, o1.y, o2.y, o3.y};
        *(GAS f32x4*)(CB + (size_t)(b * 4 + 2) * SEQ + off) = (f32x4){o0.z, o1.z, o2.z, o3.z};
        *(GAS f32x4*)(CB + (size_t)(b * 4 + 3) * SEQ + off) = (f32x4){o0.w, o1.w, o2.w, o3.w}; }
}

struct P1 { bf16 *QA, *IA, *GA, *GB, *QBH, *KBH, *VBH, *GF; float *QS; const float* LB; float* out; };
__device__ __forceinline__ void epi1_4(const P1& p, int m, int c, f32x4 v) {
    const int sec = c >> 9, cs = c & 511;
    const size_t rc = (size_t)m * 512 + cs;
    switch (sec) {
    case 0: st_bf4(p.QA + rc, v); break;
    case 1: { const f32x4 lb = *(const GAS f32x4*)(p.LB + cs); f32x4 g;
#pragma unroll
        for (int i = 0; i < 4; ++i) { const float f = lb[i] + (1.0f - lb[i]) * sigmoidf_(v[i]); g[i] = __logf(f); }
        st_bf4(p.GF + rc, g); } break;
    case 2: st_bf4(p.IA + rc, v); break;
    case 3: { f32x4 g; for (int i = 0; i < 4; ++i) g[i] = siluf_(v[i]); st_bf4(p.GA + rc, g); } break;
    case 4: if (m < MP) { const int b = m >> 13, s = m & 8191, h = cs >> 7, d = cs & 127; st_bf4(p.QBH + ((size_t)((b * 4 + h) * SEQ + s) * HD + d), v); }
            else *(GAS f32x4*)(p.QS + (size_t)(m - MP) * 512 + cs) = v;
            break;
    case 5: if (m < MP) { const int b = m >> 13, s = m & 8191, h = cs >> 7, d = cs & 127; st_bf4(p.KBH + ((size_t)((b * 4 + h) * SEQ + s) * HD + d), v); *(GAS f32x4*)(p.out + O_KP + rc) = v; }
            else *(GAS f32x4*)(p.out + O_KS + (size_t)(m - MP) * 512 + cs) = v;
            break;
    case 6: if (m < MP) { const int b = m >> 13, s = m & 8191, h = cs >> 7, d = cs & 127; st_bf4(p.VBH + ((size_t)((b * 4 + h) * SEQ + s) * HD + d), v); *(GAS f32x4*)(p.out + O_VP + rc) = v; }
            else *(GAS f32x4*)(p.out + O_VS + (size_t)(m - MP) * 512 + cs) = v;
            break;
    default: { f32x4 g; for (int i = 0; i < 4; ++i) g[i] = siluf_(v[i]); st_bf4(p.GB + rc, g); } break;
    }
}
struct P2 { const float *xp, *xs; bf16* X1B; float* SS; };
__device__ __forceinline__ float epi2_4(const P2& p, int m, int c, f32x4 v) {
    const float* xr = m < MP ? p.xp + (size_t)m * DM : p.xs + (size_t)(m - MP) * DM;
    const f32x4 o = *(const GAS f32x4*)(xr + c) + v;
    st_bf4(p.X1B + (size_t)m * DM + c, o);
    return (o.x * o.x + o.y * o.y) + (o.z * o.z + o.w * o.w);
}
struct P3 { bf16 *Q3, *K3, *V3, *G3; const float* SS; };
__device__ __forceinline__ void epi3_4(const P3& p, int m, int c, f32x4 v, float rstd) {
    v = v * rstd;
    if (c < 512) { st_bf4(p.Q3 + (size_t)m * 512 + c, v * ATT_SCALE); }
    else if (c < 1024) { st_bf4(p.K3 + (size_t)m * 512 + (c - 512), v); }
    else if (c < 2048) { st_bf4(p.V3 + (size_t)m * 1024 + (c - 1024), v); }
    else { f32x4 g; for (int i = 0; i < 4; ++i) g[i] = siluf_(v[i]); st_bf4(p.G3 + (size_t)m * 1024 + (c - 2048), g); }
}
struct P4 { const bf16* X1B; float* Y; float* SS; };
__device__ __forceinline__ float epi4_4(const P4& p, int m, int c, f32x4 v) {
    const u32x2v xb = *(const GAS u32x2v*)(p.X1B + (size_t)m * DM + c);
    const f32x4 o = (f32x4){__uint_as_float(xb.x << 16), __uint_as_float(xb.x & 0xffff0000u), __uint_as_float(xb.y << 16), __uint_as_float(xb.y & 0xffff0000u)} + v;
    *(GAS f32x4*)(p.Y + (size_t)m * DM + c) = o;
    return (o.x * o.x + o.y * o.y) + (o.z * o.z + o.w * o.w);
}

__device__ __forceinline__ f32x4 silu4(f32x4 v) { f32x4 g; g.x = siluf_(v.x); g.y = siluf_(v.y); g.z = siluf_(v.z); g.w = siluf_(v.w); return g; }
struct Epi1 { static constexpr bool PERM = true, AFTER_DRAIN = false; P1 p; int skip;
    __device__ __forceinline__ void operator()(const pg8::f32x4 (&acc)[2][2][4][2], const pg8::Unit& u, int wr, int wc, int fr, int fq) const {
        if (skip == 1) { asm volatile("" :: "v"(acc[0][0][0][0][0]), "v"(acc[1][1][3][1][3])); return; }
        if (skip == 2) {
            const int lane_ = threadIdx.x & 63, wv_ = threadIdx.x >> 6; const int sec_ = u.pn >> 1;
            bf16* sb = p.QA + ((size_t)((u.pm * 16 + u.pn) & 255) * 8 + wv_) * 65536;
            int n_ = 0;
#pragma unroll
            for (int ai = 0; ai < 2; ++ai)
#pragma unroll
                for (int m = 0; m < 4; ++m)
#pragma unroll
                    for (int bj = 0; bj < 2; ++bj) { st_bf8(sb + (size_t)n_ * 512 + lane_ * 8, acc[ai][bj][m][0], acc[ai][bj][m][1]); ++n_;
                        if (sec_ == 5 || sec_ == 6 || sec_ == 1) { float* fp = (float*)(sb + 16384) + (size_t)(2 * n_) * 256 + lane_ * 4; *(GAS f32x4*)fp = acc[ai][bj][m][0]; *(GAS f32x4*)(fp + 256) = acc[ai][bj][m][1]; } }
            return; }
        const int sec = u.pn >> 1, row0 = u.pm * 256 + wr * 64 + fr, cs0 = (u.pn & 1) * 256 + wc * 32 + 8 * fq;
#define EPI1_LOOP(...) _Pragma("unroll") for (int ai = 0; ai < 2; ++ai) _Pragma("unroll") for (int m = 0; m < 4; ++m) { const int row = row0 + ai * 128 + m * 16; \
            _Pragma("unroll") for (int bj = 0; bj < 2; ++bj) { const int cs = cs0 + bj * 128; const f32x4 v0 = acc[ai][bj][m][0], v1 = acc[ai][bj][m][1]; __VA_ARGS__ } }
        if (sec == 0) { EPI1_LOOP( st_bf8(p.QA + (size_t)row * 512 + cs, v0, v1); ) }
        else if (sec == 2) { EPI1_LOOP( st_bf8(p.IA + (size_t)row * 512 + cs, v0, v1); ) }
        else if (sec == 3) { EPI1_LOOP( st_bf8(p.GA + (size_t)row * 512 + cs, silu4(v0), silu4(v1)); ) }
        else if (sec == 7) { EPI1_LOOP( st_bf8(p.GB + (size_t)row * 512 + cs, silu4(v0), silu4(v1)); ) }
        else if (sec == 1) {
            f32x4 lb[2][2];
#pragma unroll
            for (int bj = 0; bj < 2; ++bj) { lb[bj][0] = *(const GAS f32x4*)(p.LB + cs0 + bj * 128); lb[bj][1] = *(const GAS f32x4*)(p.LB + cs0 + bj * 128 + 4); }
            EPI1_LOOP( f32x4 g0, g1;
                _Pragma("unroll") for (int i = 0; i < 4; ++i) { g0[i] = __logf(lb[bj][0][i] + (1.0f - lb[bj][0][i]) * sigmoidf_(v0[i])); g1[i] = __logf(lb[bj][1][i] + (1.0f - lb[bj][1][i]) * sigmoidf_(v1[i])); }
                st_bf8(p.GF + (size_t)row * 512 + cs, g0, g1); )
        } else {
            bf16* hb = sec == 4 ? p.QBH : sec == 5 ? p.KBH : p.VBH;
            float* fo = sec == 5 ? p.out + O_KP : p.out + O_VP;
            const int hbase = (u.pn & 1) * 2, d = wc * 32 + 8 * fq;
            EPI1_LOOP( const int b = row >> 13, s = row & 8191;
                st_bf8(hb + ((size_t)((b * 4 + hbase + bj) * SEQ + s) * HD + d), v0, v1);
                if (sec != 4) { float* op = fo + (size_t)row * 512 + cs; __builtin_nontemporal_store(v0, (GAS f32x4*)op); __builtin_nontemporal_store(v1, (GAS f32x4*)(op + 4)); } )
        }
#undef EPI1_LOOP
    } };
struct Epi2 { static constexpr bool PERM = true, AFTER_DRAIN = false; P2 p;
    __device__ __forceinline__ void operator()(const pg8::f32x4 (&acc)[2][2][4][2], const pg8::Unit& u, int wr, int wc, int fr, int fq) const {
        const int row0 = u.pm * 256 + wr * 64 + fr, c0 = u.pn * 256 + wc * 32 + 8 * fq;
#pragma unroll
        for (int ai = 0; ai < 2; ++ai)
#pragma unroll
            for (int m = 0; m < 4; ++m) { const int row = row0 + ai * 128 + m * 16; float ss = 0.f;
#pragma unroll
                for (int bj = 0; bj < 2; ++bj) { const size_t off = (size_t)row * DM + c0 + bj * 128;
                    const f32x4 o0 = *(const GAS f32x4*)(p.xp + off) + acc[ai][bj][m][0], o1 = *(const GAS f32x4*)(p.xp + off + 4) + acc[ai][bj][m][1];
                    st_bf8(p.X1B + off, o0, o1);
                    ss += ((o0.x * o0.x + o0.y * o0.y) + (o0.z * o0.z + o0.w * o0.w)) + ((o1.x * o1.x + o1.y * o1.y) + (o1.z * o1.z + o1.w * o1.w)); }
                ss += __shfl_xor(ss, 16); ss += __shfl_xor(ss, 32);
                if (fq == 0) atomicAdd(p.SS + row, ss); }
    } };
struct Epi3 { static constexpr bool PERM = true, AFTER_DRAIN = false; P3 p; int skip;
    __device__ __forceinline__ void operator()(const pg8::f32x4 (&acc)[2][2][4][2], const pg8::Unit& u, int wr, int wc, int fr, int fq) const {
        if (skip) { asm volatile("" :: "v"(acc[0][0][0][0][0]), "v"(acc[1][1][3][1][3])); return; }
        const int row0 = u.pm * 256 + wr * 64 + fr, cl = (u.pn * 256 + wc * 32 + 8 * fq);
        const int kind = u.pn < 2 ? 0 : u.pn < 4 ? 1 : u.pn < 8 ? 2 : 3;
        bf16* dst = kind == 0 ? p.Q3 : kind == 1 ? p.K3 : kind == 2 ? p.V3 : p.G3;
        const int ld = kind < 2 ? 512 : 1024, cb = kind == 0 ? cl : kind == 1 ? cl - 512 : kind == 2 ? cl - 1024 : cl - 2048;
#pragma unroll
        for (int ai = 0; ai < 2; ++ai)
#pragma unroll
            for (int m = 0; m < 4; ++m) { const int row = row0 + ai * 128 + m * 16;
                float rstd = 1.0f / sqrtf(__hip_atomic_load(p.SS + row, __ATOMIC_RELAXED, __HIP_MEMORY_SCOPE_AGENT) * (1.f / DM) + EPS);
                if (kind == 0) rstd *= ATT_SCALE;
#pragma unroll
                for (int bj = 0; bj < 2; ++bj) { f32x4 v0 = acc[ai][bj][m][0] * rstd, v1 = acc[ai][bj][m][1] * rstd;
                    if (kind == 3) { v0 = silu4(v0); v1 = silu4(v1); }
                    st_bf8(dst + (size_t)row * ld + cb + bj * 128, v0, v1); } }
    } };
struct Epi4 { static constexpr bool PERM = true, AFTER_DRAIN = false; P4 p;
    __device__ __forceinline__ void operator()(const pg8::f32x4 (&acc)[2][2][4][2], const pg8::Unit& u, int wr, int wc, int fr, int fq) const {
        const int row0 = u.pm * 256 + wr * 64 + fr, c0 = u.pn * 256 + wc * 32 + 8 * fq;
#pragma unroll
        for (int ai = 0; ai < 2; ++ai)
#pragma unroll
            for (int m = 0; m < 4; ++m) { const int row = row0 + ai * 128 + m * 16; float ss = 0.f;
#pragma unroll
                for (int bj = 0; bj < 2; ++bj) { const size_t off = (size_t)row * DM + c0 + bj * 128;
                    const v4u xb = *(const GAS v4u*)(p.X1B + off);
                    const f32x4 o0 = (f32x4){__uint_as_float(xb.x << 16), __uint_as_float(xb.x & 0xffff0000u), __uint_as_float(xb.y << 16), __uint_as_float(xb.y & 0xffff0000u)} + acc[ai][bj][m][0];
                    const f32x4 o1 = (f32x4){__uint_as_float(xb.z << 16), __uint_as_float(xb.z & 0xffff0000u), __uint_as_float(xb.w << 16), __uint_as_float(xb.w & 0xffff0000u)} + acc[ai][bj][m][1];
                    *(GAS f32x4*)(p.Y + off) = o0; *(GAS f32x4*)(p.Y + off + 4) = o1;
                    ss += ((o0.x * o0.x + o0.y * o0.y) + (o0.z * o0.z + o0.w * o0.w)) + ((o1.x * o1.x + o1.y * o1.y) + (o1.z * o1.z + o1.w * o1.w)); }
                ss += __shfl_xor(ss, 16); ss += __shfl_xor(ss, 32);
                if (fq == 0) atomicAdd(p.SS + row, ss); }
    } };

struct Epi4F { static constexpr bool PERM = true, AFTER_DRAIN = true; P4 p; const float* gain; const XcdBarrier* bar;
    __device__ __forceinline__ void fused(pg8::f32x4 (&acc)[2][2][4][2], const pg8::Unit& u, int wr, int wc, int fr, int fq, PG8_LAS unsigned char* lds, int wid, int lane) const {
        const int row0 = u.pm * 256 + wr * 64 + fr, c0 = u.pn * 256 + wc * 32 + 8 * fq;
#pragma unroll
        for (int ai = 0; ai < 2; ++ai)
#pragma unroll
            for (int m = 0; m < 4; ++m) { const int row = row0 + ai * 128 + m * 16; float ss = 0.f;
#pragma unroll
                for (int bj = 0; bj < 2; ++bj) { const size_t off = (size_t)row * DM + c0 + bj * 128;
                    const v4u xb = *(const GAS v4u*)(p.X1B + off);
                    const f32x4 o0 = (f32x4){__uint_as_float(xb.x << 16), __uint_as_float(xb.x & 0xffff0000u), __uint_as_float(xb.y << 16), __uint_as_float(xb.y & 0xffff0000u)} + acc[ai][bj][m][0];
                    const f32x4 o1 = (f32x4){__uint_as_float(xb.z << 16), __uint_as_float(xb.z & 0xffff0000u), __uint_as_float(xb.w << 16), __uint_as_float(xb.w & 0xffff0000u)} + acc[ai][bj][m][1];
                    acc[ai][bj][m][0] = o0; acc[ai][bj][m][1] = o1;
                    ss += ((o0.x * o0.x + o0.y * o0.y) + (o0.z * o0.z + o0.w * o0.w)) + ((o1.x * o1.x + o1.y * o1.y) + (o1.z * o1.z + o1.w * o1.w)); }
                ss += __shfl_xor(ss, 16); ss += __shfl_xor(ss, 32);
                if (fq == 0) atomicAdd(p.SS + row, ss); }
        xcd_barrier(*bar);
        f32x4 g[2][2];
#pragma unroll
        for (int bj = 0; bj < 2; ++bj) { g[bj][0] = *(const GAS f32x4*)(gain + c0 + bj * 128); g[bj][1] = *(const GAS f32x4*)(gain + c0 + bj * 128 + 4); }
#pragma unroll
        for (int ai = 0; ai < 2; ++ai)
#pragma unroll
            for (int m = 0; m < 4; ++m) { const int row = row0 + ai * 128 + m * 16;
                const float rstd = 1.0f / sqrtf(__hip_atomic_load(p.SS + row, __ATOMIC_RELAXED, __HIP_MEMORY_SCOPE_AGENT) * (1.f / DM) + EPS);
#pragma unroll
                for (int bj = 0; bj < 2; ++bj) { const size_t off = (size_t)row * DM + c0 + bj * 128;
                    *(GAS f32x4*)(p.Y + off) = acc[ai][bj][m][0] * rstd * g[bj][0]; *(GAS f32x4*)(p.Y + off + 4) = acc[ai][bj][m][1] * rstd * g[bj][1]; } }
    } };

template <class EpiF>
__device__ __forceinline__ void sgemm_unit(const bf16* A, const bf16* WT, int u, int wave, int lane, const EpiF& epi) {
    const int fr = lane & 15, fq = lane >> 4;
    const GAS bf16x8* wp = (const GAS bf16x8*)(WT + (size_t)(16 * u + fr) * DM + 8 * fq);
    const GAS bf16x8* ap = (const GAS bf16x8*)(A + (size_t)(MP + 16 * wave + fr) * DM + 8 * fq);
    pg8::f32x4 acc = {0.f, 0.f, 0.f, 0.f};
#pragma unroll 1
    for (int k0 = 0; k0 < 32; k0 += 16) {
        bf16x8 wv[16], av[16];
#pragma unroll
        for (int i = 0; i < 16; ++i) { wv[i] = wp[(k0 + i) * 4]; av[i] = ap[(k0 + i) * 4]; }
#pragma unroll
        for (int i = 0; i < 16; ++i) acc = __builtin_amdgcn_mfma_f32_16x16x32_bf16(wv[i], av[i], acc, 0, 0, 0);
    }
    epi(MP + 16 * wave + fr, 16 * u + 4 * fq, acc);
}

typedef short s16x4 __attribute__((ext_vector_type(4)));

struct LaArgs {
    const bf16* Q; const bf16* Kp; const bf16* G;
    const bf16* V; const bf16* GATE; int ldv;
    const float* gain;
    bf16* MIXo; int mixoff;
    bf16* SBUF; float* BTOT;
    const float* S0; float* S1;
};
template <int DV, bool HAS_K, int MODE>
__device__ __forceinline__ void la_unit(LAS unsigned char* lds, const LaArgs& a, int m0, int h, int tid, int wave, int lane) {
    constexpr int NVT = DV / 128, NCH = 4, TV = 64; static_assert(MODE == 0 || MODE == 1, "la_unit modes");
    constexpr bool FULL = MODE != 0;
    constexpr int VS = DV + 8;
    constexpr int R0 = 0;
    constexpr int R1 = 17408;
    constexpr int R2 = 34816, R2_SZ = (DV * 144 > 33792) ? DV * 144 : 33792;
    constexpr int R3 = R2 + R2_SZ, R3_SZ = 64 * VS * 2;
    constexpr int K2T_OFF = R3 + R3_SZ;
    constexpr int P_OFF = K2T_OFF + 18432;
    constexpr int TOT_OFF = P_OFF + 9216, EBR_OFF = TOT_OFF + 4096, EBL_OFF = EBR_OFF + 512, SSQ_OFF = EBL_OFF + 512;
    static_assert(SSQ_OFF + 2048 <= LDSCTL_OFF, "LA LDS");
    constexpr int A1_OFF = R0, K1_OFF = R1, VT_OFF = R2;
    LAS float* TOT = (LAS float*)(lds + TOT_OFF); LAS float* EBR = (LAS float*)(lds + EBR_OFF); LAS float* EBL = (LAS float*)(lds + EBL_OFF); LAS float* SSQ = (LAS float*)(lds + SSQ_OFF);
    f32x4 S[8][NVT];
#pragma unroll
    for (int kp = 0; kp < 4; ++kp)
#pragma unroll
        for (int vt = 0; vt < NVT; ++vt) {
            if (MODE == 0) { S[2 * kp][vt] = (f32x4){0.f, 0.f, 0.f, 0.f}; S[2 * kp + 1][vt] = (f32x4){0.f, 0.f, 0.f, 0.f}; }
            else { const v4u sv = *(const GAS v4u*)(a.SBUF + ((size_t)((wave * 4 + kp) * NVT + vt) * 64 + lane) * 8);
                S[2 * kp][vt] = (f32x4){__uint_as_float(sv.x << 16), __uint_as_float(sv.x & 0xffff0000u), __uint_as_float(sv.y << 16), __uint_as_float(sv.y & 0xffff0000u)};
                S[2 * kp + 1][vt] = (f32x4){__uint_as_float(sv.z << 16), __uint_as_float(sv.z & 0xffff0000u), __uint_as_float(sv.w << 16), __uint_as_float(sv.w & 0xffff0000u)}; }
        }
    constexpr int NV = NVT * 2, VCH = DV / 8;
    v4u rg[2], rq[2], rk[2], rv[NV];
#define TZ(name) int name = tid; asm volatile("" : "+v"(name))
#define LB(name, off) LAS unsigned char* name = lds + (off); asm volatile("" : "+v"(name))
#define LA_LOAD(chn) do { const int mr_ = m0 + 64 * (chn); TZ(tz_);                                                                                            \
        const bf16* gb_ = a.G + (size_t)mr_ * 512 + h * 128;  const bf16* qb_ = a.Q + (size_t)mr_ * 512 + h * 128; const bf16* kb_ = HAS_K ? a.Kp + (size_t)mr_ * 512 + h * 128 : nullptr; \
        const bf16* vb_ = a.V + (size_t)mr_ * a.ldv + h * DV;                                                                                                 \
        _Pragma("unroll") for (int i_ = 0; i_ < 2; ++i_) { const int e_ = tz_ + 512 * i_; const unsigned o_ = (unsigned)((e_ >> 4) * 512 + 8 * (e_ & 15));   \
            rg[i_] = *(const GAS v4u*)(gb_ + o_); if (FULL) rq[i_] = *(const GAS v4u*)(qb_ + o_); if (HAS_K) rk[i_] = *(const GAS v4u*)(kb_ + o_); }                                              \
        _Pragma("unroll") for (int i_ = 0; i_ < NV; ++i_) { const int e_ = tz_ + 512 * i_; rv[i_] = *(const GAS v4u*)(vb_ + (unsigned)((e_ / VCH) * a.ldv + 8 * (e_ % VCH))); } } while (0)
    LA_LOAD(0);
    float btot_run_A = 0.f, btot_run_B = 0.f;
#pragma unroll 1
    for (int ch = 0; ch < NCH; ++ch) {
        const int mr0 = m0 + 64 * ch;
        v4u gt[NV];
        { TZ(tz);
#pragma unroll
        for (int i = 0; i < 2; ++i) { const int e = tz + 512 * i, row = e >> 4;
            { LAS f32x4* gp = (LAS f32x4*)(lds + R2 + (row * 132 + 8 * (e & 15)) * 4);
              gp[0] = (f32x4){__uint_as_float(rg[i].x << 16), __uint_as_float(rg[i].x & 0xffff0000u), __uint_as_float(rg[i].y << 16), __uint_as_float(rg[i].y & 0xffff0000u)};
              gp[1] = (f32x4){__uint_as_float(rg[i].z << 16), __uint_as_float(rg[i].z & 0xffff0000u), __uint_as_float(rg[i].w << 16), __uint_as_float(rg[i].w & 0xffff0000u)}; }
            if (FULL) *(LAS v4u*)(lds + R0 + (row * 136 + 8 * (e & 15)) * 2) = rq[i];
            if (HAS_K) *(LAS v4u*)(lds + R1 + (row * 136 + 8 * (e & 15)) * 2) = rk[i]; }
#pragma unroll
        for (int i = 0; i < NV; ++i) { const int e = tz + 512 * i, row = e / VCH; *(LAS v4u*)(lds + R3 + (row * VS + 8 * (e % VCH)) * 2) = rv[i]; } }
        __syncthreads();
        if (NCH > 1) { const int chn = ch + 1 < NCH ? ch + 1 : ch; LA_LOAD(chn); }
        if (FULL) { const bf16* gtb = a.GATE + (size_t)mr0 * a.ldv + h * DV; TZ(tz);
#pragma unroll
            for (int i = 0; i < NV; ++i) { const int e = tz + 512 * i; gt[i] = *(const GAS v4u*)(gtb + (unsigned)((e / VCH) * a.ldv + 8 * (e % VCH))); } }
        {
        TZ(tzb); const int c2 = tzb & 63, seg = tzb >> 6, cA = 2 * c2;
        float gA[8], gB[8], kA[8], kB[8], qA[8], qB[8];
        LB(bG, R2 + (8 * seg * 132 + cA) * 4); LB(bQ, R0 + (8 * seg * 136 + cA) * 2); LB(bK, R1 + (8 * seg * 136 + cA) * 2);
#pragma unroll
        for (int i = 0; i < 8; ++i) {
            const f32x2_t gg = *(const LAS f32x2_t*)(bG + i * 528); gA[i] = gg.x; gB[i] = gg.y;
            if (FULL) { const unsigned qq = *(const LAS unsigned*)(bQ + i * 272); qA[i] = __uint_as_float(qq << 16); qB[i] = __uint_as_float(qq & 0xffff0000u); }
            if (HAS_K) { const unsigned kk = *(const LAS unsigned*)(bK + i * 272); kA[i] = __uint_as_float(kk << 16); kB[i] = __uint_as_float(kk & 0xffff0000u); } }
#pragma unroll
        for (int i = 0; i < 8; ++i) { if (!HAS_K) { kA[i] = 1.0f - __expf(gA[i]); kB[i] = 1.0f - __expf(gB[i]); } if (i) { gA[i] += gA[i - 1]; gB[i] += gB[i - 1]; } }
        LB(bT, TOT_OFF + cA * 4);
        *(LAS f32x2_t*)(bT + seg * 512) = (f32x2_t){gA[7], gB[7]};
        __syncthreads();
        float preA = 0.f, preB = 0.f, brA = 0.f, brB = 0.f, blA = 0.f, blB = 0.f;
#pragma unroll
        for (int q = 0; q < 8; ++q) { const f32x2_t tt_ = *(const LAS f32x2_t*)(bT + q * 512);
            if (q < seg) { preA += tt_.x; preB += tt_.y; } if (q < 4) { brA += tt_.x; brB += tt_.y; } blA += tt_.x; blB += tt_.y; }
        if (seg == 0) { *(LAS f32x2_t*)(bT + (EBR_OFF - TOT_OFF)) = (f32x2_t){__expf(brA), __expf(brB)}; *(LAS f32x2_t*)(bT + (EBL_OFF - TOT_OFF)) = (f32x2_t){__expf(blA), __expf(blB)}; btot_run_A += blA; btot_run_B += blB; }
        {   unsigned k2a[4], k2b[4];
#pragma unroll
            for (int i = 0; i < 8; i += 2) { const float a0 = gA[i] + preA, a1 = gA[i + 1] + preA, b0 = gB[i] + preB, b1 = gB[i + 1] + preB;
                k2a[i >> 1] = cvtpk_s(kA[i] * __expf(blA - a0), kA[i + 1] * __expf(blA - a1));
                k2b[i >> 1] = cvtpk_s(kB[i] * __expf(blB - b0), kB[i + 1] * __expf(blB - b1));
                if (FULL) {
                    *(LAS unsigned*)(bQ + i * 272) = cvtpk_s(qA[i] * __expf(a0 - brA), qB[i] * __expf(b0 - brB));
                    *(LAS unsigned*)(bQ + (i + 1) * 272) = cvtpk_s(qA[i + 1] * __expf(a1 - brA), qB[i + 1] * __expf(b1 - brB));
                    *(LAS unsigned*)(bK + i * 272) = cvtpk_s(kA[i] * __expf(brA - a0), kB[i] * __expf(brB - b0));
                    *(LAS unsigned*)(bK + (i + 1) * 272) = cvtpk_s(kA[i + 1] * __expf(brA - a1), kB[i + 1] * __expf(brB - b1)); } }
            LB(bK2, K2T_OFF + (cA * 72 + 8 * seg) * 2);
            *(LAS v4u*)(bK2) = (v4u){k2a[0], k2a[1], k2a[2], k2a[3]};
            *(LAS v4u*)(bK2 + 144) = (v4u){k2b[0], k2b[1], k2b[2], k2b[3]}; }
        LB(bVr, R3 + (8 * seg * VS + cA) * 2); LB(bVw, VT_OFF + (cA * 72 + 8 * seg) * 2);
#pragma unroll
        for (int ps = 0; ps < NVT; ++ps) { unsigned vv[8];
#pragma unroll
            for (int i = 0; i < 8; ++i) vv[i] = *(const LAS unsigned*)(bVr + (i * VS + 128 * ps) * 2);
            v4u wa, wb;
            wa.x = (vv[0] & 0xffffu) | (vv[1] << 16); wa.y = (vv[2] & 0xffffu) | (vv[3] << 16); wa.z = (vv[4] & 0xffffu) | (vv[5] << 16); wa.w = (vv[6] & 0xffffu) | (vv[7] << 16);
            wb.x = (vv[0] >> 16) | (vv[1] & 0xffff0000u); wb.y = (vv[2] >> 16) | (vv[3] & 0xffff0000u); wb.z = (vv[4] >> 16) | (vv[5] & 0xffff0000u); wb.w = (vv[6] >> 16) | (vv[7] & 0xffff0000u);
            *(LAS v4u*)(bVw + 128 * ps * 144) = wa; *(LAS v4u*)(bVw + 128 * ps * 144 + 144) = wb; }
        }
        __syncthreads();
        if (FULL) {
            TZ(tzc); const int lc = tzc & 63, fr = lc & 15, fq = lc >> 4, wv = __builtin_amdgcn_readfirstlane(tzc >> 6);
            const int tt = wv >> 1, st0 = 2 * (wv & 1);
            f32x4 p0 = {0.f, 0.f, 0.f, 0.f}, p1 = {0.f, 0.f, 0.f, 0.f};
            LB(bA, A1_OFF + ((16 * tt + fr) * 136 + 8 * fq) * 2); LB(bB, K1_OFF + ((16 * st0 + fr) * 136 + 8 * fq) * 2);
#pragma unroll
            for (int ks = 0; ks < 4; ++ks) {
                const bf16x8 av = *(const LAS bf16x8*)(bA + ks * 64);
                const bf16x8 b0 = *(const LAS bf16x8*)(bB + ks * 64);
                const bf16x8 b1 = *(const LAS bf16x8*)(bB + 16 * 272 + ks * 64);
                p0 = __builtin_amdgcn_mfma_f32_16x16x32_bf16(av, b0, p0, 0, 0, 0);
                p1 = __builtin_amdgcn_mfma_f32_16x16x32_bf16(av, b1, p1, 0, 0, 0);
            }
            LB(bP, P_OFF + ((16 * tt + 4 * fq) * 72 + 16 * st0 + fr) * 2);
#pragma unroll
            for (int j = 0; j < 4; ++j) { const int t = 16 * tt + 4 * fq + j, s0 = 16 * st0 + fr, s1 = s0 + 16;
                const float x0 = (s0 <= t) ? p0[j] : 0.f, x1 = (s1 <= t) ? p1[j] : 0.f;
                *(LAS bf16*)(bP + j * 144) = (bf16)(cvtpk_s(x0, 0.f) & 0xffffu);
                *(LAS bf16*)(bP + j * 144 + 32) = (bf16)(cvtpk_s(x1, 0.f) & 0xffffu); }
            __syncthreads();
        }
        TZ(tzd); const int ld_ = tzd & 63, fr = ld_ & 15, fq = ld_ >> 4, wave_d = __builtin_amdgcn_readfirstlane(tzd >> 6), vbase = wave_d * (DV / 8);
        bf16x8 vb[NVT][2];
        LB(bVT, VT_OFF + ((vbase + fr) * 72 + 8 * fq) * 2);
#pragma unroll
        for (int vt = 0; vt < NVT; ++vt)
#pragma unroll
            for (int ks = 0; ks < 2; ++ks) vb[vt][ks] = *(const LAS bf16x8*)(bVT + vt * 16 * 144 + ks * 64);
        f32x4 o[4][NVT];
        if (FULL) {
            LB(bPr, P_OFF + (fr * 72 + 8 * fq) * 2); LB(bE, EBR_OFF + 16 * fq); LB(bA4, A1_OFF + (fr * 136 + 4 * fq) * 2);
#pragma unroll
            for (int tt = 0; tt < 4; ++tt)
#pragma unroll
                for (int vt = 0; vt < NVT; ++vt) o[tt][vt] = (f32x4){0.f, 0.f, 0.f, 0.f};
#pragma unroll
            for (int tt = 0; tt < 4; ++tt)
#pragma unroll
                for (int ks = 0; ks < 2; ++ks) { const bf16x8 pa = *(const LAS bf16x8*)(bPr + tt * 16 * 144 + ks * 64);
#pragma unroll
                    for (int vt = 0; vt < NVT; ++vt) o[tt][vt] = __builtin_amdgcn_mfma_f32_16x16x32_bf16(pa, vb[vt][ks], o[tt][vt], 0, 0, 0); }
#pragma unroll
            for (int ks = 0; ks < 4; ++ks) {
                const f32x4 e0 = *(const LAS f32x4*)(bE + ks * 128), e1 = *(const LAS f32x4*)(bE + ks * 128 + 64);
                bf16x8 sb[NVT];
#pragma unroll
                for (int vt = 0; vt < NVT; ++vt) sb[vt] = pack8f(S[2 * ks][vt] * e0, S[2 * ks + 1][vt] * e1);
#pragma unroll
                for (int tt = 0; tt < 4; ++tt) {
                    const s16x4 alo = *(const LAS s16x4*)(bA4 + tt * 16 * 272 + ks * 64);
                    const s16x4 ahi = *(const LAS s16x4*)(bA4 + tt * 16 * 272 + ks * 64 + 32);
                    const bf16x8 aa = __builtin_shufflevector(alo, ahi, 0, 1, 2, 3, 4, 5, 6, 7);
#pragma unroll
                    for (int vt = 0; vt < NVT; ++vt) o[tt][vt] = __builtin_amdgcn_mfma_f32_16x16x32_bf16(aa, sb[vt], o[tt][vt], 0, 0, 0);
                }
            }
        }
        LB(bL, EBL_OFF + 16 * fq); LB(bK2r, K2T_OFF + (fr * 72 + 8 * fq) * 2);
#pragma unroll
        for (int kt = 0; kt < 8; ++kt) {
            const f32x4 el = *(const LAS f32x4*)(bL + kt * 64);
#pragma unroll
            for (int vt = 0; vt < NVT; ++vt) S[kt][vt] = S[kt][vt] * el;
#pragma unroll
            for (int ks = 0; ks < 2; ++ks) { const bf16x8 ka = *(const LAS bf16x8*)(bK2r + kt * 16 * 144 + ks * 64);
#pragma unroll
                for (int vt = 0; vt < NVT; ++vt) S[kt][vt] = __builtin_amdgcn_mfma_f32_16x16x32_bf16(ka, vb[vt][ks], S[kt][vt], 0, 0, 0); }
        }
        if (FULL) {
            LB(bS, SSQ_OFF + (wave_d * 64 + 4 * fq) * 4); LB(bR, TOT_OFF + 16 * fq); LB(bO, R3 + ((4 * fq) * VS + vbase + fr) * 2);
#pragma unroll
            for (int tt = 0; tt < 4; ++tt) { f32x4 ss = {0.f, 0.f, 0.f, 0.f};
#pragma unroll
                for (int vt = 0; vt < NVT; ++vt) ss += o[tt][vt] * o[tt][vt];
#pragma unroll
                for (int j = 0; j < 4; ++j) ss[j] = row16_sum(ss[j]);
                if (fr == 0) *(LAS f32x4*)(bS + tt * 64) = ss; }
            __syncthreads();
            if (ld_ < 8) { const int t = 8 * wave_d + ld_; float tot = 0.f;
#pragma unroll
                for (int w = 0; w < 8; ++w) tot += SSQ[w * 64 + t];
                TOT[t] = 1.0f / sqrtf(tot * (1.0f / DV) + EPS); }
            float gn[NVT];
#pragma unroll
            for (int vt = 0; vt < NVT; ++vt) gn[vt] = a.gain[h * DV + vbase + 16 * vt + fr];
            __syncthreads();
#pragma unroll
            for (int tt = 0; tt < 4; ++tt) {
                const f32x4 rs = *(const LAS f32x4*)(bR + tt * 64);
#pragma unroll
                for (int j = 0; j < 4; ++j) { const int t = 16 * tt + 4 * fq + j;
#pragma unroll
                    for (int vt = 0; vt < NVT; ++vt) { const float val = o[tt][vt][j] * rs[j] * gn[vt]; const float vn = dppf<0xB1>(val);
                        if ((fr & 1) == 0) *(LAS unsigned*)(bO + ((16 * tt + j) * VS + 16 * vt) * 2) = cvtpk_s(val, vn); } }
            }
            __syncthreads();
            TZ(tze);
#pragma unroll
            for (int i = 0; i < NV; ++i) { const int e = tze + 512 * i, row = e / VCH;
                { const v4u ov = *(const LAS v4u*)(lds + R3 + (row * VS + 8 * (e % VCH)) * 2); v4u w;
#pragma unroll
                    for (int k = 0; k < 4; ++k) w[k] = cvtpk_s(__uint_as_float(ov[k] << 16) * __uint_as_float(gt[i][k] << 16), __uint_as_float(ov[k] & 0xffff0000u) * __uint_as_float(gt[i][k] & 0xffff0000u));
                    *(GAS v4u*)(a.MIXo + (size_t)(mr0 + row) * 1024 + a.mixoff + h * DV + 8 * (e % VCH)) = w; } }
        }
        __syncthreads();
    }
#undef LA_LOAD
#undef TZ
#undef LB
    if (MODE == 0) {
#pragma unroll
        for (int kp = 0; kp < 4; ++kp)
#pragma unroll
            for (int vt = 0; vt < NVT; ++vt) st_bf8(a.SBUF + ((size_t)((wave * 4 + kp) * NVT + vt) * 64 + lane) * 8, S[2 * kp][vt], S[2 * kp + 1][vt]);
        if ((tid >> 6) == 0) { a.BTOT[2 * (tid & 63)] = btot_run_A; a.BTOT[2 * (tid & 63) + 1] = btot_run_B; }
    }
}

template <int DV, bool HAS_K>
__device__ __forceinline__ void la_sample_unit(LAS unsigned char* lds, const LaArgs& a, int u, int tid, int wave, int lane) {
    constexpr int KS = 512 / DV, KPT = 128 / KS, NOUT = 4 * DV / 512;
    const int b = u >> 2, h = u & 3, m0 = MP + b * 4;
    LAS float* EG = (LAS float*)lds; LAS float* KK = EG + 512; LAS float* QQ = KK + 512; LAS float* RED = QQ + 512; LAS float* WS = RED + 4 * KS * DV;
    { const int t = tid >> 7, k = tid & 127; const size_t off = (size_t)(m0 + t) * 512 + h * 128 + k;
      const float g = bf2f(a.G[off]), eg = __expf(g); EG[tid] = eg; KK[tid] = HAS_K ? bf2f(a.Kp[off]) : 1.0f - eg; QQ[tid] = bf2f(a.Q[off]); }
    __syncthreads();
    const int v = tid % DV, ks = tid / DV, k0 = ks * KPT;
    float S[KPT];
    { const float* sp = a.S0 + (size_t)k0 * DV + v;
#pragma unroll
      for (int i0 = 0; i0 < KPT; i0 += 4) { asm volatile("" : "+v"(sp));
#pragma unroll
          for (int i = 0; i < 4; ++i) S[i0 + i] = sp[i * DV];
          sp += 4 * DV; } }
#pragma unroll
    for (int t = 0; t < 4; ++t) {
        const float vt = bf2f(a.V[(size_t)(m0 + t) * a.ldv + h * DV + v]); float o = 0.f;
#pragma unroll
        for (int i = 0; i < KPT; ++i) { S[i] = S[i] * EG[t * 128 + k0 + i] + KK[t * 128 + k0 + i] * vt; o += S[i] * QQ[t * 128 + k0 + i]; }
        RED[(t * KS + ks) * DV + v] = o;
    }
    { float* sp = a.S1 + (size_t)k0 * DV + v;
#pragma unroll
      for (int i0 = 0; i0 < KPT; i0 += 4) { asm volatile("" : "+v"(sp));
#pragma unroll
          for (int i = 0; i < 4; ++i) sp[i * DV] = S[i0 + i];
          sp += 4 * DV; } }
    __syncthreads();
    float ov[NOUT];
#pragma unroll
    for (int j = 0; j < NOUT; ++j) { const int idx = tid + 512 * j, t = idx / DV, vv = idx % DV; float o = 0.f;
#pragma unroll
        for (int q = 0; q < KS; ++q) o += RED[(t * KS + q) * DV + vv];
        ov[j] = o; const float ss = wave_sum(o * o); if (lane == 0) WS[j * 8 + wave] = ss; }
    __syncthreads();
#pragma unroll
    for (int j = 0; j < NOUT; ++j) { const int idx = tid + 512 * j, t = idx / DV, vv = idx % DV;
        constexpr int WPT = DV / 64;
        const int w0 = (wave / WPT) * WPT; float tot = 0.f;
#pragma unroll
        for (int q = 0; q < WPT; ++q) tot += WS[j * 8 + w0 + q];
        const float rstd = 1.0f / sqrtf(tot * (1.0f / DV) + EPS); const size_t row = (size_t)(m0 + t);
        const float val = ov[j] * rstd * a.gain[h * DV + vv] * bf2f(a.GATE[row * a.ldv + h * DV + vv]);
        a.MIXo[row * 1024 + a.mixoff + h * DV + vv] = (bf16)(cvtpk_s(val, 0.f) & 0xffffu); }
    __syncthreads();
}

template <int DV>
__device__ __forceinline__ void la_scan(bf16* SLOC, const float* BTOT, float* outstate, int gtid, int gthreads) {
    constexpr int NVT = DV / 128, LP = 8192 * NVT;
    GAS unsigned* SW = (GAS unsigned*)SLOC;
    for (int eg = gtid; eg < 8 * LP; eg += gthreads) {
        const int bh = eg / LP, e = eg % LP;
        const int jj = e & 1, kk = (e >> 1) & 1, ln = (e >> 2) & 63, rest = e >> 8, vt = rest % NVT, kp = (rest / NVT) & 3, w = rest / (NVT * 4);
        const int k = 16 * (2 * kp + kk) + 4 * (ln >> 4) + 2 * jj, v = w * (DV / 8) + 16 * vt + (ln & 15);
        float c0 = 0.f, c1 = 0.f;
        {   constexpr int s0 = 0;
            unsigned loc[32]; f32x2_t dec[32];
#pragma unroll
            for (int sc = 0; sc < 32; ++sc) { loc[sc] = SW[(size_t)(bh * 32 + s0 + sc) * LP + e]; dec[sc] = *(const GAS f32x2_t*)(BTOT + (size_t)(bh * 32 + s0 + sc) * 128 + k); }
#pragma unroll
            for (int sc = 0; sc < 32; ++sc) { SW[(size_t)(bh * 32 + s0 + sc) * LP + e] = cvtpk_s(c0, c1);
                c0 = c0 * __expf(dec[sc].x) + __uint_as_float(loc[sc] << 16); c1 = c1 * __expf(dec[sc].y) + __uint_as_float(loc[sc] & 0xffff0000u); }
        }
        outstate[(size_t)(bh * 128 + k) * DV + v] = c0; outstate[(size_t)(bh * 128 + k + 1) * DV + v] = c1;
    }
}

namespace fox {
using TIN = __hip_bfloat16; using TOUT = __hip_bfloat16;
constexpr int D = 128, SKV = 8192, WINDOW = SKV; constexpr float THR = 8.f; constexpr bool WSKIP = false;
constexpr int OSTR = 1024, GSTR = 512;
constexpr float SCALE = 0.08838834764831845f;
constexpr int NW = 8, QBLK = 32, KVBLK = 64, QB = NW * QBLK;
constexpr int SHM_V = KVBLK * D * 2, SHM_K = KVBLK * D * 2;
constexpr int LDS_BIAS = 2 * SHM_V + 2 * SHM_K + NW * 64 * 4;
constexpr int LDS_BYTES = LDS_BIAS + 512;
constexpr int ORS = 136, OST_WAVE = 32 * ORS * 2, OST_OFF = 69632;

using bf16 = __hip_bfloat16;
typedef short bf16x8 __attribute__((ext_vector_type(8)));
typedef short s16x4 __attribute__((ext_vector_type(4)));
typedef float f32x16 __attribute__((ext_vector_type(16)));
typedef float f32x4 __attribute__((ext_vector_type(4)));
typedef unsigned u32x4 __attribute__((ext_vector_type(4)));
template <class A, class Bt> struct same_t { static constexpr bool v = false; };
template <class A> struct same_t<A, A> { static constexpr bool v = true; };

#define KSWZ(row, colB) ((row) * 256 + ((colB) ^ (((row) & 7) << 4)))
#define SBAR() __builtin_amdgcn_sched_barrier(0)
__device__ __forceinline__ int v_st(int k, int c) { const int kk = (k & ~0xC) | ((k & 4) << 1) | ((k & 8) >> 1); return ((kk >> 3) * 4 + (c >> 5)) * 512 + ((kk & 7) * 32 + (c & 31)) * 2; }
__device__ __forceinline__ int v_rd_base(int lane) { return ((lane & 3) << 3) | (((lane >> 2) & 3) << 6) | (((lane >> 4) & 1) << 5) | (((lane >> 5) & 1) << 8); }
constexpr int v_rd_off(int d0, int ks, int half) { return d0 * 512 + ks * 4096 + half * 2048; }
__device__ __forceinline__ int crow(int r, int hi) { return (r & 3) + 8 * (r >> 2) + 4 * hi; }
__device__ __forceinline__ unsigned cvtpk(float lo, float hi) {
    unsigned r; asm volatile("v_cvt_pk_bf16_f32 %0, %1, %2" : "=v"(r) : "v"(lo), "v"(hi)); return r;
}
__device__ __forceinline__ bf16x8 pack8(f32x4 a, f32x4 b) {
    u32x4 w = {cvtpk(a[0], a[1]), cvtpk(a[2], a[3]), cvtpk(b[0], b[1]), cvtpk(b[2], b[3])};
    return *reinterpret_cast<bf16x8*>(&w);
}
template <class T> __device__ __forceinline__ bf16x8 load8(const T* p) {
    if constexpr (same_t<T, float>::v) { return pack8(*(const f32x4*)p, *(const f32x4*)(p + 4)); }
    else { return *reinterpret_cast<const bf16x8*>(p); }
}
__device__ __forceinline__ void mask_tile(f32x16& p0, f32x16& p1, int dq, unsigned W) {
    const float NEG = -__builtin_inff();
#pragma unroll
    for (int r = 0; r < 16; ++r) {
        const int c = (r & 3) + 8 * (r >> 2);
        if ((unsigned)(dq - c) >= W) p0[r] = NEG;
        if ((unsigned)(dq - c - 32) >= W) p1[r] = NEG;
    }
}
__device__ __forceinline__ void partialSM(f32x16& p0, f32x16& p1, float& m_reg, float& mn, float& alpha) {
    float pmax = p0[0]; for (int r = 1; r < 16; ++r) pmax = fmaxf(pmax, p0[r]); for (int r = 0; r < 16; ++r) pmax = fmaxf(pmax, p1[r]);
    { auto rr = __builtin_amdgcn_permlane32_swap(__float_as_uint(pmax), __float_as_uint(pmax), false, false);
      pmax = fmaxf(__uint_as_float(rr[0]), __uint_as_float(rr[1])); }
    constexpr float C2 = 1.4426950408889634f * SCALE;
    if (__builtin_expect(__all((pmax - m_reg) * SCALE <= THR), 1)) { mn = m_reg; alpha = 1.f; }
    else { mn = fmaxf(m_reg, pmax); alpha = __builtin_amdgcn_exp2f((m_reg - mn) * C2); m_reg = mn; }
    const float mnL = -mn * C2;
    for (int r = 0; r < 16; ++r) p0[r] = fmaf(p0[r], C2, mnL); for (int r = 0; r < 16; ++r) p1[r] = fmaf(p1[r], C2, mnL);
    for (int r = 0; r < 16; ++r) p0[r] = __builtin_amdgcn_exp2f(p0[r]);
}
__device__ __forceinline__ void finishSM(f32x16& p0, f32x16& p1, float alpha, float& l_reg, bf16x8& pa0, bf16x8& pa1, bf16x8& pa2, bf16x8& pa3) {
    for (int r = 0; r < 16; ++r) p1[r] = __builtin_amdgcn_exp2f(p1[r]);
    float ps = 0; for (int r = 0; r < 16; ++r) ps += p0[r]; for (int r = 0; r < 16; ++r) ps += p1[r];
    { auto rr = __builtin_amdgcn_permlane32_swap(__float_as_uint(ps), __float_as_uint(ps), false, false);
      ps = __uint_as_float(rr[0]) + __uint_as_float(rr[1]); }
    l_reg = l_reg * alpha + ps;
#define PK4(P, B_, OUT) do { unsigned a0 = cvtpk(P[B_+0], P[B_+1]), a1 = cvtpk(P[B_+2], P[B_+3]);                          \
        unsigned b0 = cvtpk(P[B_+4], P[B_+5]), b1 = cvtpk(P[B_+6], P[B_+7]);                                             \
        auto r0 = __builtin_amdgcn_permlane32_swap(a0, b0, false, false); auto r1 = __builtin_amdgcn_permlane32_swap(a1, b1, false, false); \
        u32x4 w = {r0[0], r1[0], r0[1], r1[1]}; OUT = *reinterpret_cast<bf16x8*>(&w); } while (0)
    PK4(p0, 0, pa0); PK4(p0, 8, pa1); PK4(p1, 0, pa2); PK4(p1, 8, pa3);
#undef PK4
}
constexpr int NQR = 8;
template <int KB, bool SK>
__device__ __forceinline__ void qkt(f32x16& p0, f32x16& p1, const char* K_lds, int r32, int hi, const char* qs, const bf16x8* qrh, bool act) {
    if (SK && !act) { const float NEG = -__builtin_inff();
#pragma unroll
        for (int r = 0; r < 16; ++r) { p0[r] = NEG; p1[r] = NEG; } return; }
    { const float* bl = (const float*)(K_lds + 2 * SHM_K + NW * 64 * 4 + KB * 256) + 4 * hi;
#pragma unroll
      for (int g = 0; g < 4; ++g) { const f32x4 b0 = *(const f32x4*)(bl + 8 * g), b1 = *(const f32x4*)(bl + 32 + 8 * g);
          p0[4 * g] = b0[0]; p0[4 * g + 1] = b0[1]; p0[4 * g + 2] = b0[2]; p0[4 * g + 3] = b0[3]; p1[4 * g] = b1[0]; p1[4 * g + 1] = b1[1]; p1[4 * g + 2] = b1[2]; p1[4 * g + 3] = b1[3]; } }
    const char* kb[4];
#pragma unroll
    for (int dd = 0; dd < 4; ++dd) kb[dd] = K_lds + KB * SHM_K + KSWZ(r32, (dd * 16 + hi * 8) * 2);
#pragma unroll
    for (int d0 = 0; d0 < 8; ++d0) { const char* a = kb[d0 & 3] + (d0 >> 2) * 128;
        bf16x8 b0 = *reinterpret_cast<const bf16x8*>(a);
        bf16x8 b1 = *reinterpret_cast<const bf16x8*>(a + 32 * 256);
        const bf16x8 qv = d0 < NQR ? qrh[d0] : *reinterpret_cast<const bf16x8*>(qs + d0 * 32);
        p0 = __builtin_amdgcn_mfma_f32_32x32x16_bf16(b0, qv, p0, 0, 0, 0);
        p1 = __builtin_amdgcn_mfma_f32_32x32x16_bf16(b1, qv, p1, 0, 0, 0); }
}
template <int VB, bool SK>
__device__ __forceinline__ void pv_tile(f32x16* o, int vb0, bf16x8 pa0, bf16x8 pa1, bf16x8 pa2, bf16x8 pa3, bool act) {
    if (SK && !act) return;
#define TRRD(dst, off) asm volatile("ds_read_b64_tr_b16 %0, %1 offset:%2" : "=&v"(dst) : "v"(vb0), "i"(off) : "memory")
#define PV_D0(d0) do { s16x4 l0, l1, l2, l3, h0, h1, h2, h3; constexpr int b_ = VB * SHM_V + v_rd_off(d0, 0, 0);     \
        TRRD(l0, b_); TRRD(h0, b_ + 2048); TRRD(l1, b_ + 4096); TRRD(h1, b_ + 6144); TRRD(l2, b_ + 8192); TRRD(h2, b_ + 10240); TRRD(l3, b_ + 12288); TRRD(h3, b_ + 14336); \
        asm volatile("s_waitcnt lgkmcnt(0)" ::: "memory"); SBAR();                 \
        o[d0] = __builtin_amdgcn_mfma_f32_32x32x16_bf16(pa0, (bf16x8){l0[0], l0[1], l0[2], l0[3], h0[0], h0[1], h0[2], h0[3]}, o[d0], 0, 0, 0);   \
        o[d0] = __builtin_amdgcn_mfma_f32_32x32x16_bf16(pa1, (bf16x8){l1[0], l1[1], l1[2], l1[3], h1[0], h1[1], h1[2], h1[3]}, o[d0], 0, 0, 0);   \
        o[d0] = __builtin_amdgcn_mfma_f32_32x32x16_bf16(pa2, (bf16x8){l2[0], l2[1], l2[2], l2[3], h2[0], h2[1], h2[2], h2[3]}, o[d0], 0, 0, 0);   \
        o[d0] = __builtin_amdgcn_mfma_f32_32x32x16_bf16(pa3, (bf16x8){l3[0], l3[1], l3[2], l3[3], h3[0], h3[1], h3[2], h3[3]}, o[d0], 0, 0, 0); } while (0)
    PV_D0(0); PV_D0(1); PV_D0(2); PV_D0(3);
#undef PV_D0
#undef TRRD
}

template <class TIn, class TOut> struct BlockRef { const TIn* Q; const TIn* K; const TIn* V; TOut* O; int P0; const float* CB; const TIn* G; };
template <class TIn> struct Seam {
    bf16x8 qr[8];
    bf16x8 st_v0, st_v1, st_k0, st_k1; f32x4 sf0, sf1, sf2, sf3; float st_b;
    f32x4 tq[16];
};
__device__ __forceinline__ int swa_jlo(int P0, int W) { const int lowk = P0 - W + 1; return lowk > 0 ? lowk / KVBLK : 0; }
#define ROW(p, k0, rr) ((p) + (size_t)(k0) * D + (unsigned)((rr) * D + sc))
#define VMW() asm volatile("s_waitcnt vmcnt(0)" ::: "memory")
#define VMWN(n) asm volatile("s_waitcnt vmcnt(%0)" :: "i"(n) : "memory")
#define SLOAD_H(Kp, Vp, Cp, k0) do { S.st_v0 = load8<TIn>(ROW(Vp, k0, sr)); S.st_v1 = load8<TIn>(ROW(Vp, k0, 32 + sr));              \
                         S.st_k0 = load8<TIn>(ROW(Kp, k0, sr)); S.st_k1 = load8<TIn>(ROW(Kp, k0, 32 + sr)); { int tb_ = tid; asm volatile("" : "+v"(tb_)); S.st_b = ((Cp) + (k0))[(unsigned)(tb_ & 63)]; } } while (0)
#define SWRITE_HK(bf) do { *(bf16x8*)(K_lds + (bf) * SHM_K + kws) = S.st_k0; *(bf16x8*)(K_lds + (bf) * SHM_K + kws + 32 * 256) = S.st_k1; if (tid < 64) *(float*)(K_lds + 2 * SHM_K + NW * 64 * 4 + (bf) * 256 + tid * 4) = S.st_b; } while (0)
#define SWRITE_HV(bf) do { *(bf16x8*)(V_lds + (bf) * SHM_V + vst0) = S.st_v0; *(bf16x8*)(V_lds + (bf) * SHM_V + vst1) = S.st_v1; } while (0)
#define SWRITE_H(bf) do { SWRITE_HV(bf); SWRITE_HK(bf); } while (0)
#define SLOAD_F(p, k0) do { S.sf0 = *(const f32x4*)ROW(p, k0, sr); S.sf1 = *(const f32x4*)(ROW(p, k0, sr) + 4);                \
                            S.sf2 = *(const f32x4*)ROW(p, k0, 32 + sr); S.sf3 = *(const f32x4*)(ROW(p, k0, 32 + sr) + 4); } while (0)
#define SWRITE_KF(bf) do { *(bf16x8*)(K_lds + (bf) * SHM_K + kws) = pack8(S.sf0, S.sf1); *(bf16x8*)(K_lds + (bf) * SHM_K + kws + 32 * 256) = pack8(S.sf2, S.sf3); } while (0)
#define SWRITE_VF(bf) do { *(bf16x8*)(V_lds + (bf) * SHM_V + vst0) = pack8(S.sf0, S.sf1); *(bf16x8*)(V_lds + (bf) * SHM_V + vst1) = pack8(S.sf2, S.sf3); } while (0)
template <class TIn, class TOut>
__device__ __forceinline__ void causal_swa_prime(const BlockRef<TIn, TOut>& cur, int W, char* lds, Seam<TIn>& S) {
    constexpr bool F32 = same_t<TIn, float>::v;
    const int tid = threadIdx.x, wid = __builtin_amdgcn_readfirstlane(tid >> 6), lane = tid & 63, r32 = lane & 31, hi = lane >> 5;
    const int sr = tid >> 4, sc = (tid & 15) * 8, kws = KSWZ(sr, sc * 2); char* K_lds = lds + 2 * SHM_V;
    const int kb0 = swa_jlo(cur.P0, W) * KVBLK;
    for (int d0 = 0; d0 < 8; ++d0) S.qr[d0] = load8<TIn>(cur.Q + (size_t)(wid * QBLK + r32) * D + d0 * 16 + hi * 8);
    if constexpr (F32) { SLOAD_F((const float*)cur.K, kb0); VMW(); SWRITE_KF(0); SBAR(); SLOAD_F((const float*)cur.V, kb0); }
    else { SLOAD_H(cur.K, cur.V, cur.CB, kb0); VMW(); SWRITE_HK(0); }
    { char* const qsw = lds + OST_OFF + wid * OST_WAVE + r32 * ORS * 2 + hi * 16;
#pragma unroll
      for (int d0 = 0; d0 < 8; ++d0) *reinterpret_cast<bf16x8*>(qsw + d0 * 32) = S.qr[d0]; }
    __syncthreads();
}
template <class TIn, class TOut>
__device__ __forceinline__ void causal_swa_block(const BlockRef<TIn, TOut>& cur, const BlockRef<TIn, TOut>& nxt, int skv, int W, char* lds, Seam<TIn>& S) {
    constexpr bool F32 = same_t<TIn, float>::v;
    const int tid = threadIdx.x, wid = __builtin_amdgcn_readfirstlane(tid >> 6), lane = tid & 63, r32 = lane & 31, hi = lane >> 5;
    const int j_lo = swa_jlo(cur.P0, W);
    int j_hi = (cur.P0 + QB - 1) / KVBLK + 1; if (j_hi > skv / KVBLK) j_hi = skv / KVBLK;
    const int NT = j_hi - j_lo;
    const int kbn = swa_jlo(nxt.P0, W) * KVBLK;
    const int qlo = cur.P0 + wid * QBLK, qm = qlo + r32 - 4 * hi;
    char* V_lds = lds; char* K_lds = lds + 2 * SHM_V;
    float* ws = (float*)(lds + 2 * SHM_V + 2 * SHM_K) + wid * 64; float* li_l = ws, * al_l = ws + 32;
    float m_reg = -1e30f, l_reg = 0; f32x16 o[4] = {};
    const int sr = tid >> 4, sc = (tid & 15) * 8, vst0 = v_st(sr, sc), vst1 = v_st(32 + sr, sc), kws = KSWZ(sr, sc * 2);
    const int vb0 = (int)(uintptr_t)V_lds + v_rd_base(lane);
    char* const qs = lds + OST_OFF + wid * OST_WAVE + r32 * ORS * 2 + hi * 16;
    bf16x8 qrh[NQR];
#pragma unroll
    for (int d0 = 0; d0 < NQR; ++d0) qrh[d0] = *reinterpret_cast<const bf16x8*>(qs + d0 * 32);
    const TIn* Kh = cur.K; const TIn* Vh = cur.V; const float* Ch = cur.CB;
#define RESC(a) do { if (__any((a) < 1.f)) { if (hi == 0) al_l[r32] = (a); asm volatile("s_waitcnt lgkmcnt(0)" ::: "memory");              \
                     for (int d_ = 0; d_ < 4; ++d_) for (int r = 0; r < 16; ++r) o[d_][r] *= al_l[crow(r, hi)]; } } while (0)
#define KBASE(t) ((j_lo + (t)) * KVBLK)
#define ACT(t) (KBASE(t) <= qlo + QBLK - 1 && KBASE(t) + KVBLK - 1 >= qlo - W + 1)
#define MASKT(P0_, P1_, t) do { const int kb_ = KBASE(t); if ((!SK || ACT(t)) && (kb_ + KVBLK - 1 > qlo || kb_ <= qlo + QBLK - 1 - W)) mask_tile(P0_, P1_, qm - kb_, (unsigned)W); } while (0)
#define BIASADD(P0_, P1_, KB_) do { const float* bl_ = (const float*)(K_lds + 2 * SHM_K + NW * 64 * 4 + (KB_) * 256) + 4 * hi;                    \
        _Pragma("unroll") for (int g_ = 0; g_ < 4; ++g_) { const f32x4 b0_ = *(const f32x4*)(bl_ + 8 * g_), b1_ = *(const f32x4*)(bl_ + 32 + 8 * g_); \
            _Pragma("unroll") for (int i_ = 0; i_ < 4; ++i_) { P0_[4 * g_ + i_] += b0_[i_]; P1_[4 * g_ + i_] += b1_[i_]; } } } while (0)
    constexpr int NQL = F32 ? 16 : 0;
    constexpr bool SK = WSKIP && !F32;
#define SEAM_K0() do { VMWN(NQL); if constexpr (F32) { SWRITE_KF(0); SBAR(); SLOAD_F((const float*)nxt.V, kbn); } else { SWRITE_HK(0); } SBAR(); } while (0)
    f32x16 pA0, pA1, pB0, pB1; float mnA, mnB, alA, alB; bf16x8 pa0, pa1, pa2, pa3;
    if constexpr (F32) { VMW(); SWRITE_VF(0); SBAR(); } else { SWRITE_HV(0); SBAR(); }
    if (NT > 1) { if constexpr (F32) SLOAD_F((const float*)Kh, KBASE(1)); else SLOAD_H(Kh, Vh, Ch, KBASE(1)); }
    SBAR(); qkt<0, SK>(pA0, pA1, K_lds, r32, hi, qs, qrh, ACT(0));
    if constexpr (F32) { if (NT > 1) { VMW(); SWRITE_KF(1); SBAR(); SLOAD_F((const float*)Vh, KBASE(1)); } }
    MASKT(pA0, pA1, 0); partialSM(pA0, pA1, m_reg, mnA, alA);
    if (NT > 1) { VMW(); if constexpr (F32) { SWRITE_VF(1); SBAR(); if (NT > 2) SLOAD_F((const float*)Kh, KBASE(2)); } else SWRITE_H(1); }
    __syncthreads();
#define HALF_STEP(PX0, PX1, mnX, alX, PY0, PY1, alY, t, KB, VB, SB) do {                                                      \
        SBAR(); qkt<KB, SK>(PX0, PX1, K_lds, r32, hi, qs, qrh, ACT(t));                                             \
        finishSM(PY0, PY1, alY, l_reg, pa0, pa1, pa2, pa3); SBAR();                                                           \
        if ((t) + 1 < NT) { if constexpr (F32) { VMW(); SWRITE_KF(SB); SBAR(); SLOAD_F((const float*)Vh, KBASE((t) + 1)); }  \
                            else { SLOAD_H(Kh, Vh, Ch, KBASE((t) + 1)); } SBAR(); }                                               \
        pv_tile<VB, SK>(o, vb0, pa0, pa1, pa2, pa3, ACT((t) - 1)); MASKT(PX0, PX1, (t)); partialSM(PX0, PX1, m_reg, mnX, alX);                                        \
        __syncthreads();                                                                                                      \
        if ((t) + 1 < NT) { VMW(); if constexpr (F32) { SWRITE_VF(SB); SBAR(); if ((t) + 2 < NT) SLOAD_F((const float*)Kh, KBASE((t) + 2)); } \
                            else { SWRITE_H(SB); } }                                                                          \
        RESC(alX); __syncthreads(); } while (0)
    for (int t = 1; t + 1 < NT; t += 2) {
        HALF_STEP(pB0, pB1, mnB, alB, pA0, pA1, alA, t, 1, 0, 0);
        HALF_STEP(pA0, pA1, mnA, alA, pB0, pB1, alB, t + 1, 0, 1, 1);
    }
    const bool even = (NT & 1) == 0;
    if (even) { SBAR(); qkt<1, SK>(pB0, pB1, K_lds, r32, hi, qs, qrh, ACT(NT - 1)); SBAR(); }
#define QROW(e) (nxt.Q + (size_t)(wid * QBLK + r32) * D + ((e) >> 1) * 16 + hi * 8 + ((e) & 1) * 4)
    if constexpr (F32) { SLOAD_F((const float*)nxt.K, kbn); SBAR();
#pragma unroll
        for (int e = 0; e < 8; ++e) S.tq[e] = *(const f32x4*)QROW(e); }
    else { SLOAD_H(nxt.K, nxt.V, nxt.CB, kbn); SBAR(); }
    SBAR();
    finishSM(pA0, pA1, alA, l_reg, pa0, pa1, pa2, pa3); SBAR();
    if constexpr (F32) {
#pragma unroll
        for (int e = 8; e < 16; ++e) S.tq[e] = *(const f32x4*)QROW(e); SBAR(); }
#undef QROW
    pv_tile<0, SK>(o, vb0, pa0, pa1, pa2, pa3, ACT(even ? NT - 2 : NT - 1));
    if (even) { MASKT(pB0, pB1, NT - 1); partialSM(pB0, pB1, m_reg, mnB, alB); __syncthreads(); RESC(alB);
        finishSM(pB0, pB1, alB, l_reg, pa0, pa1, pa2, pa3); SBAR(); pv_tile<1, SK>(o, vb0, pa0, pa1, pa2, pa3, ACT(NT - 1)); }
    SBAR(); SEAM_K0();
    {
    int tz = threadIdx.x; asm volatile("" : "+v"(tz));
    const int lane_e = tz & 63, wid_e = __builtin_amdgcn_readfirstlane(tz >> 6), r32_e = lane_e & 31, hi_e = lane_e >> 5;
    float* li_e = (float*)(lds + 2 * SHM_V + 2 * SHM_K) + wid_e * 64;
    if (hi_e == 0) li_e[r32_e] = l_reg; asm volatile("s_waitcnt lgkmcnt(0)" ::: "memory");
    float rli[16];
#pragma unroll
    for (int r = 0; r < 16; ++r) rli[r] = __builtin_amdgcn_rcpf(li_e[crow(r, hi_e)]);
    char* ost = lds + OST_OFF + wid_e * OST_WAVE;
    {   char* ob = ost + (4 * hi_e * ORS + r32_e) * 2;
#pragma unroll
        for (int r = 0; r < 16; ++r) {
#pragma unroll
            for (int d0 = 0; d0 < 4; ++d0) { const float v = o[d0][r] * rli[r]; const float vn = __shfl_xor(v, 1);
                if ((r32_e & 1) == 0) *(unsigned*)(ob + (((r & 3) + 8 * (r >> 2)) * ORS + d0 * 32) * 2) = cvtpk(v, vn); } } }
    asm volatile("s_waitcnt lgkmcnt(0)" ::: "memory");
    if constexpr (!F32) {
        const TIn* qn = nxt.Q + (size_t)(wid_e * QBLK + r32_e) * D + hi_e * 8;
#pragma unroll
        for (int d0 = 0; d0 < 8; ++d0) S.qr[d0] = load8<TIn>(qn + d0 * 16); }
    {   const int orow = lane_e >> 4, och = lane_e & 15;
        const TOut* Ow_c = cur.O + (size_t)(wid_e * QBLK + orow) * OSTR + och * 8; TOut* Ow = const_cast<TOut*>(Ow_c);
        const TIn* Gw = cur.G + (size_t)(wid_e * QBLK + orow) * GSTR + och * 8;
#pragma unroll
        for (int i = 0; i < 8; ++i) {
            const u32x4 ov = *(const u32x4*)(ost + (4 * i + orow) * ORS * 2 + och * 16);
            const u32x4 gv = *(const u32x4*)(Gw + (size_t)(4 * i) * GSTR);
            u32x4 w;
#pragma unroll
            for (int k = 0; k < 4; ++k) w[k] = cvtpk(__uint_as_float(ov[k] << 16) * __uint_as_float(gv[k] << 16), __uint_as_float(ov[k] & 0xffff0000u) * __uint_as_float(gv[k] & 0xffff0000u));
            *(u32x4*)(Ow + (size_t)(4 * i) * OSTR) = w; } }
    if constexpr (!F32) {
        char* qsw = ost + r32_e * ORS * 2 + hi_e * 16;
#pragma unroll
        for (int d0 = 0; d0 < 8; ++d0) *reinterpret_cast<bf16x8*>(qsw + d0 * 32) = S.qr[d0]; }
    }
    if constexpr (F32) {
#pragma unroll
        for (int d0 = 0; d0 < 8; ++d0) S.qr[d0] = pack8(S.tq[2 * d0], S.tq[2 * d0 + 1]); }
    __syncthreads();
#undef RESC
#undef KBASE
#undef ACT
#undef MASKT
#undef SEAM_K0
#undef BIASADD
#undef HALF_STEP
}
#undef ROW
#undef VMW
#undef VMWN
#undef SLOAD_H
#undef SWRITE_HK
#undef SWRITE_HV
#undef SWRITE_H
#undef SLOAD_F
#undef SWRITE_KF
#undef SWRITE_VF


}

namespace dec {
constexpr int D = 128, PG16 = 16, WAVES = 4, GE = 4, GEP = 4, HPL = 1, NSPLIT = 4, TOK_STRIDE = 512;
constexpr int PPW = (PAST / PG16) / NSPLIT / WAVES;
constexpr int LDS_P = 0, LDS_MRG = WAVES * 64 * HPL, MRG_REC = 4 + D, LDS_FLOATS = LDS_MRG + WAVES * GEP * MRG_REC + 4;
using bf16x2 = __attribute__((ext_vector_type(2))) __bf16;
using u32x4  = __attribute__((ext_vector_type(4))) unsigned;
using f32x4  = __attribute__((ext_vector_type(4))) float;
using f32x8  = __attribute__((ext_vector_type(8))) float;
__device__ __forceinline__ float dot2(unsigned k, unsigned q, float acc) { return __builtin_amdgcn_fdot2_f32_bf16(__builtin_bit_cast(bf16x2, k), __builtin_bit_cast(bf16x2, q), acc, false); }
__device__ __forceinline__ unsigned cvtpk(float lo, float hi) { unsigned r; asm volatile("v_cvt_pk_bf16_f32 %0, %1, %2" : "=v"(r) : "v"(lo), "v"(hi)); return r; }
template <int CTRL> __device__ __forceinline__ float dpp(float x) { return __builtin_bit_cast(float, __builtin_amdgcn_mov_dpp(__builtin_bit_cast(int, x), CTRL, 0xf, 0xf, true)); }
constexpr int XOR1 = 0xB1, XOR2 = 0x4E, XOR7 = 0x141, XOR8 = 0x128, ROR4 = 0x124;
__device__ __forceinline__ float xrow16_max(float x) {
  auto s = __builtin_amdgcn_permlane16_swap(__float_as_uint(x), __float_as_uint(x), false, false);
  x = fmaxf(__uint_as_float(s[0]), __uint_as_float(s[1]));
  auto t = __builtin_amdgcn_permlane32_swap(__float_as_uint(x), __float_as_uint(x), false, false);
  return fmaxf(__uint_as_float(t[0]), __uint_as_float(t[1]));
}
__device__ __forceinline__ float xrow16_sum(float x) {
  auto s = __builtin_amdgcn_permlane16_swap(__float_as_uint(x), __float_as_uint(x), false, false);
  x = __uint_as_float(s[0]) + __uint_as_float(s[1]);
  auto t = __builtin_amdgcn_permlane32_swap(__float_as_uint(x), __float_as_uint(x), false, false);
  return __uint_as_float(t[0]) + __uint_as_float(t[1]);
}
__device__ __forceinline__ f32x8 ld8(const float* p) { const f32x4 lo = __builtin_nontemporal_load(reinterpret_cast<const f32x4*>(p)), hi = __builtin_nontemporal_load(reinterpret_cast<const f32x4*>(p + 64));
  return f32x8{lo[0], lo[1], lo[2], lo[3], hi[0], hi[1], hi[2], hi[3]}; }
__device__ __forceinline__ u32x4 tobf(f32x8 x) { u32x4 w = {cvtpk(x[0], x[1]), cvtpk(x[2], x[3]), cvtpk(x[4], x[5]), cvtpk(x[6], x[7])}; return w; }

struct DecArgs { const float* q; const float* k; const float* v; const int* pt; const float* sufx; float* pml; float* po; };

__device__ __forceinline__ void decode_unit(const DecArgs& a, int b, int kvh, int s, float* lds, int wave, int lane) {
  const int r = lane >> 4, c = lane & 15;
  constexpr float C2 = ATT_SCALE * 1.4426950408889634f;
  const int sp0 = s * (PAST / PG16 / NSPLIT);
  int btv = 0;
  if (lane < PPW) { const int sp = sp0 + wave + 4 * lane; btv = a.pt[b * NPAGES + (sp >> 3)] * 8 + (sp & 7); }
  u32x4 qpk[GEP];
#pragma unroll
  for (int g = 0; g < GEP; ++g) { const float* qp = a.q + ((size_t)(b * 4 + g) * 512 + kvh * D + 4 * c); const f32x4 lo = *reinterpret_cast<const f32x4*>(qp), hi = *reinterpret_cast<const f32x4*>(qp + 64);
    qpk[g] = tobf(f32x8{lo[0], lo[1], lo[2], lo[3], hi[0], hi[1], hi[2], hi[3]}); }
  const unsigned loff = (unsigned)(r * TOK_STRIDE + 4 * c);
  const float* sufx = a.sufx + (size_t)(b * 4 + kvh) * PAST; const unsigned soff = (unsigned)(r + 4 * (c >> 2));
#define PAGE_BASE(spid) ((size_t)(spid) * (PG16 * TOK_STRIDE) + (size_t)kvh * D)
#define ISSUE_K(KBUF, BV, i_) do { const int ii_ = (i_) < PPW ? (i_) : PPW - 1; const int phys_ = __builtin_amdgcn_readlane(btv, ii_); const float* kb_ = a.k + PAGE_BASE(phys_); \
    _Pragma("unroll") for (int t_ = 0; t_ < 4; ++t_) KBUF[t_] = ld8(kb_ + (loff + (unsigned)(t_ * 4 * TOK_STRIDE))); BV = sufx[(unsigned)((sp0 + wave + 4 * ii_) * PG16) + soff]; } while (0)
#define ISSUE_V(i_) do { const int ii_ = (i_) < PPW ? (i_) : PPW - 1; const int phys_ = __builtin_amdgcn_readlane(btv, ii_); const float* vb_ = a.v + PAGE_BASE(phys_); \
    _Pragma("unroll") for (int t_ = 0; t_ < 4; ++t_) Vn[t_] = ld8(vb_ + (loff + (unsigned)(t_ * 4 * TOK_STRIDE))); } while (0)
  f32x8 KA[4], KB[4], Vn[4]; float bA, bB;
  float m[HPL], l[HPL], acc[GEP * 8];
#pragma unroll
  for (int j = 0; j < HPL; ++j) { m[j] = -INFINITY; l[j] = 0.f; }
#pragma unroll
  for (int k = 0; k < GEP * 8; ++k) acc[k] = 0.f;
  ISSUE_K(KA, bA, 0); ISSUE_V(0); ISSUE_K(KB, bB, 1);
#define TR_STEP(HALF, CTRL, BIT) _Pragma("unroll") for (int h = 0; h < (HALF); ++h) _Pragma("unroll") for (int j = 0; j < HPL; ++j) { \
      const float lo_ = x[h * HPL + j], hi_ = x[(h + (HALF)) * HPL + j]; const float t1_ = lo_ + dpp<CTRL>(lo_), t2_ = hi_ + dpp<CTRL>(hi_); \
      x[h * HPL + j] = (c & (BIT)) ? t2_ : t1_; }
#define DEC_STEP(KBUF, BV, i_) do {                                                                                              \
    u32x4 Kc[4], Vc[4];                                                                                                          \
    _Pragma("unroll") for (int t = 0; t < 4; ++t) { Kc[t] = tobf(KBUF[t]); Vc[t] = tobf(Vn[t]); }                                \
    const float bias = BV;                                                                                                       \
    ISSUE_V((i_) + 1); ISSUE_K(KBUF, BV, (i_) + 2);                                                                              \
    float x[4 * GEP];                                                                                                            \
    _Pragma("unroll") for (int t = 0; t < 4; ++t) _Pragma("unroll") for (int g = 0; g < GEP; ++g) { float d = 0.f;              \
        _Pragma("unroll") for (int k = 0; k < 4; ++k) d = dot2(Kc[t][k], qpk[g][k], d);                                          \
        x[t * GEP + g] = d; }                                                                                                    \
    TR_STEP(8, XOR8, 8) TR_STEP(4, XOR7, 4) TR_STEP(2, XOR2, 2) TR_STEP(1, XOR1, 1)                                              \
    float p[HPL], alpha[HPL];                                                                                                    \
    _Pragma("unroll") for (int j = 0; j < HPL; ++j) {                                                                            \
      const float sc = x[j] * C2 + bias;                                                                                         \
      float pm = sc; pm = fmaxf(pm, dpp<ROR4>(pm)); pm = fmaxf(pm, dpp<XOR8>(pm)); pm = xrow16_max(pm);                          \
      const float mn = fmaxf(m[j], pm), msub = (mn == -INFINITY) ? 0.f : mn;                                                     \
      alpha[j] = __builtin_amdgcn_exp2f(m[j] - msub); p[j] = __builtin_amdgcn_exp2f(sc - msub);                                  \
      l[j] = fmaf(l[j], alpha[j], p[j]); m[j] = mn; }                                                                            \
    _Pragma("unroll") for (int q4 = 0; q4 < 4; ++q4) _Pragma("unroll") for (int j = 0; j < HPL; ++j) {                           \
        const float al = q4 == 0 ? dpp<0x00>(alpha[j]) : q4 == 1 ? dpp<0x55>(alpha[j]) : q4 == 2 ? dpp<0xAA>(alpha[j]) : dpp<0xFF>(alpha[j]); \
        _Pragma("unroll") for (int k = 0; k < 8; ++k) acc[(q4 * HPL + j) * 8 + k] *= al; }                                       \
    float* prow = lds + LDS_P + (wave * 4 + r) * 16 * HPL;                                                                       \
    _Pragma("unroll") for (int j = 0; j < HPL; ++j) prow[c * HPL + j] = p[j];                                                    \
    asm volatile("s_waitcnt lgkmcnt(0)" ::: "memory");                                                                           \
    f32x4 pr[GEP];                                                                                                               \
    _Pragma("unroll") for (int u = 0; u < GEP; ++u) pr[u] = *reinterpret_cast<const f32x4*>(prow + 4 * u);                       \
    _Pragma("unroll") for (int t = 0; t < 4; ++t) { float vf[8];                                                                 \
      _Pragma("unroll") for (int k = 0; k < 4; ++k) { vf[2 * k] = __builtin_bit_cast(float, Vc[t][k] << 16); vf[2 * k + 1] = __builtin_bit_cast(float, Vc[t][k] & 0xffff0000u); } \
      _Pragma("unroll") for (int g = 0; g < GE; ++g) { const float pg_ = pr[(t * GEP + g) >> 2][(t * GEP + g) & 3];              \
        _Pragma("unroll") for (int k = 0; k < 8; ++k) acc[g * 8 + k] = fmaf(pg_, vf[k], acc[g * 8 + k]); } } } while (0)
#pragma unroll 1
  for (int i = 0; i < PPW; i += 2) { DEC_STEP(KA, bA, i); DEC_STEP(KB, bB, i + 1); }
#undef DEC_STEP
#undef TR_STEP
#undef ISSUE_K
#undef ISSUE_V
#undef PAGE_BASE
#pragma unroll
  for (int k = 0; k < GE * 8; ++k) acc[k] = xrow16_sum(acc[k]);
#pragma unroll
  for (int j = 0; j < HPL; ++j) { float t = l[j]; t += dpp<ROR4>(t); t += dpp<XOR8>(t); l[j] = xrow16_sum(t); }
  float* mrg = lds + LDS_MRG;
  if (r == 0) {
#pragma unroll
    for (int g = 0; g < GE; ++g) {
      float* rec = mrg + (wave * GEP + g) * MRG_REC;
#pragma unroll
      for (int k = 0; k < 8; k += 4) *reinterpret_cast<f32x4*>(rec + 4 + 4 * c + 16 * k) = f32x4{acc[g * 8 + k], acc[g * 8 + k + 1], acc[g * 8 + k + 2], acc[g * 8 + k + 3]};
      if (c == g / HPL) { rec[0] = m[g % HPL]; rec[1] = l[g % HPL]; } } }
  __syncthreads();
  {
    const int g = wave, d0 = 2 * lane;
    const size_t row = (size_t)(b * 4 + kvh) * 4 + g;
    float M = -INFINITY;
#pragma unroll
    for (int w = 0; w < WAVES; ++w) M = fmaxf(M, mrg[(w * GEP + g) * MRG_REC]);
    float L = 0.f, o0 = 0.f, o1 = 0.f;
#pragma unroll
    for (int w = 0; w < WAVES; ++w) { const float* rec = mrg + (w * GEP + g) * MRG_REC; const float lw = rec[1];
      const float wt = (lw > 0.f) ? __builtin_amdgcn_exp2f(rec[0] - M) : 0.f;
      L = fmaf(wt, lw, L); o0 = fmaf(wt, rec[4 + d0], o0); o1 = fmaf(wt, rec[4 + d0 + 1], o1); }
    const size_t slot = row * NSPLIT + s;
    *reinterpret_cast<float2*>(a.po + slot * D + d0) = make_float2(o0, o1);
    if (lane == 0) *reinterpret_cast<float2*>(a.pml + 2 * slot) = make_float2(M, L);
  }
  __syncthreads();
}

struct CombArgs { const float* pml; const float* po; const float* q; const float* knew; const float* vnew; const float* lfb; const unsigned short* gate; unsigned short* mix; };
__device__ __forceinline__ void combine_row(const CombArgs& a, int b, int h, int t, int lane) {
  constexpr float C2 = ATT_SCALE * 1.4426950408889634f;
  const size_t row = (size_t)(b * 4 + h) * 4 + t; const int d0 = 2 * lane;
  const float* pml = a.pml + row * NSPLIT * 2; const float* po = a.po + row * NSPLIT * D;
  const float2 qv = *reinterpret_cast<const float2*>(a.q + (size_t)(b * 4 + t) * 512 + h * D + d0);
  float scn[4]; float cum = 0.f;
#pragma unroll
  for (int s = 0; s < 4; ++s) {
    const float2 kv = *reinterpret_cast<const float2*>(a.knew + (size_t)(b * 4 + s) * 512 + h * D + d0);
    float d = qv.x * kv.x + qv.y * kv.y;
#pragma unroll
    for (int o = 1; o < 64; o <<= 1) d += __shfl_xor(d, o);
    cum += a.lfb[(size_t)(MP + b * 4 + s) * 4 + h];
    scn[s] = (s <= t) ? d * C2 - cum * LOG2E : -INFINITY;
  }
  float M = -INFINITY;
#pragma unroll
  for (int s = 0; s < NSPLIT; ++s) M = fmaxf(M, pml[2 * s]);
#pragma unroll
  for (int s = 0; s < 4; ++s) M = fmaxf(M, scn[s]);
  float L = 0.f, o0 = 0.f, o1 = 0.f;
#pragma unroll
  for (int s = 0; s < NSPLIT; ++s) { const float ls = pml[2 * s + 1], w = (ls > 0.f) ? __builtin_amdgcn_exp2f(pml[2 * s] - M) : 0.f;
    const float2 av = *reinterpret_cast<const float2*>(po + (size_t)s * D + d0);
    L = fmaf(w, ls, L); o0 = fmaf(w, av.x, o0); o1 = fmaf(w, av.y, o1); }
#pragma unroll
  for (int s = 0; s < 4; ++s) { const float w = __builtin_amdgcn_exp2f(scn[s] - M);
    const float2 vv = *reinterpret_cast<const float2*>(a.vnew + (size_t)(b * 4 + s) * 512 + h * D + d0);
    L += w; o0 = fmaf(w, vv.x, o0); o1 = fmaf(w, vv.y, o1); }
  const float inv = 1.f / L;
  const size_t ms = (size_t)(MP + b * 4 + t);
  const unsigned gp = *reinterpret_cast<const unsigned*>(a.gate + ms * 512 + h * D + d0);
  const float g0 = __uint_as_float(gp << 16), g1 = __uint_as_float(gp & 0xffff0000u);
  *reinterpret_cast<unsigned*>(a.mix + ms * 1024 + 512 + h * D + d0) = cvtpk(o0 * inv * g0, o1 * inv * g1);
}
}

__device__ __forceinline__ void p6_rpass(Frame& F, int part) {
    const int gw = (int)blockIdx.x * NWAVES + F.wave, NGW = F.G * NWAVES, fr = F.lane & 15, fq = F.lane >> 4;
    const bf16* X1B = WSP(bf16, WS_XN); const bf16* WRB = WSP(bf16, WS_WR); const bf16* WGB = WSP(bf16, WS_WR + 65536);
    bf16* GF3 = WSP(bf16, WS_GF3); const float* SS1 = (const float*)(F.ctl + CW_SS1);
    LAS unsigned char* rt = F.lds + RING_OFF + F.wave * 512;
    constexpr int NU = MT / 8;
    for (int it = (NGW == 2048 && part == 1) ? 1 : 0; ; ++it) {
        int u;
        if (NGW == 2048) { if (it == 0) u = gw; else if (it == 1 && part != 0 && F.wave == 0 && blockIdx.x >= 192 && (int)blockIdx.x < 192 + (NU - 2048)) u = 2048 + (int)blockIdx.x - 192; else break; }
        else { if (part == 1) break; u = gw + it * NGW; if (u >= NU) break; }
        const int g = u >> 1, hh = u & 1, row0 = 16 * g;
        const GAS bf16x8* wp = (const GAS bf16x8*)(WRB + (size_t)fr * DM + 8 * fq);
        const GAS bf16x8* ap = (const GAS bf16x8*)(X1B + (size_t)(row0 + fr) * DM + 8 * fq);
        pg8::f32x4 acc = {0.f, 0.f, 0.f, 0.f};
#pragma unroll 1
        for (int k0 = 0; k0 < 32; k0 += 16) {
            bf16x8 wv[16], av[16];
#pragma unroll
            for (int i = 0; i < 16; ++i) { wv[i] = wp[(k0 + i) * 4]; av[i] = ap[(k0 + i) * 4]; }
#pragma unroll
            for (int i = 0; i < 16; ++i) acc = __builtin_amdgcn_mfma_f32_16x16x32_bf16(wv[i], av[i], acc, 0, 0, 0);
        }
        const float rstd = 1.0f / sqrtf(SS1[row0 + fr] * (1.f / DM) + EPS);
        acc = acc * rstd;
        { u32x2v w; w.x = cvtpk_s(acc[0], acc[1]); w.y = cvtpk_s(acc[2], acc[3]); *(LAS u32x2v*)(rt + (fr * 16 + 4 * fq) * 2) = w; }
        LDS_WAIT(); asm volatile("" ::: "memory");
        bf16x8 rb = {0, 0, 0, 0, 0, 0, 0, 0};
        if (fq < 2) rb = *(const LAS bf16x8*)(rt + (fr * 16 + 8 * fq) * 2);
        LDS_WAIT(); asm volatile("" ::: "memory");
#pragma unroll 4
        for (int ct = 16 * hh; ct < 16 * hh + 16; ++ct) {
            bf16x8 wa = {0, 0, 0, 0, 0, 0, 0, 0};
            if (fq < 2) wa = *(const GAS bf16x8*)(WGB + (size_t)(16 * ct + fr) * 16 + 8 * fq);
            const pg8::f32x4 z = {0.f, 0.f, 0.f, 0.f};
            const pg8::f32x4 d = __builtin_amdgcn_mfma_f32_16x16x32_bf16(wa, rb, z, 0, 0, 0);
            const f32x4 bg = *(const GAS f32x4*)(F.b_gla_gate + 16 * ct + 4 * fq);
            f32x4 lf; lf.x = log_sigmoidf_(d[0] + bg.x) * 0.0625f; lf.y = log_sigmoidf_(d[1] + bg.y) * 0.0625f; lf.z = log_sigmoidf_(d[2] + bg.z) * 0.0625f; lf.w = log_sigmoidf_(d[3] + bg.w) * 0.0625f;
            st_bf4(GF3 + (size_t)(row0 + fr) * 512 + 16 * ct + 4 * fq, lf);
        }
    }
    __syncthreads();
}
__device__ __forceinline__ void p11_final(Frame& F) {
    const int gw = (int)blockIdx.x * NWAVES + F.wave, NGW = F.G * NWAVES;
    const float* SS2 = (const float*)(F.ctl + CW_SS2);
    for (int m = gw; m < MT; m += NGW) {
        GAS f32x4* yr = (GAS f32x4*)(F.out + O_Y + (size_t)m * DM) + F.lane;
        const float rstd = 1.0f / sqrtf(SS2[m] * (1.f / DM) + EPS);
#pragma unroll
        for (int j = 0; j < 4; ++j) { const f32x4 g = *(const GAS f32x4*)(F.final_norm + 4 * F.lane + 256 * j); yr[64 * j] = yr[64 * j] * rstd * g; }
    }
}

struct SE1 { P1 p; __device__ __forceinline__ void operator()(int m, int c, f32x4 v) const { epi1_4(p, m, c, v); } };
struct SE2 { P2 p; __device__ __forceinline__ void operator()(int m, int c, f32x4 v) const { float ss = epi2_4(p, m, c, v); ss += __shfl_xor(ss, 16); ss += __shfl_xor(ss, 32); if (((c >> 2) & 3) == 0) atomicAdd(p.SS + m, ss); } };
struct SE3 { P3 p; __device__ __forceinline__ void operator()(int m, int c, f32x4 v) const { const float rstd = 1.0f / sqrtf(p.SS[m] * (1.f / DM) + EPS); epi3_4(p, m, c, v, rstd); } };
struct SE4 { P4 p; __device__ __forceinline__ void operator()(int m, int c, f32x4 v) const { float ss = epi4_4(p, m, c, v); ss += __shfl_xor(ss, 16); ss += __shfl_xor(ss, 32); if (((c >> 2) & 3) == 0) atomicAdd(p.SS + m, ss); } };
typedef fox::BlockRef<fox::TIN, fox::TOUT> FoxRef;
__device__ __forceinline__ FoxRef fox_ref(unsigned char* ws, int bh, int qb) {
    const fox::TIN* Q = (const fox::TIN*)(ws + WS_QBH); const fox::TIN* K = (const fox::TIN*)(ws + WS_KBH); const fox::TIN* V = (const fox::TIN*)(ws + WS_VBH);
    const int b = bh >> 2, h = bh & 3; FoxRef r;
    r.Q = Q + ((size_t)bh * SEQ + (size_t)qb * 256) * 128; r.K = K + (size_t)bh * SEQ * 128; r.V = V + (size_t)bh * SEQ * 128;
    r.O = (fox::TOUT*)(ws + WS_MIX) + ((size_t)(b * SEQ + qb * 256)) * 1024 + 512 + h * 128; r.G = (const fox::TIN*)(ws + WS_GB) + ((size_t)(b * SEQ + qb * 256)) * 512 + h * 128;
    r.CB = (const float*)(ws + WS_CB) + (size_t)bh * SEQ; r.P0 = qb * 256; return r;
}


__device__ __forceinline__ void sub_barrier(unsigned* cnt, unsigned n, unsigned& gen) {
    asm volatile("s_waitcnt vmcnt(0)" ::: "memory");
    __syncthreads();
    if (threadIdx.x == 0) {
        __builtin_amdgcn_fence(__ATOMIC_RELEASE, "agent");
        asm volatile("s_waitcnt vmcnt(0)" ::: "memory");
        (void)__hip_atomic_fetch_add(cnt, 1u, __ATOMIC_RELAXED, __HIP_MEMORY_SCOPE_AGENT);
        const unsigned target = (gen + 1u) * n; unsigned sp = 0;
        while (__hip_atomic_load(cnt, __ATOMIC_RELAXED, __HIP_MEMORY_SCOPE_AGENT) < target) { __builtin_amdgcn_s_sleep(1); if (++sp > (1u << 22)) break; }
        __builtin_amdgcn_fence(__ATOMIC_ACQUIRE, "agent");
        asm volatile("s_waitcnt vmcnt(0)" ::: "memory");
    }
    __syncthreads();
    ++gen;
}

#ifndef MK_N_LAUNCHES
#define MK_N_LAUNCHES 1
#endif
constexpr int N_LAUNCHES = MK_N_LAUNCHES;
constexpr int N_PHASES = 12;
struct Args { const void* in[21]; float* out; unsigned char* ws; int ph_lo, ph_hi, sub, pad; };
__global__ void __launch_bounds__(NWAVES * 64, 2) hybrid_fwd(Args args) {
    extern __shared__ __attribute__((aligned(16))) unsigned char lds[];
    Frame F;
    F.lds = (LAS unsigned char*)lds;
    F.MISC = (volatile LAS unsigned*)(F.lds + MISC_OFF);
    F.tid = threadIdx.x; F.lane = F.tid & 63; F.wave = __builtin_amdgcn_readfirstlane(F.tid >> 6);
    F.G = gridDim.x;
    F.ws = args.ws; F.out = args.out; F.ctl = (gu32*)(args.ws + WS_CTL);
    F.xp = (const float*)args.in[0]; F.xs = (const float*)args.in[1]; F.ck = (const float*)args.in[2]; F.cv = (const float*)args.in[3]; F.clf = (const float*)args.in[4];
    F.sh = (const float*)args.in[5]; F.sg = (const float*)args.in[6]; F.pt = (const int*)args.in[7];
    F.norm_even = (const float*)args.in[8]; F.w_in_even = (const float*)args.in[9]; F.b_fox = (const float*)args.in[10]; F.lb_logits = (const float*)args.in[11];
    F.hgrn_gain = (const float*)args.in[12]; F.w_out_even = (const float*)args.in[13]; F.norm_odd = (const float*)args.in[14]; F.w_in_odd = (const float*)args.in[15];
    F.w_gla_gate = (const float*)args.in[16]; F.b_gla_gate = (const float*)args.in[17]; F.gla_gain = (const float*)args.in[18]; F.w_out_odd = (const float*)args.in[19]; F.final_norm = (const float*)args.in[20];
    for (int u = F.tid; u < (LDS_BYTES - LDSCTL_OFF) / 4; u += NWAVES * 64) ((LAS unsigned*)(F.lds + LDSCTL_OFF))[u] = 0u;
    __syncthreads();
    XcdBarrier bar; bar.bar = (unsigned*)(F.ctl + CW_BAR); bar.x = 0; bar.st = nullptr; bar.total = 0u;
    if (N_LAUNCHES == 1) bar = xcd_barrier_post((unsigned*)(F.ctl + CW_BAR), F.MISC + 8);
    XcdBarrier bar2; bar2.bar = (unsigned*)(F.ctl + CW_BAR2); bar2.x = 0; bar2.st = nullptr; bar2.total = 0u;
    if ((int)blockIdx.x >= (int)gridDim.x / 2) { bar2 = xcd_barrier_post((unsigned*)(F.ctl + CW_BAR2), F.MISC + 12); bar2.total = gridDim.x - gridDim.x / 2; }
#define GRID_BAR() do { if (N_LAUNCHES == 1) xcd_barrier(bar); } while (0)
    const int lo = args.ph_lo, hi = args.ph_hi;
#ifndef REP_MASK
#define REP_MASK 0
#endif
#if REP_MASK
#define REPS(k) for (int rep_ = 0; rep_ <= (((REP_MASK) >> (k)) & 1); ++rep_)
#else
#define REPS(k)
#endif
#ifndef SUB_MASK
#define SUB_MASK 7
#endif
#ifndef PH_MASK
#define PH_MASK 0xFFF
#endif
#define IN(k) ((((PH_MASK) >> (k)) & 1) && lo <= (k) && (k) < hi)
#define BOTH(k) (IN(k) && IN((k) + 1))
    const int bid = blockIdx.x;

    REPS(0) if (IN(0)) { p0_prologue(F, args.sub); if (BOTH(0)) GRID_BAR(); }

    REPS(1) if (IN(1)) {
        const bool late1 = ((blockIdx.x >> 3) & 1u) != 0u;
        if (bid < NB && !(args.sub & 32)) fox_cumsum_unit(F, bid);
        P1 p{WSP(bf16, WS_QA), WSP(bf16, WS_IA), WSP(bf16, WS_GA), WSP(bf16, WS_GB), WSP(bf16, WS_QBH), WSP(bf16, WS_KBH), WSP(bf16, WS_VBH), WSP(bf16, WS_GF), WSP(float, WS_QS), WSP(float, WS_LB), F.out};
        { pg8::Gemm g{WSP(bf16, WS_XN), WSP(bf16, WS_W1T), MP, 4096, DM}; pg8::StaticOrder S; S.init(MP, 4096, F.G, bid);
          Epi1 E{p, (args.sub >> 4) & 1 ? 1 : ((args.sub >> 7) & 1 ? 2 : 0)};
          if (!late1 && !(args.sub & 32)) for (int u = bid; u < 256; u += F.G)
              sgemm_unit(WSP(bf16, WS_XN), WSP(bf16, WS_W1T), u, F.wave, F.lane, SE1{p});
          pg8::gemm_phase<Epi1, pg8::StaticOrder, true, true>(F.lds + RING_OFF, g, S, E); }
        if (late1 && !(args.sub & 32)) for (int u = bid; u < 256; u += F.G)
            sgemm_unit(WSP(bf16, WS_XN), WSP(bf16, WS_W1T), u, F.wave, F.lane, SE1{p});
        if (BOTH(1)) GRID_BAR();
    }

    REPS(2) if (IN(2)) {
        const int half = F.G / 2;
        if (args.sub & 8) {
            dec::DecArgs da{WSP(float, WS_QS), F.ck, F.cv, F.pt, WSP(float, WS_SUFX), WSP(float, WS_PML), WSP(float, WS_PO)};
            float* dl = (float*)(lds + RING_OFF) + (F.wave >> 2) * dec::LDS_FLOATS;
            for (int wu = bid; wu < 256; wu += F.G) { const int du = 2 * wu + (F.wave >> 2); dec::decode_unit(da, du >> 4, (du >> 2) & 3, du & 3, dl, F.wave & 3, F.lane); }
        } else if (bid < half) {
            if ((SUB_MASK & 1) && (args.sub & 1)) for (int L = bid; L < 128; L += half) {
                const int bh = L & 7, x = L >> 3;
                const FoxRef b0 = fox_ref(F.ws, bh, 31 - x), b1 = fox_ref(F.ws, bh, x);
                fox::Seam<fox::TIN> S;
                fox::causal_swa_prime<fox::TIN, fox::TOUT>(b0, fox::WINDOW, (char*)lds + RING_OFF, S);
                FoxRef cur = b0; int pass = 0;
                for (;;) { const bool last = pass == 1; const FoxRef nxt = last ? cur : b1;
                    fox::causal_swa_block<fox::TIN, fox::TOUT>(cur, nxt, fox::SKV, fox::WINDOW, (char*)lds + RING_OFF, S);
                    if (last) break; cur = nxt; pass = 1; }
            }
        } else {
            const int cb = bid - half, nb = F.G - half;
            if ((SUB_MASK & 2) && (args.sub & 2)) { dec::DecArgs da{WSP(float, WS_QS), F.ck, F.cv, F.pt, WSP(float, WS_SUFX), WSP(float, WS_PML), WSP(float, WS_PO)};
              float* dl = (float*)(lds + RING_OFF) + (F.wave >> 2) * dec::LDS_FLOATS;
              for (int wu = cb; wu < 256; wu += nb) { const int du = 2 * wu + (F.wave >> 2); dec::decode_unit(da, du >> 4, du & 3, (du >> 2) & 3, dl, F.wave & 3, F.lane); } }
            __syncthreads();
            LaArgs a{}; a.Q = WSP(bf16, WS_QA); a.Kp = nullptr; a.G = WSP(bf16, WS_GF); a.V = WSP(bf16, WS_IA); a.GATE = WSP(bf16, WS_GA); a.ldv = 512; a.gain = F.hgrn_gain; a.MIXo = WSP(bf16, WS_MIX); a.mixoff = 0;
            if ((SUB_MASK & 4) && (args.sub & 4)) {
              for (int u = cb; u < 256; u += nb) { const int bh = u >> 5, sc = u & 31; a.SBUF = WSP(bf16, WS_SLOC) + (size_t)u * 16384; a.BTOT = WSP(float, WS_BTOT) + (size_t)u * 128;
                  la_unit<128, false, 0>(F.lds + RING_OFF, a, (bh >> 2) * SEQ + sc * 256, bh & 3, F.tid, F.wave, F.lane); }
            }
            if (args.sub == 7) {
              xcd_barrier(bar2);
              if (cb == 0 && F.tid == 0) __hip_atomic_store((unsigned*)(F.ctl + CW_FLAG), 1u, __ATOMIC_RELAXED, __HIP_MEMORY_SCOPE_AGENT);
              la_scan<128>(WSP(bf16, WS_SLOC), WSP(float, WS_BTOT), F.out + O_HSP, cb * 512 + F.tid, nb * 512);
              xcd_barrier(bar2);
              for (int u = cb; u < 256; u += nb) { const int bh = u >> 5, sc = u & 31; a.SBUF = WSP(bf16, WS_SLOC) + (size_t)u * 16384; a.BTOT = nullptr;
                  la_unit<128, false, 1>(F.lds + RING_OFF, a, (bh >> 2) * SEQ + sc * 256, bh & 3, F.tid, F.wave, F.lane); }
            }
        }
        if (args.sub == 7) {
            constexpr int T_S = 128, T_C = 64, T_W = 160, T_ALL = T_S + T_C + T_W;
            LaArgs a{}; a.Q = WSP(bf16, WS_QA); a.Kp = nullptr; a.G = WSP(bf16, WS_GF); a.V = WSP(bf16, WS_IA); a.GATE = WSP(bf16, WS_GA); a.ldv = 512; a.gain = F.hgrn_gain; a.MIXo = WSP(bf16, WS_MIX); a.mixoff = 0;
            dec::CombArgs ca{WSP(float, WS_PML), WSP(float, WS_PO), WSP(float, WS_QS), F.out + O_KS, F.out + O_VS, WSP(float, WS_LFB), WSP(bf16, WS_GB), WSP(bf16, WS_MIX)};
            bool flagged = bid >= half; unsigned nxt = 0u; int par = 0;
            __syncthreads();
            if (F.tid == 0) nxt = __hip_atomic_fetch_add((unsigned*)(F.ctl + CW_TAIL), 1u, __ATOMIC_RELAXED, __HIP_MEMORY_SCOPE_AGENT);
            for (;;) {
                if (F.tid == 0) F.MISC[16 + par] = nxt;
                __syncthreads();
                const int it = __builtin_amdgcn_readfirstlane((int)F.MISC[16 + par]); par ^= 1;
                if (it >= T_ALL) break;
                if (F.tid == 0) nxt = __hip_atomic_fetch_add((unsigned*)(F.ctl + CW_TAIL), 1u, __ATOMIC_RELAXED, __HIP_MEMORY_SCOPE_AGENT);
                if (it < T_S) { a.S0 = F.sh + (size_t)it * 16384; a.S1 = F.out + O_HSS + (size_t)it * 16384;
                    la_sample_unit<128, false>(F.lds + RING_OFF, a, it, F.tid, F.wave, F.lane); }
                else if (it < T_S + T_C) {
                    if (!flagged) { flagged = true;
                        if (F.tid == 0) { unsigned sp = 0; while (__hip_atomic_load((unsigned*)(F.ctl + CW_FLAG), __ATOMIC_RELAXED, __HIP_MEMORY_SCOPE_AGENT) == 0u) { __builtin_amdgcn_s_sleep(2); if (++sp > (1u << 22)) break; }
                            __builtin_amdgcn_fence(__ATOMIC_ACQUIRE, "agent"); asm volatile("s_waitcnt vmcnt(0)" ::: "memory"); }
                        __syncthreads(); }
                    const int r = (it - T_S) * NWAVES + F.wave; dec::combine_row(ca, r >> 4, (r >> 2) & 3, r & 3, F.lane); }
                else { __syncthreads(); late_weights(F, (it - T_S - T_C) * 16 + F.wave, (it - T_S - T_C) * 16 + 16); }
            }
        }
        if (BOTH(2)) GRID_BAR();
    }


    REPS(5) if (IN(5)) {
        P2 p{F.xp, F.xs, WSP(bf16, WS_XN), (float*)(F.ctl + CW_SS1)};
        { pg8::Gemm g{WSP(bf16, WS_MIX), WSP(bf16, WS_W2T), MP, 1024, DM}; pg8::StaticOrder S; S.init(MP, 1024, F.G, bid);
          Epi2 E{p};
          pg8::gemm_phase<Epi2, pg8::StaticOrder, true, true>(F.lds + RING_OFF, g, S, E); }
        for (int u = bid; u < 64; u += F.G)
            sgemm_unit(WSP(bf16, WS_MIX), WSP(bf16, WS_W2T), u, F.wave, F.lane, SE2{p});
        if (BOTH(5)) GRID_BAR();
    }

    REPS(6) if (IN(6)) {
        const bool late6 = ((blockIdx.x >> 3) & 1u) != 0u;
        if ((SUB_MASK & 1) && !(args.sub & 64) && !late6) p6_rpass(F, 0);
        P3 p{WSP(bf16, WS_Q3), WSP(bf16, WS_K3), WSP(bf16, WS_V3), WSP(bf16, WS_G3), (const float*)(F.ctl + CW_SS1)};
        if (SUB_MASK & 2) { pg8::Gemm g{WSP(bf16, WS_XN), WSP(bf16, WS_W3T), MP, 3072, DM}; pg8::StaticOrder S; S.init(MP, 3072, F.G, bid);
          Epi3 E{p, (args.sub >> 4) & 1};
          pg8::gemm_phase<Epi3, pg8::StaticOrder, true, true>(F.lds + RING_OFF, g, S, E); }
        if ((SUB_MASK & 4) && !(args.sub & 32)) for (int u = bid; u < 192; u += F.G)
            sgemm_unit(WSP(bf16, WS_XN), WSP(bf16, WS_W3T), u, F.wave, F.lane, SE3{p});
        if ((SUB_MASK & 1) && !(args.sub & 64)) { __syncthreads(); p6_rpass(F, late6 ? 2 : 1); }
        if (BOTH(6)) GRID_BAR();
    }

    REPS(7) if (IN(7)) {
        LaArgs a{}; a.Q = WSP(bf16, WS_Q3); a.Kp = WSP(bf16, WS_K3); a.G = WSP(bf16, WS_GF3); a.V = WSP(bf16, WS_V3); a.GATE = WSP(bf16, WS_G3); a.ldv = 1024; a.gain = F.gla_gain; a.MIXo = WSP(bf16, WS_MIX2); a.mixoff = 0;
        for (int u = bid; u < 256; u += F.G) { const int bh = u >> 5, sc = u & 31; a.SBUF = WSP(bf16, WS_SLOC3) + (size_t)u * 32768; a.BTOT = WSP(float, WS_BTOT) + 32768 + (size_t)u * 128;
            la_unit<256, true, 0>(F.lds + RING_OFF, a, (bh >> 2) * SEQ + sc * 256, bh & 3, F.tid, F.wave, F.lane); }
        for (int u = bid; u < 128; u += F.G) { a.S0 = F.sg + (size_t)u * 32768; a.S1 = F.out + O_GSS + (size_t)u * 32768;
            la_sample_unit<256, true>(F.lds + RING_OFF, a, u, F.tid, F.wave, F.lane); }
        if (BOTH(7)) GRID_BAR();
    }
    REPS(8) if (IN(8)) {
        la_scan<256>(WSP(bf16, WS_SLOC3), WSP(float, WS_BTOT) + 32768, F.out + O_GSP, bid * 512 + F.tid, F.G * 512);
        if (F.G == 256) { P4 p{WSP(bf16, WS_XN), F.out + O_Y, (float*)(F.ctl + CW_SS2)};
            for (int u = 255 - bid; u < 64; u += F.G) sgemm_unit(WSP(bf16, WS_MIX2), WSP(bf16, WS_W4T), u, F.wave, F.lane, SE4{p}); }
        if (BOTH(8)) GRID_BAR();
    }
    REPS(9) if (IN(9)) {
        LaArgs a{}; a.Q = WSP(bf16, WS_Q3); a.Kp = WSP(bf16, WS_K3); a.G = WSP(bf16, WS_GF3); a.V = WSP(bf16, WS_V3); a.GATE = WSP(bf16, WS_G3); a.ldv = 1024; a.gain = F.gla_gain; a.MIXo = WSP(bf16, WS_MIX2); a.mixoff = 0;
        for (int u = bid; u < 256; u += F.G) { const int bh = u >> 5, sc = u & 31; a.SBUF = WSP(bf16, WS_SLOC3) + (size_t)u * 32768; a.BTOT = nullptr;
            la_unit<256, true, 1>(F.lds + RING_OFF, a, (bh >> 2) * SEQ + sc * 256, bh & 3, F.tid, F.wave, F.lane); }
        if (BOTH(9)) GRID_BAR();
    }
    REPS(10) if (IN(10)) {
        P4 p{WSP(bf16, WS_XN), F.out + O_Y, (float*)(F.ctl + CW_SS2)};
        pg8::Gemm g{WSP(bf16, WS_MIX2), WSP(bf16, WS_W4T), MP, 1024, DM}; pg8::StaticOrder S; S.init(MP, 1024, F.G, bid);
        if (F.G == 256) {
            Epi4F E{p, F.final_norm, &bar};
            pg8::gemm_phase<Epi4F, pg8::StaticOrder, false, true>(F.lds + RING_OFF, g, S, E);
            const int gw = bid * NWAVES + F.wave;
            if (gw < MS) { const int m = MP + gw; GAS f32x4* yr = (GAS f32x4*)(F.out + O_Y + (size_t)m * DM) + F.lane;
                const float rstd = 1.0f / sqrtf(__hip_atomic_load(p.SS + m, __ATOMIC_RELAXED, __HIP_MEMORY_SCOPE_AGENT) * (1.f / DM) + EPS);
#pragma unroll
                for (int j = 0; j < 4; ++j) { const f32x4 gg = *(const GAS f32x4*)(F.final_norm + 4 * F.lane + 256 * j); yr[64 * j] = yr[64 * j] * rstd * gg; } }
        } else {
            Epi4 E{p};
            pg8::gemm_phase<Epi4, pg8::StaticOrder, true, true>(F.lds + RING_OFF, g, S, E);
            for (int u = bid; u < 64; u += F.G) sgemm_unit(WSP(bf16, WS_MIX2), WSP(bf16, WS_W4T), u, F.wave, F.lane, SE4{p});
            if (BOTH(10)) GRID_BAR();
        }
    }
    if (IN(11) && F.G != 256) p11_final(F);
#undef IN
#undef BOTH
}

extern "C" void kernel_launch(void* const* d_in, const int* in_sizes, int n_in, void* d_out, int out_size, void* d_ws, size_t ws_size, hipStream_t stream) {
    static int grid = 0;
    if (grid == 0) {
        if (n_in != 21 || out_size != (int)O_END || ws_size < WS_END) { fprintf(stderr, "kernel_launch: unexpected problem (n_in %d out %d ws %zu)\n", n_in, out_size, ws_size); grid = -1; return; }
        int dev = 0, cus = 0, per_cu = 0;
        if (hipGetDevice(&dev) != hipSuccess || hipDeviceGetAttribute(&cus, hipDeviceAttributeMultiprocessorCount, dev) != hipSuccess) { grid = -1; return; }
        if (hipFuncSetAttribute((const void*)hybrid_fwd, hipFuncAttributeMaxDynamicSharedMemorySize, LDS_BYTES) != hipSuccess) { fprintf(stderr, "kernel_launch: hipFuncSetAttribute failed\n"); grid = -1; return; }
        if (hipOccupancyMaxActiveBlocksPerMultiprocessor(&per_cu, (const void*)hybrid_fwd, NWAVES * 64, LDS_BYTES) != hipSuccess || per_cu < 1)
            fprintf(stderr, "kernel_launch: occupancy query reports %d workgroups per CU\n", per_cu);
        (void)hipGetLastError();
        grid = cus;
    }
    if (grid < 0) return;
    if (hipMemsetAsync((char*)d_ws + WS_CTL, 0, CTL_ZERO_BYTES, stream) != hipSuccess) { fprintf(stderr, "kernel_launch: memset failed\n"); return; }
    Args a{};
    for (int i = 0; i < 21; ++i) a.in[i] = d_in[i];
    a.out = (float*)d_out; a.ws = (unsigned char*)d_ws; a.sub = 7;
    for (int li = 0; li < N_LAUNCHES; ++li) {
        a.ph_lo = (N_LAUNCHES == 1) ? 0 : li; a.ph_hi = (N_LAUNCHES == 1) ? N_PHASES : li + 1;
        hipLaunchKernelGGL(hybrid_fwd, dim3(grid), dim3(NWAVES * 64), LDS_BYTES, stream, a);
        const hipError_t le = hipPeekAtLastError();
        if (le != hipSuccess) { fprintf(stderr, "kernel_launch: launch %d failed: %s\n", li, hipGetErrorName(le)); break; }
    }
#if defined(PROBE_LO)
    for (int r = 0; r < PROBE_REPS; ++r)
        for (int ph = PROBE_LO; ph < PROBE_HI; ++ph) { (void)hipMemsetAsync((char*)d_ws + WS_CTL + (size_t)CW_BAR * 4, 0, (size_t)(CW_SS1 - CW_BAR) * 4, stream); a.sub = PROBE_SUB; a.ph_lo = ph; a.ph_hi = ph + 1; hipLaunchKernelGGL(hybrid_fwd, dim3(grid), dim3(NWAVES * 64), LDS_BYTES, stream, a); }
#endif
}
```

```cpp
#include <hip/hip_runtime.h>
#include <hip/hip_bf16.h>
#include <cstdio>
#include <cstdint>

constexpr int DM = 1024;
constexpr int SEQ = 8192, NB = 2;
constexpr int MP = NB * SEQ;
constexpr int DB = 32, DT = 4;
constexpr int MS = DB * DT;
constexpr int MT = MP + MS;
constexpr int MTP = 16640;
constexpr int EVEN_IN = 4100, ODD_IN = 3088;
constexpr int NH = 4, HD = 128;
constexpr int PAST = 8192, PAGE = 128, NPAGES = PAST / PAGE;
constexpr float EPS = 1e-6f;
constexpr float ATT_SCALE = 0.08838834764831845f;
constexpr float LOG2E = 1.4426950408889634f;

constexpr size_t O_Y = 0;
constexpr size_t O_KP = (size_t)MT * DM;
constexpr size_t O_VP = O_KP + (size_t)MP * 512;
constexpr size_t O_LFP = O_VP + (size_t)MP * 512;
constexpr size_t O_HSP = O_LFP + (size_t)MP * 4;
constexpr size_t O_GSP = O_HSP + (size_t)NB * NH * 128 * 128;
constexpr size_t O_KS = O_GSP + (size_t)NB * NH * 128 * 256;
constexpr size_t O_VS = O_KS + (size_t)MS * 512;
constexpr size_t O_LFS = O_VS + (size_t)MS * 512;
constexpr size_t O_HSS = O_LFS + (size_t)MS * 4;
constexpr size_t O_GSS = O_HSS + (size_t)DB * NH * 128 * 128;
constexpr size_t O_END = O_GSS + (size_t)DB * NH * 128 * 256;
static_assert(O_END == 40567296, "output size");

constexpr size_t MiB = 1u << 20;
constexpr size_t WS_CTL = 0, CTL_ZERO_BYTES = 1 * MiB;
constexpr size_t WS_W1T = 2 * MiB;
constexpr size_t WS_W2T = 10 * MiB;
constexpr size_t WS_W3T = 12 * MiB;
constexpr size_t WS_W4T = 18 * MiB;
constexpr size_t WS_LB = 20 * MiB;
constexpr size_t WS_LFB = 20 * MiB + 65536;
constexpr size_t WS_CB = 21 * MiB;
constexpr size_t WS_SUFX = 22 * MiB;
constexpr size_t WS_PML = 26 * MiB;
constexpr size_t WS_PO = 26 * MiB + 65536;
constexpr size_t WS_BTOT = 28 * MiB;
constexpr size_t WS_WR = 29 * MiB;
constexpr size_t WS_XN = 32 * MiB;
constexpr size_t WS_QA = 66 * MiB;
constexpr size_t WS_IA = 84 * MiB;
constexpr size_t WS_GA = 102 * MiB;
constexpr size_t WS_GB = 120 * MiB;
constexpr size_t WS_GF = 138 * MiB;
constexpr size_t WS_QBH = 172 * MiB;
constexpr size_t WS_KBH = 188 * MiB;
constexpr size_t WS_VBH = 204 * MiB;
constexpr size_t WS_QS = 220 * MiB;
constexpr size_t WS_MIX = 224 * MiB;
constexpr size_t WS_X1 = 258 * MiB;
constexpr size_t WS_SLOC = 324 * MiB;
constexpr size_t WS_Q3 = 342 * MiB;
constexpr size_t WS_K3 = 360 * MiB;
constexpr size_t WS_V3 = 378 * MiB;
constexpr size_t WS_G3 = 412 * MiB;
constexpr size_t WS_GF3 = 446 * MiB;
constexpr size_t WS_SLOC3 = 480 * MiB;
constexpr size_t WS_MIX2 = 512 * MiB;
constexpr size_t WS_END = 546 * MiB;
constexpr int CW_TMO = 0;
constexpr int CW_BAR = 4096;
constexpr int CW_FLAG = 8192;
constexpr int CW_TAIL = 8192 + 64;
constexpr int CW_BAR2 = 12288;
constexpr int CW_SS1 = 16384;
constexpr int CW_SS2 = 40960;
static_assert((CW_SS2 + MT) * 4 <= (int)CTL_ZERO_BYTES, "CTL");

constexpr int RING_OFF = 0, RING_BYTES = 131072;
constexpr int LDSCTL_OFF = 146944, MISC_OFF = LDSCTL_OFF + 320;
constexpr int LDS_BYTES = 147456;
constexpr int NWAVES = 8;
namespace pg8 {
#define PG8_LAS __attribute__((address_space(3)))
typedef unsigned short bf16_t;
typedef short bf16x8 __attribute__((ext_vector_type(8)));
typedef float f32x4 __attribute__((ext_vector_type(4)));
typedef unsigned u32x4 __attribute__((ext_vector_type(4)));
constexpr int BM = 256, BK = 64, HALF = 128, HTB = HALF * BK * 2  , STAGE_BYTES = 8 * HTB, NXCD = 8, WGM = 8;

__host__ __device__ __forceinline__ int lds_byte(int r, int c) { const int st = (r >> 4) * 2 + (c >> 5), rr = r & 15, cc = c & 31, ob = rr * 64 + cc * 2; return st * 1024 + (ob ^ (((ob >> 9) & 1) << 5)); }
__host__ __device__ __forceinline__ void stage_rc(int b, int& R, int& C) { const int st = b / 1024, sb = b % 1024, swz = sb ^ (((sb >> 9) & 1) << 5); R = (st >> 1) * 16 + swz / 64; C = (st & 1) * 32 + (swz % 64) / 2; }
__host__ __device__ __forceinline__ int perm32(int rho) { const int n = rho >> 4, i = rho & 15; return 8 * (i >> 2) + 4 * n + (i & 3); }

struct Unit { int pm, pn; };
struct Gemm { const bf16_t* A; const bf16_t* Bt; int M, N, K; };

struct StaticOrder {
    int nM, nN, nwg, G, c;
    __host__ __device__ void init(int M, int N, int G_, int c_) { nM = M / BM; nN = N / BM; nwg = nM * nN; G = G_; c = c_; }
    __host__ __device__ bool next(int i, Unit& u) const {
        const long L = (long)i * G + c; if (L >= nwg) return false;
        int wgid = (int)L; { const int q = nwg / NXCD, r = nwg % NXCD, xcd = wgid % NXCD, off = wgid / NXCD; wgid = (xcd < r ? xcd * (q + 1) : r * (q + 1) + (xcd - r) * q) + off; }
        const int nig = WGM * nN, gid = wgid / nig, fm = gid * WGM, gsz = (nM - fm) < WGM ? (nM - fm) : WGM;
        u.pm = fm + ((wgid % nig) % gsz); u.pn = (wgid % nig) / gsz; return true;
    }
    __device__ __forceinline__ void a_ready(const Unit&) const {}
    __device__ __forceinline__ void done(const Unit&) const {}
};

__device__ __forceinline__ unsigned cvt_pk_bf16(float lo, float hi) { unsigned r; asm volatile("v_cvt_pk_bf16_f32 %0, %1, %2" : "=v"(r) : "v"(lo), "v"(hi)); return r; }
typedef float f32x2 __attribute__((ext_vector_type(2)));
template <class Epi, class Sched, bool ALIGN_EPI = false, bool SP2 = false>
__device__ __forceinline__ void gemm_phase(PG8_LAS unsigned char* lds, const Gemm g, const Sched& S, const Epi& E) {
    const int tid = threadIdx.x, wid = __builtin_amdgcn_readfirstlane(tid >> 6), lane = tid & 63, wr = wid >> 2, wc = wid & 3, fr = lane & 15, fq = lane >> 4;
    const int K = g.K, nt = K / BK;
    unsigned voffA[2], voffB[2];
#pragma unroll
    for (int i = 0; i < 2; ++i) { int R, C; stage_rc(tid * 16 + i * 8192, R, C); const int Rb = Epi::PERM ? ((R & ~31) + perm32(R & 31)) : R;
        voffA[i] = (unsigned)(R * K + C) * 2u; voffB[i] = (unsigned)(Rb * K + C) * 2u; }
    const size_t kstep = (size_t)(BK * 2);
    const size_t hstep = (size_t)HALF * K * 2;
    const size_t tstep = 2 * hstep;
    const unsigned ldsw = (unsigned)wid * 1024u;
    const int aoff = lds_byte(wr * 64 + fr, fq * 8), boff = lds_byte(wc * 32 + fr, fq * 8);
#define PG8_SA(b, h) (((b) * 2 + (h)) * HTB)
#define PG8_SB(b, h) ((4 + (b) * 2 + (h)) * HTB)
#define PG8_STAGE(bufoff, gbase, voff) do { _Pragma("unroll") for (int _i = 0; _i < 2; ++_i) \
        __builtin_amdgcn_global_load_lds((const unsigned*)((const char*)(gbase) + (voff)[_i]), (PG8_LAS unsigned*)(lds + (bufoff) + ldsw + _i * 8192), 16, 0, 0); } while (0)
#define PG8_LDA(dst, b, h) do { _Pragma("unroll") for (int m = 0; m < 4; ++m) _Pragma("unroll") for (int k = 0; k < 2; ++k) dst[m][k] = *(const PG8_LAS bf16x8*)(lds + PG8_SA(b, h) + aoff + m * 2048 + k * 1024); } while (0)
#define PG8_LDB(dst, b, h) do { _Pragma("unroll") for (int n = 0; n < 2; ++n) _Pragma("unroll") for (int k = 0; k < 2; ++k) dst[n][k] = *(const PG8_LAS bf16x8*)(lds + PG8_SB(b, h) + boff + n * 2048 + k * 1024); } while (0)
#define PG8_MMA(ai, bj, At, Bt) do { __builtin_amdgcn_s_setprio(1); _Pragma("unroll") for (int m = 0; m < 4; ++m) _Pragma("unroll") for (int n = 0; n < 2; ++n) _Pragma("unroll") for (int k = 0; k < 2; ++k) \
        acc[ai][bj][m][n] = __builtin_amdgcn_mfma_f32_16x16x32_bf16(Bt[n][k], At[m][k], acc[ai][bj][m][n], 0, 0, 0); __builtin_amdgcn_s_setprio(0); } while (0)
#define PG8_WAIT_V(n) asm volatile("s_waitcnt vmcnt(" #n ")" ::: "memory")
#define PG8_WAIT_L(n) asm volatile("s_waitcnt lgkmcnt(" #n ")" ::: "memory")
#define PG8_BAR __builtin_amdgcn_s_barrier()
#define PG8_SCHED __builtin_amdgcn_sched_barrier(0)
    Unit cur, nxt; int ui = 0;
    if (!S.next(0, cur)) return;
    f32x4 acc[2][2][4][2];
#pragma unroll
    for (int a = 0; a < 2; ++a)
#pragma unroll
        for (int b = 0; b < 2; ++b)
#pragma unroll
            for (int m = 0; m < 4; ++m)
#pragma unroll
                for (int n = 0; n < 2; ++n) acc[a][b][m][n] = (f32x4){0.f, 0.f, 0.f, 0.f};
    bf16x8 At[4][2], B0[2][2], B1[2][2];
    const char* cA = (const char*)g.A + (size_t)cur.pm * tstep; const char* cB = (const char*)g.Bt + (size_t)cur.pn * tstep;
    S.a_ready(cur);
    if constexpr (SP2) {
        PG8_STAGE(PG8_SB(0, 0), cB, voffB); PG8_STAGE(PG8_SB(0, 1), cB + hstep, voffB); PG8_STAGE(PG8_SA(0, 0), cA, voffA); PG8_STAGE(PG8_SA(0, 1), cA + hstep, voffA);
        if (wr == 1) PG8_BAR;
        PG8_WAIT_V(2); PG8_BAR;
        PG8_STAGE(PG8_SB(1, 0), cB + kstep, voffB); PG8_STAGE(PG8_SA(1, 0), cA + kstep, voffA); PG8_STAGE(PG8_SB(1, 1), cB + hstep + kstep, voffB);
        PG8_WAIT_V(6); PG8_BAR;
    } else {
        PG8_STAGE(PG8_SB(0, 0), cB, voffB); PG8_STAGE(PG8_SA(0, 0), cA, voffA); PG8_STAGE(PG8_SB(0, 1), cB + hstep, voffB); PG8_STAGE(PG8_SA(0, 1), cA + hstep, voffA);
        if (wr == 1) PG8_BAR;
        PG8_WAIT_V(4); PG8_BAR;
        PG8_STAGE(PG8_SB(1, 0), cB + kstep, voffB); PG8_STAGE(PG8_SA(1, 0), cA + kstep, voffA); PG8_STAGE(PG8_SB(1, 1), cB + hstep + kstep, voffB);
        PG8_WAIT_V(6); PG8_BAR;
    }
    for (;;) {
        const bool has_next = S.next(ui + 1, nxt);
        const char* nA = has_next ? (const char*)g.A + (size_t)nxt.pm * tstep : cA; const char* nB = has_next ? (const char*)g.Bt + (size_t)nxt.pn * tstep : cB;
        for (int t = 0; t < nt; t += 2) {
            const bool last = (t == nt - 2);
            const char* a1 = cA + (size_t)(t + 1) * kstep;
            const char* a2 = last ? nA : cA + (size_t)(t + 2) * kstep; const char* b2 = last ? nB : cB + (size_t)(t + 2) * kstep;
            const char* a3 = a2 + kstep; const char* b3 = b2 + kstep;
            if (last && has_next) S.a_ready(nxt);
            if constexpr (SP2) {
            PG8_LDB(B0, 0, 0); PG8_LDB(B1, 0, 1); PG8_SCHED; PG8_LDA(At, 0, 0); PG8_STAGE(PG8_SA(1, 1), a1 + hstep, voffA);
            PG8_WAIT_V(8); PG8_WAIT_L(0); PG8_BAR; PG8_MMA(0, 0, At, B0); PG8_MMA(0, 1, At, B1); PG8_BAR; PG8_SCHED;
            PG8_LDA(At, 0, 1); PG8_STAGE(PG8_SB(0, 0), b2, voffB); PG8_STAGE(PG8_SB(0, 1), b2 + hstep, voffB); PG8_STAGE(PG8_SA(0, 0), a2, voffA);
            PG8_WAIT_V(8); PG8_WAIT_L(0); PG8_BAR; PG8_MMA(1, 0, At, B0); PG8_MMA(1, 1, At, B1); PG8_BAR; PG8_SCHED;
            PG8_LDB(B0, 1, 0); PG8_LDB(B1, 1, 1); PG8_SCHED; PG8_LDA(At, 1, 0); PG8_STAGE(PG8_SA(0, 1), a2 + hstep, voffA);
            PG8_WAIT_V(8); PG8_WAIT_L(0); PG8_BAR; PG8_MMA(0, 0, At, B0); PG8_MMA(0, 1, At, B1); PG8_BAR; PG8_SCHED;
            PG8_LDA(At, 1, 1); PG8_STAGE(PG8_SB(1, 0), b3, voffB); PG8_STAGE(PG8_SB(1, 1), b3 + hstep, voffB); PG8_STAGE(PG8_SA(1, 0), a3, voffA);
            PG8_WAIT_V(8); PG8_WAIT_L(0); PG8_BAR; PG8_MMA(1, 0, At, B0); PG8_MMA(1, 1, At, B1); PG8_BAR; PG8_SCHED;
            } else {
            PG8_LDB(B0, 0, 0); PG8_SCHED; PG8_LDA(At, 0, 0); PG8_STAGE(PG8_SA(1, 1), a1 + hstep, voffA);
            PG8_WAIT_L(8); PG8_BAR; PG8_WAIT_L(0); PG8_MMA(0, 0, At, B0); PG8_BAR; PG8_SCHED;
            PG8_LDB(B1, 0, 1); PG8_STAGE(PG8_SB(0, 0), b2, voffB);
            PG8_BAR; PG8_WAIT_L(0); PG8_MMA(0, 1, At, B1); PG8_BAR;
            PG8_LDA(At, 0, 1); PG8_STAGE(PG8_SA(0, 0), a2, voffA);
            PG8_BAR; PG8_WAIT_L(0); PG8_MMA(1, 0, At, B0); PG8_BAR; PG8_SCHED;
            PG8_STAGE(PG8_SB(0, 1), b2 + hstep, voffB);
            PG8_WAIT_V(6); PG8_BAR; PG8_MMA(1, 1, At, B1); PG8_BAR;
            PG8_LDB(B0, 1, 0); PG8_SCHED; PG8_LDA(At, 1, 0); PG8_STAGE(PG8_SA(0, 1), a2 + hstep, voffA);
            PG8_WAIT_L(8); PG8_BAR; PG8_WAIT_L(0); PG8_MMA(0, 0, At, B0); PG8_BAR; PG8_SCHED;
            PG8_LDB(B1, 1, 1); PG8_STAGE(PG8_SB(1, 0), b3, voffB);
            PG8_BAR; PG8_WAIT_L(0); PG8_MMA(0, 1, At, B1); PG8_BAR;
            PG8_LDA(At, 1, 1); PG8_STAGE(PG8_SA(1, 0), a3, voffA);
            PG8_BAR; PG8_WAIT_L(0); PG8_MMA(1, 0, At, B0); PG8_BAR; PG8_SCHED;
            PG8_STAGE(PG8_SB(1, 1), b3 + hstep, voffB);
            PG8_WAIT_V(6); PG8_BAR; PG8_MMA(1, 1, At, B1); PG8_BAR;
            }
        }
        if constexpr (ALIGN_EPI) { if (wr == 0) PG8_BAR; }
        if constexpr (!Epi::AFTER_DRAIN) { E(acc, cur, wr, wc, fr, fq); S.done(cur); }
        if (!has_next) break;
#pragma unroll
        for (int a = 0; a < 2; ++a)
#pragma unroll
            for (int b = 0; b < 2; ++b)
#pragma unroll
                for (int m = 0; m < 4; ++m)
#pragma unroll
                    for (int n = 0; n < 2; ++n) acc[a][b][m][n] = (f32x4){0.f, 0.f, 0.f, 0.f};
        cur = nxt; cA = nA; cB = nB; ++ui;
        if constexpr (ALIGN_EPI) { if (wr == 1) PG8_BAR; }
    }
    PG8_WAIT_V(0);
    if constexpr (!ALIGN_EPI) { if (wr == 0) PG8_BAR; }
    PG8_BAR;
    if constexpr (Epi::AFTER_DRAIN) { E.fused(acc, cur, wr, wc, fr, fq, lds, wid, lane); S.done(cur); }
#undef PG8_SA
#undef PG8_SB
#undef PG8_STAGE
#undef PG8_LDA
#undef PG8_LDB
#undef PG8_MMA
#undef PG8_WAIT_V
#undef PG8_WAIT_L
#undef PG8_BAR
#undef PG8_SCHED
}
}
#define GAS __attribute__((address_space(1)))
#define LAS __attribute__((address_space(3)))
typedef unsigned short bf16;
typedef unsigned v4u __attribute__((ext_vector_type(4)));
typedef float f32x4 __attribute__((ext_vector_type(4)));
typedef short bf16x8 __attribute__((ext_vector_type(8)));
typedef GAS unsigned gu32;
typedef GAS unsigned long long gu64;
#define RLX_AGENT __ATOMIC_RELAXED, __HIP_MEMORY_SCOPE_AGENT
#define LDS_WAIT() asm volatile("s_waitcnt lgkmcnt(0)" ::: "memory")
#define VM_WAIT() asm volatile("s_waitcnt vmcnt(0)" ::: "memory")
__device__ __forceinline__ unsigned long long rt() { return __builtin_amdgcn_s_memrealtime(); }
__device__ __forceinline__ unsigned f2bf(float f) { unsigned u = __builtin_bit_cast(unsigned, f); return (u + 0x7fffu + ((u >> 16) & 1u)) >> 16; }
__device__ __forceinline__ unsigned pk2(float lo, float hi) { return f2bf(lo) | (f2bf(hi) << 16); }

#define XB_TMO      128
#define XB_XCNT(j)  (256  + 64 * (j))
#define XB_XSUB(j)  (1280 + 64 * (j))
#define XB_XGEN(j)  (2304 + 64 * (j))
#define XB_TOP      3328
#define XB_TOPGEN   3392
#define XCD_BAR_WORDS 3456
#define XB_SPIN_CAP (1u << 18)

__device__ __forceinline__ unsigned xb_ld(unsigned* p)              { return __hip_atomic_load(p, __ATOMIC_RELAXED, __HIP_MEMORY_SCOPE_AGENT); }
__device__ __forceinline__ unsigned xb_add(unsigned* p, unsigned v) { return __hip_atomic_fetch_add(p, v, __ATOMIC_RELAXED, __HIP_MEMORY_SCOPE_AGENT); }
__device__ __forceinline__ unsigned xb_xcc_id() { return (unsigned)__builtin_amdgcn_s_getreg((3 << 11) | 20) & 0xFu; }
#define XB_SPIN(cond, bar) do { unsigned _sp = 0; while (cond) { __builtin_amdgcn_s_sleep(1); \
    if ((++_sp & 255u) == 0u) { if (xb_ld(&(bar)[XB_TMO])) break; if (_sp > XB_SPIN_CAP) { atomicAdd(&(bar)[XB_TMO], 1u); break; } } } } while (0)

struct XcdBarrier {
    unsigned* bar; unsigned x;
    volatile LAS unsigned* st;
    unsigned total;
};

__device__ __forceinline__ XcdBarrier xcd_barrier_post(unsigned* bar, volatile LAS unsigned* st) {
    XcdBarrier b; b.bar = bar; b.x = xb_xcc_id(); b.st = st; b.total = 0u;
    if (threadIdx.x == 0) (void)xb_add(&bar[XB_XCNT(b.x)], 1u);
    return b;
}
__device__ __forceinline__ void xcd_barrier_complete(unsigned* bar, unsigned x, unsigned& nloc, unsigned& nx, unsigned total) {
    const unsigned G = total ? total : gridDim.x * gridDim.y * gridDim.z;
    unsigned sum, cnt, mine, sp = 0u;
    for (;;) {
        sum = 0u; cnt = 0u; mine = 0u;
#pragma unroll
        for (unsigned j = 0; j < 16; ++j) { const unsigned c = xb_ld(&bar[XB_XCNT(j)]); sum += c; cnt += (c > 0u) ? 1u : 0u; mine = (j == x) ? c : mine; }
        if (sum == G) break;
        __builtin_amdgcn_s_sleep(1);
        if ((++sp & 255u) == 0u) { if (xb_ld(&bar[XB_TMO])) break; if (sp > XB_SPIN_CAP) { atomicAdd(&bar[XB_TMO], 1u); break; } }
    }
    nloc = mine > 0u ? mine : 1u; nx = cnt > 0u ? cnt : 1u;
}

__device__ __forceinline__ void xcd_barrier(const XcdBarrier& b) {
    asm volatile("s_waitcnt vmcnt(0)" ::: "memory");
    __syncthreads();
    if (threadIdx.x == 0) {
        unsigned* bar = b.bar;
        __builtin_amdgcn_s_waitcnt(0);
        unsigned nloc = b.st[0], nx = b.st[1];
        if (nloc == 0u) { xcd_barrier_complete(bar, b.x, nloc, nx, b.total); b.st[0] = nloc; b.st[1] = nx; }
        const unsigned old = xb_add(&bar[XB_XSUB(b.x)], 1u);
        const unsigned gen = old / nloc;
        if (old + 1u == (gen + 1u) * nloc) {
            __builtin_amdgcn_fence(__ATOMIC_RELEASE, "agent");
            asm volatile("s_waitcnt vmcnt(0)" ::: "memory");
            const unsigned og = xb_add(&bar[XB_TOP], 1u);
            const unsigned tg = og / nx;
            if (og + 1u == (tg + 1u) * nx) xb_add(&bar[XB_TOPGEN], 1u);
            else XB_SPIN(xb_ld(&bar[XB_TOPGEN]) == tg, bar);
            __builtin_amdgcn_fence(__ATOMIC_ACQUIRE, "agent");
            xb_add(&bar[XB_XGEN(b.x)], 1u);
            asm volatile("s_waitcnt vmcnt(0)" ::: "memory");
        } else {
            XB_SPIN(xb_ld(&bar[XB_XGEN(b.x)]) == gen, bar);
            __builtin_amdgcn_fence(__ATOMIC_ACQUIRE, "agent");
            asm volatile("s_waitcnt vmcnt(0)" ::: "memory");
        }
    }
    __syncthreads();
}

typedef unsigned u32x2v __attribute__((ext_vector_type(2)));
struct Frame {
    LAS unsigned char* lds;
    volatile LAS unsigned* MISC;
    gu32* ctl;
    int tid, lane, wave;
    int G;
    unsigned char* ws;
    float* out;
    const float *xp, *xs, *ck, *cv, *clf, *sh, *sg; const int* pt;
    const float *norm_even, *w_in_even, *b_fox, *lb_logits, *hgrn_gain, *w_out_even, *norm_odd, *w_in_odd, *w_gla_gate, *b_gla_gate, *gla_gain, *w_out_odd, *final_norm;
};
#define WSP(T, off) ((T*)(F.ws + (off)))

template <int CTRL> __device__ __forceinline__ float dppf(float x) { return __builtin_bit_cast(float, __builtin_amdgcn_mov_dpp(__builtin_bit_cast(int, x), CTRL, 0xf, 0xf, true)); }
__device__ __forceinline__ float row16_sum(float v) { v += dppf<0xB1>(v); v += dppf<0x4E>(v); v += dppf<0x141>(v); v += dppf<0x140>(v); return v; }
__device__ __forceinline__ float wave_sum(float v) {
    v = row16_sum(v);
    auto s = __builtin_amdgcn_permlane16_swap(__float_as_uint(v), __float_as_uint(v), false, false); v = __uint_as_float(s[0]) + __uint_as_float(s[1]);
    auto t = __builtin_amdgcn_permlane32_swap(__float_as_uint(v), __float_as_uint(v), false, false); return __uint_as_float(t[0]) + __uint_as_float(t[1]);
}
__device__ __forceinline__ float fast_exp(float x) { return __builtin_amdgcn_exp2f(x * LOG2E); }
__device__ __forceinline__ float sigmoidf_(float x) { return __builtin_amdgcn_rcpf(1.0f + fast_exp(-x)); }
__device__ __forceinline__ float siluf_(float x) { return x * sigmoidf_(x); }
__device__ __forceinline__ float log_sigmoidf_(float x) {
    const float e = __builtin_amdgcn_exp2f(-fabsf(x) * LOG2E);
    return fminf(x, 0.f) - __builtin_amdgcn_logf(1.0f + e) * 0.6931471805599453f;
}
typedef float f32x2_t __attribute__((ext_vector_type(2)));
typedef __bf16 bf16x2_t __attribute__((ext_vector_type(2)));
__device__ __forceinline__ unsigned cvtpk_s(float lo, float hi) { f32x2_t v = {lo, hi}; bf16x2_t b = __builtin_convertvector(v, bf16x2_t); return __builtin_bit_cast(unsigned, b); }
__device__ __forceinline__ bf16x8 pack8f(f32x4 a, f32x4 b) { v4u w = {cvtpk_s(a[0], a[1]), cvtpk_s(a[2], a[3]), cvtpk_s(b[0], b[1]), cvtpk_s(b[2], b[3])}; return __builtin_bit_cast(bf16x8, w); }
__device__ __forceinline__ float bf2f(unsigned short b) { return __builtin_bit_cast(float, (unsigned)b << 16); }
__device__ __forceinline__ void st_bf4(bf16* p, f32x4 v) { u32x2v w; w.x = cvtpk_s(v[0], v[1]); w.y = cvtpk_s(v[2], v[3]); *(GAS u32x2v*)p = w; }
__device__ __forceinline__ void st_bf8(bf16* p, f32x4 a, f32x4 b) { v4u w = {cvtpk_s(a[0], a[1]), cvtpk_s(a[2], a[3]), cvtpk_s(b[0], b[1]), cvtpk_s(b[2], b[3])}; *(GAS v4u*)p = w; }

__device__ __forceinline__ void p0_transpose_item(const float* W, int K, int ld, int N, bf16* WT, LAS float* scr, int item, int lane, const float* gain) {
    const int nblk = N / 32, kb = item / nblk, nb = item % nblk, k0 = 64 * kb, n0 = 32 * nb;
    float wv[32];
#pragma unroll
    for (int i = 0; i < 32; ++i) { const int kk = 2 * i + (lane >> 5); wv[i] = W[(size_t)(k0 + kk) * ld + n0 + (lane & 31)]; }
#pragma unroll
    for (int i = 0; i < 32; ++i) { const int kk = 2 * i + (lane >> 5); float w = wv[i]; if (gain) w *= gain[k0 + kk]; scr[kk * 33 + (lane & 31)] = w; }
    LDS_WAIT(); asm volatile("" ::: "memory");
    const int c = lane & 7;
#pragma unroll
    for (int j = 0; j < 4; ++j) { const int n = (lane >> 3) + 8 * j; const LAS float* s = scr + (8 * c) * 33 + n;
        v4u o; o.x = pk2(s[0 * 33], s[1 * 33]); o.y = pk2(s[2 * 33], s[3 * 33]); o.z = pk2(s[4 * 33], s[5 * 33]); o.w = pk2(s[6 * 33], s[7 * 33]);
        *(GAS v4u*)(WT + (size_t)(n0 + n) * K + k0 + 8 * c) = o; }
    LDS_WAIT(); asm volatile("" ::: "memory");
}

__device__ __forceinline__ float block_excl_scan(float v, LAS float* scr, int lane, int wave, float* total) {
    float inc = v;
#pragma unroll
    for (int o = 1; o < 64; o <<= 1) { const float t = __shfl_up(inc, o); if (lane >= o) inc += t; }
    if (lane == 63) scr[wave] = inc;
    __syncthreads();
    float pre = 0.f, tot = 0.f;
#pragma unroll
    for (int w = 0; w < 8; ++w) { const float t = scr[w]; if (w < wave) pre += t; tot += t; }
    __syncthreads();
    *total = tot;
    return pre + inc - v;
}

__device__ __forceinline__ void p0_prologue(Frame& F, int sub) {
    LAS float* scr = (LAS float*)(F.lds + RING_OFF + F.wave * 16384);
    const int gw = (int)blockIdx.x * NWAVES + F.wave, NGW = F.G * NWAVES;
    constexpr int I1 = 16 * (4096 / 32);
    if (sub & 1) for (int it = gw; it < I1; it += NGW) p0_transpose_item(F.w_in_even, DM, EVEN_IN, 4096, WSP(bf16, WS_W1T), scr, it, F.lane, nullptr);
    if (blockIdx.x == 0) { float* LB = WSP(float, WS_LB); const int c = F.tid; LB[c] = 1.0f / (1.0f + __expf(F.lb_logits[512 + c] - F.lb_logits[c])); }
    { bf16* WRB = WSP(bf16, WS_WR); bf16* WGB = WSP(bf16, WS_WR + 65536); const int gt = (int)blockIdx.x * 512 + F.tid;
      for (int e = gt; e < 16 * 1024; e += F.G * 512) { const int j = e >> 10, k = e & 1023; WRB[e] = (bf16)(cvtpk_s(F.w_in_odd[(size_t)k * ODD_IN + 3072 + j] * F.norm_odd[k], 0.f) & 0xffffu); }
      for (int e = gt; e < 512 * 16; e += F.G * 512) { const int c = e >> 4, j = e & 15; WGB[e] = (bf16)(cvtpk_s(F.w_gla_gate[j * 512 + c], 0.f) & 0xffffu); } }
    __syncthreads();
    if ((sub & 2) && blockIdx.x < DB) {
        const int b = blockIdx.x; float* SUFX = WSP(float, WS_SUFX);
        LAS float* sscr = (LAS float*)(F.lds + RING_OFF);
        const int i = F.tid; f32x4 v[16];
#pragma unroll
        for (int j = 0; j < 16; ++j) { const int s = 8191 - (16 * i + j); const int pg = F.pt[b * NPAGES + (s >> 7)]; v[j] = *(const GAS f32x4*)(F.clf + ((size_t)pg * PAGE + (s & 127)) * 4); }
        f32x4 run = {0.f, 0.f, 0.f, 0.f};
#pragma unroll
        for (int j = 0; j < 16; ++j) { const f32x4 t = v[j]; v[j] = run; run += t; }
        f32x4 pre;
        {
            f32x4 inc = run;
#pragma unroll
            for (int o = 1; o < 64; o <<= 1) { f32x4 t; t.x = __shfl_up(inc.x, o); t.y = __shfl_up(inc.y, o); t.z = __shfl_up(inc.z, o); t.w = __shfl_up(inc.w, o); if (F.lane >= o) inc += t; }
            if (F.lane == 63) *(LAS f32x4*)(sscr + 4 * F.wave) = inc;
            __syncthreads();
            f32x4 p = {0.f, 0.f, 0.f, 0.f};
#pragma unroll
            for (int w = 0; w < 8; ++w) { const f32x4 t = *(const LAS f32x4*)(sscr + 4 * w); if (w < F.wave) p += t; }
            pre = p + inc - run; }
        const int sb = 8191 - (16 * i + 15);
#pragma unroll
        for (int q = 0; q < 4; ++q) {
            const f32x4 o3 = (v[15 - 4 * q] + pre) * LOG2E, o2 = (v[14 - 4 * q] + pre) * LOG2E, o1 = (v[13 - 4 * q] + pre) * LOG2E, o0 = (v[12 - 4 * q] + pre) * LOG2E;
            *(GAS f32x4*)(SUFX + (size_t)(b * 4 + 0) * PAST + sb + 4 * q) = (f32x4){o3.x, o2.x, o1.x, o0.x};
            *(GAS f32x4*)(SUFX + (size_t)(b * 4 + 1) * PAST + sb + 4 * q) = (f32x4){o3.y, o2.y, o1.y, o0.y};
            *(GAS f32x4*)(SUFX + (size_t)(b * 4 + 2) * PAST + sb + 4 * q) = (f32x4){o3.z, o2.z, o1.z, o0.z};
            *(GAS f32x4*)(SUFX + (size_t)(b * 4 + 3) * PAST + sb + 4 * q) = (f32x4){o3.w, o2.w, o1.w, o0.w}; }
    }
    LAS float* wfb = (LAS float*)(F.lds + RING_OFF);
    __syncthreads();
    for (int k = F.tid; k < 1024; k += 512) *(LAS f32x4*)(wfb + 4 * k) = *(const GAS f32x4*)(F.w_in_even + (size_t)k * EVEN_IN + 4096);
    __syncthreads();
    bf16* XN = WSP(bf16, WS_XN); float* LFB = WSP(float, WS_LFB);
    const float bfl = F.b_fox[F.lane & 3];
    f32x4 gn[4];
#pragma unroll
    for (int j = 0; j < 4; ++j) gn[j] = *(const GAS f32x4*)(F.norm_even + 4 * F.lane + 256 * j);
    constexpr int NSW = DB * NWAVES, RSPLIT = MT - 5 * NSW;
    int m0r = gw, mstep = NGW, mend = MT;
    if (NGW > NSW) { if (gw < NSW) { m0r = RSPLIT + gw; mstep = NSW; mend = MT; } else { m0r = gw - NSW; mstep = NGW - NSW; mend = RSPLIT; } }
    f32x4 vn[4];
    if (m0r < mend) { const float* xrow = m0r < MP ? F.xp + (size_t)m0r * DM : F.xs + (size_t)(m0r - MP) * DM; const GAS f32x4* xr = (const GAS f32x4*)xrow + F.lane;
#pragma unroll
        for (int j = 0; j < 4; ++j) vn[j] = __builtin_nontemporal_load(xr + 64 * j); }
    if (sub & 4) for (int m = m0r; m < mend; m += mstep) {
        f32x4 v[4]; float s = 0.f;
#pragma unroll
        for (int j = 0; j < 4; ++j) v[j] = vn[j];
        { const int mn = (m + mstep < mend) ? m + mstep : m; const float* xrow = mn < MP ? F.xp + (size_t)mn * DM : F.xs + (size_t)(mn - MP) * DM; const GAS f32x4* xr = (const GAS f32x4*)xrow + F.lane;
#pragma unroll
            for (int j = 0; j < 4; ++j) vn[j] = __builtin_nontemporal_load(xr + 64 * j); }
#pragma unroll
        for (int j = 0; j < 4; ++j) s += (v[j].x * v[j].x + v[j].y * v[j].y) + (v[j].z * v[j].z + v[j].w * v[j].w);
        const float rstd = 1.0f / sqrtf(wave_sum(s) * (1.f / DM) + EPS);
        f32x4 d = {0.f, 0.f, 0.f, 0.f};
        GAS unsigned long long* o8 = (GAS unsigned long long*)(XN + (size_t)m * DM) + F.lane;
#pragma unroll
        for (int j = 0; j < 4; ++j) { const int c0 = 4 * F.lane + 256 * j;
            const f32x4 h = v[j] * rstd * gn[j];
            o8[64 * j] = (unsigned long long)cvtpk_s(h.x, h.y) | ((unsigned long long)cvtpk_s(h.z, h.w) << 32);
            d += h.x * *(LAS f32x4*)(wfb + 4 * c0) + h.y * *(LAS f32x4*)(wfb + 4 * c0 + 4) + h.z * *(LAS f32x4*)(wfb + 4 * c0 + 8) + h.w * *(LAS f32x4*)(wfb + 4 * c0 + 12); }
        d.x = wave_sum(d.x); d.y = wave_sum(d.y); d.z = wave_sum(d.z); d.w = wave_sum(d.w);
        if (F.lane < 4) { const float dj = F.lane == 0 ? d.x : F.lane == 1 ? d.y : F.lane == 2 ? d.z : d.w; const float lf = log_sigmoidf_(dj + bfl);
            LFB[(size_t)m * 4 + F.lane] = lf;
            float* o = m < MP ? F.out + O_LFP + (size_t)m * 4 : F.out + O_LFS + (size_t)(m - MP) * 4; o[F.lane] = lf; }
    }
    __syncthreads();
}

__device__ __forceinline__ void late_weights(Frame& F, int gwi, int nw) {
    LAS float* scr = (LAS float*)(F.lds + RING_OFF + F.wave * 16384);
    constexpr int I2 = 16 * (1024 / 32), I3 = 16 * (3072 / 32), I4 = I2;
    for (int it = gwi; it < I2 + I3 + I4 && it < nw; it += NWAVES) {
        int r = it;
        if (r < I2) { p0_transpose_item(F.w_out_even, DM, DM, 1024, WSP(bf16, WS_W2T), scr, r, F.lane, nullptr); continue; } r -= I2;
        if (r < I3) { p0_transpose_item(F.w_in_odd, DM, ODD_IN, 3072, WSP(bf16, WS_W3T), scr, r, F.lane, F.norm_odd); continue; } r -= I3;
        p0_transpose_item(F.w_out_odd, DM, DM, 1024, WSP(bf16, WS_W4T), scr, r, F.lane, nullptr);
    }
}
__device__ __forceinline__ void fox_cumsum_unit(Frame& F, int b) {
    const float* LFB = WSP(float, WS_LFB); float* CB = WSP(float, WS_CB);
    LAS float* sscr = (LAS float*)(F.lds + RING_OFF);
    f32x4 v[16]; f32x4 run = {0.f, 0.f, 0.f, 0.f};
#pragma unroll
    for (int j = 0; j < 16; ++j) v[j] = *(const GAS f32x4*)(LFB + (size_t)(b * SEQ + 16 * F.tid + j) * 4);
#pragma unroll
    for (int j = 0; j < 16; ++j) { run += v[j]; v[j] = run; }
    f32x4 pre;
    {   f32x4 inc = run;
#pragma unroll
        for (int o = 1; o < 64; o <<= 1) { f32x4 t; t.x = __shfl_up(inc.x, o); t.y = __shfl_up(inc.y, o); t.z = __shfl_up(inc.z, o); t.w = __shfl_up(inc.w, o); if (F.lane >= o) inc += t; }
        if (F.lane == 63) *(LAS f32x4*)(sscr + 4 * F.wave) = inc;
        __syncthreads();
        f32x4 p = {0.f, 0.f, 0.f, 0.f};
#pragma unroll
        for (int w = 0; w < 8; ++w) { const f32x4 t = *(const LAS f32x4*)(sscr + 4 * w); if (w < F.wave) p += t; }
        pre = p + inc - run;
        __syncthreads(); }
    const float ns = -1.0f / ATT_SCALE;
#pragma unroll
    for (int q = 0; q < 4; ++q) { const f32x4 o0 = (v[4 * q] + pre) * ns, o1 = (v[4 * q + 1] + pre) * ns, o2 = (v[4 * q + 2] + pre) * ns, o3 = (v[4 * q + 3] + pre) * ns;
        const size_t off = (size_t)16 * F.tid + 4 * q;
        *(GAS f32x4*)(CB + (size_t)(b * 4 + 0) * SEQ + off) = (f32x4){o0.x, o1.x, o2.x, o3.x};
        *(GAS f32x4*)(CB + (size_t)(b * 4 + 1) * SEQ + off) = (f32x4){o0.y, o1.y, o2.y, o3.y};
        *(GAS f32x4*)(CB + (size_t)(b * 4 + 2) * SEQ + off) = (f32x4){o0.z, o1.z, o2.z, o3.z};
        *(GAS f32x4*)(CB + (size_t)(b * 4 + 3) * SEQ + off) = (f32x4){o0.w, o1.w, o2.w, o3.w}; }
}

struct P1 { bf16 *QA, *IA, *GA, *GB, *QBH, *KBH, *VBH, *GF; float *QS; const float* LB; float* out; };
__device__ __forceinline__ void epi1_4(const P1& p, int m, int c, f32x4 v) {
    const int sec = c >> 9, cs = c & 511;
    const size_t rc = (size_t)m * 512 + cs;
    switch (sec) {
    case 0: st_bf4(p.QA + rc, v); break;
    case 1: { const f32x4 lb = *(const GAS f32x4*)(p.LB + cs); f32x4 g;
#pragma unroll
        for (int i = 0; i < 4; ++i) { const float f = lb[i] + (1.0f - lb[i]) * sigmoidf_(v[i]); g[i] = __logf(f); }
        st_bf4(p.GF + rc, g); } break;
    case 2: st_bf4(p.IA + rc, v); break;
    case 3: { f32x4 g; for (int i = 0; i < 4; ++i) g[i] = siluf_(v[i]); st_bf4(p.GA + rc, g); } break;
    case 4: if (m < MP) { const int b = m >> 13, s = m & 8191, h = cs >> 7, d = cs & 127; st_bf4(p.QBH + ((size_t)((b * 4 + h) * SEQ + s) * HD + d), v); }
            else *(GAS f32x4*)(p.QS + (size_t)(m - MP) * 512 + cs) = v;
            break;
    case 5: if (m < MP) { const int b = m >> 13, s = m & 8191, h = cs >> 7, d = cs & 127; st_bf4(p.KBH + ((size_t)((b * 4 + h) * SEQ + s) * HD + d), v); *(GAS f32x4*)(p.out + O_KP + rc) = v; }
            else *(GAS f32x4*)(p.out + O_KS + (size_t)(m - MP) * 512 + cs) = v;
            break;
    case 6: if (m < MP) { const int b = m >> 13, s = m & 8191, h = cs >> 7, d = cs & 127; st_bf4(p.VBH + ((size_t)((b * 4 + h) * SEQ + s) * HD + d), v); *(GAS f32x4*)(p.out + O_VP + rc) = v; }
            else *(GAS f32x4*)(p.out + O_VS + (size_t)(m - MP) * 512 + cs) = v;
            break;
    default: { f32x4 g; for (int i = 0; i < 4; ++i) g[i] = siluf_(v[i]); st_bf4(p.GB + rc, g); } break;
    }
}
struct P2 { const float *xp, *xs; bf16* X1B; float* SS; };
__device__ __forceinline__ float epi2_4(const P2& p, int m, int c, f32x4 v) {
    const float* xr = m < MP ? p.xp + (size_t)m * DM : p.xs + (size_t)(m - MP) * DM;
    const f32x4 o = *(const GAS f32x4*)(xr + c) + v;
    st_bf4(p.X1B + (size_t)m * DM + c, o);
    return (o.x * o.x + o.y * o.y) + (o.z * o.z + o.w * o.w);
}
struct P3 { bf16 *Q3, *K3, *V3, *G3; const float* SS; };
__device__ __forceinline__ void epi3_4(const P3& p, int m, int c, f32x4 v, float rstd) {
    v = v * rstd;
    if (c < 512) { st_bf4(p.Q3 + (size_t)m * 512 + c, v * ATT_SCALE); }
    else if (c < 1024) { st_bf4(p.K3 + (size_t)m * 512 + (c - 512), v); }
    else if (c < 2048) { st_bf4(p.V3 + (size_t)m * 1024 + (c - 1024), v); }
    else { f32x4 g; for (int i = 0; i < 4; ++i) g[i] = siluf_(v[i]); st_bf4(p.G3 + (size_t)m * 1024 + (c - 2048), g); }
}
struct P4 { const bf16* X1B; float* Y; float* SS; };
__device__ __forceinline__ float epi4_4(const P4& p, int m, int c, f32x4 v) {
    const u32x2v xb = *(const GAS u32x2v*)(p.X1B + (size_t)m * DM + c);
    const f32x4 o = (f32x4){__uint_as_float(xb.x << 16), __uint_as_float(xb.x & 0xffff0000u), __uint_as_float(xb.y << 16), __uint_as_float(xb.y & 0xffff0000u)} + v;
    *(GAS f32x4*)(p.Y + (size_t)m * DM + c) = o;
    return (o.x * o.x + o.y * o.y) + (o.z * o.z + o.w * o.w);
}

__device__ __forceinline__ f32x4 silu4(f32x4 v) { f32x4 g; g.x = siluf_(v.x); g.y = siluf_(v.y); g.z = siluf_(v.z); g.w = siluf_(v.w); return g; }
struct Epi1 { static constexpr bool PERM = true, AFTER_DRAIN = false; P1 p; int skip;
    __device__ __forceinline__ void operator()(const pg8::f32x4 (&acc)[2][2][4][2], const pg8::Unit& u, int wr, int wc, int fr, int fq) const {
        if (skip == 1) { asm volatile("" :: "v"(acc[0][0][0][0][0]), "v"(acc[1][1][3][1][3])); return; }
        if (skip == 2) {
            const int lane_ = threadIdx.x & 63, wv_ = threadIdx.x >> 6; const int sec_ = u.pn >> 1;
            bf16* sb = p.QA + ((size_t)((u.pm * 16 + u.pn) & 255) * 8 + wv_) * 65536;
            int n_ = 0;
#pragma unroll
            for (int ai = 0; ai < 2; ++ai)
#pragma unroll
                for (int m = 0; m < 4; ++m)
#pragma unroll
                    for (int bj = 0; bj < 2; ++bj) { st_bf8(sb + (size_t)n_ * 512 + lane_ * 8, acc[ai][bj][m][0], acc[ai][bj][m][1]); ++n_;
                        if (sec_ == 5 || sec_ == 6 || sec_ == 1) { float* fp = (float*)(sb + 16384) + (size_t)(2 * n_) * 256 + lane_ * 4; *(GAS f32x4*)fp = acc[ai][bj][m][0]; *(GAS f32x4*)(fp + 256) = acc[ai][bj][m][1]; } }
            return; }
        const int sec = u.pn >> 1, row0 = u.pm * 256 + wr * 64 + fr, cs0 = (u.pn & 1) * 256 + wc * 32 + 8 * fq;
#define EPI1_LOOP(...) _Pragma("unroll") for (int ai = 0; ai < 2; ++ai) _Pragma("unroll") for (int m = 0; m < 4; ++m) { const int row = row0 + ai * 128 + m * 16; \
            _Pragma("unroll") for (int bj = 0; bj < 2; ++bj) { const int cs = cs0 + bj * 128; const f32x4 v0 = acc[ai][bj][m][0], v1 = acc[ai][bj][m][1]; __VA_ARGS__ } }
        if (sec == 0) { EPI1_LOOP( st_bf8(p.QA + (size_t)row * 512 + cs, v0, v1); ) }
        else if (sec == 2) { EPI1_LOOP( st_bf8(p.IA + (size_t)row * 512 + cs, v0, v1); ) }
        else if (sec == 3) { EPI1_LOOP( st_bf8(p.GA + (size_t)row * 512 + cs, silu4(v0), silu4(v1)); ) }
        else if (sec == 7) { EPI1_LOOP( st_bf8(p.GB + (size_t)row * 512 + cs, silu4(v0), silu4(v1)); ) }
        else if (sec == 1) {
            f32x4 lb[2][2];
#pragma unroll
            for (int bj = 0; bj < 2; ++bj) { lb[bj][0] = *(const GAS f32x4*)(p.LB + cs0 + bj * 128); lb[bj][1] = *(const GAS f32x4*)(p.LB + cs0 + bj * 128 + 4); }
            EPI1_LOOP( f32x4 g0, g1;
                _Pragma("unroll") for (int i = 0; i < 4; ++i) { g0[i] = __logf(lb[bj][0][i] + (1.0f - lb[bj][0][i]) * sigmoidf_(v0[i])); g1[i] = __logf(lb[bj][1][i] + (1.0f - lb[bj][1][i]) * sigmoidf_(v1[i])); }
                st_bf8(p.GF + (size_t)row * 512 + cs, g0, g1); )
        } else {
            bf16* hb = sec == 4 ? p.QBH : sec == 5 ? p.KBH : p.VBH;
            float* fo = sec == 5 ? p.out + O_KP : p.out + O_VP;
            const int hbase = (u.pn & 1) * 2, d = wc * 32 + 8 * fq;
            EPI1_LOOP( const int b = row >> 13, s = row & 8191;
                st_bf8(hb + ((size_t)((b * 4 + hbase + bj) * SEQ + s) * HD + d), v0, v1);
                if (sec != 4) { float* op = fo + (size_t)row * 512 + cs; __builtin_nontemporal_store(v0, (GAS f32x4*)op); __builtin_nontemporal_store(v1, (GAS f32x4*)(op + 4)); } )
        }
#undef EPI1_LOOP
    } };
struct Epi2 { static constexpr bool PERM = true, AFTER_DRAIN = false; P2 p;
    __device__ __forceinline__ void operator()(const pg8::f32x4 (&acc)[2][2][4][2], const pg8::Unit& u, int wr, int wc, int fr, int fq) const {
        const int row0 = u.pm * 256 + wr * 64 + fr, c0 = u.pn * 256 + wc * 32 + 8 * fq;
#pragma unroll
        for (int ai = 0; ai < 2; ++ai)
#pragma unroll
            for (int m = 0; m < 4; ++m) { const int row = row0 + ai * 128 + m * 16; float ss = 0.f;
#pragma unroll
                for (int bj = 0; bj < 2; ++bj) { const size_t off = (size_t)row * DM + c0 + bj * 128;
                    const f32x4 o0 = *(const GAS f32x4*)(p.xp + off) + acc[ai][bj][m][0], o1 = *(const GAS f32x4*)(p.xp + off + 4) + acc[ai][bj][m][1];
                    st_bf8(p.X1B + off, o0, o1);
                    ss += ((o0.x * o0.x + o0.y * o0.y) + (o0.z * o0.z + o0.w * o0.w)) + ((o1.x * o1.x + o1.y * o1.y) + (o1.z * o1.z + o1.w * o1.w)); }
                ss += __shfl_xor(ss, 16); ss += __shfl_xor(ss, 32);
                if (fq == 0) atomicAdd(p.SS + row, ss); }
    } };
struct Epi3 { static constexpr bool PERM = true, AFTER_DRAIN = false; P3 p; int skip;
    __device__ __forceinline__ void operator()(const pg8::f32x4 (&acc)[2][2][4][2], const pg8::Unit& u, int wr, int wc, int fr, int fq) const {
        if (skip) { asm volatile("" :: "v"(acc[0][0][0][0][0]), "v"(acc[1][1][3][1][3])); return; }
        const int row0 = u.pm * 256 + wr * 64 + fr, cl = (u.pn * 256 + wc * 32 + 8 * fq);
        const int kind = u.pn < 2 ? 0 : u.pn < 4 ? 1 : u.pn < 8 ? 2 : 3;
        bf16* dst = kind == 0 ? p.Q3 : kind == 1 ? p.K3 : kind == 2 ? p.V3 : p.G3;
        const int ld = kind < 2 ? 512 : 1024, cb = kind == 0 ? cl : kind == 1 ? cl - 512 : kind == 2 ? cl - 1024 : cl - 2048;
#pragma unroll
        for (int ai = 0; ai < 2; ++ai)
#pragma unroll
            for (int m = 0; m < 4; ++m) { const int row = row0 + ai * 128 + m * 16;
                float rstd = 1.0f / sqrtf(__hip_atomic_load(p.SS + row, __ATOMIC_RELAXED, __HIP_MEMORY_SCOPE_AGENT) * (1.f / DM) + EPS);
                if (kind == 0) rstd *= ATT_SCALE;
#pragma unroll
                for (int bj = 0; bj < 2; ++bj) { f32x4 v0 = acc[ai][bj][m][0] * rstd, v1 = acc[ai][bj][m][1] * rstd;
                    if (kind == 3) { v0 = silu4(v0); v1 = silu4(v1); }
                    st_bf8(dst + (size_t)row * ld + cb + bj * 128, v0, v1); } }
    } };
struct Epi4 { static constexpr bool PERM = true, AFTER_DRAIN = false; P4 p;
    __device__ __forceinline__ void operator()(const pg8::f32x4 (&acc)[2][2][4][2], const pg8::Unit& u, int wr, int wc, int fr, int fq) const {
        const int row0 = u.pm * 256 + wr * 64 + fr, c0 = u.pn * 256 + wc * 32 + 8 * fq;
#pragma unroll
        for (int ai = 0; ai < 2; ++ai)
#pragma unroll
            for (int m = 0; m < 4; ++m) { const int row = row0 + ai * 128 + m * 16; float ss = 0.f;
#pragma unroll
                for (int bj = 0; bj < 2; ++bj) { const size_t off = (size_t)row * DM + c0 + bj * 128;
                    const v4u xb = *(const GAS v4u*)(p.X1B + off);
                    const f32x4 o0 = (f32x4){__uint_as_float(xb.x << 16), __uint_as_float(xb.x & 0xffff0000u), __uint_as_float(xb.y << 16), __uint_as_float(xb.y & 0xffff0000u)} + acc[ai][bj][m][0];
                    const f32x4 o1 = (f32x4){__uint_as_float(xb.z << 16), __uint_as_float(xb.z & 0xffff0000u), __uint_as_float(xb.w << 16), __uint_as_float(xb.w & 0xffff0000u)} + acc[ai][bj][m][1];
                    *(GAS f32x4*)(p.Y + off) = o0; *(GAS f32x4*)(p.Y + off + 4) = o1;
                    ss += ((o0.x * o0.x + o0.y * o0.y) + (o0.z * o0.z + o0.w * o0.w)) + ((o1.x * o1.x + o1.y * o1.y) + (o1.z * o1.z + o1.w * o1.w)); }
                ss += __shfl_xor(ss, 16); ss += __shfl_xor(ss, 32);
                if (fq == 0) atomicAdd(p.SS + row, ss); }
    } };

struct Epi4F { static constexpr bool PERM = true, AFTER_DRAIN = true; P4 p; const float* gain; const XcdBarrier* bar;
    __device__ __forceinline__ void fused(pg8::f32x4 (&acc)[2][2][4][2], const pg8::Unit& u, int wr, int wc, int fr, int fq, PG8_LAS unsigned char* lds, int wid, int lane) const {
        const int row0 = u.pm * 256 + wr * 64 + fr, c0 = u.pn * 256 + wc * 32 + 8 * fq;
#pragma unroll
        for (int ai = 0; ai < 2; ++ai)
#pragma unroll
            for (int m = 0; m < 4; ++m) { const int row = row0 + ai * 128 + m * 16; float ss = 0.f;
#pragma unroll
                for (int bj = 0; bj < 2; ++bj) { const size_t off = (size_t)row * DM + c0 + bj * 128;
                    const v4u xb = *(const GAS v4u*)(p.X1B + off);
                    const f32x4 o0 = (f32x4){__uint_as_float(xb.x << 16), __uint_as_float(xb.x & 0xffff0000u), __uint_as_float(xb.y << 16), __uint_as_float(xb.y & 0xffff0000u)} + acc[ai][bj][m][0];
                    const f32x4 o1 = (f32x4){__uint_as_float(xb.z << 16), __uint_as_float(xb.z & 0xffff0000u), __uint_as_float(xb.w << 16), __uint_as_float(xb.w & 0xffff0000u)} + acc[ai][bj][m][1];
                    acc[ai][bj][m][0] = o0; acc[ai][bj][m][1] = o1;
                    ss += ((o0.x * o0.x + o0.y * o0.y) + (o0.z * o0.z + o0.w * o0.w)) + ((o1.x * o1.x + o1.y * o1.y) + (o1.z * o1.z + o1.w * o1.w)); }
                ss += __shfl_xor(ss, 16); ss += __shfl_xor(ss, 32);
                if (fq == 0) atomicAdd(p.SS + row, ss); }
        xcd_barrier(*bar);
        f32x4 g[2][2];
#pragma unroll
        for (int bj = 0; bj < 2; ++bj) { g[bj][0] = *(const GAS f32x4*)(gain + c0 + bj * 128); g[bj][1] = *(const GAS f32x4*)(gain + c0 + bj * 128 + 4); }
#pragma unroll
        for (int ai = 0; ai < 2; ++ai)
#pragma unroll
            for (int m = 0; m < 4; ++m) { const int row = row0 + ai * 128 + m * 16;
                const float rstd = 1.0f / sqrtf(__hip_atomic_load(p.SS + row, __ATOMIC_RELAXED, __HIP_MEMORY_SCOPE_AGENT) * (1.f / DM) + EPS);
#pragma unroll
                for (int bj = 0; bj < 2; ++bj) { const size_t off = (size_t)row * DM + c0 + bj * 128;
                    *(GAS f32x4*)(p.Y + off) = acc[ai][bj][m][0] * rstd * g[bj][0]; *(GAS f32x4*)(p.Y + off + 4) = acc[ai][bj][m][1] * rstd * g[bj][1]; } }
    } };

template <class EpiF>
__device__ __forceinline__ void sgemm_unit(const bf16* A, const bf16* WT, int u, int wave, int lane, const EpiF& epi) {
    const int fr = lane & 15, fq = lane >> 4;
    const GAS bf16x8* wp = (const GAS bf16x8*)(WT + (size_t)(16 * u + fr) * DM + 8 * fq);
    const GAS bf16x8* ap = (const GAS bf16x8*)(A + (size_t)(MP + 16 * wave + fr) * DM + 8 * fq);
    pg8::f32x4 acc = {0.f, 0.f, 0.f, 0.f};
#pragma unroll 1
    for (int k0 = 0; k0 < 32; k0 += 16) {
        bf16x8 wv[16], av[16];
#pragma unroll
        for (int i = 0; i < 16; ++i) { wv[i] = wp[(k0 + i) * 4]; av[i] = ap[(k0 + i) * 4]; }
#pragma unroll
        for (int i = 0; i < 16; ++i) acc = __builtin_amdgcn_mfma_f32_16x16x32_bf16(wv[i], av[i], acc, 0, 0, 0);
    }
    epi(MP + 16 * wave + fr, 16 * u + 4 * fq, acc);
}

typedef short s16x4 __attribute__((ext_vector_type(4)));

struct LaArgs {
    const bf16* Q; const bf16* Kp; const bf16* G;
    const bf16* V; const bf16* GATE; int ldv;
    const float* gain;
    bf16* MIXo; int mixoff;
    bf16* SBUF; float* BTOT;
    const float* S0; float* S1;
};
template <int DV, bool HAS_K, int MODE>
__device__ __forceinline__ void la_unit(LAS unsigned char* lds, const LaArgs& a, int m0, int h, int tid, int wave, int lane) {
    constexpr int NVT = DV / 128, NCH = 4, TV = 64; static_assert(MODE == 0 || MODE == 1, "la_unit modes");
    constexpr bool FULL = MODE != 0;
    constexpr int VS = DV + 8;
    constexpr int R0 = 0;
    constexpr int R1 = 17408;
    constexpr int R2 = 34816, R2_SZ = (DV * 144 > 33792) ? DV * 144 : 33792;
    constexpr int R3 = R2 + R2_SZ, R3_SZ = 64 * VS * 2;
    constexpr int K2T_OFF = R3 + R3_SZ;
    constexpr int P_OFF = K2T_OFF + 18432;
    constexpr int TOT_OFF = P_OFF + 9216, EBR_OFF = TOT_OFF + 4096, EBL_OFF = EBR_OFF + 512, SSQ_OFF = EBL_OFF + 512;
    static_assert(SSQ_OFF + 2048 <= LDSCTL_OFF, "LA LDS");
    constexpr int A1_OFF = R0, K1_OFF = R1, VT_OFF = R2;
    LAS float* TOT = (LAS float*)(lds + TOT_OFF); LAS float* EBR = (LAS float*)(lds + EBR_OFF); LAS float* EBL = (LAS float*)(lds + EBL_OFF); LAS float* SSQ = (LAS float*)(lds + SSQ_OFF);
    f32x4 S[8][NVT];
#pragma unroll
    for (int kp = 0; kp < 4; ++kp)
#pragma unroll
        for (int vt = 0; vt < NVT; ++vt) {
            if (MODE == 0) { S[2 * kp][vt] = (f32x4){0.f, 0.f, 0.f, 0.f}; S[2 * kp + 1][vt] = (f32x4){0.f, 0.f, 0.f, 0.f}; }
            else { const v4u sv = *(const GAS v4u*)(a.SBUF + ((size_t)((wave * 4 + kp) * NVT + vt) * 64 + lane) * 8);
                S[2 * kp][vt] = (f32x4){__uint_as_float(sv.x << 16), __uint_as_float(sv.x & 0xffff0000u), __uint_as_float(sv.y << 16), __uint_as_float(sv.y & 0xffff0000u)};
                S[2 * kp + 1][vt] = (f32x4){__uint_as_float(sv.z << 16), __uint_as_float(sv.z & 0xffff0000u), __uint_as_float(sv.w << 16), __uint_as_float(sv.w & 0xffff0000u)}; }
        }
    constexpr int NV = NVT * 2, VCH = DV / 8;
    v4u rg[2], rq[2], rk[2], rv[NV];
#define TZ(name) int name = tid; asm volatile("" : "+v"(name))
#define LB(name, off) LAS unsigned char* name = lds + (off); asm volatile("" : "+v"(name))
#define LA_LD(p) ((HAS_K && MODE == 1) ? __builtin_nontemporal_load((const GAS v4u*)(p)) : *(const GAS v4u*)(p))
#define LA_LOAD(chn) do { const int mr_ = m0 + 64 * (chn); TZ(tz_);                                                                                            \
        const bf16* gb_ = a.G + (size_t)mr_ * 512 + h * 128;  const bf16* qb_ = a.Q + (size_t)mr_ * 512 + h * 128; const bf16* kb_ = HAS_K ? a.Kp + (size_t)mr_ * 512 + h * 128 : nullptr; \
        const bf16* vb_ = a.V + (size_t)mr_ * a.ldv + h * DV;                                                                                                 \
        _Pragma("unroll") for (int i_ = 0; i_ < 2; ++i_) { const int e_ = tz_ + 512 * i_; const unsigned o_ = (unsigned)((e_ >> 4) * 512 + 8 * (e_ & 15));   \
            rg[i_] = LA_LD(gb_ + o_); if (FULL) rq[i_] = LA_LD(qb_ + o_); if (HAS_K) rk[i_] = LA_LD(kb_ + o_); }                                              \
        _Pragma("unroll") for (int i_ = 0; i_ < NV; ++i_) { const int e_ = tz_ + 512 * i_; rv[i_] = LA_LD(vb_ + (unsigned)((e_ / VCH) * a.ldv + 8 * (e_ % VCH))); } } while (0)
    LA_LOAD(0);
    float btot_run_A = 0.f, btot_run_B = 0.f;
#pragma unroll 1
    for (int ch = 0; ch < NCH; ++ch) {
        const int mr0 = m0 + 64 * ch;
        v4u gt[NV];
        { TZ(tz);
#pragma unroll
        for (int i = 0; i < 2; ++i) { const int e = tz + 512 * i, row = e >> 4;
            { LAS f32x4* gp = (LAS f32x4*)(lds + R2 + (row * 132 + 8 * (e & 15)) * 4);
              gp[0] = (f32x4){__uint_as_float(rg[i].x << 16), __uint_as_float(rg[i].x & 0xffff0000u), __uint_as_float(rg[i].y << 16), __uint_as_float(rg[i].y & 0xffff0000u)};
              gp[1] = (f32x4){__uint_as_float(rg[i].z << 16), __uint_as_float(rg[i].z & 0xffff0000u), __uint_as_float(rg[i].w << 16), __uint_as_float(rg[i].w & 0xffff0000u)}; }
            if (FULL) *(LAS v4u*)(lds + R0 + (row * 136 + 8 * (e & 15)) * 2) = rq[i];
            if (HAS_K) *(LAS v4u*)(lds + R1 + (row * 136 + 8 * (e & 15)) * 2) = rk[i]; }
#pragma unroll
        for (int i = 0; i < NV; ++i) { const int e = tz + 512 * i, row = e / VCH; *(LAS v4u*)(lds + R3 + (row * VS + 8 * (e % VCH)) * 2) = rv[i]; } }
        __syncthreads();
        if (NCH > 1) { const int chn = ch + 1 < NCH ? ch + 1 : ch; LA_LOAD(chn); }
        if (FULL) { const bf16* gtb = a.GATE + (size_t)mr0 * a.ldv + h * DV; TZ(tz);
#pragma unroll
            for (int i = 0; i < NV; ++i) { const int e = tz + 512 * i; gt[i] = LA_LD(gtb + (unsigned)((e / VCH) * a.ldv + 8 * (e % VCH))); } }
        {
        TZ(tzb); const int c2 = tzb & 63, seg = tzb >> 6, cA = 2 * c2;
        float gA[8], gB[8], kA[8], kB[8], qA[8], qB[8];
        LB(bG, R2 + (8 * seg * 132 + cA) * 4); LB(bQ, R0 + (8 * seg * 136 + cA) * 2); LB(bK, R1 + (8 * seg * 136 + cA) * 2);
#pragma unroll
        for (int i = 0; i < 8; ++i) {
            const f32x2_t gg = *(const LAS f32x2_t*)(bG + i * 528); gA[i] = gg.x; gB[i] = gg.y;
            if (FULL) { const unsigned qq = *(const LAS unsigned*)(bQ + i * 272); qA[i] = __uint_as_float(qq << 16); qB[i] = __uint_as_float(qq & 0xffff0000u); }
            if (HAS_K) { const unsigned kk = *(const LAS unsigned*)(bK + i * 272); kA[i] = __uint_as_float(kk << 16); kB[i] = __uint_as_float(kk & 0xffff0000u); } }
#pragma unroll
        for (int i = 0; i < 8; ++i) { if (!HAS_K) { kA[i] = 1.0f - __expf(gA[i]); kB[i] = 1.0f - __expf(gB[i]); } if (i) { gA[i] += gA[i - 1]; gB[i] += gB[i - 1]; } }
        LB(bT, TOT_OFF + cA * 4);
        *(LAS f32x2_t*)(bT + seg * 512) = (f32x2_t){gA[7], gB[7]};
        __syncthreads();
        float preA = 0.f, preB = 0.f, brA = 0.f, brB = 0.f, blA = 0.f, blB = 0.f;
#pragma unroll
        for (int q = 0; q < 8; ++q) { const f32x2_t tt_ = *(const LAS f32x2_t*)(bT + q * 512);
            if (q < seg) { preA += tt_.x; preB += tt_.y; } if (q < 4) { brA += tt_.x; brB += tt_.y; } blA += tt_.x; blB += tt_.y; }
        if (seg == 0) { *(LAS f32x2_t*)(bT + (EBR_OFF - TOT_OFF)) = (f32x2_t){__expf(brA), __expf(brB)}; *(LAS f32x2_t*)(bT + (EBL_OFF - TOT_OFF)) = (f32x2_t){__expf(blA), __expf(blB)}; btot_run_A += blA; btot_run_B += blB; }
        {   unsigned k2a[4], k2b[4];
#pragma unroll
            for (int i = 0; i < 8; i += 2) { const float a0 = gA[i] + preA, a1 = gA[i + 1] + preA, b0 = gB[i] + preB, b1 = gB[i + 1] + preB;
                k2a[i >> 1] = cvtpk_s(kA[i] * __expf(blA - a0), kA[i + 1] * __expf(blA - a1));
                k2b[i >> 1] = cvtpk_s(kB[i] * __expf(blB - b0), kB[i + 1] * __expf(blB - b1));
                if (FULL) {
                    *(LAS unsigned*)(bQ + i * 272) = cvtpk_s(qA[i] * __expf(a0 - brA), qB[i] * __expf(b0 - brB));
                    *(LAS unsigned*)(bQ + (i + 1) * 272) = cvtpk_s(qA[i + 1] * __expf(a1 - brA), qB[i + 1] * __expf(b1 - brB));
                    *(LAS unsigned*)(bK + i * 272) = cvtpk_s(kA[i] * __expf(brA - a0), kB[i] * __expf(brB - b0));
                    *(LAS unsigned*)(bK + (i + 1) * 272) = cvtpk_s(kA[i + 1] * __expf(brA - a1), kB[i + 1] * __expf(brB - b1)); } }
            LB(bK2, K2T_OFF + (cA * 72 + 8 * seg) * 2);
            *(LAS v4u*)(bK2) = (v4u){k2a[0], k2a[1], k2a[2], k2a[3]};
            *(LAS v4u*)(bK2 + 144) = (v4u){k2b[0], k2b[1], k2b[2], k2b[3]}; }
        LB(bVr, R3 + (8 * seg * VS + cA) * 2); LB(bVw, VT_OFF + (cA * 72 + 8 * seg) * 2);
#pragma unroll
        for (int ps = 0; ps < NVT; ++ps) { unsigned vv[8];
#pragma unroll
            for (int i = 0; i < 8; ++i) vv[i] = *(const LAS unsigned*)(bVr + (i * VS + 128 * ps) * 2);
            v4u wa, wb;
            wa.x = (vv[0] & 0xffffu) | (vv[1] << 16); wa.y = (vv[2] & 0xffffu) | (vv[3] << 16); wa.z = (vv[4] & 0xffffu) | (vv[5] << 16); wa.w = (vv[6] & 0xffffu) | (vv[7] << 16);
            wb.x = (vv[0] >> 16) | (vv[1] & 0xffff0000u); wb.y = (vv[2] >> 16) | (vv[3] & 0xffff0000u); wb.z = (vv[4] >> 16) | (vv[5] & 0xffff0000u); wb.w = (vv[6] >> 16) | (vv[7] & 0xffff0000u);
            *(LAS v4u*)(bVw + 128 * ps * 144) = wa; *(LAS v4u*)(bVw + 128 * ps * 144 + 144) = wb; }
        }
        __syncthreads();
        if (FULL) {
            TZ(tzc); const int lc = tzc & 63, fr = lc & 15, fq = lc >> 4, wv = __builtin_amdgcn_readfirstlane(tzc >> 6);
            const int tt = wv >> 1, st0 = 2 * (wv & 1);
            f32x4 p0 = {0.f, 0.f, 0.f, 0.f}, p1 = {0.f, 0.f, 0.f, 0.f};
            LB(bA, A1_OFF + ((16 * tt + fr) * 136 + 8 * fq) * 2); LB(bB, K1_OFF + ((16 * st0 + fr) * 136 + 8 * fq) * 2);
#pragma unroll
            for (int ks = 0; ks < 4; ++ks) {
                const bf16x8 av = *(const LAS bf16x8*)(bA + ks * 64);
                const bf16x8 b0 = *(const LAS bf16x8*)(bB + ks * 64);
                const bf16x8 b1 = *(const LAS bf16x8*)(bB + 16 * 272 + ks * 64);
                p0 = __builtin_amdgcn_mfma_f32_16x16x32_bf16(av, b0, p0, 0, 0, 0);
                p1 = __builtin_amdgcn_mfma_f32_16x16x32_bf16(av, b1, p1, 0, 0, 0);
            }
            LB(bP, P_OFF + ((16 * tt + 4 * fq) * 72 + 16 * st0 + fr) * 2);
#pragma unroll
            for (int j = 0; j < 4; ++j) { const int t = 16 * tt + 4 * fq + j, s0 = 16 * st0 + fr, s1 = s0 + 16;
                const float x0 = (s0 <= t) ? p0[j] : 0.f, x1 = (s1 <= t) ? p1[j] : 0.f;
                *(LAS bf16*)(bP + j * 144) = (bf16)(cvtpk_s(x0, 0.f) & 0xffffu);
                *(LAS bf16*)(bP + j * 144 + 32) = (bf16)(cvtpk_s(x1, 0.f) & 0xffffu); }
            __syncthreads();
        }
        TZ(tzd); const int ld_ = tzd & 63, fr = ld_ & 15, fq = ld_ >> 4, wave_d = __builtin_amdgcn_readfirstlane(tzd >> 6), vbase = wave_d * (DV / 8);
        bf16x8 vb[NVT][2];
        LB(bVT, VT_OFF + ((vbase + fr) * 72 + 8 * fq) * 2);
#pragma unroll
        for (int vt = 0; vt < NVT; ++vt)
#pragma unroll
            for (int ks = 0; ks < 2; ++ks) vb[vt][ks] = *(const LAS bf16x8*)(bVT + vt * 16 * 144 + ks * 64);
        f32x4 o[4][NVT];
        if (FULL) {
            LB(bPr, P_OFF + (fr * 72 + 8 * fq) * 2); LB(bE, EBR_OFF + 16 * fq); LB(bA4, A1_OFF + (fr * 136 + 4 * fq) * 2);
#pragma unroll
            for (int tt = 0; tt < 4; ++tt)
#pragma unroll
                for (int vt = 0; vt < NVT; ++vt) o[tt][vt] = (f32x4){0.f, 0.f, 0.f, 0.f};
#pragma unroll
            for (int tt = 0; tt < 4; ++tt)
#pragma unroll
                for (int ks = 0; ks < 2; ++ks) { const bf16x8 pa = *(const LAS bf16x8*)(bPr + tt * 16 * 144 + ks * 64);
#pragma unroll
                    for (int vt = 0; vt < NVT; ++vt) o[tt][vt] = __builtin_amdgcn_mfma_f32_16x16x32_bf16(pa, vb[vt][ks], o[tt][vt], 0, 0, 0); }
#pragma unroll
            for (int ks = 0; ks < 4; ++ks) {
                const f32x4 e0 = *(const LAS f32x4*)(bE + ks * 128), e1 = *(const LAS f32x4*)(bE + ks * 128 + 64);
                bf16x8 sb[NVT];
#pragma unroll
                for (int vt = 0; vt < NVT; ++vt) sb[vt] = pack8f(S[2 * ks][vt] * e0, S[2 * ks + 1][vt] * e1);
#pragma unroll
                for (int tt = 0; tt < 4; ++tt) {
                    const s16x4 alo = *(const LAS s16x4*)(bA4 + tt * 16 * 272 + ks * 64);
                    const s16x4 ahi = *(const LAS s16x4*)(bA4 + tt * 16 * 272 + ks * 64 + 32);
                    const bf16x8 aa = __builtin_shufflevector(alo, ahi, 0, 1, 2, 3, 4, 5, 6, 7);
#pragma unroll
                    for (int vt = 0; vt < NVT; ++vt) o[tt][vt] = __builtin_amdgcn_mfma_f32_16x16x32_bf16(aa, sb[vt], o[tt][vt], 0, 0, 0);
                }
            }
        }
        LB(bL, EBL_OFF + 16 * fq); LB(bK2r, K2T_OFF + (fr * 72 + 8 * fq) * 2);
#pragma unroll
        for (int kt = 0; kt < 8; ++kt) {
            const f32x4 el = *(const LAS f32x4*)(bL + kt * 64);
#pragma unroll
            for (int vt = 0; vt < NVT; ++vt) S[kt][vt] = S[kt][vt] * el;
#pragma unroll
            for (int ks = 0; ks < 2; ++ks) { const bf16x8 ka = *(const LAS bf16x8*)(bK2r + kt * 16 * 144 + ks * 64);
#pragma unroll
                for (int vt = 0; vt < NVT; ++vt) S[kt][vt] = __builtin_amdgcn_mfma_f32_16x16x32_bf16(ka, vb[vt][ks], S[kt][vt], 0, 0, 0); }
        }
        if (FULL) {
            LB(bS, SSQ_OFF + (wave_d * 64 + 4 * fq) * 4); LB(bR, TOT_OFF + 16 * fq); LB(bO, R3 + ((4 * fq) * VS + vbase + fr) * 2);
#pragma unroll
            for (int tt = 0; tt < 4; ++tt) { f32x4 ss = {0.f, 0.f, 0.f, 0.f};
#pragma unroll
                for (int vt = 0; vt < NVT; ++vt) ss += o[tt][vt] * o[tt][vt];
#pragma unroll
                for (int j = 0; j < 4; ++j) ss[j] = row16_sum(ss[j]);
                if (fr == 0) *(LAS f32x4*)(bS + tt * 64) = ss; }
            __syncthreads();
            if (ld_ < 8) { const int t = 8 * wave_d + ld_; float tot = 0.f;
#pragma unroll
                for (int w = 0; w < 8; ++w) tot += SSQ[w * 64 + t];
                TOT[t] = 1.0f / sqrtf(tot * (1.0f / DV) + EPS); }
            float gn[NVT];
#pragma unroll
            for (int vt = 0; vt < NVT; ++vt) gn[vt] = a.gain[h * DV + vbase + 16 * vt + fr];
            __syncthreads();
#pragma unroll
            for (int tt = 0; tt < 4; ++tt) {
                const f32x4 rs = *(const LAS f32x4*)(bR + tt * 64);
#pragma unroll
                for (int j = 0; j < 4; ++j) { const int t = 16 * tt + 4 * fq + j;
#pragma unroll
                    for (int vt = 0; vt < NVT; ++vt) { const float val = o[tt][vt][j] * rs[j] * gn[vt]; const float vn = dppf<0xB1>(val);
                        if ((fr & 1) == 0) *(LAS unsigned*)(bO + ((16 * tt + j) * VS + 16 * vt) * 2) = cvtpk_s(val, vn); } }
            }
            __syncthreads();
            TZ(tze);
#pragma unroll
            for (int i = 0; i < NV; ++i) { const int e = tze + 512 * i, row = e / VCH;
                { const v4u ov = *(const LAS v4u*)(lds + R3 + (row * VS + 8 * (e % VCH)) * 2); v4u w;
#pragma unroll
                    for (int k = 0; k < 4; ++k) w[k] = cvtpk_s(__uint_as_float(ov[k] << 16) * __uint_as_float(gt[i][k] << 16), __uint_as_float(ov[k] & 0xffff0000u) * __uint_as_float(gt[i][k] & 0xffff0000u));
                    *(GAS v4u*)(a.MIXo + (size_t)(mr0 + row) * 1024 + a.mixoff + h * DV + 8 * (e % VCH)) = w; } }
        }
        __syncthreads();
    }
#undef LA_LOAD
#undef TZ
#undef LB
    if (MODE == 0) {
#pragma unroll
        for (int kp = 0; kp < 4; ++kp)
#pragma unroll
            for (int vt = 0; vt < NVT; ++vt) st_bf8(a.SBUF + ((size_t)((wave * 4 + kp) * NVT + vt) * 64 + lane) * 8, S[2 * kp][vt], S[2 * kp + 1][vt]);
        if ((tid >> 6) == 0) { a.BTOT[2 * (tid & 63)] = btot_run_A; a.BTOT[2 * (tid & 63) + 1] = btot_run_B; }
    }
}

template <int DV, bool HAS_K>
__device__ __forceinline__ void la_sample_unit(LAS unsigned char* lds, const LaArgs& a, int u, int tid, int wave, int lane) {
    constexpr int KS = 512 / DV, KPT = 128 / KS, NOUT = 4 * DV / 512;
    const int b = u >> 2, h = u & 3, m0 = MP + b * 4;
    LAS float* EG = (LAS float*)lds; LAS float* KK = EG + 512; LAS float* QQ = KK + 512; LAS float* RED = QQ + 512; LAS float* WS = RED + 4 * KS * DV;
    { const int t = tid >> 7, k = tid & 127; const size_t off = (size_t)(m0 + t) * 512 + h * 128 + k;
      const float g = bf2f(a.G[off]), eg = __expf(g); EG[tid] = eg; KK[tid] = HAS_K ? bf2f(a.Kp[off]) : 1.0f - eg; QQ[tid] = bf2f(a.Q[off]); }
    __syncthreads();
    const int v = tid % DV, ks = tid / DV, k0 = ks * KPT;
    float S[KPT];
    { const float* sp = a.S0 + (size_t)k0 * DV + v;
#pragma unroll
      for (int i0 = 0; i0 < KPT; i0 += 4) { asm volatile("" : "+v"(sp));
#pragma unroll
          for (int i = 0; i < 4; ++i) S[i0 + i] = sp[i * DV];
          sp += 4 * DV; } }
#pragma unroll
    for (int t = 0; t < 4; ++t) {
        const float vt = bf2f(a.V[(size_t)(m0 + t) * a.ldv + h * DV + v]); float o = 0.f;
#pragma unroll
        for (int i = 0; i < KPT; ++i) { S[i] = S[i] * EG[t * 128 + k0 + i] + KK[t * 128 + k0 + i] * vt; o += S[i] * QQ[t * 128 + k0 + i]; }
        RED[(t * KS + ks) * DV + v] = o;
    }
    { float* sp = a.S1 + (size_t)k0 * DV + v;
#pragma unroll
      for (int i0 = 0; i0 < KPT; i0 += 4) { asm volatile("" : "+v"(sp));
#pragma unroll
          for (int i = 0; i < 4; ++i) sp[i * DV] = S[i0 + i];
          sp += 4 * DV; } }
    __syncthreads();
    float ov[NOUT];
#pragma unroll
    for (int j = 0; j < NOUT; ++j) { const int idx = tid + 512 * j, t = idx / DV, vv = idx % DV; float o = 0.f;
#pragma unroll
        for (int q = 0; q < KS; ++q) o += RED[(t * KS + q) * DV + vv];
        ov[j] = o; const float ss = wave_sum(o * o); if (lane == 0) WS[j * 8 + wave] = ss; }
    __syncthreads();
#pragma unroll
    for (int j = 0; j < NOUT; ++j) { const int idx = tid + 512 * j, t = idx / DV, vv = idx % DV;
        constexpr int WPT = DV / 64;
        const int w0 = (wave / WPT) * WPT; float tot = 0.f;
#pragma unroll
        for (int q = 0; q < WPT; ++q) tot += WS[j * 8 + w0 + q];
        const float rstd = 1.0f / sqrtf(tot * (1.0f / DV) + EPS); const size_t row = (size_t)(m0 + t);
        const float val = ov[j] * rstd * a.gain[h * DV + vv] * bf2f(a.GATE[row * a.ldv + h * DV + vv]);
        a.MIXo[row * 1024 + a.mixoff + h * DV + vv] = (bf16)(cvtpk_s(val, 0.f) & 0xffffu); }
    __syncthreads();
}

template <int DV>
__device__ __forceinline__ void la_scan(bf16* SLOC, const float* BTOT, float* outstate, int gtid, int gthreads) {
    constexpr int NVT = DV / 128, LP = 8192 * NVT;
    GAS unsigned* SW = (GAS unsigned*)SLOC;
    for (int eg = gtid; eg < 8 * LP; eg += gthreads) {
        const int bh = eg / LP, e = eg % LP;
        const int jj = e & 1, kk = (e >> 1) & 1, ln = (e >> 2) & 63, rest = e >> 8, vt = rest % NVT, kp = (rest / NVT) & 3, w = rest / (NVT * 4);
        const int k = 16 * (2 * kp + kk) + 4 * (ln >> 4) + 2 * jj, v = w * (DV / 8) + 16 * vt + (ln & 15);
        float c0 = 0.f, c1 = 0.f;
        {   constexpr int s0 = 0;
            unsigned loc[32]; f32x2_t dec[32];
#pragma unroll
            for (int sc = 0; sc < 32; ++sc) { loc[sc] = SW[(size_t)(bh * 32 + s0 + sc) * LP + e]; dec[sc] = *(const GAS f32x2_t*)(BTOT + (size_t)(bh * 32 + s0 + sc) * 128 + k); }
#pragma unroll
            for (int sc = 0; sc < 32; ++sc) { SW[(size_t)(bh * 32 + s0 + sc) * LP + e] = cvtpk_s(c0, c1);
                c0 = c0 * __expf(dec[sc].x) + __uint_as_float(loc[sc] << 16); c1 = c1 * __expf(dec[sc].y) + __uint_as_float(loc[sc] & 0xffff0000u); }
        }
        outstate[(size_t)(bh * 128 + k) * DV + v] = c0; outstate[(size_t)(bh * 128 + k + 1) * DV + v] = c1;
    }
}

namespace fox {
using TIN = __hip_bfloat16; using TOUT = __hip_bfloat16;
constexpr int D = 128, SKV = 8192, WINDOW = SKV; constexpr float THR = 8.f; constexpr bool WSKIP = false;
constexpr int OSTR = 1024, GSTR = 512;
constexpr float SCALE = 0.08838834764831845f;
constexpr int NW = 8, QBLK = 32, KVBLK = 64, QB = NW * QBLK;
constexpr int SHM_V = KVBLK * D * 2, SHM_K = KVBLK * D * 2;
constexpr int LDS_BIAS = 2 * SHM_V + 2 * SHM_K + NW * 64 * 4;
constexpr int LDS_BYTES = LDS_BIAS + 512;
constexpr int ORS = 136, OST_WAVE = 32 * ORS * 2, OST_OFF = 69632;

using bf16 = __hip_bfloat16;
typedef short bf16x8 __attribute__((ext_vector_type(8)));
typedef short s16x4 __attribute__((ext_vector_type(4)));
typedef float f32x16 __attribute__((ext_vector_type(16)));
typedef float f32x4 __attribute__((ext_vector_type(4)));
typedef unsigned u32x4 __attribute__((ext_vector_type(4)));
template <class A, class Bt> struct same_t { static constexpr bool v = false; };
template <class A> struct same_t<A, A> { static constexpr bool v = true; };

#define KSWZ(row, colB) ((row) * 256 + ((colB) ^ (((row) & 7) << 4)))
#define SBAR() __builtin_amdgcn_sched_barrier(0)
__device__ __forceinline__ int v_st(int k, int c) { const int kk = (k & ~0xC) | ((k & 4) << 1) | ((k & 8) >> 1); return ((kk >> 3) * 4 + (c >> 5)) * 512 + ((kk & 7) * 32 + (c & 31)) * 2; }
__device__ __forceinline__ int v_rd_base(int lane) { return ((lane & 3) << 3) | (((lane >> 2) & 3) << 6) | (((lane >> 4) & 1) << 5) | (((lane >> 5) & 1) << 8); }
constexpr int v_rd_off(int d0, int ks, int half) { return d0 * 512 + ks * 4096 + half * 2048; }
__device__ __forceinline__ int crow(int r, int hi) { return (r & 3) + 8 * (r >> 2) + 4 * hi; }
__device__ __forceinline__ unsigned cvtpk(float lo, float hi) {
    unsigned r; asm volatile("v_cvt_pk_bf16_f32 %0, %1, %2" : "=v"(r) : "v"(lo), "v"(hi)); return r;
}
__device__ __forceinline__ bf16x8 pack8(f32x4 a, f32x4 b) {
    u32x4 w = {cvtpk(a[0], a[1]), cvtpk(a[2], a[3]), cvtpk(b[0], b[1]), cvtpk(b[2], b[3])};
    return *reinterpret_cast<bf16x8*>(&w);
}
template <class T> __device__ __forceinline__ bf16x8 load8(const T* p) {
    if constexpr (same_t<T, float>::v) { return pack8(*(const f32x4*)p, *(const f32x4*)(p + 4)); }
    else { return *reinterpret_cast<const bf16x8*>(p); }
}
__device__ __forceinline__ void mask_tile(f32x16& p0, f32x16& p1, int dq, unsigned W) {
    const float NEG = -__builtin_inff();
#pragma unroll
    for (int r = 0; r < 16; ++r) {
        const int c = (r & 3) + 8 * (r >> 2);
        if ((unsigned)(dq - c) >= W) p0[r] = NEG;
        if ((unsigned)(dq - c - 32) >= W) p1[r] = NEG;
    }
}
__device__ __forceinline__ void partialSM(f32x16& p0, f32x16& p1, float& m_reg, float& mn, float& alpha) {
    float pmax = p0[0]; for (int r = 1; r < 16; ++r) pmax = fmaxf(pmax, p0[r]); for (int r = 0; r < 16; ++r) pmax = fmaxf(pmax, p1[r]);
    { auto rr = __builtin_amdgcn_permlane32_swap(__float_as_uint(pmax), __float_as_uint(pmax), false, false);
      pmax = fmaxf(__uint_as_float(rr[0]), __uint_as_float(rr[1])); }
    constexpr float C2 = 1.4426950408889634f * SCALE;
    if (__builtin_expect(__all((pmax - m_reg) * SCALE <= THR), 1)) { mn = m_reg; alpha = 1.f; }
    else { mn = fmaxf(m_reg, pmax); alpha = __builtin_amdgcn_exp2f((m_reg - mn) * C2); m_reg = mn; }
    const float mnL = -mn * C2;
    for (int r = 0; r < 16; ++r) p0[r] = fmaf(p0[r], C2, mnL); for (int r = 0; r < 16; ++r) p1[r] = fmaf(p1[r], C2, mnL);
    for (int r = 0; r < 16; ++r) p0[r] = __builtin_amdgcn_exp2f(p0[r]);
}
__device__ __forceinline__ void finishSM(f32x16& p0, f32x16& p1, float alpha, float& l_reg, bf16x8& pa0, bf16x8& pa1, bf16x8& pa2, bf16x8& pa3) {
    for (int r = 0; r < 16; ++r) p1[r] = __builtin_amdgcn_exp2f(p1[r]);
    float ps = 0; for (int r = 0; r < 16; ++r) ps += p0[r]; for (int r = 0; r < 16; ++r) ps += p1[r];
    { auto rr = __builtin_amdgcn_permlane32_swap(__float_as_uint(ps), __float_as_uint(ps), false, false);
      ps = __uint_as_float(rr[0]) + __uint_as_float(rr[1]); }
    l_reg = l_reg * alpha + ps;
#define PK4(P, B_, OUT) do { unsigned a0 = cvtpk(P[B_+0], P[B_+1]), a1 = cvtpk(P[B_+2], P[B_+3]);                          \
        unsigned b0 = cvtpk(P[B_+4], P[B_+5]), b1 = cvtpk(P[B_+6], P[B_+7]);                                             \
        auto r0 = __builtin_amdgcn_permlane32_swap(a0, b0, false, false); auto r1 = __builtin_amdgcn_permlane32_swap(a1, b1, false, false); \
        u32x4 w = {r0[0], r1[0], r0[1], r1[1]}; OUT = *reinterpret_cast<bf16x8*>(&w); } while (0)
    PK4(p0, 0, pa0); PK4(p0, 8, pa1); PK4(p1, 0, pa2); PK4(p1, 8, pa3);
#undef PK4
}
constexpr int NQR = 8;
template <int KB, bool SK>
__device__ __forceinline__ void qkt(f32x16& p0, f32x16& p1, const char* K_lds, int r32, int hi, const char* qs, const bf16x8* qrh, bool act) {
    if (SK && !act) { const float NEG = -__builtin_inff();
#pragma unroll
        for (int r = 0; r < 16; ++r) { p0[r] = NEG; p1[r] = NEG; } return; }
    { const float* bl = (const float*)(K_lds + 2 * SHM_K + NW * 64 * 4 + KB * 256) + 4 * hi;
#pragma unroll
      for (int g = 0; g < 4; ++g) { const f32x4 b0 = *(const f32x4*)(bl + 8 * g), b1 = *(const f32x4*)(bl + 32 + 8 * g);
          p0[4 * g] = b0[0]; p0[4 * g + 1] = b0[1]; p0[4 * g + 2] = b0[2]; p0[4 * g + 3] = b0[3]; p1[4 * g] = b1[0]; p1[4 * g + 1] = b1[1]; p1[4 * g + 2] = b1[2]; p1[4 * g + 3] = b1[3]; } }
    const char* kb[4];
#pragma unroll
    for (int dd = 0; dd < 4; ++dd) kb[dd] = K_lds + KB * SHM_K + KSWZ(r32, (dd * 16 + hi * 8) * 2);
#pragma unroll
    for (int d0 = 0; d0 < 8; ++d0) { const char* a = kb[d0 & 3] + (d0 >> 2) * 128;
        bf16x8 b0 = *reinterpret_cast<const bf16x8*>(a);
        bf16x8 b1 = *reinterpret_cast<const bf16x8*>(a + 32 * 256);
        const bf16x8 qv = d0 < NQR ? qrh[d0] : *reinterpret_cast<const bf16x8*>(qs + d0 * 32);
        p0 = __builtin_amdgcn_mfma_f32_32x32x16_bf16(b0, qv, p0, 0, 0, 0);
        p1 = __builtin_amdgcn_mfma_f32_32x32x16_bf16(b1, qv, p1, 0, 0, 0); }
}
template <int VB, bool SK>
__device__ __forceinline__ void pv_tile(f32x16* o, int vb0, bf16x8 pa0, bf16x8 pa1, bf16x8 pa2, bf16x8 pa3, bool act) {
    if (SK && !act) return;
#define TRRD(dst, off) asm volatile("ds_read_b64_tr_b16 %0, %1 offset:%2" : "=&v"(dst) : "v"(vb0), "i"(off) : "memory")
#define PV_D0(d0) do { s16x4 l0, l1, l2, l3, h0, h1, h2, h3; constexpr int b_ = VB * SHM_V + v_rd_off(d0, 0, 0);     \
        TRRD(l0, b_); TRRD(h0, b_ + 2048); TRRD(l1, b_ + 4096); TRRD(h1, b_ + 6144); TRRD(l2, b_ + 8192); TRRD(h2, b_ + 10240); TRRD(l3, b_ + 12288); TRRD(h3, b_ + 14336); \
        asm volatile("s_waitcnt lgkmcnt(0)" ::: "memory"); SBAR();                 \
        o[d0] = __builtin_amdgcn_mfma_f32_32x32x16_bf16(pa0, (bf16x8){l0[0], l0[1], l0[2], l0[3], h0[0], h0[1], h0[2], h0[3]}, o[d0], 0, 0, 0);   \
        o[d0] = __builtin_amdgcn_mfma_f32_32x32x16_bf16(pa1, (bf16x8){l1[0], l1[1], l1[2], l1[3], h1[0], h1[1], h1[2], h1[3]}, o[d0], 0, 0, 0);   \
        o[d0] = __builtin_amdgcn_mfma_f32_32x32x16_bf16(pa2, (bf16x8){l2[0], l2[1], l2[2], l2[3], h2[0], h2[1], h2[2], h2[3]}, o[d0], 0, 0, 0);   \
        o[d0] = __builtin_amdgcn_mfma_f32_32x32x16_bf16(pa3, (bf16x8){l3[0], l3[1], l3[2], l3[3], h3[0], h3[1], h3[2], h3[3]}, o[d0], 0, 0, 0); } while (0)
    PV_D0(0); PV_D0(1); PV_D0(2); PV_D0(3);
#undef PV_D0
#undef TRRD
}

template <class TIn, class TOut> struct BlockRef { const TIn* Q; const TIn* K; const TIn* V; TOut* O; int P0; const float* CB; const TIn* G; };
template <class TIn> struct Seam {
    bf16x8 qr[8];
    bf16x8 st_v0, st_v1, st_k0, st_k1; f32x4 sf0, sf1, sf2, sf3; float st_b;
    f32x4 tq[16];
};
__device__ __forceinline__ int swa_jlo(int P0, int W) { const int lowk = P0 - W + 1; return lowk > 0 ? lowk / KVBLK : 0; }
#define ROW(p, k0, rr) ((p) + (size_t)(k0) * D + (unsigned)((rr) * D + sc))
#define VMW() asm volatile("s_waitcnt vmcnt(0)" ::: "memory")
#define VMWN(n) asm volatile("s_waitcnt vmcnt(%0)" :: "i"(n) : "memory")
#define SLOAD_H(Kp, Vp, Cp, k0) do { S.st_v0 = load8<TIn>(ROW(Vp, k0, sr)); S.st_v1 = load8<TIn>(ROW(Vp, k0, 32 + sr));              \
                         S.st_k0 = load8<TIn>(ROW(Kp, k0, sr)); S.st_k1 = load8<TIn>(ROW(Kp, k0, 32 + sr)); { int tb_ = tid; asm volatile("" : "+v"(tb_)); S.st_b = ((Cp) + (k0))[(unsigned)(tb_ & 63)]; } } while (0)
#define SWRITE_HK(bf) do { *(bf16x8*)(K_lds + (bf) * SHM_K + kws) = S.st_k0; *(bf16x8*)(K_lds + (bf) * SHM_K + kws + 32 * 256) = S.st_k1; if (tid < 64) *(float*)(K_lds + 2 * SHM_K + NW * 64 * 4 + (bf) * 256 + tid * 4) = S.st_b; } while (0)
#define SWRITE_HV(bf) do { *(bf16x8*)(V_lds + (bf) * SHM_V + vst0) = S.st_v0; *(bf16x8*)(V_lds + (bf) * SHM_V + vst1) = S.st_v1; } while (0)
#define SWRITE_H(bf) do { SWRITE_HV(bf); SWRITE_HK(bf); } while (0)
#define SLOAD_F(p, k0) do { S.sf0 = *(const f32x4*)ROW(p, k0, sr); S.sf1 = *(const f32x4*)(ROW(p, k0, sr) + 4);                \
                            S.sf2 = *(const f32x4*)ROW(p, k0, 32 + sr); S.sf3 = *(const f32x4*)(ROW(p, k0, 32 + sr) + 4); } while (0)
#define SWRITE_KF(bf) do { *(bf16x8*)(K_lds + (bf) * SHM_K + kws) = pack8(S.sf0, S.sf1); *(bf16x8*)(K_lds + (bf) * SHM_K + kws + 32 * 256) = pack8(S.sf2, S.sf3); } while (0)
#define SWRITE_VF(bf) do { *(bf16x8*)(V_lds + (bf) * SHM_V + vst0) = pack8(S.sf0, S.sf1); *(bf16x8*)(V_lds + (bf) * SHM_V + vst1) = pack8(S.sf2, S.sf3); } while (0)
template <class TIn, class TOut>
__device__ __forceinline__ void causal_swa_prime(const BlockRef<TIn, TOut>& cur, int W, char* lds, Seam<TIn>& S) {
    constexpr bool F32 = same_t<TIn, float>::v;
    const int tid = threadIdx.x, wid = __builtin_amdgcn_readfirstlane(tid >> 6), lane = tid & 63, r32 = lane & 31, hi = lane >> 5;
    const int sr = tid >> 4, sc = (tid & 15) * 8, kws = KSWZ(sr, sc * 2); char* K_lds = lds + 2 * SHM_V;
    const int kb0 = swa_jlo(cur.P0, W) * KVBLK;
    for (int d0 = 0; d0 < 8; ++d0) S.qr[d0] = load8<TIn>(cur.Q + (size_t)(wid * QBLK + r32) * D + d0 * 16 + hi * 8);
    if constexpr (F32) { SLOAD_F((const float*)cur.K, kb0); VMW(); SWRITE_KF(0); SBAR(); SLOAD_F((const float*)cur.V, kb0); }
    else { SLOAD_H(cur.K, cur.V, cur.CB, kb0); VMW(); SWRITE_HK(0); }
    { char* const qsw = lds + OST_OFF + wid * OST_WAVE + r32 * ORS * 2 + hi * 16;
#pragma unroll
      for (int d0 = 0; d0 < 8; ++d0) *reinterpret_cast<bf16x8*>(qsw + d0 * 32) = S.qr[d0]; }
    __syncthreads();
}
template <class TIn, class TOut>
__device__ __forceinline__ void causal_swa_block(const BlockRef<TIn, TOut>& cur, const BlockRef<TIn, TOut>& nxt, int skv, int W, char* lds, Seam<TIn>& S) {
    constexpr bool F32 = same_t<TIn, float>::v;
    const int tid = threadIdx.x, wid = __builtin_amdgcn_readfirstlane(tid >> 6), lane = tid & 63, r32 = lane & 31, hi = lane >> 5;
    const int j_lo = swa_jlo(cur.P0, W);
    int j_hi = (cur.P0 + QB - 1) / KVBLK + 1; if (j_hi > skv / KVBLK) j_hi = skv / KVBLK;
    const int NT = j_hi - j_lo;
    const int kbn = swa_jlo(nxt.P0, W) * KVBLK;
    const int qlo = cur.P0 + wid * QBLK, qm = qlo + r32 - 4 * hi;
    char* V_lds = lds; char* K_lds = lds + 2 * SHM_V;
    float* ws = (float*)(lds + 2 * SHM_V + 2 * SHM_K) + wid * 64; float* li_l = ws, * al_l = ws + 32;
    float m_reg = -1e30f, l_reg = 0; f32x16 o[4] = {};
    const int sr = tid >> 4, sc = (tid & 15) * 8, vst0 = v_st(sr, sc), vst1 = v_st(32 + sr, sc), kws = KSWZ(sr, sc * 2);
    const int vb0 = (int)(uintptr_t)V_lds + v_rd_base(lane);
    char* const qs = lds + OST_OFF + wid * OST_WAVE + r32 * ORS * 2 + hi * 16;
    bf16x8 qrh[NQR];
#pragma unroll
    for (int d0 = 0; d0 < NQR; ++d0) qrh[d0] = *reinterpret_cast<const bf16x8*>(qs + d0 * 32);
    const TIn* Kh = cur.K; const TIn* Vh = cur.V; const float* Ch = cur.CB;
#define RESC(a) do { if (__any((a) < 1.f)) { if (hi == 0) al_l[r32] = (a); asm volatile("s_waitcnt lgkmcnt(0)" ::: "memory");              \
                     for (int d_ = 0; d_ < 4; ++d_) for (int r = 0; r < 16; ++r) o[d_][r] *= al_l[crow(r, hi)]; } } while (0)
#define KBASE(t) ((j_lo + (t)) * KVBLK)
#define ACT(t) (KBASE(t) <= qlo + QBLK - 1 && KBASE(t) + KVBLK - 1 >= qlo - W + 1)
#define MASKT(P0_, P1_, t) do { const int kb_ = KBASE(t); if ((!SK || ACT(t)) && (kb_ + KVBLK - 1 > qlo || kb_ <= qlo + QBLK - 1 - W)) mask_tile(P0_, P1_, qm - kb_, (unsigned)W); } while (0)
#define BIASADD(P0_, P1_, KB_) do { const float* bl_ = (const float*)(K_lds + 2 * SHM_K + NW * 64 * 4 + (KB_) * 256) + 4 * hi;                    \
        _Pragma("unroll") for (int g_ = 0; g_ < 4; ++g_) { const f32x4 b0_ = *(const f32x4*)(bl_ + 8 * g_), b1_ = *(const f32x4*)(bl_ + 32 + 8 * g_); \
            _Pragma("unroll") for (int i_ = 0; i_ < 4; ++i_) { P0_[4 * g_ + i_] += b0_[i_]; P1_[4 * g_ + i_] += b1_[i_]; } } } while (0)
    constexpr int NQL = F32 ? 16 : 0;
    constexpr bool SK = WSKIP && !F32;
#define SEAM_K0() do { VMWN(NQL); if constexpr (F32) { SWRITE_KF(0); SBAR(); SLOAD_F((const float*)nxt.V, kbn); } else { SWRITE_HK(0); } SBAR(); } while (0)
    f32x16 pA0, pA1, pB0, pB1; float mnA, mnB, alA, alB; bf16x8 pa0, pa1, pa2, pa3;
    if constexpr (F32) { VMW(); SWRITE_VF(0); SBAR(); } else { SWRITE_HV(0); SBAR(); }
    if (NT > 1) { if constexpr (F32) SLOAD_F((const float*)Kh, KBASE(1)); else SLOAD_H(Kh, Vh, Ch, KBASE(1)); }
    SBAR(); qkt<0, SK>(pA0, pA1, K_lds, r32, hi, qs, qrh, ACT(0));
    if constexpr (F32) { if (NT > 1) { VMW(); SWRITE_KF(1); SBAR(); SLOAD_F((const float*)Vh, KBASE(1)); } }
    MASKT(pA0, pA1, 0); partialSM(pA0, pA1, m_reg, mnA, alA);
    if (NT > 1) { VMW(); if constexpr (F32) { SWRITE_VF(1); SBAR(); if (NT > 2) SLOAD_F((const float*)Kh, KBASE(2)); } else SWRITE_H(1); }
    __syncthreads();
#define HALF_STEP(PX0, PX1, mnX, alX, PY0, PY1, alY, t, KB, VB, SB) do {                                                      \
        SBAR(); qkt<KB, SK>(PX0, PX1, K_lds, r32, hi, qs, qrh, ACT(t));                                             \
        finishSM(PY0, PY1, alY, l_reg, pa0, pa1, pa2, pa3); SBAR();                                                           \
        if ((t) + 1 < NT) { if constexpr (F32) { VMW(); SWRITE_KF(SB); SBAR(); SLOAD_F((const float*)Vh, KBASE((t) + 1)); }  \
                            else { SLOAD_H(Kh, Vh, Ch, KBASE((t) + 1)); } SBAR(); }                                               \
        pv_tile<VB, SK>(o, vb0, pa0, pa1, pa2, pa3, ACT((t) - 1)); MASKT(PX0, PX1, (t)); partialSM(PX0, PX1, m_reg, mnX, alX);                                        \
        __syncthreads();                                                                                                      \
        if ((t) + 1 < NT) { VMW(); if constexpr (F32) { SWRITE_VF(SB); SBAR(); if ((t) + 2 < NT) SLOAD_F((const float*)Kh, KBASE((t) + 2)); } \
                            else { SWRITE_H(SB); } }                                                                          \
        RESC(alX); __syncthreads(); } while (0)
    for (int t = 1; t + 1 < NT; t += 2) {
        HALF_STEP(pB0, pB1, mnB, alB, pA0, pA1, alA, t, 1, 0, 0);
        HALF_STEP(pA0, pA1, mnA, alA, pB0, pB1, alB, t + 1, 0, 1, 1);
    }
    const bool even = (NT & 1) == 0;
    if (even) { SBAR(); qkt<1, SK>(pB0, pB1, K_lds, r32, hi, qs, qrh, ACT(NT - 1)); SBAR(); }
#define QROW(e) (nxt.Q + (size_t)(wid * QBLK + r32) * D + ((e) >> 1) * 16 + hi * 8 + ((e) & 1) * 4)
    if constexpr (F32) { SLOAD_F((const float*)nxt.K, kbn); SBAR();
#pragma unroll
        for (int e = 0; e < 8; ++e) S.tq[e] = *(const f32x4*)QROW(e); }
    else { SLOAD_H(nxt.K, nxt.V, nxt.CB, kbn); SBAR(); }
    SBAR();
    finishSM(pA0, pA1, alA, l_reg, pa0, pa1, pa2, pa3); SBAR();
    if constexpr (F32) {
#pragma unroll
        for (int e = 8; e < 16; ++e) S.tq[e] = *(const f32x4*)QROW(e); SBAR(); }
#undef QROW
    pv_tile<0, SK>(o, vb0, pa0, pa1, pa2, pa3, ACT(even ? NT - 2 : NT - 1));
    if (even) { MASKT(pB0, pB1, NT - 1); partialSM(pB0, pB1, m_reg, mnB, alB); __syncthreads(); RESC(alB);
        finishSM(pB0, pB1, alB, l_reg, pa0, pa1, pa2, pa3); SBAR(); pv_tile<1, SK>(o, vb0, pa0, pa1, pa2, pa3, ACT(NT - 1)); }
    SBAR(); SEAM_K0();
    {
    int tz = threadIdx.x; asm volatile("" : "+v"(tz));
    const int lane_e = tz & 63, wid_e = __builtin_amdgcn_readfirstlane(tz >> 6), r32_e = lane_e & 31, hi_e = lane_e >> 5;
    float* li_e = (float*)(lds + 2 * SHM_V + 2 * SHM_K) + wid_e * 64;
    if (hi_e == 0) li_e[r32_e] = l_reg; asm volatile("s_waitcnt lgkmcnt(0)" ::: "memory");
    float rli[16];
#pragma unroll
    for (int r = 0; r < 16; ++r) rli[r] = __builtin_amdgcn_rcpf(li_e[crow(r, hi_e)]);
    char* ost = lds + OST_OFF + wid_e * OST_WAVE;
    {   char* ob = ost + (4 * hi_e * ORS + r32_e) * 2;
#pragma unroll
        for (int r = 0; r < 16; ++r) {
#pragma unroll
            for (int d0 = 0; d0 < 4; ++d0) { const float v = o[d0][r] * rli[r]; const float vn = __shfl_xor(v, 1);
                if ((r32_e & 1) == 0) *(unsigned*)(ob + (((r & 3) + 8 * (r >> 2)) * ORS + d0 * 32) * 2) = cvtpk(v, vn); } } }
    asm volatile("s_waitcnt lgkmcnt(0)" ::: "memory");
    if constexpr (!F32) {
        const TIn* qn = nxt.Q + (size_t)(wid_e * QBLK + r32_e) * D + hi_e * 8;
#pragma unroll
        for (int d0 = 0; d0 < 8; ++d0) S.qr[d0] = load8<TIn>(qn + d0 * 16); }
    {   const int orow = lane_e >> 4, och = lane_e & 15;
        const TOut* Ow_c = cur.O + (size_t)(wid_e * QBLK + orow) * OSTR + och * 8; TOut* Ow = const_cast<TOut*>(Ow_c);
        const TIn* Gw = cur.G + (size_t)(wid_e * QBLK + orow) * GSTR + och * 8;
#pragma unroll
        for (int i = 0; i < 8; ++i) {
            const u32x4 ov = *(const u32x4*)(ost + (4 * i + orow) * ORS * 2 + och * 16);
            const u32x4 gv = *(const u32x4*)(Gw + (size_t)(4 * i) * GSTR);
            u32x4 w;
#pragma unroll
            for (int k = 0; k < 4; ++k) w[k] = cvtpk(__uint_as_float(ov[k] << 16) * __uint_as_float(gv[k] << 16), __uint_as_float(ov[k] & 0xffff0000u) * __uint_as_float(gv[k] & 0xffff0000u));
            *(u32x4*)(Ow + (size_t)(4 * i) * OSTR) = w; } }
    if constexpr (!F32) {
        char* qsw = ost + r32_e * ORS * 2 + hi_e * 16;
#pragma unroll
        for (int d0 = 0; d0 < 8; ++d0) *reinterpret_cast<bf16x8*>(qsw + d0 * 32) = S.qr[d0]; }
    }
    if constexpr (F32) {
#pragma unroll
        for (int d0 = 0; d0 < 8; ++d0) S.qr[d0] = pack8(S.tq[2 * d0], S.tq[2 * d0 + 1]); }
    __syncthreads();
#undef RESC
#undef KBASE
#undef ACT
#undef MASKT
#undef SEAM_K0
#undef BIASADD
#undef HALF_STEP
}
#undef ROW
#undef VMW
#undef VMWN
#undef SLOAD_H
#undef SWRITE_HK
#undef SWRITE_HV
#undef SWRITE_H
#undef SLOAD_F
#undef SWRITE_KF
#undef SWRITE_VF


}

namespace dec {
constexpr int D = 128, PG16 = 16, WAVES = 4, GE = 4, GEP = 4, HPL = 1, NSPLIT = 4, TOK_STRIDE = 512;
constexpr int PPW = (PAST / PG16) / NSPLIT / WAVES;
constexpr int LDS_P = 0, LDS_MRG = WAVES * 64 * HPL, MRG_REC = 4 + D, LDS_FLOATS = LDS_MRG + WAVES * GEP * MRG_REC + 4;
using bf16x2 = __attribute__((ext_vector_type(2))) __bf16;
using u32x4  = __attribute__((ext_vector_type(4))) unsigned;
using f32x4  = __attribute__((ext_vector_type(4))) float;
using f32x8  = __attribute__((ext_vector_type(8))) float;
__device__ __forceinline__ float dot2(unsigned k, unsigned q, float acc) { return __builtin_amdgcn_fdot2_f32_bf16(__builtin_bit_cast(bf16x2, k), __builtin_bit_cast(bf16x2, q), acc, false); }
__device__ __forceinline__ unsigned cvtpk(float lo, float hi) { unsigned r; asm volatile("v_cvt_pk_bf16_f32 %0, %1, %2" : "=v"(r) : "v"(lo), "v"(hi)); return r; }
template <int CTRL> __device__ __forceinline__ float dpp(float x) { return __builtin_bit_cast(float, __builtin_amdgcn_mov_dpp(__builtin_bit_cast(int, x), CTRL, 0xf, 0xf, true)); }
constexpr int XOR1 = 0xB1, XOR2 = 0x4E, XOR7 = 0x141, XOR8 = 0x128, ROR4 = 0x124;
__device__ __forceinline__ float xrow16_max(float x) {
  auto s = __builtin_amdgcn_permlane16_swap(__float_as_uint(x), __float_as_uint(x), false, false);
  x = fmaxf(__uint_as_float(s[0]), __uint_as_float(s[1]));
  auto t = __builtin_amdgcn_permlane32_swap(__float_as_uint(x), __float_as_uint(x), false, false);
  return fmaxf(__uint_as_float(t[0]), __uint_as_float(t[1]));
}
__device__ __forceinline__ float xrow16_sum(float x) {
  auto s = __builtin_amdgcn_permlane16_swap(__float_as_uint(x), __float_as_uint(x), false, false);
  x = __uint_as_float(s[0]) + __uint_as_float(s[1]);
  auto t = __builtin_amdgcn_permlane32_swap(__float_as_uint(x), __float_as_uint(x), false, false);
  return __uint_as_float(t[0]) + __uint_as_float(t[1]);
}
__device__ __forceinline__ f32x8 ld8(const float* p) { const f32x4 lo = __builtin_nontemporal_load(reinterpret_cast<const f32x4*>(p)), hi = __builtin_nontemporal_load(reinterpret_cast<const f32x4*>(p + 64));
  return f32x8{lo[0], lo[1], lo[2], lo[3], hi[0], hi[1], hi[2], hi[3]}; }
__device__ __forceinline__ u32x4 tobf(f32x8 x) { u32x4 w = {cvtpk(x[0], x[1]), cvtpk(x[2], x[3]), cvtpk(x[4], x[5]), cvtpk(x[6], x[7])}; return w; }

struct DecArgs { const float* q; const float* k; const float* v; const int* pt; const float* sufx; float* pml; float* po; };

__device__ __forceinline__ void decode_unit(const DecArgs& a, int b, int kvh, int s, float* lds, int wave, int lane) {
  const int r = lane >> 4, c = lane & 15;
  constexpr float C2 = ATT_SCALE * 1.4426950408889634f;
  const int sp0 = s * (PAST / PG16 / NSPLIT);
  int btv = 0;
  if (lane < PPW) { const int sp = sp0 + wave + 4 * lane; btv = a.pt[b * NPAGES + (sp >> 3)] * 8 + (sp & 7); }
  u32x4 qpk[GEP];
#pragma unroll
  for (int g = 0; g < GEP; ++g) { const float* qp = a.q + ((size_t)(b * 4 + g) * 512 + kvh * D + 4 * c); const f32x4 lo = *reinterpret_cast<const f32x4*>(qp), hi = *reinterpret_cast<const f32x4*>(qp + 64);
    qpk[g] = tobf(f32x8{lo[0], lo[1], lo[2], lo[3], hi[0], hi[1], hi[2], hi[3]}); }
  const unsigned loff = (unsigned)(r * TOK_STRIDE + 4 * c);
  const float* sufx = a.sufx + (size_t)(b * 4 + kvh) * PAST; const unsigned soff = (unsigned)(r + 4 * (c >> 2));
#define PAGE_BASE(spid) ((size_t)(spid) * (PG16 * TOK_STRIDE) + (size_t)kvh * D)
#define ISSUE_K(KBUF, BV, i_) do { const int ii_ = (i_) < PPW ? (i_) : PPW - 1; const int phys_ = __builtin_amdgcn_readlane(btv, ii_); const float* kb_ = a.k + PAGE_BASE(phys_); \
    _Pragma("unroll") for (int t_ = 0; t_ < 4; ++t_) KBUF[t_] = ld8(kb_ + (loff + (unsigned)(t_ * 4 * TOK_STRIDE))); BV = sufx[(unsigned)((sp0 + wave + 4 * ii_) * PG16) + soff]; } while (0)
#define ISSUE_V(i_) do { const int ii_ = (i_) < PPW ? (i_) : PPW - 1; const int phys_ = __builtin_amdgcn_readlane(btv, ii_); const float* vb_ = a.v + PAGE_BASE(phys_); \
    _Pragma("unroll") for (int t_ = 0; t_ < 4; ++t_) Vn[t_] = ld8(vb_ + (loff + (unsigned)(t_ * 4 * TOK_STRIDE))); } while (0)
  f32x8 KA[4], KB[4], Vn[4]; float bA, bB;
  float m[HPL], l[HPL], acc[GEP * 8];
#pragma unroll
  for (int j = 0; j < HPL; ++j) { m[j] = -INFINITY; l[j] = 0.f; }
#pragma unroll
  for (int k = 0; k < GEP * 8; ++k) acc[k] = 0.f;
  ISSUE_K(KA, bA, 0); ISSUE_V(0); ISSUE_K(KB, bB, 1);
#define TR_STEP(HALF, CTRL, BIT) _Pragma("unroll") for (int h = 0; h < (HALF); ++h) _Pragma("unroll") for (int j = 0; j < HPL; ++j) { \
      const float lo_ = x[h * HPL + j], hi_ = x[(h + (HALF)) * HPL + j]; const float t1_ = lo_ + dpp<CTRL>(lo_), t2_ = hi_ + dpp<CTRL>(hi_); \
      x[h * HPL + j] = (c & (BIT)) ? t2_ : t1_; }
#define DEC_STEP(KBUF, BV, i_) do {                                                                                              \
    u32x4 Kc[4], Vc[4];                                                                                                          \
    _Pragma("unroll") for (int t = 0; t < 4; ++t) { Kc[t] = tobf(KBUF[t]); Vc[t] = tobf(Vn[t]); }                                \
    const float bias = BV;                                                                                                       \
    ISSUE_V((i_) + 1); ISSUE_K(KBUF, BV, (i_) + 2);                                                                              \
    float x[4 * GEP];                                                                                                            \
    _Pragma("unroll") for (int t = 0; t < 4; ++t) _Pragma("unroll") for (int g = 0; g < GEP; ++g) { float d = 0.f;              \
        _Pragma("unroll") for (int k = 0; k < 4; ++k) d = dot2(Kc[t][k], qpk[g][k], d);                                          \
        x[t * GEP + g] = d; }                                                                                                    \
    TR_STEP(8, XOR8, 8) TR_STEP(4, XOR7, 4) TR_STEP(2, XOR2, 2) TR_STEP(1, XOR1, 1)                                              \
    float p[HPL], alpha[HPL];                                                                                                    \
    _Pragma("unroll") for (int j = 0; j < HPL; ++j) {                                                                            \
      const float sc = x[j] * C2 + bias;                                                                                         \
      float pm = sc; pm = fmaxf(pm, dpp<ROR4>(pm)); pm = fmaxf(pm, dpp<XOR8>(pm)); pm = xrow16_max(pm);                          \
      const float mn = fmaxf(m[j], pm), msub = (mn == -INFINITY) ? 0.f : mn;                                                     \
      alpha[j] = __builtin_amdgcn_exp2f(m[j] - msub); p[j] = __builtin_amdgcn_exp2f(sc - msub);                                  \
      l[j] = fmaf(l[j], alpha[j], p[j]); m[j] = mn; }                                                                            \
    _Pragma("unroll") for (int q4 = 0; q4 < 4; ++q4) _Pragma("unroll") for (int j = 0; j < HPL; ++j) {                           \
        const float al = q4 == 0 ? dpp<0x00>(alpha[j]) : q4 == 1 ? dpp<0x55>(alpha[j]) : q4 == 2 ? dpp<0xAA>(alpha[j]) : dpp<0xFF>(alpha[j]); \
        _Pragma("unroll") for (int k = 0; k < 8; ++k) acc[(q4 * HPL + j) * 8 + k] *= al; }                                       \
    float* prow = lds + LDS_P + (wave * 4 + r) * 16 * HPL;                                                                       \
    _Pragma("unroll") for (int j = 0; j < HPL; ++j) prow[c * HPL + j] = p[j];                                                    \
    asm volatile("s_waitcnt lgkmcnt(0)" ::: "memory");                                                                           \
    f32x4 pr[GEP];                                                                                                               \
    _Pragma("unroll") for (int u = 0; u < GEP; ++u) pr[u] = *reinterpret_cast<const f32x4*>(prow + 4 * u);                       \
    _Pragma("unroll") for (int t = 0; t < 4; ++t) { float vf[8];                                                                 \
      _Pragma("unroll") for (int k = 0; k < 4; ++k) { vf[2 * k] = __builtin_bit_cast(float, Vc[t][k] << 16); vf[2 * k + 1] = __builtin_bit_cast(float, Vc[t][k] & 0xffff0000u); } \
      _Pragma("unroll") for (int g = 0; g < GE; ++g) { const float pg_ = pr[(t * GEP + g) >> 2][(t * GEP + g) & 3];              \
        _Pragma("unroll") for (int k = 0; k < 8; ++k) acc[g * 8 + k] = fmaf(pg_, vf[k], acc[g * 8 + k]); } } } while (0)
#pragma unroll 1
  for (int i = 0; i < PPW; i += 2) { DEC_STEP(KA, bA, i); DEC_STEP(KB, bB, i + 1); }
#undef DEC_STEP
#undef TR_STEP
#undef ISSUE_K
#undef ISSUE_V
#undef PAGE_BASE
#pragma unroll
  for (int k = 0; k < GE * 8; ++k) acc[k] = xrow16_sum(acc[k]);
#pragma unroll
  for (int j = 0; j < HPL; ++j) { float t = l[j]; t += dpp<ROR4>(t); t += dpp<XOR8>(t); l[j] = xrow16_sum(t); }
  float* mrg = lds + LDS_MRG;
  if (r == 0) {
#pragma unroll
    for (int g = 0; g < GE; ++g) {
      float* rec = mrg + (wave * GEP + g) * MRG_REC;
#pragma unroll
      for (int k = 0; k < 8; k += 4) *reinterpret_cast<f32x4*>(rec + 4 + 4 * c + 16 * k) = f32x4{acc[g * 8 + k], acc[g * 8 + k + 1], acc[g * 8 + k + 2], acc[g * 8 + k + 3]};
      if (c == g / HPL) { rec[0] = m[g % HPL]; rec[1] = l[g % HPL]; } } }
  __syncthreads();
  {
    const int g = wave, d0 = 2 * lane;
    const size_t row = (size_t)(b * 4 + kvh) * 4 + g;
    float M = -INFINITY;
#pragma unroll
    for (int w = 0; w < WAVES; ++w) M = fmaxf(M, mrg[(w * GEP + g) * MRG_REC]);
    float L = 0.f, o0 = 0.f, o1 = 0.f;
#pragma unroll
    for (int w = 0; w < WAVES; ++w) { const float* rec = mrg + (w * GEP + g) * MRG_REC; const float lw = rec[1];
      const float wt = (lw > 0.f) ? __builtin_amdgcn_exp2f(rec[0] - M) : 0.f;
      L = fmaf(wt, lw, L); o0 = fmaf(wt, rec[4 + d0], o0); o1 = fmaf(wt, rec[4 + d0 + 1], o1); }
    const size_t slot = row * NSPLIT + s;
    *reinterpret_cast<float2*>(a.po + slot * D + d0) = make_float2(o0, o1);
    if (lane == 0) *reinterpret_cast<float2*>(a.pml + 2 * slot) = make_float2(M, L);
  }
  __syncthreads();
}

struct CombArgs { const float* pml; const float* po; const float* q; const float* knew; const float* vnew; const float* lfb; const unsigned short* gate; unsigned short* mix; };
__device__ __forceinline__ void combine_row(const CombArgs& a, int b, int h, int t, int lane) {
  constexpr float C2 = ATT_SCALE * 1.4426950408889634f;
  const size_t row = (size_t)(b * 4 + h) * 4 + t; const int d0 = 2 * lane;
  const float* pml = a.pml + row * NSPLIT * 2; const float* po = a.po + row * NSPLIT * D;
  const float2 qv = *reinterpret_cast<const float2*>(a.q + (size_t)(b * 4 + t) * 512 + h * D + d0);
  float scn[4]; float cum = 0.f;
#pragma unroll
  for (int s = 0; s < 4; ++s) {
    const float2 kv = *reinterpret_cast<const float2*>(a.knew + (size_t)(b * 4 + s) * 512 + h * D + d0);
    float d = qv.x * kv.x + qv.y * kv.y;
#pragma unroll
    for (int o = 1; o < 64; o <<= 1) d += __shfl_xor(d, o);
    cum += a.lfb[(size_t)(MP + b * 4 + s) * 4 + h];
    scn[s] = (s <= t) ? d * C2 - cum * LOG2E : -INFINITY;
  }
  float M = -INFINITY;
#pragma unroll
  for (int s = 0; s < NSPLIT; ++s) M = fmaxf(M, pml[2 * s]);
#pragma unroll
  for (int s = 0; s < 4; ++s) M = fmaxf(M, scn[s]);
  float L = 0.f, o0 = 0.f, o1 = 0.f;
#pragma unroll
  for (int s = 0; s < NSPLIT; ++s) { const float ls = pml[2 * s + 1], w = (ls > 0.f) ? __builtin_amdgcn_exp2f(pml[2 * s] - M) : 0.f;
    const float2 av = *reinterpret_cast<const float2*>(po + (size_t)s * D + d0);
    L = fmaf(w, ls, L); o0 = fmaf(w, av.x, o0); o1 = fmaf(w, av.y, o1); }
#pragma unroll
  for (int s = 0; s < 4; ++s) { const float w = __builtin_amdgcn_exp2f(scn[s] - M);
    const float2 vv = *reinterpret_cast<const float2*>(a.vnew + (size_t)(b * 4 + s) * 512 + h * D + d0);
    L += w; o0 = fmaf(w, vv.x, o0); o1 = fmaf(w, vv.y, o1); }
  const float inv = 1.f / L;
  const size_t ms = (size_t)(MP + b * 4 + t);
  const unsigned gp = *reinterpret_cast<const unsigned*>(a.gate + ms * 512 + h * D + d0);
  const float g0 = __uint_as_float(gp << 16), g1 = __uint_as_float(gp & 0xffff0000u);
  *reinterpret_cast<unsigned*>(a.mix + ms * 1024 + 512 + h * D + d0) = cvtpk(o0 * inv * g0, o1 * inv * g1);
}
}

__device__ __forceinline__ void p6_rpass(Frame& F, int part) {
    const int gw = (int)blockIdx.x * NWAVES + F.wave, NGW = F.G * NWAVES, fr = F.lane & 15, fq = F.lane >> 4;
    const bf16* X1B = WSP(bf16, WS_XN); const bf16* WRB = WSP(bf16, WS_WR); const bf16* WGB = WSP(bf16, WS_WR + 65536);
    bf16* GF3 = WSP(bf16, WS_GF3); const float* SS1 = (const float*)(F.ctl + CW_SS1);
    LAS unsigned char* rt = F.lds + RING_OFF + F.wave * 512;
    constexpr int NU = MT / 8;
    for (int it = (NGW == 2048 && part == 1) ? 1 : 0; ; ++it) {
        int u;
        if (NGW == 2048) { if (it == 0) u = gw; else if (it == 1 && part != 0 && F.wave == 0 && blockIdx.x >= 192 && (int)blockIdx.x < 192 + (NU - 2048)) u = 2048 + (int)blockIdx.x - 192; else break; }
        else { if (part == 1) break; u = gw + it * NGW; if (u >= NU) break; }
        const int g = u >> 1, hh = u & 1, row0 = 16 * g;
        const GAS bf16x8* wp = (const GAS bf16x8*)(WRB + (size_t)fr * DM + 8 * fq);
        const GAS bf16x8* ap = (const GAS bf16x8*)(X1B + (size_t)(row0 + fr) * DM + 8 * fq);
        pg8::f32x4 acc = {0.f, 0.f, 0.f, 0.f};
#pragma unroll 1
        for (int k0 = 0; k0 < 32; k0 += 16) {
            bf16x8 wv[16], av[16];
#pragma unroll
            for (int i = 0; i < 16; ++i) { wv[i] = wp[(k0 + i) * 4]; av[i] = ap[(k0 + i) * 4]; }
#pragma unroll
            for (int i = 0; i < 16; ++i) acc = __builtin_amdgcn_mfma_f32_16x16x32_bf16(wv[i], av[i], acc, 0, 0, 0);
        }
        const float rstd = 1.0f / sqrtf(SS1[row0 + fr] * (1.f / DM) + EPS);
        acc = acc * rstd;
        { u32x2v w; w.x = cvtpk_s(acc[0], acc[1]); w.y = cvtpk_s(acc[2], acc[3]); *(LAS u32x2v*)(rt + (fr * 16 + 4 * fq) * 2) = w; }
        LDS_WAIT(); asm volatile("" ::: "memory");
        bf16x8 rb = {0, 0, 0, 0, 0, 0, 0, 0};
        if (fq < 2) rb = *(const LAS bf16x8*)(rt + (fr * 16 + 8 * fq) * 2);
        LDS_WAIT(); asm volatile("" ::: "memory");
#pragma unroll 4
        for (int ct = 16 * hh; ct < 16 * hh + 16; ++ct) {
            bf16x8 wa = {0, 0, 0, 0, 0, 0, 0, 0};
            if (fq < 2) wa = *(const GAS bf16x8*)(WGB + (size_t)(16 * ct + fr) * 16 + 8 * fq);
            const pg8::f32x4 z = {0.f, 0.f, 0.f, 0.f};
            const pg8::f32x4 d = __builtin_amdgcn_mfma_f32_16x16x32_bf16(wa, rb, z, 0, 0, 0);
            const f32x4 bg = *(const GAS f32x4*)(F.b_gla_gate + 16 * ct + 4 * fq);
            f32x4 lf; lf.x = log_sigmoidf_(d[0] + bg.x) * 0.0625f; lf.y = log_sigmoidf_(d[1] + bg.y) * 0.0625f; lf.z = log_sigmoidf_(d[2] + bg.z) * 0.0625f; lf.w = log_sigmoidf_(d[3] + bg.w) * 0.0625f;
            st_bf4(GF3 + (size_t)(row0 + fr) * 512 + 16 * ct + 4 * fq, lf);
        }
    }
    __syncthreads();
}
__device__ __forceinline__ void p11_final(Frame& F) {
    const int gw = (int)blockIdx.x * NWAVES + F.wave, NGW = F.G * NWAVES;
    const float* SS2 = (const float*)(F.ctl + CW_SS2);
    for (int m = gw; m < MT; m += NGW) {
        GAS f32x4* yr = (GAS f32x4*)(F.out + O_Y + (size_t)m * DM) + F.lane;
        const float rstd = 1.0f / sqrtf(SS2[m] * (1.f / DM) + EPS);
#pragma unroll
        for (int j = 0; j < 4; ++j) { const f32x4 g = *(const GAS f32x4*)(F.final_norm + 4 * F.lane + 256 * j); yr[64 * j] = yr[64 * j] * rstd * g; }
    }
}

struct SE1 { P1 p; __device__ __forceinline__ void operator()(int m, int c, f32x4 v) const { epi1_4(p, m, c, v); } };
struct SE2 { P2 p; __device__ __forceinline__ void operator()(int m, int c, f32x4 v) const { float ss = epi2_4(p, m, c, v); ss += __shfl_xor(ss, 16); ss += __shfl_xor(ss, 32); if (((c >> 2) & 3) == 0) atomicAdd(p.SS + m, ss); } };
struct SE3 { P3 p; __device__ __forceinline__ void operator()(int m, int c, f32x4 v) const { const float rstd = 1.0f / sqrtf(p.SS[m] * (1.f / DM) + EPS); epi3_4(p, m, c, v, rstd); } };
struct SE4 { P4 p; __device__ __forceinline__ void operator()(int m, int c, f32x4 v) const { float ss = epi4_4(p, m, c, v); ss += __shfl_xor(ss, 16); ss += __shfl_xor(ss, 32); if (((c >> 2) & 3) == 0) atomicAdd(p.SS + m, ss); } };
typedef fox::BlockRef<fox::TIN, fox::TOUT> FoxRef;
__device__ __forceinline__ FoxRef fox_ref(unsigned char* ws, int bh, int qb) {
    const fox::TIN* Q = (const fox::TIN*)(ws + WS_QBH); const fox::TIN* K = (const fox::TIN*)(ws + WS_KBH); const fox::TIN* V = (const fox::TIN*)(ws + WS_VBH);
    const int b = bh >> 2, h = bh & 3; FoxRef r;
    r.Q = Q + ((size_t)bh * SEQ + (size_t)qb * 256) * 128; r.K = K + (size_t)bh * SEQ * 128; r.V = V + (size_t)bh * SEQ * 128;
    r.O = (fox::TOUT*)(ws + WS_MIX) + ((size_t)(b * SEQ + qb * 256)) * 1024 + 512 + h * 128; r.G = (const fox::TIN*)(ws + WS_GB) + ((size_t)(b * SEQ + qb * 256)) * 512 + h * 128;
    r.CB = (const float*)(ws + WS_CB) + (size_t)bh * SEQ; r.P0 = qb * 256; return r;
}


__device__ __forceinline__ void sub_barrier(unsigned* cnt, unsigned n, unsigned& gen) {
    asm volatile("s_waitcnt vmcnt(0)" ::: "memory");
    __syncthreads();
    if (threadIdx.x == 0) {
        __builtin_amdgcn_fence(__ATOMIC_RELEASE, "agent");
        asm volatile("s_waitcnt vmcnt(0)" ::: "memory");
        (void)__hip_atomic_fetch_add(cnt, 1u, __ATOMIC_RELAXED, __HIP_MEMORY_SCOPE_AGENT);
        const unsigned target = (gen + 1u) * n; unsigned sp = 0;
        while (__hip_atomic_load(cnt, __ATOMIC_RELAXED, __HIP_MEMORY_SCOPE_AGENT) < target) { __builtin_amdgcn_s_sleep(1); if (++sp > (1u << 22)) break; }
        __builtin_amdgcn_fence(__ATOMIC_ACQUIRE, "agent");
        asm volatile("s_waitcnt vmcnt(0)" ::: "memory");
    }
    __syncthreads();
    ++gen;
}

#ifndef MK_N_LAUNCHES
#define MK_N_LAUNCHES 1
#endif
constexpr int N_LAUNCHES = MK_N_LAUNCHES;
constexpr int N_PHASES = 12;
struct Args { const void* in[21]; float* out; unsigned char* ws; int ph_lo, ph_hi, sub, pad; };
__global__ void __launch_bounds__(NWAVES * 64, 2) hybrid_fwd(Args args) {
    extern __shared__ __attribute__((aligned(16))) unsigned char lds[];
    Frame F;
    F.lds = (LAS unsigned char*)lds;
    F.MISC = (volatile LAS unsigned*)(F.lds + MISC_OFF);
    F.tid = threadIdx.x; F.lane = F.tid & 63; F.wave = __builtin_amdgcn_readfirstlane(F.tid >> 6);
    F.G = gridDim.x;
    F.ws = args.ws; F.out = args.out; F.ctl = (gu32*)(args.ws + WS_CTL);
    F.xp = (const float*)args.in[0]; F.xs = (const float*)args.in[1]; F.ck = (const float*)args.in[2]; F.cv = (const float*)args.in[3]; F.clf = (const float*)args.in[4];
    F.sh = (const float*)args.in[5]; F.sg = (const float*)args.in[6]; F.pt = (const int*)args.in[7];
    F.norm_even = (const float*)args.in[8]; F.w_in_even = (const float*)args.in[9]; F.b_fox = (const float*)args.in[10]; F.lb_logits = (const float*)args.in[11];
    F.hgrn_gain = (const float*)args.in[12]; F.w_out_even = (const float*)args.in[13]; F.norm_odd = (const float*)args.in[14]; F.w_in_odd = (const float*)args.in[15];
    F.w_gla_gate = (const float*)args.in[16]; F.b_gla_gate = (const float*)args.in[17]; F.gla_gain = (const float*)args.in[18]; F.w_out_odd = (const float*)args.in[19]; F.final_norm = (const float*)args.in[20];
    for (int u = F.tid; u < (LDS_BYTES - LDSCTL_OFF) / 4; u += NWAVES * 64) ((LAS unsigned*)(F.lds + LDSCTL_OFF))[u] = 0u;
    __syncthreads();
    XcdBarrier bar; bar.bar = (unsigned*)(F.ctl + CW_BAR); bar.x = 0; bar.st = nullptr; bar.total = 0u;
    if (N_LAUNCHES == 1) bar = xcd_barrier_post((unsigned*)(F.ctl + CW_BAR), F.MISC + 8);
    XcdBarrier bar2; bar2.bar = (unsigned*)(F.ctl + CW_BAR2); bar2.x = 0; bar2.st = nullptr; bar2.total = 0u;
    if ((int)blockIdx.x >= (int)gridDim.x / 2) { bar2 = xcd_barrier_post((unsigned*)(F.ctl + CW_BAR2), F.MISC + 12); bar2.total = gridDim.x - gridDim.x / 2; }
#define GRID_BAR() do { if (N_LAUNCHES == 1) xcd_barrier(bar); } while (0)
    const int lo = args.ph_lo, hi = args.ph_hi;
#ifndef REP_MASK
#define REP_MASK 0
#endif
#if REP_MASK
#define REPS(k) for (int rep_ = 0; rep_ <= (((REP_MASK) >> (k)) & 1); ++rep_)
#else
#define REPS(k)
#endif
#ifndef SUB_MASK
#define SUB_MASK 7
#endif
#ifndef PH_MASK
#define PH_MASK 0xFFF
#endif
#define IN(k) ((((PH_MASK) >> (k)) & 1) && lo <= (k) && (k) < hi)
#define BOTH(k) (IN(k) && IN((k) + 1))
    const int bid = blockIdx.x;

    REPS(0) if (IN(0)) { p0_prologue(F, args.sub); if (BOTH(0)) GRID_BAR(); }

    REPS(1) if (IN(1)) {
        const bool late1 = ((blockIdx.x >> 3) & 1u) != 0u;
        if (bid < NB && !(args.sub & 32)) fox_cumsum_unit(F, bid);
        P1 p{WSP(bf16, WS_QA), WSP(bf16, WS_IA), WSP(bf16, WS_GA), WSP(bf16, WS_GB), WSP(bf16, WS_QBH), WSP(bf16, WS_KBH), WSP(bf16, WS_VBH), WSP(bf16, WS_GF), WSP(float, WS_QS), WSP(float, WS_LB), F.out};
        { pg8::Gemm g{WSP(bf16, WS_XN), WSP(bf16, WS_W1T), MP, 4096, DM}; pg8::StaticOrder S; S.init(MP, 4096, F.G, bid);
          Epi1 E{p, (args.sub >> 4) & 1 ? 1 : ((args.sub >> 7) & 1 ? 2 : 0)};
          if (!late1 && !(args.sub & 32)) for (int u = bid; u < 256; u += F.G)
              sgemm_unit(WSP(bf16, WS_XN), WSP(bf16, WS_W1T), u, F.wave, F.lane, SE1{p});
          pg8::gemm_phase<Epi1, pg8::StaticOrder, true, true>(F.lds + RING_OFF, g, S, E); }
        if (late1 && !(args.sub & 32)) for (int u = bid; u < 256; u += F.G)
            sgemm_unit(WSP(bf16, WS_XN), WSP(bf16, WS_W1T), u, F.wave, F.lane, SE1{p});
        if (BOTH(1)) GRID_BAR();
    }

    REPS(2) if (IN(2)) {
        const int half = F.G / 2;
        if (args.sub & 8) {
            dec::DecArgs da{WSP(float, WS_QS), F.ck, F.cv, F.pt, WSP(float, WS_SUFX), WSP(float, WS_PML), WSP(float, WS_PO)};
            float* dl = (float*)(lds + RING_OFF) + (F.wave >> 2) * dec::LDS_FLOATS;
            for (int wu = bid; wu < 256; wu += F.G) { const int du = 2 * wu + (F.wave >> 2); dec::decode_unit(da, du >> 4, (du >> 2) & 3, du & 3, dl, F.wave & 3, F.lane); }
        } else if (bid < half) {
            if ((SUB_MASK & 1) && (args.sub & 1)) for (int L = bid; L < 128; L += half) {
                const int bh = L & 7, x = L >> 3;
                const FoxRef b0 = fox_ref(F.ws, bh, 31 - x), b1 = fox_ref(F.ws, bh, x);
                fox::Seam<fox::TIN> S;
                fox::causal_swa_prime<fox::TIN, fox::TOUT>(b0, fox::WINDOW, (char*)lds + RING_OFF, S);
                FoxRef cur = b0; int pass = 0;
                for (;;) { const bool last = pass == 1; const FoxRef nxt = last ? cur : b1;
                    fox::causal_swa_block<fox::TIN, fox::TOUT>(cur, nxt, fox::SKV, fox::WINDOW, (char*)lds + RING_OFF, S);
                    if (last) break; cur = nxt; pass = 1; }
            }
        } else {
            const int cb = bid - half, nb = F.G - half;
            if ((SUB_MASK & 2) && (args.sub & 2)) { dec::DecArgs da{WSP(float, WS_QS), F.ck, F.cv, F.pt, WSP(float, WS_SUFX), WSP(float, WS_PML), WSP(float, WS_PO)};
              float* dl = (float*)(lds + RING_OFF) + (F.wave >> 2) * dec::LDS_FLOATS;
              for (int wu = cb; wu < 256; wu += nb) { const int du = 2 * wu + (F.wave >> 2); dec::decode_unit(da, du >> 4, du & 3, (du >> 2) & 3, dl, F.wave & 3, F.lane); } }
            __syncthreads();
            LaArgs a{}; a.Q = WSP(bf16, WS_QA); a.Kp = nullptr; a.G = WSP(bf16, WS_GF); a.V = WSP(bf16, WS_IA); a.GATE = WSP(bf16, WS_GA); a.ldv = 512; a.gain = F.hgrn_gain; a.MIXo = WSP(bf16, WS_MIX); a.mixoff = 0;
            if ((SUB_MASK & 4) && (args.sub & 4)) {
              for (int u = cb; u < 256; u += nb) { const int bh = u >> 5, sc = u & 31; a.SBUF = WSP(bf16, WS_SLOC) + (size_t)u * 16384; a.BTOT = WSP(float, WS_BTOT) + (size_t)u * 128;
                  la_unit<128, false, 0>(F.lds + RING_OFF, a, (bh >> 2) * SEQ + sc * 256, bh & 3, F.tid, F.wave, F.lane); }
            }
            if (args.sub == 7) {
              xcd_barrier(bar2);
              if (cb == 0 && F.tid == 0) __hip_atomic_store((unsigned*)(F.ctl + CW_FLAG), 1u, __ATOMIC_RELAXED, __HIP_MEMORY_SCOPE_AGENT);
              la_scan<128>(WSP(bf16, WS_SLOC), WSP(float, WS_BTOT), F.out + O_HSP, cb * 512 + F.tid, nb * 512);
              xcd_barrier(bar2);
              for (int u = cb; u < 256; u += nb) { const int bh = u >> 5, sc = u & 31; a.SBUF = WSP(bf16, WS_SLOC) + (size_t)u * 16384; a.BTOT = nullptr;
                  la_unit<128, false, 1>(F.lds + RING_OFF, a, (bh >> 2) * SEQ + sc * 256, bh & 3, F.tid, F.wave, F.lane); }
            }
        }
        if (args.sub == 7) {
            constexpr int T_S = 128, T_C = 64, T_W = 160, T_ALL = T_S + T_C + T_W;
            LaArgs a{}; a.Q = WSP(bf16, WS_QA); a.Kp = nullptr; a.G = WSP(bf16, WS_GF); a.V = WSP(bf16, WS_IA); a.GATE = WSP(bf16, WS_GA); a.ldv = 512; a.gain = F.hgrn_gain; a.MIXo = WSP(bf16, WS_MIX); a.mixoff = 0;
            dec::CombArgs ca{WSP(float, WS_PML), WSP(float, WS_PO), WSP(float, WS_QS), F.out + O_KS, F.out + O_VS, WSP(float, WS_LFB), WSP(bf16, WS_GB), WSP(bf16, WS_MIX)};
            bool flagged = bid >= half; unsigned nxt = 0u; int par = 0;
            __syncthreads();
            if (F.tid == 0) nxt = __hip_atomic_fetch_add((unsigned*)(F.ctl + CW_TAIL), 1u, __ATOMIC_RELAXED, __HIP_MEMORY_SCOPE_AGENT);
            for (;;) {
                if (F.tid == 0) F.MISC[16 + par] = nxt;
                __syncthreads();
                const int it = __builtin_amdgcn_readfirstlane((int)F.MISC[16 + par]); par ^= 1;
                if (it >= T_ALL) break;
                if (F.tid == 0) nxt = __hip_atomic_fetch_add((unsigned*)(F.ctl + CW_TAIL), 1u, __ATOMIC_RELAXED, __HIP_MEMORY_SCOPE_AGENT);
                if (it < T_S) { a.S0 = F.sh + (size_t)it * 16384; a.S1 = F.out + O_HSS + (size_t)it * 16384;
                    la_sample_unit<128, false>(F.lds + RING_OFF, a, it, F.tid, F.wave, F.lane); }
                else if (it < T_S + T_C) {
                    if (!flagged) { flagged = true;
                        if (F.tid == 0) { unsigned sp = 0; while (__hip_atomic_load((unsigned*)(F.ctl + CW_FLAG), __ATOMIC_RELAXED, __HIP_MEMORY_SCOPE_AGENT) == 0u) { __builtin_amdgcn_s_sleep(2); if (++sp > (1u << 22)) break; }
                            __builtin_amdgcn_fence(__ATOMIC_ACQUIRE, "agent"); asm volatile("s_waitcnt vmcnt(0)" ::: "memory"); }
                        __syncthreads(); }
                    const int r = (it - T_S) * NWAVES + F.wave; dec::combine_row(ca, r >> 4, (r >> 2) & 3, r & 3, F.lane); }
                else { __syncthreads(); late_weights(F, (it - T_S - T_C) * 16 + F.wave, (it - T_S - T_C) * 16 + 16); }
            }
        }
        if (BOTH(2)) GRID_BAR();
    }


    REPS(5) if (IN(5)) {
        P2 p{F.xp, F.xs, WSP(bf16, WS_XN), (float*)(F.ctl + CW_SS1)};
        { pg8::Gemm g{WSP(bf16, WS_MIX), WSP(bf16, WS_W2T), MP, 1024, DM}; pg8::StaticOrder S; S.init(MP, 1024, F.G, bid);
          Epi2 E{p};
          pg8::gemm_phase<Epi2, pg8::StaticOrder, true, true>(F.lds + RING_OFF, g, S, E); }
        for (int u = bid; u < 64; u += F.G)
            sgemm_unit(WSP(bf16, WS_MIX), WSP(bf16, WS_W2T), u, F.wave, F.lane, SE2{p});
        if (BOTH(5)) GRID_BAR();
    }

    REPS(6) if (IN(6)) {
        const bool late6 = ((blockIdx.x >> 3) & 1u) != 0u;
        if ((SUB_MASK & 1) && !(args.sub & 64) && !late6) p6_rpass(F, 0);
        P3 p{WSP(bf16, WS_Q3), WSP(bf16, WS_K3), WSP(bf16, WS_V3), WSP(bf16, WS_G3), (const float*)(F.ctl + CW_SS1)};
        if (SUB_MASK & 2) { pg8::Gemm g{WSP(bf16, WS_XN), WSP(bf16, WS_W3T), MP, 3072, DM}; pg8::StaticOrder S; S.init(MP, 3072, F.G, bid);
          Epi3 E{p, (args.sub >> 4) & 1};
          pg8::gemm_phase<Epi3, pg8::StaticOrder, true, true>(F.lds + RING_OFF, g, S, E); }
        if ((SUB_MASK & 4) && !(args.sub & 32)) for (int u = bid; u < 192; u += F.G)
            sgemm_unit(WSP(bf16, WS_XN), WSP(bf16, WS_W3T), u, F.wave, F.lane, SE3{p});
        if ((SUB_MASK & 1) && !(args.sub & 64)) { __syncthreads(); p6_rpass(F, late6 ? 2 : 1); }
        if (BOTH(6)) GRID_BAR();
    }

    REPS(7) if (IN(7)) {
        LaArgs a{}; a.Q = WSP(bf16, WS_Q3); a.Kp = WSP(bf16, WS_K3); a.G = WSP(bf16, WS_GF3); a.V = WSP(bf16, WS_V3); a.GATE = WSP(bf16, WS_G3); a.ldv = 1024; a.gain = F.gla_gain; a.MIXo = WSP(bf16, WS_MIX2); a.mixoff = 0;
        for (int u = bid; u < 256; u += F.G) { const int bh = u >> 5, sc = u & 31; a.SBUF = WSP(bf16, WS_SLOC3) + (size_t)u * 32768; a.BTOT = WSP(float, WS_BTOT) + 32768 + (size_t)u * 128;
            la_unit<256, true, 0>(F.lds + RING_OFF, a, (bh >> 2) * SEQ + sc * 256, bh & 3, F.tid, F.wave, F.lane); }
        for (int u = bid; u < 128; u += F.G) { a.S0 = F.sg + (size_t)u * 32768; a.S1 = F.out + O_GSS + (size_t)u * 32768;
            la_sample_unit<256, true>(F.lds + RING_OFF, a, u, F.tid, F.wave, F.lane); }
        if (BOTH(7)) GRID_BAR();
    }
    REPS(8) if (IN(8)) {
        la_scan<256>(WSP(bf16, WS_SLOC3), WSP(float, WS_BTOT) + 32768, F.out + O_GSP, bid * 512 + F.tid, F.G * 512);
        if (F.G == 256) { P4 p{WSP(bf16, WS_XN), F.out + O_Y, (float*)(F.ctl + CW_SS2)};
            for (int u = 255 - bid; u < 64; u += F.G) sgemm_unit(WSP(bf16, WS_MIX2), WSP(bf16, WS_W4T), u, F.wave, F.lane, SE4{p}); }
        if (BOTH(8)) GRID_BAR();
    }
    REPS(9) if (IN(9)) {
        LaArgs a{}; a.Q = WSP(bf16, WS_Q3); a.Kp = WSP(bf16, WS_K3); a.G = WSP(bf16, WS_GF3); a.V = WSP(bf16, WS_V3); a.GATE = WSP(bf16, WS_G3); a.ldv = 1024; a.gain = F.gla_gain; a.MIXo = WSP(bf16, WS_MIX2); a.mixoff = 0;
        for (int u = bid; u < 256; u += F.G) { const int bh = u >> 5, sc = u & 31; a.SBUF = WSP(bf16, WS_SLOC3) + (size_t)u * 32768; a.BTOT = nullptr;
            la_unit<256, true, 1>(F.lds + RING_OFF, a, (bh >> 2) * SEQ + sc * 256, bh & 3, F.tid, F.wave, F.lane); }
        if (BOTH(9)) GRID_BAR();
    }
    REPS(10) if (IN(10)) {
        P4 p{WSP(bf16, WS_XN), F.out + O_Y, (float*)(F.ctl + CW_SS2)};
        pg8::Gemm g{WSP(bf16, WS_MIX2), WSP(bf16, WS_W4T), MP, 1024, DM}; pg8::StaticOrder S; S.init(MP, 1024, F.G, bid);
        if (F.G == 256) {
            Epi4F E{p, F.final_norm, &bar};
            pg8::gemm_phase<Epi4F, pg8::StaticOrder, false, true>(F.lds + RING_OFF, g, S, E);
            const int gw = bid * NWAVES + F.wave;
            if (gw < MS) { const int m = MP + gw; GAS f32x4* yr = (GAS f32x4*)(F.out + O_Y + (size_t)m * DM) + F.lane;
                const float rstd = 1.0f / sqrtf(__hip_atomic_load(p.SS + m, __ATOMIC_RELAXED, __HIP_MEMORY_SCOPE_AGENT) * (1.f / DM) + EPS);
#pragma unroll
                for (int j = 0; j < 4; ++j) { const f32x4 gg = *(const GAS f32x4*)(F.final_norm + 4 * F.lane + 256 * j); yr[64 * j] = yr[64 * j] * rstd * gg; } }
        } else {
            Epi4 E{p};
            pg8::gemm_phase<Epi4, pg8::StaticOrder, true, true>(F.lds + RING_OFF, g, S, E);
            for (int u = bid; u < 64; u += F.G) sgemm_unit(WSP(bf16, WS_MIX2), WSP(bf16, WS_W4T), u, F.wave, F.lane, SE4{p});
            if (BOTH(10)) GRID_BAR();
        }
    }
    if (IN(11) && F.G != 256) p11_final(F);
#undef IN
#undef BOTH
}

extern "C" void kernel_launch(void* const* d_in, const int* in_sizes, int n_in, void* d_out, int out_size, void* d_ws, size_t ws_size, hipStream_t stream) {
    static int grid = 0;
    if (grid == 0) {
        if (n_in != 21 || out_size != (int)O_END || ws_size < WS_END) { fprintf(stderr, "kernel_launch: unexpected problem (n_in %d out %d ws %zu)\n", n_in, out_size, ws_size); grid = -1; return; }
        int dev = 0, cus = 0, per_cu = 0;
        if (hipGetDevice(&dev) != hipSuccess || hipDeviceGetAttribute(&cus, hipDeviceAttributeMultiprocessorCount, dev) != hipSuccess) { grid = -1; return; }
        if (hipFuncSetAttribute((const void*)hybrid_fwd, hipFuncAttributeMaxDynamicSharedMemorySize, LDS_BYTES) != hipSuccess) { fprintf(stderr, "kernel_launch: hipFuncSetAttribute failed\n"); grid = -1; return; }
        if (hipOccupancyMaxActiveBlocksPerMultiprocessor(&per_cu, (const void*)hybrid_fwd, NWAVES * 64, LDS_BYTES) != hipSuccess || per_cu < 1)
            fprintf(stderr, "kernel_launch: occupancy query reports %d workgroups per CU\n", per_cu);
        (void)hipGetLastError();
        grid = cus;
    }
    if (grid < 0) return;
    if (hipMemsetAsync((char*)d_ws + WS_CTL, 0, CTL_ZERO_BYTES, stream) != hipSuccess) { fprintf(stderr, "kernel_launch: memset failed\n"); return; }
    Args a{};
    for (int i = 0; i < 21; ++i) a.in[i] = d_in[i];
    a.out = (float*)d_out; a.ws = (unsigned char*)d_ws; a.sub = 7;
    for (int li = 0; li < N_LAUNCHES; ++li) {
        a.ph_lo = (N_LAUNCHES == 1) ? 0 : li; a.ph_hi = (N_LAUNCHES == 1) ? N_PHASES : li + 1;
        hipLaunchKernelGGL(hybrid_fwd, dim3(grid), dim3(NWAVES * 64), LDS_BYTES, stream, a);
        const hipError_t le = hipPeekAtLastError();
        if (le != hipSuccess) { fprintf(stderr, "kernel_launch: launch %d failed: %s\n", li, hipGetErrorName(le)); break; }
    }
#if defined(PROBE_LO)
    for (int r = 0; r < PROBE_REPS; ++r)
        for (int ph = PROBE_LO; ph < PROBE_HI; ++ph) { (void)hipMemsetAsync((char*)d_ws + WS_CTL + (size_t)CW_BAR * 4, 0, (size_t)(CW_SS1 - CW_BAR) * 4, stream); a.sub = PROBE_SUB; a.ph_lo = ph; a.ph_hi = ph + 1; hipLaunchKernelGGL(hybrid_fwd, dim3(grid), dim3(NWAVES * 64), LDS_BYTES, stream, a); }
#endif
}
```
